# Optimizing an MI355X kernel written in HIP

```python
import math
import jax, jax.numpy as jnp
from jax import lax
import numpy as np

D_MODEL = 1024
BATCH = 8
SEQ = 4096
DEPTH = 2

CHUNK = 64
BRANCH_WIDTH = 512
N_BRANCH = 4
CONV_WIDTH = 3
SG_CHUNK = 128
SG_GROUPS = 4
SG_GROUP_DIM = BRANCH_WIDTH // SG_GROUPS
ATT_HEADS = 4
ATT_QK_DIM = 64
ATT_V_DIM = 2 * ATT_QK_DIM
Q_BLOCK = 128
SSM_GROUP = 16
SSM_GROUPS = BRANCH_WIDTH // SSM_GROUP
SSM_STATE = 64
FFN_HIDDEN = -(-8 * D_MODEL // (3 * 256)) * 256

QK_COLS = ATT_HEADS * 2 * ATT_QK_DIM
V_COLS = ATT_HEADS * ATT_V_DIM
SPLIT_SIZES = [BRANCH_WIDTH, BRANCH_WIDTH, BRANCH_WIDTH,
               2 * BRANCH_WIDTH,
               QK_COLS, QK_COLS, V_COLS,
               BRANCH_WIDTH,
               N_BRANCH * D_MODEL]
IN_COLS = sum(SPLIT_SIZES)
SPLIT_POINTS = [int(p) for p in np.cumsum(SPLIT_SIZES)[:-1]]

kernel_name = 'hybrid_gated_parallel_streaming_encoder'


def rmsnorm(x, g, eps=1e-6):
    xf = x.astype(jnp.float32)
    y = xf * lax.rsqrt(jnp.mean(xf * xf, axis=-1, keepdims=True) + eps)
    return (y * g.astype(jnp.float32)).astype(x.dtype)


def layernorm(x, g, b, eps=1e-5):
    xf = x.astype(jnp.float32)
    mu = jnp.mean(xf, axis=-1, keepdims=True)
    var = jnp.mean(jnp.square(xf - mu), axis=-1, keepdims=True)
    y = (xf - mu) * lax.rsqrt(var + eps)
    return (y * g.astype(jnp.float32) + b.astype(jnp.float32)).astype(x.dtype)


def short_conv_mixer(b_gate, c_gate, xin, conv_w, conv_b):
    z = c_gate * xin
    z = lax.conv_general_dilated(
        z, conv_w[:, None, :], window_strides=(1,), padding=[(CONV_WIDTH - 1, 0)],
        dimension_numbers=('NWC', 'WIO', 'NWC'), feature_group_count=BRANCH_WIDTH)
    return b_gate * (z + conv_b)


def spatial_gating_mixer(z, sg_w, sg_b, ln_g, ln_b):
    z = jax.nn.gelu(z)
    u, v = jnp.split(z, 2, axis=-1)
    v = layernorm(v, ln_g, ln_b)
    bsz, s, _ = v.shape
    v = v.reshape(bsz, s // SG_CHUNK, SG_CHUNK, SG_GROUPS, SG_GROUP_DIM)
    tri = jnp.tril(jnp.ones((SG_CHUNK, SG_CHUNK), dtype=bool))
    w = jnp.where(tri, sg_w, jnp.zeros_like(sg_w))
    mixed = jnp.einsum('gts,bcsgd->bctgd', w, v) + sg_b.T[:, :, None]
    return u * mixed.reshape(bsz, s, BRANCH_WIDTH)


def diff_attention_mixer(q, k, v, lam_qk, subln_g, lam_init):
    bsz, s, _ = q.shape
    q = q.reshape(bsz, s, ATT_HEADS, 2, ATT_QK_DIM)
    k = k.reshape(bsz, s, ATT_HEADS, 2, ATT_QK_DIM)
    v = v.reshape(bsz, s, ATT_HEADS, ATT_V_DIM)
    lf = lam_qk.astype(jnp.float32)
    lam = jnp.exp(jnp.sum(lf[0] * lf[1])) - jnp.exp(jnp.sum(lf[2] * lf[3])) + lam_init
    scale = ATT_QK_DIM ** -0.5
    n_blocks = s // Q_BLOCK
    q_blocks = q.reshape(bsz, n_blocks, Q_BLOCK, ATT_HEADS, 2, ATT_QK_DIM).transpose(1, 0, 2, 3, 4, 5)
    key_chunk = jnp.arange(s) // CHUNK

    def attend(args):
        qb, blk = args
        q_chunk = (blk * Q_BLOCK + jnp.arange(Q_BLOCK)) // CHUNK
        allowed = key_chunk[None, :] <= q_chunk[:, None]
        sc = jnp.einsum('bqhmd,bkhmd->bhmqk', qb, k).astype(jnp.float32) * scale
        sc = jnp.where(allowed, sc, -jnp.inf)
        p = jax.nn.softmax(sc, axis=-1)
        attn = p[:, :, 0] - lam * p[:, :, 1]
        return jnp.einsum('bhqk,bkhd->bqhd', attn.astype(v.dtype), v)

    o = lax.map(attend, (q_blocks, jnp.arange(n_blocks)))
    o = o.transpose(1, 0, 2, 3, 4).reshape(bsz, s, ATT_HEADS, ATT_V_DIM)
    o = rmsnorm(o, subln_g, eps=1e-5) * (1.0 - lam_init)
    return o.reshape(bsz, s, BRANCH_WIDTH)


def _linear_recurrence_combine(earlier, later):
    ar1, ai1, br1, bi1 = earlier
    ar2, ai2, br2, bi2 = later
    return (ar2 * ar1 - ai2 * ai1,
            ar2 * ai1 + ai2 * ar1,
            ar2 * br1 - ai2 * bi1 + br2,
            ar2 * bi1 + ai2 * br1 + bi2)


def s5_mixer(u, a_re, a_im, log_dt, b_re, b_im, c_re, c_im, d_skip, w_glu, b_glu):
    dtype = u.dtype
    f32 = jnp.float32
    bsz, s, _ = u.shape
    uf = u.astype(f32).reshape(bsz, s, SSM_GROUPS, SSM_GROUP)
    a_re, a_im = a_re.astype(f32), a_im.astype(f32)
    b_re, b_im = b_re.astype(f32), b_im.astype(f32)
    c_re, c_im = c_re.astype(f32), c_im.astype(f32)
    dt = jnp.exp(log_dt.astype(f32))[:, None]
    mag = jnp.exp(dt * a_re)
    ab_re = mag * jnp.cos(dt * a_im)
    ab_im = mag * jnp.sin(dt * a_im)
    den = a_re * a_re + a_im * a_im
    nr, ni = ab_re - 1.0, ab_im
    coef_re = (nr * a_re + ni * a_im) / den
    coef_im = (ni * a_re - nr * a_im) / den
    bb_re = coef_re[..., None] * b_re - coef_im[..., None] * b_im
    bb_im = coef_re[..., None] * b_im + coef_im[..., None] * b_re
    bu_re = jnp.einsum('bsgh,gph->bsgp', uf, bb_re)
    bu_im = jnp.einsum('bsgh,gph->bsgp', uf, bb_im)
    a_seq_re = jnp.broadcast_to(ab_re, bu_re.shape)
    a_seq_im = jnp.broadcast_to(ab_im, bu_re.shape)
    _, _, x_re, x_im = lax.associative_scan(
        _linear_recurrence_combine, (a_seq_re, a_seq_im, bu_re, bu_im), axis=1)
    y = jnp.einsum('bsgp,ghp->bsgh', x_re, c_re) - jnp.einsum('bsgp,ghp->bsgh', x_im, c_im)
    y = y.reshape(bsz, s, BRANCH_WIDTH) + d_skip.astype(f32) * uf.reshape(bsz, s, BRANCH_WIDTH)
    y = jax.nn.gelu(y)
    y = y * jax.nn.sigmoid(y @ w_glu.astype(f32) + b_glu.astype(f32))
    return y.astype(dtype)


def setup_inputs(seed: int = 0) -> dict:
    key = jax.random.key(seed)
    ks = jax.random.split(key, 32)
    f32 = jnp.float32
    L, D, W = DEPTH, D_MODEL, BRANCH_WIDTH
    G, P, H = SSM_GROUPS, SSM_STATE, SSM_GROUP

    def nrm(k, shape, scale):
        return jax.random.normal(k, shape, f32) * scale

    n_idx = jnp.arange(P, dtype=f32)
    return {
        'x': nrm(ks[0], (BATCH, SEQ, D), 1.0),
        'g_mix': 1.0 + nrm(ks[1], (L, D), 0.02),
        'w_in': nrm(ks[2], (L, D, IN_COLS), D ** -0.5),
        'conv_w': nrm(ks[3], (L, CONV_WIDTH, W), CONV_WIDTH ** -0.5),
        'conv_b': nrm(ks[4], (L, W), 0.02),
        'sg_w': nrm(ks[5], (L, SG_GROUPS, SG_CHUNK, SG_CHUNK), SG_CHUNK ** -0.5),
        'sg_b': 1.0 + nrm(ks[6], (L, SG_GROUPS, SG_CHUNK), 0.02),
        'sg_ln_g': 1.0 + nrm(ks[7], (L, W), 0.02),
        'sg_ln_b': nrm(ks[8], (L, W), 0.02),
        'lam_qk': nrm(ks[9], (L, 4, ATT_QK_DIM), 0.1),
        'subln_g': 1.0 + nrm(ks[10], (L, ATT_V_DIM), 0.02),
        'ssm_a_re': -0.5 + nrm(ks[11], (L, G, P), 0.01),
        'ssm_a_im': jnp.pi * n_idx + nrm(ks[12], (L, G, P), 0.01),
        'ssm_log_dt': jax.random.uniform(ks[13], (L, G), f32, math.log(1e-3), math.log(1e-1)),
        'ssm_b_re': nrm(ks[14], (L, G, P, H), (2 * H) ** -0.5),
        'ssm_b_im': nrm(ks[15], (L, G, P, H), (2 * H) ** -0.5),
        'ssm_c_re': nrm(ks[16], (L, G, H, P), P ** -0.5),
        'ssm_c_im': nrm(ks[17], (L, G, H, P), P ** -0.5),
        'ssm_d': nrm(ks[18], (L, W), 0.5),
        'w_glu': nrm(ks[19], (L, W, W), W ** -0.5),
        'b_glu': nrm(ks[20], (L, W), 0.02),
        'w_br': nrm(ks[21], (L, N_BRANCH, W, D), W ** -0.5),
        'w_o': nrm(ks[22], (L, D, D), D ** -0.5),
        'g_ffn': 1.0 + nrm(ks[23], (L, D), 0.02),
        'w_ffn_gate': nrm(ks[24], (L, D, FFN_HIDDEN), D ** -0.5),
        'w_ffn_up': nrm(ks[25], (L, D, FFN_HIDDEN), D ** -0.5),
        'w_ffn_down': nrm(ks[26], (L, FFN_HIDDEN, D), FFN_HIDDEN ** -0.5),
        'g_final': 1.0 + nrm(ks[27], (D,), 0.02),
    }


def reference(x, g_mix, w_in, conv_w, conv_b, sg_w, sg_b, sg_ln_g, sg_ln_b, lam_qk, subln_g,
              ssm_a_re, ssm_a_im, ssm_log_dt, ssm_b_re, ssm_b_im, ssm_c_re, ssm_c_im, ssm_d,
              w_glu, b_glu, w_br, w_o, g_ffn, w_ffn_gate, w_ffn_up, w_ffn_down, g_final):
    bsz, s, _ = x.shape
    for l in range(DEPTH):
        lam_init = 0.8 - 0.6 * math.exp(-0.3 * l)
        h = rmsnorm(x, g_mix[l])
        proj = h @ w_in[l]
        a_b, a_c, a_x, b_uv, c_q, c_k, c_v, d_u, gate_logits = jnp.split(proj, SPLIT_POINTS, axis=-1)

        y_a = short_conv_mixer(a_b, a_c, a_x, conv_w[l], conv_b[l])
        y_b = spatial_gating_mixer(b_uv, sg_w[l], sg_b[l], sg_ln_g[l], sg_ln_b[l])
        y_c = diff_attention_mixer(c_q, c_k, c_v, lam_qk[l], subln_g[l], lam_init)
        y_d = s5_mixer(d_u, ssm_a_re[l], ssm_a_im[l], ssm_log_dt[l], ssm_b_re[l], ssm_b_im[l],
                       ssm_c_re[l], ssm_c_im[l], ssm_d[l], w_glu[l], b_glu[l])

        gates = jax.nn.sigmoid(gate_logits).reshape(bsz, s, N_BRANCH, D_MODEL)
        branches = (y_a, y_b, y_c, y_d)
        merged = gates[:, :, 0] * (branches[0] @ w_br[l, 0])
        for n in range(1, N_BRANCH):
            merged = merged + gates[:, :, n] * (branches[n] @ w_br[l, n])
        x = x + merged @ w_o[l]

        h = rmsnorm(x, g_ffn[l])
        x = x + (jax.nn.silu(h @ w_ffn_gate[l]) * (h @ w_ffn_up[l])) @ w_ffn_down[l]
    return rmsnorm(x, g_final)
```

```cpp
#include <hip/hip_runtime.h>
#include <hip/hip_cooperative_groups.h>
#include <cstdio>
#include <cstdint>
#ifndef ONE_LAUNCH
#define ONE_LAUNCH 1
#endif
namespace cg = cooperative_groups;
typedef __bf16 mk_bf16x2_t __attribute__((ext_vector_type(2)));
typedef float mk_f32x2_t __attribute__((ext_vector_type(2)));
__device__ __forceinline__ unsigned mk_pk2(float lo, float hi) { mk_f32x2_t v = {lo, hi}; mk_bf16x2_t b = __builtin_convertvector(v, mk_bf16x2_t); return __builtin_bit_cast(unsigned, b); }
__device__ __forceinline__ float mk_lo(unsigned w) { return __uint_as_float(w << 16); }
__device__ __forceinline__ float mk_hi(unsigned w) { return __uint_as_float(w & 0xffff0000u); }
__device__ __forceinline__ float mk_sigm(float x) { return __builtin_amdgcn_rcpf(1.0f + __expf(-x)); }
__device__ __forceinline__ float mk_gelu(float x) { const float u = 1.5957691216f * (x + 0.044715f * x * x * x); return x * __builtin_amdgcn_rcpf(1.0f + __expf(-u)); }
namespace pg8 {
#define PG8_LAS __attribute__((address_space(3)))
typedef unsigned short bf16_t;
typedef short bf16x8 __attribute__((ext_vector_type(8)));
typedef float f32x4 __attribute__((ext_vector_type(4)));
typedef unsigned u32x4 __attribute__((ext_vector_type(4)));
constexpr int BM = 256, BK = 64, HALF = 128, HTB = HALF * BK * 2  , STAGE_BYTES = 8 * HTB, NXCD = 8, WGM = 8;

__host__ __device__ __forceinline__ int lds_byte(int r, int c) { const int st = (r >> 4) * 2 + (c >> 5), rr = r & 15, cc = c & 31, ob = rr * 64 + cc * 2; return st * 1024 + (ob ^ (((ob >> 9) & 1) << 5)); }
__host__ __device__ __forceinline__ void stage_rc(int b, int& R, int& C) { const int st = b / 1024, sb = b % 1024, swz = sb ^ (((sb >> 9) & 1) << 5); R = (st >> 1) * 16 + swz / 64; C = (st & 1) * 32 + (swz % 64) / 2; }
__host__ __device__ __forceinline__ int perm32(int rho) { const int n = rho >> 4, i = rho & 15; return 8 * (i >> 2) + 4 * n + (i & 3); }

struct Unit { int pm, pn; };
struct Gemm { const bf16_t* A; const bf16_t* Bt; int M, N, K; };

struct StaticOrder {
    int nM, nN, nwg, G, c;
    __host__ __device__ void init(int M, int N, int G_, int c_) { nM = M / BM; nN = N / BM; nwg = nM * nN; G = G_; c = c_; }
    __host__ __device__ bool next(int i, Unit& u) const {
        const long L = (long)i * G + c; if (L >= nwg) return false;
        int wgid = (int)L; { const int q = nwg / NXCD, r = nwg % NXCD, xcd = wgid % NXCD, off = wgid / NXCD; wgid = (xcd < r ? xcd * (q + 1) : r * (q + 1) + (xcd - r) * q) + off; }
        const int nig = WGM * nN, gid = wgid / nig, fm = gid * WGM, gsz = (nM - fm) < WGM ? (nM - fm) : WGM;
        u.pm = fm + ((wgid % nig) % gsz); u.pn = (wgid % nig) / gsz; return true;
    }
    __device__ __forceinline__ void a_ready(const Unit&) const {}
    __device__ __forceinline__ void done(const Unit&) const {}
};
typedef unsigned u32x2 __attribute__((ext_vector_type(2)));
constexpr int MK_TOK = 32768;
#define MK_EPI_LOOP_AM _Pragma("unroll") for (int ai = 0; ai < 2; ++ai) _Pragma("unroll") for (int m = 0; m < 4; ++m)
__device__ __forceinline__ u32x4 pack8(const f32x4 a, const f32x4 b) { u32x4 w; w.x = mk_pk2(a[0], a[1]); w.y = mk_pk2(a[2], a[3]); w.z = mk_pk2(b[0], b[1]); w.w = mk_pk2(b[2], b[3]); return w; }
__device__ __forceinline__ void unpack8(const u32x4 w, f32x4& a, f32x4& b) { a = (f32x4){mk_lo(w.x), mk_hi(w.x), mk_lo(w.y), mk_hi(w.y)}; b = (f32x4){mk_lo(w.z), mk_hi(w.z), mk_lo(w.w), mk_hi(w.w)}; }
__device__ __forceinline__ float rstd_of(float ss) { return rsqrtf(ss * (1.0f / 1024.0f) + 1e-6f); }

struct EpiProj { static constexpr bool PERM = true, AFTER_DRAIN = false; bf16_t* P; const float* rowss;
    __device__ __forceinline__ void operator()(const f32x4 (&acc)[2][2][4][2], const Unit& u, int wr, int wc, int fr, int fq) const {
        const int row0 = u.pm * BM + wr * 64 + fr;
        bf16_t* base = P + (size_t)(u.pn >> 1) * ((size_t)MK_TOK * 512) + (u.pn & 1) * 256 + wc * 32 + 8 * fq;
        MK_EPI_LOOP_AM { const int row = row0 + ai * HALF + m * 16; const float rs = rstd_of(rowss[row]); bf16_t* rp = base + (size_t)row * 512;
#pragma unroll
            for (int bj = 0; bj < 2; ++bj) *(u32x4*)(rp + bj * HALF) = pack8(acc[ai][bj][m][0] * rs, acc[ai][bj][m][1] * rs); }
    }
};
struct EpiVT { static constexpr bool PERM = true, AFTER_DRAIN = false; bf16_t* VT; const float* rowss;
    __device__ __forceinline__ void operator()(const f32x4 (&acc)[2][2][4][2], const Unit& u, int wr, int wc, int fr, int fq) const {
        const int row0 = u.pm * BM + wr * 64 + fr, col0 = u.pn * BM + wc * 32 + 8 * fq;
        f32x4 rs[2][2];
#pragma unroll
        for (int bj = 0; bj < 2; ++bj)
#pragma unroll
            for (int n = 0; n < 2; ++n) { const f32x4 s = *(const f32x4*)(rowss + col0 + bj * HALF + 4 * n); rs[bj][n] = (f32x4){rstd_of(s[0]), rstd_of(s[1]), rstd_of(s[2]), rstd_of(s[3])}; }
        MK_EPI_LOOP_AM { const int row = row0 + ai * HALF + m * 16; bf16_t* rp = VT + (size_t)row * MK_TOK + col0;
#pragma unroll
            for (int bj = 0; bj < 2; ++bj) *(u32x4*)(rp + bj * HALF) = pack8(acc[ai][bj][m][0] * rs[bj][0], acc[ai][bj][m][1] * rs[bj][1]); }
    }
};
struct EpiGlu { static constexpr bool PERM = true, AFTER_DRAIN = false; const bf16_t* YG; bf16_t* O; const float* bias;
    __device__ __forceinline__ void operator()(const f32x4 (&acc)[2][2][4][2], const Unit& u, int wr, int wc, int fr, int fq) const {
        const int row0 = u.pm * BM + wr * 64 + fr, col0 = u.pn * BM + wc * 32 + 8 * fq;
        f32x4 bv[2][2];
#pragma unroll
        for (int bj = 0; bj < 2; ++bj)
#pragma unroll
            for (int n = 0; n < 2; ++n) bv[bj][n] = *(const f32x4*)(bias + col0 + bj * HALF + 4 * n);
        MK_EPI_LOOP_AM { const int row = row0 + ai * HALF + m * 16; const size_t off = (size_t)row * 512 + col0;
#pragma unroll
            for (int bj = 0; bj < 2; ++bj) { f32x4 y0, y1; unpack8(*(const u32x4*)(YG + off + bj * HALF), y0, y1);
                f32x4 a0 = acc[ai][bj][m][0] + bv[bj][0], a1 = acc[ai][bj][m][1] + bv[bj][1];
#pragma unroll
                for (int j = 0; j < 4; ++j) { y0[j] *= mk_sigm(a0[j]); y1[j] *= mk_sigm(a1[j]); }
                *(u32x4*)(O + off + bj * HALF) = pack8(y0, y1); } }
    }
};
struct EpiGate { static constexpr bool PERM = true, AFTER_DRAIN = false; bf16_t* GS; const float* rowss;
    __device__ __forceinline__ void operator()(const f32x4 (&acc)[2][2][4][2], const Unit& u, int wr, int wc, int fr, int fq) const {
        const int row0 = u.pm * BM + wr * 64 + fr, col0 = u.pn * BM + wc * 32 + 8 * fq;
        MK_EPI_LOOP_AM { const int row = row0 + ai * HALF + m * 16; const float rs = rstd_of(rowss[row]); const size_t off = (size_t)row * 1024 + col0;
#pragma unroll
            for (int bj = 0; bj < 2; ++bj) { f32x4 a0 = acc[ai][bj][m][0] * rs, a1 = acc[ai][bj][m][1] * rs;
#pragma unroll
                for (int j = 0; j < 4; ++j) { a0[j] = mk_sigm(a0[j]); a1[j] = mk_sigm(a1[j]); }
                *(u32x4*)(GS + off + bj * HALF) = pack8(a0, a1); } }
    }
};
template <bool FIRST> struct EpiBr { static constexpr bool PERM = true, AFTER_DRAIN = false; const bf16_t* GS; bf16_t* MG;
    __device__ __forceinline__ void operator()(const f32x4 (&acc)[2][2][4][2], const Unit& u, int wr, int wc, int fr, int fq) const {
        const int row0 = u.pm * BM + wr * 64 + fr, col0 = u.pn * BM + wc * 32 + 8 * fq;
        MK_EPI_LOOP_AM { const int row = row0 + ai * HALF + m * 16; const size_t off = (size_t)row * 1024 + col0;
#pragma unroll
            for (int bj = 0; bj < 2; ++bj) { f32x4 g0, g1; unpack8(*(const u32x4*)(GS + off + bj * HALF), g0, g1);
                f32x4 v0 = g0 * acc[ai][bj][m][0], v1 = g1 * acc[ai][bj][m][1];
                if (!FIRST) { f32x4 p0, p1; unpack8(*(const u32x4*)(MG + off + bj * HALF), p0, p1); v0 += p0; v1 += p1; }
                *(u32x4*)(MG + off + bj * HALF) = pack8(v0, v1); } }
    }
};
struct EpiResid { static constexpr bool PERM = false, AFTER_DRAIN = false; const float* xold; float* out; bf16_t* xb; float* rowss_next;
    __device__ __forceinline__ void operator()(const f32x4 (&acc)[2][2][4][2], const Unit& u, int wr, int wc, int fr, int fq) const {
        const int row0 = u.pm * BM + wr * 64 + fr, col0 = u.pn * BM + wc * 32 + 4 * fq;
        MK_EPI_LOOP_AM { const int row = row0 + ai * HALF + m * 16; const size_t off = (size_t)row * 1024 + col0; float ss = 0.f;
#pragma unroll
            for (int bj = 0; bj < 2; ++bj)
#pragma unroll
                for (int n = 0; n < 2; ++n) { const size_t o = off + bj * HALF + n * 16; const f32x4 xn = *(const f32x4*)(xold + o) + acc[ai][bj][m][n];
                    *(f32x4*)(out + o) = xn; u32x2 w; w.x = mk_pk2(xn[0], xn[1]); w.y = mk_pk2(xn[2], xn[3]); *(u32x2*)(xb + o) = w;
                    ss += (xn[0] * xn[0] + xn[1] * xn[1]) + (xn[2] * xn[2] + xn[3] * xn[3]); }
            ss += __shfl_xor(ss, 16); ss += __shfl_xor(ss, 32);
            if (fq == 0) __hip_atomic_fetch_add(rowss_next + row, ss, __ATOMIC_RELAXED, __HIP_MEMORY_SCOPE_AGENT); }
    }
};
struct EpiFfnUp { static constexpr bool PERM = true, AFTER_DRAIN = false; bf16_t* H; const float* rowss;
    __device__ __forceinline__ void operator()(const f32x4 (&acc)[2][2][4][2], const Unit& u, int wr, int wc, int fr, int fq) const {
        const int row0 = u.pm * BM + wr * 64 + fr, col0 = u.pn * HALF + wc * 32 + 8 * fq;
        MK_EPI_LOOP_AM { const int row = row0 + ai * HALF + m * 16; const float rs = rstd_of(rowss[row]);
            f32x4 g0 = acc[ai][0][m][0] * rs, g1 = acc[ai][0][m][1] * rs, u0 = acc[ai][1][m][0] * rs, u1 = acc[ai][1][m][1] * rs;
#pragma unroll
            for (int j = 0; j < 4; ++j) { g0[j] = g0[j] * mk_sigm(g0[j]) * u0[j]; g1[j] = g1[j] * mk_sigm(g1[j]) * u1[j]; }
            *(u32x4*)(H + (size_t)row * 2816 + col0) = pack8(g0, g1); }
    }
};
template <class Epi, class Sched, bool STAMP = false>
__device__ __forceinline__ void gemm_phase(PG8_LAS unsigned char* lds, const Gemm g, const Sched& S, const Epi& E, unsigned long long* stamps) {
    int tid_l = threadIdx.x; asm volatile("" : "+v"(tid_l)); const int tid = tid_l, wid = __builtin_amdgcn_readfirstlane(tid >> 6), lane = tid & 63, wr = wid >> 2, wc = wid & 3, fr = lane & 15, fq = lane >> 4;
    const int K = g.K, nt = K / BK;
    int ts_lo = 0, ts_hi = 0, nts = 0; const unsigned long long rt_entry = STAMP ? (unsigned long long)wall_clock64() : 0ull;
#define PG8_STAMP() do { if (STAMP && wid == 0 && nts < 64) { const unsigned long long _c = (unsigned long long)clock64(); \
        ts_lo = (lane == nts) ? (int)(unsigned)_c : ts_lo; ts_hi = (lane == nts) ? (int)(unsigned)(_c >> 32) : ts_hi; ++nts; } } while (0)
    PG8_STAMP();
    unsigned voffA[2], voffB[2];
#pragma unroll
    for (int i = 0; i < 2; ++i) { int R, C; stage_rc(tid * 16 + i * 8192, R, C); const int Rb = Epi::PERM ? ((R & ~31) + perm32(R & 31)) : R;
        voffA[i] = (unsigned)(R * K + C) * 2u; voffB[i] = (unsigned)(Rb * K + C) * 2u; }
    const size_t kstep = (size_t)(BK * 2);
    const size_t hstep = (size_t)HALF * K * 2;
    const size_t tstep = 2 * hstep;
    const unsigned ldsw = (unsigned)wid * 1024u;
    const int aoff = lds_byte(wr * 64 + fr, fq * 8), boff = lds_byte(wc * 32 + fr, fq * 8);
#define PG8_SA(b, h) (((b) * 2 + (h)) * HTB)
#define PG8_SB(b, h) ((4 + (b) * 2 + (h)) * HTB)
#define PG8_STAGE(bufoff, gbase, voff) do { _Pragma("unroll") for (int _i = 0; _i < 2; ++_i) \
        __builtin_amdgcn_global_load_lds((const unsigned*)((const char*)(gbase) + (voff)[_i]), (PG8_LAS unsigned*)(lds + (bufoff) + ldsw + _i * 8192), 16, 0, 0); } while (0)
#define PG8_LDA(dst, b, h) do { _Pragma("unroll") for (int m = 0; m < 4; ++m) _Pragma("unroll") for (int k = 0; k < 2; ++k) dst[m][k] = *(const PG8_LAS bf16x8*)(lds + PG8_SA(b, h) + aoff + m * 2048 + k * 1024); } while (0)
#define PG8_LDB(dst, b, h) do { _Pragma("unroll") for (int n = 0; n < 2; ++n) _Pragma("unroll") for (int k = 0; k < 2; ++k) dst[n][k] = *(const PG8_LAS bf16x8*)(lds + PG8_SB(b, h) + boff + n * 2048 + k * 1024); } while (0)
#define PG8_MMA(ai, bj, At, Bt) do { __builtin_amdgcn_s_setprio(1); _Pragma("unroll") for (int m = 0; m < 4; ++m) _Pragma("unroll") for (int n = 0; n < 2; ++n) _Pragma("unroll") for (int k = 0; k < 2; ++k) \
        acc[ai][bj][m][n] = __builtin_amdgcn_mfma_f32_16x16x32_bf16(Bt[n][k], At[m][k], acc[ai][bj][m][n], 0, 0, 0); __builtin_amdgcn_s_setprio(0); } while (0)
#define PG8_WAIT_V(n) asm volatile("s_waitcnt vmcnt(" #n ")" ::: "memory")
#define PG8_WAIT_L(n) asm volatile("s_waitcnt lgkmcnt(" #n ")" ::: "memory")
#define PG8_BAR __builtin_amdgcn_s_barrier()
#define PG8_SCHED __builtin_amdgcn_sched_barrier(0)
    Unit cur, nxt; int ui = 0;
    if (!S.next(0, cur)) return;
    f32x4 acc[2][2][4][2];
#pragma unroll
    for (int a = 0; a < 2; ++a)
#pragma unroll
        for (int b = 0; b < 2; ++b)
#pragma unroll
            for (int m = 0; m < 4; ++m)
#pragma unroll
                for (int n = 0; n < 2; ++n) acc[a][b][m][n] = (f32x4){0.f, 0.f, 0.f, 0.f};
    bf16x8 At[4][2], B0[2][2], B1[2][2];
    const char* cA = (const char*)g.A + (size_t)cur.pm * tstep; const char* cB = (const char*)g.Bt + (size_t)cur.pn * tstep;
    S.a_ready(cur);
    PG8_STAGE(PG8_SB(0, 0), cB, voffB); PG8_STAGE(PG8_SA(0, 0), cA, voffA); PG8_STAGE(PG8_SB(0, 1), cB + hstep, voffB); PG8_STAGE(PG8_SA(0, 1), cA + hstep, voffA);
    if (wr == 1) PG8_BAR;
    PG8_WAIT_V(4); PG8_BAR;
    PG8_STAGE(PG8_SB(1, 0), cB + kstep, voffB); PG8_STAGE(PG8_SA(1, 0), cA + kstep, voffA); PG8_STAGE(PG8_SB(1, 1), cB + hstep + kstep, voffB);
    PG8_WAIT_V(6); PG8_BAR;
    PG8_STAMP();
    for (;;) {
        const bool has_next = S.next(ui + 1, nxt);
        const char* nA = has_next ? (const char*)g.A + (size_t)nxt.pm * tstep : cA; const char* nB = has_next ? (const char*)g.Bt + (size_t)nxt.pn * tstep : cB;
        for (int t = 0; t < nt; t += 2) {
            const bool last = (t == nt - 2);
            const char* a1 = cA + (size_t)(t + 1) * kstep;
            const char* a2 = last ? nA : cA + (size_t)(t + 2) * kstep; const char* b2 = last ? nB : cB + (size_t)(t + 2) * kstep;
            const char* a3 = a2 + kstep; const char* b3 = b2 + kstep;
            if (last && has_next) S.a_ready(nxt);
            PG8_LDB(B0, 0, 0); PG8_SCHED; PG8_LDA(At, 0, 0); PG8_STAGE(PG8_SA(1, 1), a1 + hstep, voffA);
            PG8_WAIT_L(8); PG8_BAR; PG8_WAIT_L(0); PG8_MMA(0, 0, At, B0); PG8_BAR; PG8_SCHED;
            PG8_LDB(B1, 0, 1); PG8_STAGE(PG8_SB(0, 0), b2, voffB);
            PG8_BAR; PG8_WAIT_L(0); PG8_MMA(0, 1, At, B1); PG8_BAR;
            PG8_LDA(At, 0, 1); PG8_STAGE(PG8_SA(0, 0), a2, voffA);
            PG8_BAR; PG8_WAIT_L(0); PG8_MMA(1, 0, At, B0); PG8_BAR; PG8_SCHED;
            PG8_STAGE(PG8_SB(0, 1), b2 + hstep, voffB);
            PG8_WAIT_V(6); PG8_BAR; PG8_MMA(1, 1, At, B1); PG8_BAR;
            PG8_LDB(B0, 1, 0); PG8_SCHED; PG8_LDA(At, 1, 0); PG8_STAGE(PG8_SA(0, 1), a2 + hstep, voffA);
            PG8_WAIT_L(8); PG8_BAR; PG8_WAIT_L(0); PG8_MMA(0, 0, At, B0); PG8_BAR; PG8_SCHED;
            PG8_LDB(B1, 1, 1); PG8_STAGE(PG8_SB(1, 0), b3, voffB);
            PG8_BAR; PG8_WAIT_L(0); PG8_MMA(0, 1, At, B1); PG8_BAR;
            PG8_LDA(At, 1, 1); PG8_STAGE(PG8_SA(1, 0), a3, voffA);
            PG8_BAR; PG8_WAIT_L(0); PG8_MMA(1, 0, At, B0); PG8_BAR; PG8_SCHED;
            PG8_STAGE(PG8_SB(1, 1), b3 + hstep, voffB);
            PG8_WAIT_V(6); PG8_BAR; PG8_MMA(1, 1, At, B1); PG8_BAR;
        }
        PG8_STAMP();
        if constexpr (!Epi::AFTER_DRAIN) { E(acc, cur, wr, wc, fr, fq); S.done(cur); }
        PG8_STAMP();
        if (!has_next) break;
#pragma unroll
        for (int a = 0; a < 2; ++a)
#pragma unroll
            for (int b = 0; b < 2; ++b)
#pragma unroll
                for (int m = 0; m < 4; ++m)
#pragma unroll
                    for (int n = 0; n < 2; ++n) acc[a][b][m][n] = (f32x4){0.f, 0.f, 0.f, 0.f};
        cur = nxt; cA = nA; cB = nB; ++ui;
    }
    PG8_WAIT_V(0);
    if (wr == 0) PG8_BAR;
    PG8_BAR;
    if constexpr (Epi::AFTER_DRAIN) { E.fused(acc, cur, wr, wc, fr, fq, lds, wid, lane); S.done(cur); }
    PG8_STAMP();
    if (STAMP && wid == 0) { stamps[lane] = lane < nts ? (((unsigned long long)(unsigned)ts_hi << 32) | (unsigned)ts_lo) : 0ull;
        if (lane == 62) stamps[62] = rt_entry; if (lane == 63) stamps[63] = (unsigned long long)wall_clock64(); }
#undef PG8_STAMP
#undef PG8_SA
#undef PG8_SB
#undef PG8_STAGE
#undef PG8_LDA
#undef PG8_LDB
#undef PG8_MMA
#undef PG8_WAIT_V
#undef PG8_WAIT_L
#undef PG8_BAR
#undef PG8_SCHED
}
}

namespace mk {
#define LAS __attribute__((address_space(3)))
#define DI __device__ __forceinline__
typedef unsigned short bf16;
typedef pg8::bf16x8 bf16x8; typedef pg8::f32x4 f32x4; typedef pg8::u32x4 u32x4; typedef pg8::u32x2 u32x2;
typedef float f32x16 __attribute__((ext_vector_type(16)));
constexpr int TOK = 32768, DM = 1024, SEQ = 4096, BW = 512, FFH = 2816, NTHR = 512;
constexpr size_t MiB = 1024 * 1024;
constexpr size_t WS_ROWSS = 0;
constexpr size_t WS_BB = 1 * MiB;
constexpr size_t WS_CM = WS_BB + 262144;
constexpr size_t WS_AP = WS_CM + 262144;
constexpr size_t WS_SGW = WS_AP + 131072;
constexpr size_t WS_E = 2 * MiB;
constexpr size_t WS_W = 10 * MiB;
constexpr size_t WL_IN = 0, WL_GLU = 17825792, WL_BR = WL_GLU + 524288, WL_O = WL_BR + 4194304, WL_FF = WL_O + 2097152, WL_D = WL_FF + 11534336, WL_SIZE = WL_D + 5767168;
static_assert(WL_SIZE == 40 * MiB, "weights per layer");
constexpr size_t WS_XB = 90 * MiB;
constexpr size_t WS_P = 154 * MiB;
constexpr size_t PBUF = 32 * MiB;
constexpr size_t WS_YG = WS_P + 9 * PBUF;
constexpr size_t WS_END = WS_YG + 32 * MiB;
constexpr int LDS_BYTES = 143360;

DI float bf2f(bf16 v) { return __uint_as_float(((unsigned)v) << 16); }
DI bf16 f2bf(float f) { return (bf16)(mk_pk2(f, 0.f) & 0xffffu); }
DI float wave_sum(float v) {
#pragma unroll
    for (int o = 1; o < 64; o <<= 1) v += __shfl_xor(v, o);
    return v; }
DI f32x16 mfma32(bf16x8 a, bf16x8 b, f32x16 c) { return __builtin_amdgcn_mfma_f32_32x32x16_bf16(a, b, c, 0, 0, 0); }
DI f32x4 mfma16(bf16x8 a, bf16x8 b, f32x4 c) { return __builtin_amdgcn_mfma_f32_16x16x32_bf16(a, b, c, 0, 0, 0); }
DI int crow(int i, int h) { return (i & 3) + 8 * (i >> 2) + 4 * h; }
DI f32x16 zero16() { f32x16 z;
#pragma unroll
    for (int i = 0; i < 16; ++i) z[i] = 0.f;
    return z; }
#define LDS_WAIT() asm volatile("s_waitcnt lgkmcnt(0)" ::: "memory")

struct Params { const float* in[28]; float* out; unsigned char* ws; int ph_lo, ph_hi; };
enum { I_X = 0, I_GMIX, I_WIN, I_CONVW, I_CONVB, I_SGW, I_SGB, I_LNG, I_LNB, I_LAMQK, I_SUBLN, I_ARE, I_AIM, I_LOGDT, I_BRE, I_BIM, I_CRE, I_CIM, I_SSMD, I_WGLU, I_BGLU, I_WBR, I_WO, I_GFFN, I_WFG, I_WFU, I_WFD, I_GFIN };

DI void tr_item(const float* W, int ldn, int k0, int n0, const float* gs, bf16* WT, int ldk, int drow0, LAS float* scr, int lane) {
#pragma unroll 8
    for (int i = 0; i < 32; ++i) { const int kk = 2 * i + (lane >> 5); float v = W[(size_t)(k0 + kk) * ldn + n0 + (lane & 31)]; if (gs) v *= gs[k0 + kk]; scr[kk * 33 + (lane & 31)] = v; }
    LDS_WAIT();
    const int c = lane & 7;
#pragma unroll
    for (int j = 0; j < 4; ++j) { const int n = (lane >> 3) + 8 * j; const LAS float* s = scr + (8 * c) * 33 + n;
        u32x4 o; o.x = mk_pk2(s[0 * 33], s[1 * 33]); o.y = mk_pk2(s[2 * 33], s[3 * 33]); o.z = mk_pk2(s[4 * 33], s[5 * 33]); o.w = mk_pk2(s[6 * 33], s[7 * 33]);
        *(u32x4*)(WT + (size_t)(drow0 + n) * ldk + k0 + 8 * c) = o; }
    LDS_WAIT();
}
DI void dsincos(double x, double& s, double& c) {
    const double twopi = 6.283185307179586476925; const double k = rint(x / twopi); const double r = x - k * twopi, r2 = r * r;
    double ss = 1.0, cc = 1.0;
#pragma unroll
    for (int n = 13; n >= 1; --n) { ss = 1.0 - r2 * (1.0 / ((2.0 * n) * (2.0 * n + 1.0))) * ss; cc = 1.0 - r2 * (1.0 / ((2.0 * n - 1.0) * (2.0 * n))) * cc; }
    s = ss * r; c = cc;
}
DI void phase_prep(const Params& p, LAS unsigned char* lds, int tid, int lane, int wave, int G) {
    unsigned char* ws = p.ws;
    const int gw = blockIdx.x * 8 + wave, NGW = G * 8, gt = blockIdx.x * NTHR + tid, NGT = G * NTHR;
    LAS float* scr = (LAS float*)(lds + wave * 8704);
    for (int l = 0; l < 2; ++l) {
        unsigned char* wl = ws + WS_W + (size_t)l * WL_SIZE;
        for (int mi = 0; mi < 10; ++mi) {
            const float* src; int K, N; const float* gs = nullptr; bf16* dst; int map = 0;
            if (mi == 0) { src = p.in[I_WIN] + (size_t)l * 1024 * 8704; K = 1024; N = 8704; gs = p.in[I_GMIX] + l * 1024; dst = (bf16*)(wl + WL_IN); map = 1; }
            else if (mi == 1) { src = p.in[I_WGLU] + (size_t)l * 512 * 512; K = 512; N = 512; dst = (bf16*)(wl + WL_GLU); }
            else if (mi < 6) { const int b = mi - 2; src = p.in[I_WBR] + ((size_t)l * 4 + b) * 512 * 1024; K = 512; N = 1024; dst = (bf16*)(wl + WL_BR) + (size_t)b * 1024 * 512; }
            else if (mi == 6) { src = p.in[I_WO] + (size_t)l * 1024 * 1024; K = 1024; N = 1024; dst = (bf16*)(wl + WL_O); }
            else if (mi == 7) { src = p.in[I_WFG] + (size_t)l * 1024 * 2816; K = 1024; N = 2816; gs = p.in[I_GFFN] + l * 1024; dst = (bf16*)(wl + WL_FF); map = 2; }
            else if (mi == 8) { src = p.in[I_WFU] + (size_t)l * 1024 * 2816; K = 1024; N = 2816; gs = p.in[I_GFFN] + l * 1024; dst = (bf16*)(wl + WL_FF); map = 3; }
            else { src = p.in[I_WFD] + (size_t)l * 2816 * 1024; K = 2816; N = 1024; dst = (bf16*)(wl + WL_D); }
            const int nblk = N / 32, nit = (K / 64) * nblk;
            for (int it = gw; it < nit; it += NGW) {
                const int kb = it / nblk, nb = it % nblk, n0 = nb * 32; int dr = n0;
                if (map == 1) { if (n0 >= 3584 && n0 < 4096) dr = n0 + 512; else if (n0 >= 4096 && n0 < 4608) dr = n0 - 512; }
                else if (map == 2) dr = (n0 >> 7) * 256 + (n0 & 127);
                else if (map == 3) dr = (n0 >> 7) * 256 + 128 + (n0 & 127);
                tr_item(src, N, kb * 64, n0, gs, dst, K, dr, scr, lane);
            }
        }
    }
    { const float* x = p.in[I_X]; bf16* xb = (bf16*)(ws + WS_XB); float* rowss = (float*)(ws + WS_ROWSS);
        for (int row = gw; row < TOK; row += NGW) { const f32x4* xr = (const f32x4*)(x + (size_t)row * DM) + lane; float ss = 0.f;
#pragma unroll
            for (int j = 0; j < 4; ++j) { const f32x4 v = xr[64 * j]; ss += (v[0] * v[0] + v[1] * v[1]) + (v[2] * v[2] + v[3] * v[3]);
                u32x2 w; w.x = mk_pk2(v[0], v[1]); w.y = mk_pk2(v[2], v[3]); *((u32x2*)(xb + (size_t)row * DM) + lane + 64 * j) = w; }
            ss = wave_sum(ss); if (lane == 0) rowss[row] = ss; }
        for (int i = gt; i < 4 * TOK; i += NGT) rowss[TOK + i] = 0.f; }
    { const float* sgw = p.in[I_SGW]; bf16* o = (bf16*)(ws + WS_SGW);
        for (int i = gt; i < 2 * 4 * 128 * 128; i += NGT) { const int s = i & 127, t = (i >> 7) & 127; o[i] = f2bf(s <= t ? sgw[i] : 0.f); } }
    for (int i = gt; i < 2 * 32 * 64; i += NGT) {
        const int pp = i & 63, lg = i >> 6;
        const double dt = exp((double)p.in[I_LOGDT][lg]); const double are = p.in[I_ARE][i], aim = p.in[I_AIM][i];
        const double mag = exp(dt * are); double sn, cs; dsincos(dt * aim, sn, cs);
        const double abr = mag * cs, abi = mag * sn, den = are * are + aim * aim, nr = abr - 1.0, ni = abi;
        const double cr = (nr * are + ni * aim) / den, ci = (ni * are - nr * aim) / den;
        bf16* bb = (bf16*)(ws + WS_BB) + (size_t)lg * 128 * 16; const float* bre = p.in[I_BRE] + (size_t)i * 16; const float* bim = p.in[I_BIM] + (size_t)i * 16;
        for (int h = 0; h < 16; ++h) { const double br = bre[h], bi = bim[h]; bb[pp * 16 + h] = f2bf((float)(cr * br - ci * bi)); bb[(64 + pp) * 16 + h] = f2bf((float)(cr * bi + ci * br)); }
        bf16* cm = (bf16*)(ws + WS_CM) + (size_t)lg * 16 * 128; const float* cre = p.in[I_CRE] + (size_t)lg * 16 * 64; const float* cim = p.in[I_CIM] + (size_t)lg * 16 * 64;
        for (int h = 0; h < 16; ++h) { cm[h * 128 + pp] = f2bf(cre[h * 64 + pp]); cm[h * 128 + 64 + pp] = f2bf(-cim[h * 64 + pp]); }
        double pr = abr, pi = abi; float* ap = (float*)(ws + WS_AP) + (size_t)i * 8; ap[0] = (float)pr; ap[1] = (float)pi;
        for (int q = 0; q < 5; ++q) { const double t = pr * pr - pi * pi; pi = 2.0 * pr * pi; pr = t; }
        ap[2] = (float)pr; ap[3] = (float)pi;
        { const double t = pr * pr - pi * pi; pi = 2.0 * pr * pi; pr = t; }
        ap[4] = (float)pr; ap[5] = (float)pi; ap[6] = 0.f; ap[7] = 0.f;
    }
}

DI void phase_branchA(const Params& p, int l, int tid, int G) {
    bf16* AB = (bf16*)(p.ws + WS_P); const bf16* AC = (const bf16*)(p.ws + WS_P + PBUF); const bf16* AX = (const bf16*)(p.ws + WS_P + 2 * PBUF);
    const float* cw = p.in[I_CONVW] + l * 3 * 512; const float* cb = p.in[I_CONVB] + l * 512;
    for (int idx = blockIdx.x * NTHR + tid; idx < (TOK / 16) * 64; idx += G * NTHR) {
        const int cgp = idx & 63, run = idx >> 6, c0 = cgp * 8, t0 = run * 16;
        f32x4 w0[2], w1[2], w2[2], bb[2];
#pragma unroll
        for (int e = 0; e < 2; ++e) { w0[e] = *(const f32x4*)(cw + c0 + 4 * e); w1[e] = *(const f32x4*)(cw + 512 + c0 + 4 * e); w2[e] = *(const f32x4*)(cw + 1024 + c0 + 4 * e); bb[e] = *(const f32x4*)(cb + c0 + 4 * e); }
        f32x4 zm2[2] = {{0.f, 0.f, 0.f, 0.f}, {0.f, 0.f, 0.f, 0.f}}, zm1[2] = {{0.f, 0.f, 0.f, 0.f}, {0.f, 0.f, 0.f, 0.f}};
        if ((t0 & (SEQ - 1)) != 0) {
            f32x4 a0, a1, x0, x1;
            pg8::unpack8(*(const u32x4*)(AC + (size_t)(t0 - 2) * 512 + c0), a0, a1); pg8::unpack8(*(const u32x4*)(AX + (size_t)(t0 - 2) * 512 + c0), x0, x1); zm2[0] = a0 * x0; zm2[1] = a1 * x1;
            pg8::unpack8(*(const u32x4*)(AC + (size_t)(t0 - 1) * 512 + c0), a0, a1); pg8::unpack8(*(const u32x4*)(AX + (size_t)(t0 - 1) * 512 + c0), x0, x1); zm1[0] = a0 * x0; zm1[1] = a1 * x1;
        }
#pragma unroll 4
        for (int i = 0; i < 16; ++i) { const size_t off = (size_t)(t0 + i) * 512 + c0;
            f32x4 a0, a1, x0, x1, b0, b1; pg8::unpack8(*(const u32x4*)(AC + off), a0, a1); pg8::unpack8(*(const u32x4*)(AX + off), x0, x1); pg8::unpack8(*(const u32x4*)(AB + off), b0, b1);
            const f32x4 z0 = a0 * x0, z1 = a1 * x1;
            const f32x4 y0 = b0 * (w0[0] * zm2[0] + w1[0] * zm1[0] + w2[0] * z0 + bb[0]), y1 = b1 * (w0[1] * zm2[1] + w1[1] * zm1[1] + w2[1] * z1 + bb[1]);
            *(u32x4*)(AB + off) = pg8::pack8(y0, y1);
            zm2[0] = zm1[0]; zm2[1] = zm1[1]; zm1[0] = z0; zm1[1] = z1; }
    }
}

DI void phase_branchB(const Params& p, int l, LAS unsigned char* lds, int tid, int lane, int wave, int G) {
    bf16* BU = (bf16*)(p.ws + WS_P + 3 * PBUF); const bf16* BV = (const bf16*)(p.ws + WS_P + 4 * PBUF);
    const bf16* SGW = (const bf16*)(p.ws + WS_SGW) + (size_t)l * 4 * 128 * 128; const float* sgb = p.in[I_SGB] + l * 4 * 128;
    const float* lng = p.in[I_LNG] + l * 512 + lane * 8; const float* lnb = p.in[I_LNB] + l * 512 + lane * 8;
    constexpr int RS = 1040;
    const int r = lane & 31, half = lane >> 5;
    for (int item = blockIdx.x; item < TOK / 128; item += G) {
        const int tok0 = item * 128;
        { const f32x4 g0 = *(const f32x4*)lng, g1 = *(const f32x4*)(lng + 4), b0 = *(const f32x4*)lnb, b1 = *(const f32x4*)(lnb + 4);
            for (int tt = 0; tt < 16; ++tt) { const int s = wave * 16 + tt;
                f32x4 v0, v1; pg8::unpack8(*(const u32x4*)(BV + (size_t)(tok0 + s) * 512 + lane * 8), v0, v1);
#pragma unroll
                for (int j = 0; j < 4; ++j) { v0[j] = mk_gelu(v0[j]); v1[j] = mk_gelu(v1[j]); }
                const float mean = wave_sum((v0[0] + v0[1]) + (v0[2] + v0[3]) + (v1[0] + v1[1]) + (v1[2] + v1[3])) * (1.0f / 512.0f);
                v0 = v0 - mean; v1 = v1 - mean;
                const float var = wave_sum((v0[0] * v0[0] + v0[1] * v0[1]) + (v0[2] * v0[2] + v0[3] * v0[3]) + (v1[0] * v1[0] + v1[1] * v1[1]) + (v1[2] * v1[2] + v1[3] * v1[3])) * (1.0f / 512.0f);
                const float rstd = rsqrtf(var + 1e-5f);
                v0 = v0 * rstd * g0 + b0; v1 = v1 * rstd * g1 + b1;
                *(LAS u32x4*)(lds + s * RS + lane * 16) = pg8::pack8(v0, v1); } }
        __syncthreads();
        const int g = wave >> 1, dh = wave & 1;
        f32x16 acc[4][2];
#pragma unroll
        for (int a = 0; a < 4; ++a) { acc[a][0] = zero16(); acc[a][1] = zero16(); }
#pragma unroll
        for (int ks = 0; ks < 8; ++ks) {
            bf16x8 Vf[2];
#pragma unroll
            for (int dt = 0; dt < 2; ++dt) { const LAS unsigned short* vp = (const LAS unsigned short*)(lds + (16 * ks + 8 * half) * RS + (g * 128 + dh * 64 + dt * 32 + r) * 2);
#pragma unroll
                for (int j = 0; j < 8; ++j) Vf[dt][j] = (short)vp[j * (RS / 2)]; }
#pragma unroll
            for (int tt = ks >> 1; tt < 4; ++tt) { const bf16x8 Wf = *(const bf16x8*)(SGW + ((size_t)g * 128 + 32 * tt + r) * 128 + 16 * ks + 8 * half);
                acc[tt][0] = mfma32(Vf[0], Wf, acc[tt][0]); acc[tt][1] = mfma32(Vf[1], Wf, acc[tt][1]); }
        }
#pragma unroll
        for (int tt = 0; tt < 4; ++tt) { const int t = 32 * tt + r; const float bias = sgb[g * 128 + t];
#pragma unroll
            for (int dt = 0; dt < 2; ++dt)
#pragma unroll
                for (int ig = 0; ig < 4; ++ig) { bf16* up = BU + (size_t)(tok0 + t) * 512 + g * 128 + dh * 64 + dt * 32 + 8 * ig + 4 * half;
                    const u32x2 uw = *(const u32x2*)up;
                    const float y0 = mk_gelu(mk_lo(uw.x)) * (acc[tt][dt][4 * ig + 0] + bias), y1 = mk_gelu(mk_hi(uw.x)) * (acc[tt][dt][4 * ig + 1] + bias);
                    const float y2 = mk_gelu(mk_lo(uw.y)) * (acc[tt][dt][4 * ig + 2] + bias), y3 = mk_gelu(mk_hi(uw.y)) * (acc[tt][dt][4 * ig + 3] + bias);
                    u32x2 o; o.x = mk_pk2(y0, y1); o.y = mk_pk2(y2, y3); *(u32x2*)up = o; } }
        __syncthreads();
    }
}

DI void phase_attn(const Params& p, int l, LAS unsigned char* lds, int tid, int lane, int wave, int G) {
    bf16* CQ = (bf16*)(p.ws + WS_P + 5 * PBUF); const bf16* CK = (const bf16*)(p.ws + WS_P + 6 * PBUF); const bf16* VT = (const bf16*)(p.ws + WS_P + 8 * PBUF);
    const float lam_init = 0.8f - 0.6f * expf(-0.3f * (float)l);
    const float* lq = p.in[I_LAMQK] + l * 256;
    const float lam = expf(wave_sum(lq[lane] * lq[64 + lane])) - expf(wave_sum(lq[128 + lane] * lq[192 + lane])) + lam_init;
    const float* sg = p.in[I_SUBLN] + l * 128;
    const int m = wave & 1, sub = wave >> 1, r = lane & 31, half = lane >> 5;
    constexpr int KROW = 144, KBYTES = 64 * KROW  , VOFF = 2 * KBYTES  , STAGE = VOFF + 128 * KROW  ;
    const float cs = 0.125f * 1.44269504089f;
    for (int pi = blockIdx.x; pi < 512; pi += G) {
#pragma unroll 1
        for (int uu = 0; uu < 2; ++uu) {
            const int bh = pi >> 4, jp = pi & 15, qb = uu ? 31 - jp : jp, b = bh >> 2, h = bh & 3;
            const int tokq0 = b * SEQ + qb * 128, qrow = tokq0 + 32 * sub + r;
            bf16x8 Qf[4];
#pragma unroll
            for (int ks = 0; ks < 4; ++ks) Qf[ks] = *(const bf16x8*)(CQ + (size_t)qrow * 512 + h * 128 + m * 64 + 16 * ks + 8 * half);
            const int nt = 2 * qb + 2, my_last = 2 * qb + (sub >> 1);
            const bf16* kg[2]; const bf16* vg[2]; int kl[2], vl[2];
#pragma unroll
            for (int i = 0; i < 2; ++i) { const int idx = tid + 512 * i; const int key = idx >> 4, c16 = idx & 15;
                kg[i] = CK + (size_t)(b * SEQ + key) * 512 + h * 128 + c16 * 8; kl[i] = (c16 >> 3) * KBYTES + key * KROW + (c16 & 7) * 16;
                const int dv = idx >> 3, c8 = idx & 7;
                vg[i] = VT + (size_t)(h * 128 + dv) * TOK + b * SEQ + c8 * 8; vl[i] = VOFF + dv * KROW + c8 * 16; }
            u32x4 st[4];
            st[0] = *(const u32x4*)kg[0]; st[1] = *(const u32x4*)kg[1]; st[2] = *(const u32x4*)vg[0]; st[3] = *(const u32x4*)vg[1];
            *(LAS u32x4*)(lds + kl[0]) = st[0]; *(LAS u32x4*)(lds + kl[1]) = st[1]; *(LAS u32x4*)(lds + vl[0]) = st[2]; *(LAS u32x4*)(lds + vl[1]) = st[3];
            __syncthreads();
            f32x16 O[4];
#pragma unroll
            for (int i = 0; i < 4; ++i) O[i] = zero16();
            float m_run = -INFINITY, l_run = 0.f;
#pragma unroll 1
            for (int kt = 0; kt < nt; ++kt) {
                const bool more = (kt + 1 < nt);
                if (more) { const size_t ko = (size_t)(kt + 1) * 64 * 512, vo = (size_t)(kt + 1) * 64;
                    st[0] = *(const u32x4*)(kg[0] + ko); st[1] = *(const u32x4*)(kg[1] + ko); st[2] = *(const u32x4*)(vg[0] + vo); st[3] = *(const u32x4*)(vg[1] + vo); }
                const LAS unsigned char* buf = lds + (kt & 1) * STAGE;
                if (kt <= my_last) {
                    f32x16 S[2];
#pragma unroll
                    for (int u = 0; u < 2; ++u) { S[u] = zero16();
#pragma unroll
                        for (int ks = 0; ks < 4; ++ks) { const bf16x8 A = *(const LAS bf16x8*)(buf + m * KBYTES + (32 * u + r) * KROW + (16 * ks + 8 * half) * 2); S[u] = mfma32(A, Qf[ks], S[u]); } }
                    float mx = -INFINITY;
#pragma unroll
                    for (int u = 0; u < 2; ++u)
#pragma unroll
                        for (int i = 0; i < 16; ++i) mx = fmaxf(mx, S[u][i]);
                    mx = fmaxf(mx, __shfl_xor(mx, 32));
                    const float m_new = fmaxf(m_run, mx * cs), alpha = __builtin_amdgcn_exp2f(m_run - m_new);
                    float ps = 0.f;
#pragma unroll
                    for (int u = 0; u < 2; ++u)
#pragma unroll
                        for (int i = 0; i < 16; ++i) { const float e = __builtin_amdgcn_exp2f(S[u][i] * cs - m_new); S[u][i] = e; ps += e; }
                    ps += __shfl_xor(ps, 32);
                    l_run = l_run * alpha + ps; m_run = m_new;
#pragma unroll
                    for (int d = 0; d < 4; ++d)
#pragma unroll
                        for (int i = 0; i < 16; ++i) O[d][i] *= alpha;
                    bf16x8 Pf[2][2];
#pragma unroll
                    for (int u = 0; u < 2; ++u)
#pragma unroll
                        for (int s = 0; s < 2; ++s) { u32x4 w; w.x = mk_pk2(S[u][8 * s + 0], S[u][8 * s + 1]); w.y = mk_pk2(S[u][8 * s + 2], S[u][8 * s + 3]); w.z = mk_pk2(S[u][8 * s + 4], S[u][8 * s + 5]); w.w = mk_pk2(S[u][8 * s + 6], S[u][8 * s + 7]);
                            Pf[u][s] = __builtin_bit_cast(bf16x8, w); }
#pragma unroll
                    for (int d = 0; d < 4; ++d)
#pragma unroll
                        for (int u = 0; u < 2; ++u)
#pragma unroll
                            for (int s = 0; s < 2; ++s) { const LAS unsigned char* va = buf + VOFF + (32 * d + r) * KROW + (32 * u + 16 * s + 4 * half) * 2;
                                const u32x2 lo = *(const LAS u32x2*)va, hi = *(const LAS u32x2*)(va + 16);
                                u32x4 w; w.x = lo.x; w.y = lo.y; w.z = hi.x; w.w = hi.y;
                                O[d] = mfma32(__builtin_bit_cast(bf16x8, w), Pf[u][s], O[d]); }
                }
                if (more) { LAS unsigned char* nb = lds + ((kt + 1) & 1) * STAGE;
                    *(LAS u32x4*)(nb + kl[0]) = st[0]; *(LAS u32x4*)(nb + kl[1]) = st[1]; *(LAS u32x4*)(nb + vl[0]) = st[2]; *(LAS u32x4*)(nb + vl[1]) = st[3]; }
                __syncthreads();
            }
            const float inv = 1.0f / l_run;
            LAS float* Cb = (LAS float*)lds;
            if (m == 1) { const float f = inv * lam;
#pragma unroll
                for (int d = 0; d < 4; ++d)
#pragma unroll
                    for (int i = 0; i < 16; ++i) Cb[(sub * 128 + 32 * d + crow(i, half)) * 33 + r] = O[d][i] * f; }
            __syncthreads();
            if (m == 0) { float ss = 0.f;
#pragma unroll
                for (int d = 0; d < 4; ++d)
#pragma unroll
                    for (int i = 0; i < 16; ++i) { const float o = O[d][i] * inv - Cb[(sub * 128 + 32 * d + crow(i, half)) * 33 + r]; O[d][i] = o; ss += o * o; }
                ss += __shfl_xor(ss, 32);
                const float rs = rsqrtf(ss * (1.0f / 128.0f) + 1e-5f) * (1.0f - lam_init);
#pragma unroll
                for (int d = 0; d < 4; ++d)
#pragma unroll
                    for (int ig = 0; ig < 4; ++ig) { const int dv0 = 32 * d + 8 * ig + 4 * half; const f32x4 gn = *(const f32x4*)(sg + dv0);
                        u32x2 w; w.x = mk_pk2(O[d][4 * ig + 0] * rs * gn[0], O[d][4 * ig + 1] * rs * gn[1]); w.y = mk_pk2(O[d][4 * ig + 2] * rs * gn[2], O[d][4 * ig + 3] * rs * gn[3]);
                        *(u32x2*)(CQ + (size_t)qrow * 512 + h * 128 + dv0) = w; } }
            __syncthreads();
        }
    }
}

template <bool P2> DI void phase_ssm(const Params& p, int l, LAS unsigned char* lds, int lane, int wave, int G) {
    const bf16* DU = (const bf16*)(p.ws + WS_P + 7 * PBUF); bf16* YG = (bf16*)(p.ws + WS_YG); float* E = (float*)(p.ws + WS_E);
    const bf16* BB = (const bf16*)(p.ws + WS_BB) + (size_t)l * 32 * 128 * 16; const bf16* CM = (const bf16*)(p.ws + WS_CM) + (size_t)l * 32 * 16 * 128;
    const float* AP = (const float*)(p.ws + WS_AP) + (size_t)l * 32 * 64 * 8; const float* dsk = p.in[I_SSMD] + l * 512;
    const int r = lane & 31, half = lane >> 5, r16 = lane & 15, q4 = lane >> 4;
    constexpr int XRS = 272;
    LAS unsigned char* Xs = lds + wave * (64 * XRS);
    for (int it = blockIdx.x * 8 + wave; it < 16384; it += G * 8) {
        const int c = it & 63, g = (it >> 6) & 31, b = it >> 11, tok0 = b * SEQ + c * 64;
        f32x16 X[4][2];
        { bf16x8 Uf[2], Bf[4];
#pragma unroll
            for (int tt = 0; tt < 2; ++tt) { const int tau = 32 * ((r >> 2) & 1) + 16 * tt + (r & 3) + 4 * (r >> 3); Uf[tt] = *(const bf16x8*)(DU + (size_t)(tok0 + tau) * 512 + g * 16 + 8 * half); }
#pragma unroll
            for (int pt = 0; pt < 4; ++pt) Bf[pt] = *(const bf16x8*)(BB + ((size_t)g * 128 + 32 * pt + r) * 16 + 8 * half);
#pragma unroll
            for (int pt = 0; pt < 4; ++pt)
#pragma unroll
                for (int tt = 0; tt < 2; ++tt) X[pt][tt] = mfma32(Uf[tt], Bf[pt], zero16()); }
        float ar[2], ai[2], a32r[2], a32i[2], a64r[2], a64i[2];
#pragma unroll
        for (int s = 0; s < 2; ++s) { const float* ap = AP + ((size_t)g * 64 + 32 * s + r) * 8; const f32x4 v = *(const f32x4*)ap; ar[s] = v[0]; ai[s] = v[1]; a32r[s] = v[2]; a32i[s] = v[3]; a64r[s] = ap[4]; a64i[s] = ap[5]; }
        float xr[2] = {0.f, 0.f}, xi[2] = {0.f, 0.f};
        if (P2) {
            const float* e0 = E + (((size_t)(b * 32 + g) * 64) * 64 + r) * 2;
            float sr0 = 0.f, si0 = 0.f, sr1 = 0.f, si1 = 0.f;
#pragma unroll 4
            for (int j = 0; j < c; ++j) { const float2 ea = *(const float2*)(e0 + (size_t)j * 128), eb = *(const float2*)(e0 + (size_t)j * 128 + 64);
                const float t0 = a64r[0] * sr0 - a64i[0] * si0 + ea.x; si0 = a64r[0] * si0 + a64i[0] * sr0 + ea.y; sr0 = t0;
                const float t1 = a64r[1] * sr1 - a64i[1] * si1 + eb.x; si1 = a64r[1] * si1 + a64i[1] * sr1 + eb.y; sr1 = t1; }
            if (half == 0) { xr[0] = sr0; xi[0] = si0; xr[1] = sr1; xi[1] = si1; }
        }
#pragma unroll
        for (int s = 0; s < 2; ++s)
#pragma unroll
            for (int tt = 0; tt < 2; ++tt)
#pragma unroll
                for (int i = 0; i < 16; ++i) { const float nr = ar[s] * xr[s] - ai[s] * xi[s] + X[s][tt][i], ni = ar[s] * xi[s] + ai[s] * xr[s] + X[2 + s][tt][i]; X[s][tt][i] = nr; X[2 + s][tt][i] = ni; xr[s] = nr; xi[s] = ni; }
        float oxr[2], oxi[2];
#pragma unroll
        for (int s = 0; s < 2; ++s) { oxr[s] = __shfl_xor(xr[s], 32); oxi[s] = __shfl_xor(xi[s], 32); }
        if (!P2) {
            if (half == 1) {
#pragma unroll
                for (int s = 0; s < 2; ++s) { float2 e; e.x = xr[s] + a32r[s] * oxr[s] - a32i[s] * oxi[s]; e.y = xi[s] + a32r[s] * oxi[s] + a32i[s] * oxr[s];
                    *(float2*)(E + (((size_t)(b * 32 + g) * 64 + c) * 64 + 32 * s + r) * 2) = e; } }
        } else {
#pragma unroll
            for (int s = 0; s < 2; ++s) { float wr_ = half ? oxr[s] : 0.f, wi_ = half ? oxi[s] : 0.f;
#pragma unroll
                for (int tt = 0; tt < 2; ++tt)
#pragma unroll
                    for (int i = 0; i < 16; ++i) { const float t = ar[s] * wr_ - ai[s] * wi_; wi_ = ar[s] * wi_ + ai[s] * wr_; wr_ = t; X[s][tt][i] += wr_; X[2 + s][tt][i] += wi_; } }
#pragma unroll
            for (int pt = 0; pt < 4; ++pt)
#pragma unroll
                for (int tt = 0; tt < 2; ++tt)
#pragma unroll
                    for (int i = 0; i < 16; ++i) *(LAS unsigned short*)(Xs + (32 * half + 16 * tt + i) * XRS + (32 * pt + r) * 2) = f2bf(X[pt][tt][i]);
            LDS_WAIT();
            bf16x8 Cf[4];
#pragma unroll
            for (int ks = 0; ks < 4; ++ks) Cf[ks] = *(const bf16x8*)(CM + ((size_t)g * 16 + r16) * 128 + 32 * ks + 8 * q4);
            const int ch = g * 16 + r16; const float dk = dsk[ch];
#pragma unroll
            for (int mt = 0; mt < 4; ++mt) { f32x4 acc = {0.f, 0.f, 0.f, 0.f};
#pragma unroll
                for (int ks = 0; ks < 4; ++ks) { const bf16x8 A = *(const LAS bf16x8*)(Xs + (16 * mt + r16) * XRS + (32 * ks + 8 * q4) * 2); acc = mfma16(A, Cf[ks], acc); }
#pragma unroll
                for (int j = 0; j < 4; ++j) { const size_t o = (size_t)(tok0 + 16 * mt + 4 * q4 + j) * 512 + ch; const float y = acc[j] + dk * bf2f(DU[o]); YG[o] = f2bf(mk_gelu(y)); } }
            LDS_WAIT();
        }
    }
}

DI void phase_final(const Params& p, int tid, int G) {
    const float* rowss = (const float*)(p.ws + WS_ROWSS) + 4 * TOK; const float* gf = p.in[I_GFIN]; float* out = p.out;
    for (size_t i = (size_t)blockIdx.x * NTHR + tid; i < (size_t)TOK * 256; i += (size_t)G * NTHR) { const int row = (int)(i >> 8), c4 = (int)(i & 255);
        const float rs = pg8::rstd_of(rowss[row]); const f32x4 v = *((const f32x4*)out + i), gv = *((const f32x4*)gf + c4); *((f32x4*)out + i) = v * rs * gv; }
}

__global__ void __launch_bounds__(NTHR) mega(Params p) {
    extern __shared__ __attribute__((aligned(16))) unsigned char lds_raw[];
    LAS unsigned char* lds = (LAS unsigned char*)lds_raw;
    const int G = gridDim.x;
#define LAUNDER() int tid = threadIdx.x; asm volatile("" : "+v"(tid)); const int lane = tid & 63, wave = __builtin_amdgcn_readfirstlane(tid >> 6); (void)lane; (void)wave
    const int lo = p.ph_lo, hi = p.ph_hi;
    unsigned char* ws = p.ws;
    int ph = 0;
#ifndef ONLY_KIND
#define ONLY_KIND -1
#endif
#define KEN(k) (ONLY_KIND < 0 || ONLY_KIND == (k))
#define IN_PH() (lo <= ph && ph < hi)
#define END_PH() do { if (ONE_LAUNCH && lo <= ph && ph + 1 < hi) cg::this_grid().sync(); ++ph; } while (0)
    if (IN_PH() && KEN(0)) { LAUNDER(); phase_prep(p, lds, tid, lane, wave, G); }
    END_PH();
    bf16* XB = (bf16*)(ws + WS_XB); float* rowss = (float*)(ws + WS_ROWSS);
    for (int l = 0; l < 2; ++l) {
        unsigned char* wl = ws + WS_W + (size_t)l * WL_SIZE;
        const bf16* WinT = (const bf16*)(wl + WL_IN);
        bf16* P0 = (bf16*)(ws + WS_P);
        const float* rs_mix = rowss + (size_t)(2 * l) * TOK; float* rs_ffn = rowss + (size_t)(2 * l + 1) * TOK; float* rs_next = rowss + (size_t)(2 * l + 2) * TOK;
        pg8::StaticOrder S;
        if (IN_PH()) {
            if (KEN(1)) { pg8::Gemm g{XB, WinT, TOK, 4096, 1024}; S.init(TOK, 4096, G, (int)blockIdx.x); pg8::EpiProj E{P0, rs_mix}; pg8::gemm_phase<pg8::EpiProj, pg8::StaticOrder>(lds, g, S, E, nullptr); }
            if (KEN(2)) { pg8::Gemm g{WinT + (size_t)4096 * 1024, XB, 512, TOK, 1024}; S.init(512, TOK, G, (int)blockIdx.x); pg8::EpiVT E{(bf16*)(ws + WS_P + 8 * PBUF), rs_mix}; pg8::gemm_phase<pg8::EpiVT, pg8::StaticOrder>(lds, g, S, E, nullptr); }
        }
        END_PH();
        if (IN_PH()) { if (KEN(20)) { LAUNDER(); phase_attn(p, l, lds, tid, lane, wave, G); } if (KEN(21)) { LAUNDER(); phase_branchB(p, l, lds, tid, lane, wave, G); } if (KEN(22)) { LAUNDER(); phase_ssm<false>(p, l, lds, lane, wave, G); } if (KEN(23)) { LAUNDER(); phase_branchA(p, l, tid, G); } }
        END_PH();
        if (IN_PH() && KEN(3)) { LAUNDER(); phase_ssm<true>(p, l, lds, lane, wave, G); }
        END_PH();
        if (IN_PH() && KEN(4)) { pg8::Gemm g{(const bf16*)(ws + WS_YG), (const bf16*)(wl + WL_GLU), TOK, 512, 512}; S.init(TOK, 512, G, (int)blockIdx.x);
            pg8::EpiGlu E{(const bf16*)(ws + WS_YG), (bf16*)(ws + WS_P + 7 * PBUF), p.in[I_BGLU] + l * 512}; pg8::gemm_phase<pg8::EpiGlu, pg8::StaticOrder>(lds, g, S, E, nullptr); }
        END_PH();
        bf16* GS = (bf16*)(ws + WS_P + 1 * PBUF); bf16* MG = (bf16*)(ws + WS_P + 8 * PBUF);
        if (IN_PH() && KEN(5)) {
#pragma unroll 1
            for (int b = 0; b < 4; ++b) {
                { pg8::Gemm g{XB, WinT + (size_t)(4608 + 1024 * b) * 1024, TOK, 1024, 1024}; S.init(TOK, 1024, G, (int)blockIdx.x); pg8::EpiGate E{GS, rs_mix}; pg8::gemm_phase<pg8::EpiGate, pg8::StaticOrder>(lds, g, S, E, nullptr); }
                const size_t yb = (b == 0) ? 0 : (b == 1) ? 3 : (b == 2) ? 5 : 7;
                pg8::Gemm g{(const bf16*)(ws + WS_P + yb * PBUF), (const bf16*)(wl + WL_BR) + (size_t)b * 1024 * 512, TOK, 1024, 512}; S.init(TOK, 1024, G, (int)blockIdx.x);
                if (b == 0) { pg8::EpiBr<true> E{GS, MG}; pg8::gemm_phase<pg8::EpiBr<true>, pg8::StaticOrder>(lds, g, S, E, nullptr); }
                else { pg8::EpiBr<false> E{GS, MG}; pg8::gemm_phase<pg8::EpiBr<false>, pg8::StaticOrder>(lds, g, S, E, nullptr); }
            }
        }
        END_PH();
        if (IN_PH() && KEN(6)) { pg8::Gemm g{MG, (const bf16*)(wl + WL_O), TOK, 1024, 1024}; S.init(TOK, 1024, G, (int)blockIdx.x);
            pg8::EpiResid E{l == 0 ? p.in[I_X] : (const float*)p.out, p.out, XB, rs_ffn}; pg8::gemm_phase<pg8::EpiResid, pg8::StaticOrder>(lds, g, S, E, nullptr); }
        END_PH();
        bf16* H = (bf16*)(ws + WS_P);
        if (IN_PH() && KEN(7)) { pg8::Gemm g{XB, (const bf16*)(wl + WL_FF), TOK, 5632, 1024}; S.init(TOK, 5632, G, (int)blockIdx.x);
            pg8::EpiFfnUp E{H, rs_ffn}; pg8::gemm_phase<pg8::EpiFfnUp, pg8::StaticOrder>(lds, g, S, E, nullptr); }
        END_PH();
        if (IN_PH() && KEN(8)) { pg8::Gemm g{H, (const bf16*)(wl + WL_D), TOK, 1024, 2816}; S.init(TOK, 1024, G, (int)blockIdx.x);
            pg8::EpiResid E{(const float*)p.out, p.out, XB, rs_next}; pg8::gemm_phase<pg8::EpiResid, pg8::StaticOrder>(lds, g, S, E, nullptr); }
        END_PH();
    }
    if (IN_PH() && KEN(9)) { LAUNDER(); phase_final(p, tid, G); }
}
constexpr int N_PHASES = 18;
}

extern "C" void kernel_launch(void* const* d_in, const int* in_sizes, int n_in, void* d_out, int out_size, void* d_ws, size_t ws_size, hipStream_t stream) {
    static int grid = 0;
    if (grid == 0) {
        if (n_in != 28 || out_size != mk::TOK * mk::DM || ws_size < mk::WS_END) { fprintf(stderr, "kernel_launch: unexpected shapes (n_in %d out %d ws %zu need %zu)\n", n_in, out_size, ws_size, (size_t)mk::WS_END); grid = -1; return; }
        int dev = 0, cus = 0, per_cu = 0;
        hipGetDevice(&dev); hipDeviceGetAttribute(&cus, hipDeviceAttributeMultiprocessorCount, dev);
        if (hipFuncSetAttribute((const void*)mk::mega, hipFuncAttributeMaxDynamicSharedMemorySize, mk::LDS_BYTES) != hipSuccess) { fprintf(stderr, "kernel_launch: hipFuncSetAttribute failed\n"); grid = -1; return; }
        if (hipOccupancyMaxActiveBlocksPerMultiprocessor(&per_cu, (const void*)mk::mega, mk::NTHR, mk::LDS_BYTES) != hipSuccess || per_cu < 1) { fprintf(stderr, "kernel_launch: occupancy query says %d\n", per_cu); per_cu = 1; }
        (void)hipGetLastError();
        grid = cus * 1;
        if (grid <= 0) grid = 256;
    }
    if (grid < 0) return;
    mk::Params p{};
    for (int i = 0; i < 28; ++i) p.in[i] = (const float*)d_in[i];
    p.out = (float*)d_out; p.ws = (unsigned char*)d_ws;
#if ONE_LAUNCH
    p.ph_lo = 0; p.ph_hi = mk::N_PHASES;
    void* args[] = {&p};
    hipError_t e = hipLaunchCooperativeKernel((const void*)mk::mega, dim3(grid), dim3(mk::NTHR), args, mk::LDS_BYTES, stream);
    if (e != hipSuccess) fprintf(stderr, "cooperative launch failed: %s (grid %d)\n", hipGetErrorString(e), grid);
#else
    for (int ph = 0; ph < mk::N_PHASES; ++ph) { p.ph_lo = ph; p.ph_hi = ph + 1;
        hipLaunchKernelGGL(mk::mega, dim3(grid), dim3(mk::NTHR), mk::LDS_BYTES, stream, p); }
#endif
}
```

```cpp
#include <hip/hip_runtime.h>
#include <hip/hip_cooperative_groups.h>
#include <cstdio>
#include <cstdint>
#ifndef ONE_LAUNCH
#define ONE_LAUNCH 1
#endif
namespace cg = cooperative_groups;
typedef __bf16 mk_bf16x2_t __attribute__((ext_vector_type(2)));
typedef float mk_f32x2_t __attribute__((ext_vector_type(2)));
__device__ __forceinline__ unsigned mk_pk2(float lo, float hi) { mk_f32x2_t v = {lo, hi}; mk_bf16x2_t b = __builtin_convertvector(v, mk_bf16x2_t); return __builtin_bit_cast(unsigned, b); }
__device__ __forceinline__ float mk_lo(unsigned w) { return __uint_as_float(w << 16); }
__device__ __forceinline__ float mk_hi(unsigned w) { return __uint_as_float(w & 0xffff0000u); }
__device__ __forceinline__ float mk_sigm(float x) { return __builtin_amdgcn_rcpf(1.0f + __expf(-x)); }
__device__ __forceinline__ float mk_gelu(float x) { const float u = 1.5957691216f * (x + 0.044715f * x * x * x); return x * __builtin_amdgcn_rcpf(1.0f + __expf(-u)); }
namespace pg8 {
#define PG8_LAS __attribute__((address_space(3)))
typedef unsigned short bf16_t;
typedef short bf16x8 __attribute__((ext_vector_type(8)));
typedef float f32x4 __attribute__((ext_vector_type(4)));
typedef unsigned u32x4 __attribute__((ext_vector_type(4)));
constexpr int BM = 256, BK = 64, HALF = 128, HTB = HALF * BK * 2  , STAGE_BYTES = 8 * HTB, NXCD = 8, WGM = 8;

__host__ __device__ __forceinline__ int lds_byte(int r, int c) { const int st = (r >> 4) * 2 + (c >> 5), rr = r & 15, cc = c & 31, ob = rr * 64 + cc * 2; return st * 1024 + (ob ^ (((ob >> 9) & 1) << 5)); }
__host__ __device__ __forceinline__ void stage_rc(int b, int& R, int& C) { const int st = b / 1024, sb = b % 1024, swz = sb ^ (((sb >> 9) & 1) << 5); R = (st >> 1) * 16 + swz / 64; C = (st & 1) * 32 + (swz % 64) / 2; }
__host__ __device__ __forceinline__ int perm32(int rho) { const int n = rho >> 4, i = rho & 15; return 8 * (i >> 2) + 4 * n + (i & 3); }

struct Unit { int pm, pn; };
struct Gemm { const bf16_t* A; const bf16_t* Bt; int M, N, K; };

struct StaticOrder {
    int nM, nN, nwg, G, c;
    __host__ __device__ void init(int M, int N, int G_, int c_) { nM = M / BM; nN = N / BM; nwg = nM * nN; G = G_; c = c_; }
    __host__ __device__ bool next(int i, Unit& u) const {
        const long L = (long)i * G + c; if (L >= nwg) return false;
        int wgid = (int)L; { const int q = nwg / NXCD, r = nwg % NXCD, xcd = wgid % NXCD, off = wgid / NXCD; wgid = (xcd < r ? xcd * (q + 1) : r * (q + 1) + (xcd - r) * q) + off; }
        const int nig = WGM * nN, gid = wgid / nig, fm = gid * WGM, gsz = (nM - fm) < WGM ? (nM - fm) : WGM;
        u.pm = fm + ((wgid % nig) % gsz); u.pn = (wgid % nig) / gsz; return true;
    }
    __device__ __forceinline__ void a_ready(const Unit&) const {}
    __device__ __forceinline__ void done(const Unit&) const {}
};
typedef unsigned u32x2 __attribute__((ext_vector_type(2)));
constexpr int MK_TOK = 32768;
#define MK_EPI_LOOP_AM _Pragma("unroll") for (int ai = 0; ai < 2; ++ai) _Pragma("unroll") for (int m = 0; m < 4; ++m)
__device__ __forceinline__ u32x4 pack8(const f32x4 a, const f32x4 b) { u32x4 w; w.x = mk_pk2(a[0], a[1]); w.y = mk_pk2(a[2], a[3]); w.z = mk_pk2(b[0], b[1]); w.w = mk_pk2(b[2], b[3]); return w; }
__device__ __forceinline__ void unpack8(const u32x4 w, f32x4& a, f32x4& b) { a = (f32x4){mk_lo(w.x), mk_hi(w.x), mk_lo(w.y), mk_hi(w.y)}; b = (f32x4){mk_lo(w.z), mk_hi(w.z), mk_lo(w.w), mk_hi(w.w)}; }
__device__ __forceinline__ float rstd_of(float ss) { return rsqrtf(ss * (1.0f / 1024.0f) + 1e-6f); }

struct EpiProj { static constexpr bool PERM = true, AFTER_DRAIN = false; bf16_t* P; const float* rowss;
    __device__ __forceinline__ void operator()(const f32x4 (&acc)[2][2][4][2], const Unit& u, int wr, int wc, int fr, int fq) const {
        const int row0 = u.pm * BM + wr * 64 + fr;
        bf16_t* base = P + (size_t)(u.pn >> 1) * ((size_t)MK_TOK * 512) + (u.pn & 1) * 256 + wc * 32 + 8 * fq;
        MK_EPI_LOOP_AM { const int row = row0 + ai * HALF + m * 16; const float rs = rstd_of(rowss[row]); bf16_t* rp = base + (size_t)row * 512;
#pragma unroll
            for (int bj = 0; bj < 2; ++bj) *(u32x4*)(rp + bj * HALF) = pack8(acc[ai][bj][m][0] * rs, acc[ai][bj][m][1] * rs); }
    }
};
struct EpiVT { static constexpr bool PERM = true, AFTER_DRAIN = false; bf16_t* VT; const float* rowss;
    __device__ __forceinline__ void operator()(const f32x4 (&acc)[2][2][4][2], const Unit& u, int wr, int wc, int fr, int fq) const {
        const int row0 = u.pm * BM + wr * 64 + fr, col0 = u.pn * BM + wc * 32 + 8 * fq;
        f32x4 rs[2][2];
#pragma unroll
        for (int bj = 0; bj < 2; ++bj)
#pragma unroll
            for (int n = 0; n < 2; ++n) { const f32x4 s = *(const f32x4*)(rowss + col0 + bj * HALF + 4 * n); rs[bj][n] = (f32x4){rstd_of(s[0]), rstd_of(s[1]), rstd_of(s[2]), rstd_of(s[3])}; }
        MK_EPI_LOOP_AM { const int row = row0 + ai * HALF + m * 16; bf16_t* rp = VT + (size_t)row * MK_TOK + col0;
#pragma unroll
            for (int bj = 0; bj < 2; ++bj) *(u32x4*)(rp + bj * HALF) = pack8(acc[ai][bj][m][0] * rs[bj][0], acc[ai][bj][m][1] * rs[bj][1]); }
    }
};
struct EpiGlu { static constexpr bool PERM = true, AFTER_DRAIN = false; const bf16_t* YG; bf16_t* O; const float* bias;
    __device__ __forceinline__ void operator()(const f32x4 (&acc)[2][2][4][2], const Unit& u, int wr, int wc, int fr, int fq) const {
        const int row0 = u.pm * BM + wr * 64 + fr, col0 = u.pn * BM + wc * 32 + 8 * fq;
        f32x4 bv[2][2];
#pragma unroll
        for (int bj = 0; bj < 2; ++bj)
#pragma unroll
            for (int n = 0; n < 2; ++n) bv[bj][n] = *(const f32x4*)(bias + col0 + bj * HALF + 4 * n);
        MK_EPI_LOOP_AM { const int row = row0 + ai * HALF + m * 16; const size_t off = (size_t)row * 512 + col0;
#pragma unroll
            for (int bj = 0; bj < 2; ++bj) { f32x4 y0, y1; unpack8(*(const u32x4*)(YG + off + bj * HALF), y0, y1);
                f32x4 a0 = acc[ai][bj][m][0] + bv[bj][0], a1 = acc[ai][bj][m][1] + bv[bj][1];
#pragma unroll
                for (int j = 0; j < 4; ++j) { y0[j] *= mk_sigm(a0[j]); y1[j] *= mk_sigm(a1[j]); }
                *(u32x4*)(O + off + bj * HALF) = pack8(y0, y1); } }
    }
};
struct EpiGate { static constexpr bool PERM = true, AFTER_DRAIN = false; bf16_t* GS; const float* rowss;
    __device__ __forceinline__ void operator()(const f32x4 (&acc)[2][2][4][2], const Unit& u, int wr, int wc, int fr, int fq) const {
        const int row0 = u.pm * BM + wr * 64 + fr, col0 = u.pn * BM + wc * 32 + 8 * fq;
        MK_EPI_LOOP_AM { const int row = row0 + ai * HALF + m * 16; const float rs = rstd_of(rowss[row]); const size_t off = (size_t)row * 1024 + col0;
#pragma unroll
            for (int bj = 0; bj < 2; ++bj) { f32x4 a0 = acc[ai][bj][m][0] * rs, a1 = acc[ai][bj][m][1] * rs;
#pragma unroll
                for (int j = 0; j < 4; ++j) { a0[j] = mk_sigm(a0[j]); a1[j] = mk_sigm(a1[j]); }
                *(u32x4*)(GS + off + bj * HALF) = pack8(a0, a1); } }
    }
};
template <bool FIRST> struct EpiBr { static constexpr bool PERM = true, AFTER_DRAIN = false; const bf16_t* GS; bf16_t* MG;
    __device__ __forceinline__ void operator()(const f32x4 (&acc)[2][2][4][2], const Unit& u, int wr, int wc, int fr, int fq) const {
        const int row0 = u.pm * BM + wr * 64 + fr, col0 = u.pn * BM + wc * 32 + 8 * fq;
        MK_EPI_LOOP_AM { const int row = row0 + ai * HALF + m * 16; const size_t off = (size_t)row * 1024 + col0;
#pragma unroll
            for (int bj = 0; bj < 2; ++bj) { f32x4 g0, g1; unpack8(*(const u32x4*)(GS + off + bj * HALF), g0, g1);
                f32x4 v0 = g0 * acc[ai][bj][m][0], v1 = g1 * acc[ai][bj][m][1];
                if (!FIRST) { f32x4 p0, p1; unpack8(*(const u32x4*)(MG + off + bj * HALF), p0, p1); v0 += p0; v1 += p1; }
                *(u32x4*)(MG + off + bj * HALF) = pack8(v0, v1); } }
    }
};
struct EpiResid { static constexpr bool PERM = false, AFTER_DRAIN = false; const float* xold; float* out; bf16_t* xb; float* rowss_next;
    __device__ __forceinline__ void operator()(const f32x4 (&acc)[2][2][4][2], const Unit& u, int wr, int wc, int fr, int fq) const {
        const int row0 = u.pm * BM + wr * 64 + fr, col0 = u.pn * BM + wc * 32 + 4 * fq;
        MK_EPI_LOOP_AM { const int row = row0 + ai * HALF + m * 16; const size_t off = (size_t)row * 1024 + col0; float ss = 0.f;
#pragma unroll
            for (int bj = 0; bj < 2; ++bj)
#pragma unroll
                for (int n = 0; n < 2; ++n) { const size_t o = off + bj * HALF + n * 16; const f32x4 xn = *(const f32x4*)(xold + o) + acc[ai][bj][m][n];
                    *(f32x4*)(out + o) = xn; u32x2 w; w.x = mk_pk2(xn[0], xn[1]); w.y = mk_pk2(xn[2], xn[3]); *(u32x2*)(xb + o) = w;
                    ss += (xn[0] * xn[0] + xn[1] * xn[1]) + (xn[2] * xn[2] + xn[3] * xn[3]); }
            ss += __shfl_xor(ss, 16); ss += __shfl_xor(ss, 32);
            if (fq == 0) __hip_atomic_fetch_add(rowss_next + row, ss, __ATOMIC_RELAXED, __HIP_MEMORY_SCOPE_AGENT); }
    }
};
struct EpiFfnUp { static constexpr bool PERM = true, AFTER_DRAIN = false; bf16_t* H; const float* rowss;
    __device__ __forceinline__ void operator()(const f32x4 (&acc)[2][2][4][2], const Unit& u, int wr, int wc, int fr, int fq) const {
        const int row0 = u.pm * BM + wr * 64 + fr, col0 = u.pn * HALF + wc * 32 + 8 * fq;
        MK_EPI_LOOP_AM { const int row = row0 + ai * HALF + m * 16; const float rs = rstd_of(rowss[row]);
            f32x4 g0 = acc[ai][0][m][0] * rs, g1 = acc[ai][0][m][1] * rs, u0 = acc[ai][1][m][0] * rs, u1 = acc[ai][1][m][1] * rs;
#pragma unroll
            for (int j = 0; j < 4; ++j) { g0[j] = g0[j] * mk_sigm(g0[j]) * u0[j]; g1[j] = g1[j] * mk_sigm(g1[j]) * u1[j]; }
            *(u32x4*)(H + (size_t)row * 2816 + col0) = pack8(g0, g1); }
    }
};
template <class Epi, class Sched, bool STAMP = false>
__device__ __forceinline__ void gemm_phase(PG8_LAS unsigned char* lds, const Gemm g, const Sched& S, const Epi& E, unsigned long long* stamps) {
    int tid_l = threadIdx.x; asm volatile("" : "+v"(tid_l)); const int tid = tid_l, wid = __builtin_amdgcn_readfirstlane(tid >> 6), lane = tid & 63, wr = wid >> 2, wc = wid & 3, fr = lane & 15, fq = lane >> 4;
    const int K = g.K, nt = K / BK;
    int ts_lo = 0, ts_hi = 0, nts = 0; const unsigned long long rt_entry = STAMP ? (unsigned long long)wall_clock64() : 0ull;
#define PG8_STAMP() do { if (STAMP && wid == 0 && nts < 64) { const unsigned long long _c = (unsigned long long)clock64(); \
        ts_lo = (lane == nts) ? (int)(unsigned)_c : ts_lo; ts_hi = (lane == nts) ? (int)(unsigned)(_c >> 32) : ts_hi; ++nts; } } while (0)
    PG8_STAMP();
    unsigned voffA[2], voffB[2];
#pragma unroll
    for (int i = 0; i < 2; ++i) { int R, C; stage_rc(tid * 16 + i * 8192, R, C); const int Rb = Epi::PERM ? ((R & ~31) + perm32(R & 31)) : R;
        voffA[i] = (unsigned)(R * K + C) * 2u; voffB[i] = (unsigned)(Rb * K + C) * 2u; }
    const size_t kstep = (size_t)(BK * 2);
    const size_t hstep = (size_t)HALF * K * 2;
    const size_t tstep = 2 * hstep;
    const unsigned ldsw = (unsigned)wid * 1024u;
    const int aoff = lds_byte(wr * 64 + fr, fq * 8), boff = lds_byte(wc * 32 + fr, fq * 8);
#define PG8_SA(b, h) (((b) * 2 + (h)) * HTB)
#define PG8_SB(b, h) ((4 + (b) * 2 + (h)) * HTB)
#define PG8_STAGE(bufoff, gbase, voff) do { _Pragma("unroll") for (int _i = 0; _i < 2; ++_i) \
        __builtin_amdgcn_global_load_lds((const unsigned*)((const char*)(gbase) + (voff)[_i]), (PG8_LAS unsigned*)(lds + (bufoff) + ldsw + _i * 8192), 16, 0, 0); } while (0)
#define PG8_LDA(dst, b, h) do { _Pragma("unroll") for (int m = 0; m < 4; ++m) _Pragma("unroll") for (int k = 0; k < 2; ++k) dst[m][k] = *(const PG8_LAS bf16x8*)(lds + PG8_SA(b, h) + aoff + m * 2048 + k * 1024); } while (0)
#define PG8_LDB(dst, b, h) do { _Pragma("unroll") for (int n = 0; n < 2; ++n) _Pragma("unroll") for (int k = 0; k < 2; ++k) dst[n][k] = *(const PG8_LAS bf16x8*)(lds + PG8_SB(b, h) + boff + n * 2048 + k * 1024); } while (0)
#define PG8_MMA(ai, bj, At, Bt) do { __builtin_amdgcn_s_setprio(1); _Pragma("unroll") for (int m = 0; m < 4; ++m) _Pragma("unroll") for (int n = 0; n < 2; ++n) _Pragma("unroll") for (int k = 0; k < 2; ++k) \
        acc[ai][bj][m][n] = __builtin_amdgcn_mfma_f32_16x16x32_bf16(Bt[n][k], At[m][k], acc[ai][bj][m][n], 0, 0, 0); __builtin_amdgcn_s_setprio(0); } while (0)
#define PG8_WAIT_V(n) asm volatile("s_waitcnt vmcnt(" #n ")" ::: "memory")
#define PG8_WAIT_L(n) asm volatile("s_waitcnt lgkmcnt(" #n ")" ::: "memory")
#define PG8_BAR __builtin_amdgcn_s_barrier()
#define PG8_SCHED __builtin_amdgcn_sched_barrier(0)
    Unit cur, nxt; int ui = 0;
    if (!S.next(0, cur)) return;
    f32x4 acc[2][2][4][2];
#pragma unroll
    for (int a = 0; a < 2; ++a)
#pragma unroll
        for (int b = 0; b < 2; ++b)
#pragma unroll
            for (int m = 0; m < 4; ++m)
#pragma unroll
                for (int n = 0; n < 2; ++n) acc[a][b][m][n] = (f32x4){0.f, 0.f, 0.f, 0.f};
    bf16x8 At[4][2], B0[2][2], B1[2][2];
    const char* cA = (const char*)g.A + (size_t)cur.pm * tstep; const char* cB = (const char*)g.Bt + (size_t)cur.pn * tstep;
    S.a_ready(cur);
    PG8_STAGE(PG8_SB(0, 0), cB, voffB); PG8_STAGE(PG8_SA(0, 0), cA, voffA); PG8_STAGE(PG8_SB(0, 1), cB + hstep, voffB); PG8_STAGE(PG8_SA(0, 1), cA + hstep, voffA);
    if (wr == 1) PG8_BAR;
    PG8_WAIT_V(4); PG8_BAR;
    PG8_STAGE(PG8_SB(1, 0), cB + kstep, voffB); PG8_STAGE(PG8_SA(1, 0), cA + kstep, voffA); PG8_STAGE(PG8_SB(1, 1), cB + hstep + kstep, voffB);
    PG8_WAIT_V(6); PG8_BAR;
    PG8_STAMP();
    for (;;) {
        const bool has_next = S.next(ui + 1, nxt);
        const char* nA = has_next ? (const char*)g.A + (size_t)nxt.pm * tstep : cA; const char* nB = has_next ? (const char*)g.Bt + (size_t)nxt.pn * tstep : cB;
        for (int t = 0; t < nt; t += 2) {
            const bool last = (t == nt - 2);
            const char* a1 = cA + (size_t)(t + 1) * kstep;
            const char* a2 = last ? nA : cA + (size_t)(t + 2) * kstep; const char* b2 = last ? nB : cB + (size_t)(t + 2) * kstep;
            const char* a3 = a2 + kstep; const char* b3 = b2 + kstep;
            if (last && has_next) S.a_ready(nxt);
            PG8_LDB(B0, 0, 0); PG8_SCHED; PG8_LDA(At, 0, 0); PG8_STAGE(PG8_SA(1, 1), a1 + hstep, voffA);
            PG8_WAIT_L(8); PG8_BAR; PG8_WAIT_L(0); PG8_MMA(0, 0, At, B0); PG8_BAR; PG8_SCHED;
            PG8_LDB(B1, 0, 1); PG8_STAGE(PG8_SB(0, 0), b2, voffB);
            PG8_BAR; PG8_WAIT_L(0); PG8_MMA(0, 1, At, B1); PG8_BAR;
            PG8_LDA(At, 0, 1); PG8_STAGE(PG8_SA(0, 0), a2, voffA);
            PG8_BAR; PG8_WAIT_L(0); PG8_MMA(1, 0, At, B0); PG8_BAR; PG8_SCHED;
            PG8_STAGE(PG8_SB(0, 1), b2 + hstep, voffB);
            PG8_WAIT_V(6); PG8_BAR; PG8_MMA(1, 1, At, B1); PG8_BAR;
            PG8_LDB(B0, 1, 0); PG8_SCHED; PG8_LDA(At, 1, 0); PG8_STAGE(PG8_SA(0, 1), a2 + hstep, voffA);
            PG8_WAIT_L(8); PG8_BAR; PG8_WAIT_L(0); PG8_MMA(0, 0, At, B0); PG8_BAR; PG8_SCHED;
            PG8_LDB(B1, 1, 1); PG8_STAGE(PG8_SB(1, 0), b3, voffB);
            PG8_BAR; PG8_WAIT_L(0); PG8_MMA(0, 1, At, B1); PG8_BAR;
            PG8_LDA(At, 1, 1); PG8_STAGE(PG8_SA(1, 0), a3, voffA);
            PG8_BAR; PG8_WAIT_L(0); PG8_MMA(1, 0, At, B0); PG8_BAR; PG8_SCHED;
            PG8_STAGE(PG8_SB(1, 1), b3 + hstep, voffB);
            PG8_WAIT_V(6); PG8_BAR; PG8_MMA(1, 1, At, B1); PG8_BAR;
        }
        PG8_STAMP();
        if constexpr (!Epi::AFTER_DRAIN) { E(acc, cur, wr, wc, fr, fq); S.done(cur); }
        PG8_STAMP();
        if (!has_next) break;
#pragma unroll
        for (int a = 0; a < 2; ++a)
#pragma unroll
            for (int b = 0; b < 2; ++b)
#pragma unroll
                for (int m = 0; m < 4; ++m)
#pragma unroll
                    for (int n = 0; n < 2; ++n) acc[a][b][m][n] = (f32x4){0.f, 0.f, 0.f, 0.f};
        cur = nxt; cA = nA; cB = nB; ++ui;
    }
    PG8_WAIT_V(0);
    if (wr == 0) PG8_BAR;
    PG8_BAR;
    if constexpr (Epi::AFTER_DRAIN) { E.fused(acc, cur, wr, wc, fr, fq, lds, wid, lane); S.done(cur); }
    PG8_STAMP();
    if (STAMP && wid == 0) { stamps[lane] = lane < nts ? (((unsigned long long)(unsigned)ts_hi << 32) | (unsigned)ts_lo) : 0ull;
        if (lane == 62) stamps[62] = rt_entry; if (lane == 63) stamps[63] = (unsigned long long)wall_clock64(); }
#undef PG8_STAMP
#undef PG8_SA
#undef PG8_SB
#undef PG8_STAGE
#undef PG8_LDA
#undef PG8_LDB
#undef PG8_MMA
#undef PG8_WAIT_V
#undef PG8_WAIT_L
#undef PG8_BAR
#undef PG8_SCHED
}
}

namespace mk {
#define LAS __attribute__((address_space(3)))
#define DI __device__ __forceinline__
typedef unsigned short bf16;
typedef pg8::bf16x8 bf16x8; typedef pg8::f32x4 f32x4; typedef pg8::u32x4 u32x4; typedef pg8::u32x2 u32x2;
typedef float f32x16 __attribute__((ext_vector_type(16)));
constexpr int TOK = 32768, DM = 1024, SEQ = 4096, BW = 512, FFH = 2816, NTHR = 512;
constexpr size_t MiB = 1024 * 1024;
constexpr size_t WS_ROWSS = 0;
constexpr size_t WS_BAR = 768 * 1024;
constexpr size_t WS_BB = 1 * MiB;
constexpr size_t WS_CM = WS_BB + 262144;
constexpr size_t WS_AP = WS_CM + 262144;
constexpr size_t WS_SGW = WS_AP + 131072;
constexpr size_t WS_E = 2 * MiB;
constexpr size_t WS_W = 10 * MiB;
constexpr size_t WL_IN = 0, WL_GLU = 17825792, WL_BR = WL_GLU + 524288, WL_O = WL_BR + 4194304, WL_FF = WL_O + 2097152, WL_D = WL_FF + 11534336, WL_SIZE = WL_D + 5767168;
static_assert(WL_SIZE == 40 * MiB, "weights per layer");
constexpr size_t WS_XB = 90 * MiB;
constexpr size_t WS_P = 154 * MiB;
constexpr size_t PBUF = 32 * MiB;
constexpr size_t WS_YG = WS_P + 9 * PBUF;
constexpr size_t WS_END = WS_YG + 32 * MiB;
constexpr int LDS_BYTES = 143360;

DI float bf2f(bf16 v) { return __uint_as_float(((unsigned)v) << 16); }
DI bf16 f2bf(float f) { return (bf16)(mk_pk2(f, 0.f) & 0xffffu); }
DI float wave_sum(float v) {
#pragma unroll
    for (int o = 1; o < 64; o <<= 1) v += __shfl_xor(v, o);
    return v; }
DI f32x16 mfma32(bf16x8 a, bf16x8 b, f32x16 c) { return __builtin_amdgcn_mfma_f32_32x32x16_bf16(a, b, c, 0, 0, 0); }
DI f32x4 mfma16(bf16x8 a, bf16x8 b, f32x4 c) { return __builtin_amdgcn_mfma_f32_16x16x32_bf16(a, b, c, 0, 0, 0); }
DI int crow(int i, int h) { return (i & 3) + 8 * (i >> 2) + 4 * h; }
DI f32x16 zero16() { f32x16 z;
#pragma unroll
    for (int i = 0; i < 16; ++i) z[i] = 0.f;
    return z; }
#define LDS_WAIT() asm volatile("s_waitcnt lgkmcnt(0)" ::: "memory")

struct Params { const float* in[28]; float* out; unsigned char* ws; int ph_lo, ph_hi; };
enum { I_X = 0, I_GMIX, I_WIN, I_CONVW, I_CONVB, I_SGW, I_SGB, I_LNG, I_LNB, I_LAMQK, I_SUBLN, I_ARE, I_AIM, I_LOGDT, I_BRE, I_BIM, I_CRE, I_CIM, I_SSMD, I_WGLU, I_BGLU, I_WBR, I_WO, I_GFFN, I_WFG, I_WFU, I_WFD, I_GFIN };

DI void tr_item(const float* W, int ldn, int k0, int n0, const float* gs, bf16* WT, int ldk, int drow0, LAS float* scr, int lane) {
    float tv[32];
#pragma unroll
    for (int i = 0; i < 32; ++i) { const int kk = 2 * i + (lane >> 5); tv[i] = W[(size_t)(k0 + kk) * ldn + n0 + (lane & 31)]; }
    if (gs) {
#pragma unroll
        for (int i = 0; i < 32; ++i) tv[i] *= gs[k0 + 2 * i + (lane >> 5)]; }
#pragma unroll
    for (int i = 0; i < 32; ++i) scr[(2 * i + (lane >> 5)) * 33 + (lane & 31)] = tv[i];
    LDS_WAIT();
    const int c = lane & 7;
#pragma unroll
    for (int j = 0; j < 4; ++j) { const int n = (lane >> 3) + 8 * j; const LAS float* s = scr + (8 * c) * 33 + n;
        u32x4 o; o.x = mk_pk2(s[0 * 33], s[1 * 33]); o.y = mk_pk2(s[2 * 33], s[3 * 33]); o.z = mk_pk2(s[4 * 33], s[5 * 33]); o.w = mk_pk2(s[6 * 33], s[7 * 33]);
        *(u32x4*)(WT + (size_t)(drow0 + n) * ldk + k0 + 8 * c) = o; }
    LDS_WAIT();
}
DI void dsincos(double x, double& s, double& c) {
    const double twopi = 6.283185307179586476925; const double k = rint(x / twopi); const double r = x - k * twopi, r2 = r * r;
    double ss = 1.0, cc = 1.0;
#pragma unroll
    for (int n = 13; n >= 1; --n) { ss = 1.0 - r2 * (1.0 / ((2.0 * n) * (2.0 * n + 1.0))) * ss; cc = 1.0 - r2 * (1.0 / ((2.0 * n - 1.0) * (2.0 * n))) * cc; }
    s = ss * r; c = cc;
}
DI void phase_prep(const Params& p, LAS unsigned char* lds, int tid, int lane, int wave, int G) {
    unsigned char* ws = p.ws;
    const int gw = blockIdx.x * 8 + wave, NGW = G * 8, gt = blockIdx.x * NTHR + tid, NGT = G * NTHR;
    LAS float* scr = (LAS float*)(lds + wave * 8704);
    for (int l = 0; l < 2; ++l) {
        unsigned char* wl = ws + WS_W + (size_t)l * WL_SIZE;
        for (int mi = 0; mi < 10; ++mi) {
            const float* src; int K, N; const float* gs = nullptr; bf16* dst; int map = 0;
            if (mi == 0) { src = p.in[I_WIN] + (size_t)l * 1024 * 8704; K = 1024; N = 8704; gs = p.in[I_GMIX] + l * 1024; dst = (bf16*)(wl + WL_IN); map = 1; }
            else if (mi == 1) { src = p.in[I_WGLU] + (size_t)l * 512 * 512; K = 512; N = 512; dst = (bf16*)(wl + WL_GLU); }
            else if (mi < 6) { const int b = mi - 2; src = p.in[I_WBR] + ((size_t)l * 4 + b) * 512 * 1024; K = 512; N = 1024; dst = (bf16*)(wl + WL_BR) + (size_t)b * 1024 * 512; }
            else if (mi == 6) { src = p.in[I_WO] + (size_t)l * 1024 * 1024; K = 1024; N = 1024; dst = (bf16*)(wl + WL_O); }
            else if (mi == 7) { src = p.in[I_WFG] + (size_t)l * 1024 * 2816; K = 1024; N = 2816; gs = p.in[I_GFFN] + l * 1024; dst = (bf16*)(wl + WL_FF); map = 2; }
            else if (mi == 8) { src = p.in[I_WFU] + (size_t)l * 1024 * 2816; K = 1024; N = 2816; gs = p.in[I_GFFN] + l * 1024; dst = (bf16*)(wl + WL_FF); map = 3; }
            else { src = p.in[I_WFD] + (size_t)l * 2816 * 1024; K = 2816; N = 1024; dst = (bf16*)(wl + WL_D); }
            const int nblk = N / 32, nit = (K / 64) * nblk;
            for (int it = gw; it < nit; it += NGW) {
                const int kb = it / nblk, nb = it % nblk, n0 = nb * 32; int dr = n0;
                if (map == 1) { if (n0 >= 3584 && n0 < 4096) dr = n0 + 512; else if (n0 >= 4096 && n0 < 4608) dr = n0 - 512; }
                else if (map == 2) dr = (n0 >> 7) * 256 + (n0 & 127);
                else if (map == 3) dr = (n0 >> 7) * 256 + 128 + (n0 & 127);
                tr_item(src, N, kb * 64, n0, gs, dst, K, dr, scr, lane);
            }
        }
    }
    { const float* x = p.in[I_X]; bf16* xb = (bf16*)(ws + WS_XB); float* rowss = (float*)(ws + WS_ROWSS);
        for (int row0 = gw * 4; row0 < TOK; row0 += NGW * 4) { f32x4 v[4][4];
#pragma unroll
            for (int q = 0; q < 4; ++q)
#pragma unroll
                for (int j = 0; j < 4; ++j) v[q][j] = *((const f32x4*)(x + (size_t)(row0 + q) * DM) + lane + 64 * j);
#pragma unroll
            for (int q = 0; q < 4; ++q) { float ss = 0.f;
#pragma unroll
                for (int j = 0; j < 4; ++j) { const f32x4 t = v[q][j]; ss += (t[0] * t[0] + t[1] * t[1]) + (t[2] * t[2] + t[3] * t[3]);
                    u32x2 w; w.x = mk_pk2(t[0], t[1]); w.y = mk_pk2(t[2], t[3]); *((u32x2*)(xb + (size_t)(row0 + q) * DM) + lane + 64 * j) = w; }
                ss = wave_sum(ss); if (lane == 0) rowss[row0 + q] = ss; } }
        for (int i = gt; i < 4 * TOK; i += NGT) rowss[TOK + i] = 0.f; }
    { const float* sgw = p.in[I_SGW]; bf16* o = (bf16*)(ws + WS_SGW);
        for (int i = gt; i < 2 * 4 * 128 * 128; i += NGT) { const int s = i & 127, t = (i >> 7) & 127; o[i] = f2bf(s <= t ? sgw[i] : 0.f); } }
    for (int i = gt; i < 2 * 32 * 64; i += NGT) {
        const int pp = i & 63, lg = i >> 6;
        const double dt = exp((double)p.in[I_LOGDT][lg]); const double are = p.in[I_ARE][i], aim = p.in[I_AIM][i];
        const double mag = exp(dt * are); double sn, cs; dsincos(dt * aim, sn, cs);
        const double abr = mag * cs, abi = mag * sn, den = are * are + aim * aim, nr = abr - 1.0, ni = abi;
        const double cr = (nr * are + ni * aim) / den, ci = (ni * are - nr * aim) / den;
        bf16* bb = (bf16*)(ws + WS_BB) + (size_t)lg * 128 * 16; const float* bre = p.in[I_BRE] + (size_t)i * 16; const float* bim = p.in[I_BIM] + (size_t)i * 16;
        for (int h = 0; h < 16; ++h) { const double br = bre[h], bi = bim[h]; bb[pp * 16 + h] = f2bf((float)(cr * br - ci * bi)); bb[(64 + pp) * 16 + h] = f2bf((float)(cr * bi + ci * br)); }
        bf16* cm = (bf16*)(ws + WS_CM) + (size_t)lg * 16 * 128; const float* cre = p.in[I_CRE] + (size_t)lg * 16 * 64; const float* cim = p.in[I_CIM] + (size_t)lg * 16 * 64;
        for (int h = 0; h < 16; ++h) { cm[h * 128 + pp] = f2bf(cre[h * 64 + pp]); cm[h * 128 + 64 + pp] = f2bf(-cim[h * 64 + pp]); }
        double pr = abr, pi = abi; float* ap = (float*)(ws + WS_AP) + (size_t)i * 8; ap[0] = (float)pr; ap[1] = (float)pi;
        for (int q = 0; q < 5; ++q) { const double t = pr * pr - pi * pi; pi = 2.0 * pr * pi; pr = t; }
        ap[2] = (float)pr; ap[3] = (float)pi;
        { const double t = pr * pr - pi * pi; pi = 2.0 * pr * pi; pr = t; }
        ap[4] = (float)pr; ap[5] = (float)pi; ap[6] = 0.f; ap[7] = 0.f;
    }
}

DI void phase_branchA(const Params& p, int l, int tid, int G) {
    bf16* AB = (bf16*)(p.ws + WS_P); const bf16* AC = (const bf16*)(p.ws + WS_P + PBUF); const bf16* AX = (const bf16*)(p.ws + WS_P + 2 * PBUF);
    const float* cw = p.in[I_CONVW] + l * 3 * 512; const float* cb = p.in[I_CONVB] + l * 512;
    for (int idx = blockIdx.x * NTHR + tid; idx < (TOK / 16) * 64; idx += G * NTHR) {
        const int cgp = idx & 63, run = idx >> 6, c0 = cgp * 8, t0 = run * 16;
        f32x4 w0[2], w1[2], w2[2], bb[2];
#pragma unroll
        for (int e = 0; e < 2; ++e) { w0[e] = *(const f32x4*)(cw + c0 + 4 * e); w1[e] = *(const f32x4*)(cw + 512 + c0 + 4 * e); w2[e] = *(const f32x4*)(cw + 1024 + c0 + 4 * e); bb[e] = *(const f32x4*)(cb + c0 + 4 * e); }
        f32x4 zm2[2] = {{0.f, 0.f, 0.f, 0.f}, {0.f, 0.f, 0.f, 0.f}}, zm1[2] = {{0.f, 0.f, 0.f, 0.f}, {0.f, 0.f, 0.f, 0.f}};
        if ((t0 & (SEQ - 1)) != 0) {
            f32x4 a0, a1, x0, x1;
            pg8::unpack8(*(const u32x4*)(AC + (size_t)(t0 - 2) * 512 + c0), a0, a1); pg8::unpack8(*(const u32x4*)(AX + (size_t)(t0 - 2) * 512 + c0), x0, x1); zm2[0] = a0 * x0; zm2[1] = a1 * x1;
            pg8::unpack8(*(const u32x4*)(AC + (size_t)(t0 - 1) * 512 + c0), a0, a1); pg8::unpack8(*(const u32x4*)(AX + (size_t)(t0 - 1) * 512 + c0), x0, x1); zm1[0] = a0 * x0; zm1[1] = a1 * x1;
        }
#pragma unroll 4
        for (int i = 0; i < 16; ++i) { const size_t off = (size_t)(t0 + i) * 512 + c0;
            f32x4 a0, a1, x0, x1, b0, b1; pg8::unpack8(*(const u32x4*)(AC + off), a0, a1); pg8::unpack8(*(const u32x4*)(AX + off), x0, x1); pg8::unpack8(*(const u32x4*)(AB + off), b0, b1);
            const f32x4 z0 = a0 * x0, z1 = a1 * x1;
            const f32x4 y0 = b0 * (w0[0] * zm2[0] + w1[0] * zm1[0] + w2[0] * z0 + bb[0]), y1 = b1 * (w0[1] * zm2[1] + w1[1] * zm1[1] + w2[1] * z1 + bb[1]);
            *(u32x4*)(AB + off) = pg8::pack8(y0, y1);
            zm2[0] = zm1[0]; zm2[1] = zm1[1]; zm1[0] = z0; zm1[1] = z1; }
    }
}

DI void phase_branchB(const Params& p, int l, LAS unsigned char* lds, int tid, int lane, int wave, int G) {
    bf16* BU = (bf16*)(p.ws + WS_P + 3 * PBUF); const bf16* BV = (const bf16*)(p.ws + WS_P + 4 * PBUF);
    const bf16* SGW = (const bf16*)(p.ws + WS_SGW) + (size_t)l * 4 * 128 * 128; const float* sgb = p.in[I_SGB] + l * 4 * 128;
    const float* lng = p.in[I_LNG] + l * 512 + lane * 8; const float* lnb = p.in[I_LNB] + l * 512 + lane * 8;
    constexpr int RS = 1040;
    const int r = lane & 31, half = lane >> 5;
    for (int item = blockIdx.x; item < TOK / 128; item += G) {
        const int tok0 = item * 128;
        { const f32x4 g0 = *(const f32x4*)lng, g1 = *(const f32x4*)(lng + 4), b0 = *(const f32x4*)lnb, b1 = *(const f32x4*)(lnb + 4);
            for (int tt = 0; tt < 16; ++tt) { const int s = wave * 16 + tt;
                f32x4 v0, v1; pg8::unpack8(*(const u32x4*)(BV + (size_t)(tok0 + s) * 512 + lane * 8), v0, v1);
#pragma unroll
                for (int j = 0; j < 4; ++j) { v0[j] = mk_gelu(v0[j]); v1[j] = mk_gelu(v1[j]); }
                const float mean = wave_sum((v0[0] + v0[1]) + (v0[2] + v0[3]) + (v1[0] + v1[1]) + (v1[2] + v1[3])) * (1.0f / 512.0f);
                v0 = v0 - mean; v1 = v1 - mean;
                const float var = wave_sum((v0[0] * v0[0] + v0[1] * v0[1]) + (v0[2] * v0[2] + v0[3] * v0[3]) + (v1[0] * v1[0] + v1[1] * v1[1]) + (v1[2] * v1[2] + v1[3] * v1[3])) * (1.0f / 512.0f);
                const float rstd = rsqrtf(var + 1e-5f);
                v0 = v0 * rstd * g0 + b0; v1 = v1 * rstd * g1 + b1;
                *(LAS u32x4*)(lds + s * RS + lane * 16) = pg8::pack8(v0, v1); } }
        __syncthreads();
        const int g = wave >> 1, dh = wave & 1;
        f32x16 acc[4][2];
#pragma unroll
        for (int a = 0; a < 4; ++a) { acc[a][0] = zero16(); acc[a][1] = zero16(); }
#pragma unroll
        for (int ks = 0; ks < 8; ++ks) {
            bf16x8 Vf[2];
#pragma unroll
            for (int dt = 0; dt < 2; ++dt) { const LAS unsigned short* vp = (const LAS unsigned short*)(lds + (16 * ks + 8 * half) * RS + (g * 128 + dh * 64 + dt * 32 + r) * 2);
#pragma unroll
                for (int j = 0; j < 8; ++j) Vf[dt][j] = (short)vp[j * (RS / 2)]; }
#pragma unroll
            for (int tt = ks >> 1; tt < 4; ++tt) { const bf16x8 Wf = *(const bf16x8*)(SGW + ((size_t)g * 128 + 32 * tt + r) * 128 + 16 * ks + 8 * half);
                acc[tt][0] = mfma32(Vf[0], Wf, acc[tt][0]); acc[tt][1] = mfma32(Vf[1], Wf, acc[tt][1]); }
        }
        asm volatile("s_nop 15\n\ts_nop 7" : "+v"(acc[0][0]), "+v"(acc[0][1]), "+v"(acc[1][0]), "+v"(acc[1][1]), "+v"(acc[2][0]), "+v"(acc[2][1]), "+v"(acc[3][0]), "+v"(acc[3][1]));
#pragma unroll
        for (int tt = 0; tt < 4; ++tt) { const int t = 32 * tt + r; const float bias = sgb[g * 128 + t];
#pragma unroll
            for (int dt = 0; dt < 2; ++dt)
#pragma unroll
                for (int ig = 0; ig < 4; ++ig) { bf16* up = BU + (size_t)(tok0 + t) * 512 + g * 128 + dh * 64 + dt * 32 + 8 * ig + 4 * half;
                    const u32x2 uw = *(const u32x2*)up;
                    const float y0 = mk_gelu(mk_lo(uw.x)) * (acc[tt][dt][4 * ig + 0] + bias), y1 = mk_gelu(mk_hi(uw.x)) * (acc[tt][dt][4 * ig + 1] + bias);
                    const float y2 = mk_gelu(mk_lo(uw.y)) * (acc[tt][dt][4 * ig + 2] + bias), y3 = mk_gelu(mk_hi(uw.y)) * (acc[tt][dt][4 * ig + 3] + bias);
                    u32x2 o; o.x = mk_pk2(y0, y1); o.y = mk_pk2(y2, y3); *(u32x2*)up = o; } }
        __syncthreads();
    }
}

DI void phase_attn(const Params& p, int l, LAS unsigned char* lds, int tid, int lane, int wave, int G, bf16* OUTP) {
    const bf16* CQ = (const bf16*)(p.ws + WS_P + 5 * PBUF); const bf16* CK = (const bf16*)(p.ws + WS_P + 6 * PBUF); const bf16* VT = (const bf16*)(p.ws + WS_P + 8 * PBUF);
    const float lam_init = 0.8f - 0.6f * expf(-0.3f * (float)l);
    const float* lq = p.in[I_LAMQK] + l * 256;
    const float lam = expf(wave_sum(lq[lane] * lq[64 + lane])) - expf(wave_sum(lq[128 + lane] * lq[192 + lane])) + lam_init;
    const float* sg = p.in[I_SUBLN] + l * 128;
    const int m = wave & 1, sub = wave >> 1, r = lane & 31, half = lane >> 5;
    constexpr int KROW = 144, KBYTES = 64 * KROW  , VOFF = 2 * KBYTES  , STAGE = VOFF + 128 * KROW  ;
    const float cs = 0.125f * 1.44269504089f;
    for (int pi = blockIdx.x; pi < 512; pi += G) {
#pragma unroll 1
        for (int uu = 0; uu < 2; ++uu) {
            const int bh = pi >> 4, jp = pi & 15, qb = uu ? 31 - jp : jp, b = bh >> 2, h = bh & 3;
            const int tokq0 = b * SEQ + qb * 128, qrow = tokq0 + 32 * sub + r;
            bf16x8 Qf[4];
#pragma unroll
            for (int ks = 0; ks < 4; ++ks) Qf[ks] = *(const bf16x8*)(CQ + (size_t)qrow * 512 + h * 128 + m * 64 + 16 * ks + 8 * half);
            const int nt = 2 * qb + 2, my_last = 2 * qb + (sub >> 1);
            const bf16* kg[2]; const bf16* vg[2]; int kl[2], vl[2];
#pragma unroll
            for (int i = 0; i < 2; ++i) { const int idx = tid + 512 * i; const int key = idx >> 4, c16 = idx & 15;
                kg[i] = CK + (size_t)(b * SEQ + key) * 512 + h * 128 + c16 * 8; kl[i] = (c16 >> 3) * KBYTES + key * KROW + (c16 & 7) * 16;
                const int dv = idx >> 3, c8 = idx & 7;
                vg[i] = VT + (size_t)(h * 128 + dv) * TOK + b * SEQ + c8 * 8; vl[i] = VOFF + dv * KROW + c8 * 16; }
            u32x4 st[4];
            st[0] = *(const u32x4*)kg[0]; st[1] = *(const u32x4*)kg[1]; st[2] = *(const u32x4*)vg[0]; st[3] = *(const u32x4*)vg[1];
            *(LAS u32x4*)(lds + kl[0]) = st[0]; *(LAS u32x4*)(lds + kl[1]) = st[1]; *(LAS u32x4*)(lds + vl[0]) = st[2]; *(LAS u32x4*)(lds + vl[1]) = st[3];
            __syncthreads();
            f32x16 O[4];
#pragma unroll
            for (int i = 0; i < 4; ++i) O[i] = zero16();
            float m_run = -INFINITY, l_run = 0.f;
#pragma unroll 1
            for (int kt = 0; kt < nt; ++kt) {
                const bool more = (kt + 1 < nt);
                if (more) { const size_t ko = (size_t)(kt + 1) * 64 * 512, vo = (size_t)(kt + 1) * 64;
                    st[0] = *(const u32x4*)(kg[0] + ko); st[1] = *(const u32x4*)(kg[1] + ko); st[2] = *(const u32x4*)(vg[0] + vo); st[3] = *(const u32x4*)(vg[1] + vo); }
                const LAS unsigned char* buf = lds + (kt & 1) * STAGE;
                if (kt <= my_last) {
                    f32x16 S[2];
#pragma unroll
                    for (int u = 0; u < 2; ++u) { S[u] = zero16();
#pragma unroll
                        for (int ks = 0; ks < 4; ++ks) { const bf16x8 A = *(const LAS bf16x8*)(buf + m * KBYTES + (32 * u + r) * KROW + (16 * ks + 8 * half) * 2); S[u] = mfma32(A, Qf[ks], S[u]); } }
                    asm volatile("s_nop 15\n\ts_nop 7" : "+v"(S[0]), "+v"(S[1]));
                    float mx = -INFINITY;
#pragma unroll
                    for (int u = 0; u < 2; ++u)
#pragma unroll
                        for (int i = 0; i < 16; ++i) mx = fmaxf(mx, S[u][i]);
                    mx = fmaxf(mx, __shfl_xor(mx, 32));
                    const float m_new = fmaxf(m_run, mx * cs), alpha = __builtin_amdgcn_exp2f(m_run - m_new);
                    float ps = 0.f;
#pragma unroll
                    for (int u = 0; u < 2; ++u)
#pragma unroll
                        for (int i = 0; i < 16; ++i) { const float e = __builtin_amdgcn_exp2f(S[u][i] * cs - m_new); S[u][i] = e; ps += e; }
                    ps += __shfl_xor(ps, 32);
                    l_run = l_run * alpha + ps; m_run = m_new;
#pragma unroll
                    for (int d = 0; d < 4; ++d)
#pragma unroll
                        for (int i = 0; i < 16; ++i) O[d][i] *= alpha;
                    bf16x8 Pf[2][2];
#pragma unroll
                    for (int u = 0; u < 2; ++u)
#pragma unroll
                        for (int s = 0; s < 2; ++s) { u32x4 w; w.x = mk_pk2(S[u][8 * s + 0], S[u][8 * s + 1]); w.y = mk_pk2(S[u][8 * s + 2], S[u][8 * s + 3]); w.z = mk_pk2(S[u][8 * s + 4], S[u][8 * s + 5]); w.w = mk_pk2(S[u][8 * s + 6], S[u][8 * s + 7]);
                            Pf[u][s] = __builtin_bit_cast(bf16x8, w); }
#pragma unroll
                    for (int d = 0; d < 4; ++d)
#pragma unroll
                        for (int u = 0; u < 2; ++u)
#pragma unroll
                            for (int s = 0; s < 2; ++s) { const LAS unsigned char* va = buf + VOFF + (32 * d + r) * KROW + (32 * u + 16 * s + 4 * half) * 2;
                                const u32x2 lo = *(const LAS u32x2*)va, hi = *(const LAS u32x2*)(va + 16);
                                u32x4 w; w.x = lo.x; w.y = lo.y; w.z = hi.x; w.w = hi.y;
                                O[d] = mfma32(__builtin_bit_cast(bf16x8, w), Pf[u][s], O[d]); }
                }
                if (more) { LAS unsigned char* nb = lds + ((kt + 1) & 1) * STAGE;
                    *(LAS u32x4*)(nb + kl[0]) = st[0]; *(LAS u32x4*)(nb + kl[1]) = st[1]; *(LAS u32x4*)(nb + vl[0]) = st[2]; *(LAS u32x4*)(nb + vl[1]) = st[3]; }
                __syncthreads();
            }
            asm volatile("s_nop 15\n\ts_nop 7" : "+v"(O[0]), "+v"(O[1]), "+v"(O[2]), "+v"(O[3]));
            const float inv = 1.0f / l_run;
            LAS float* Cb = (LAS float*)lds;
            if (m == 1) { const float f = inv * lam;
#pragma unroll
                for (int d = 0; d < 4; ++d)
#pragma unroll
                    for (int i = 0; i < 16; ++i) Cb[(sub * 128 + 32 * d + crow(i, half)) * 33 + r] = O[d][i] * f; }
            __syncthreads();
            if (m == 0) { float ss = 0.f;
#pragma unroll
                for (int d = 0; d < 4; ++d)
#pragma unroll
                    for (int i = 0; i < 16; ++i) { const float o = O[d][i] * inv - Cb[(sub * 128 + 32 * d + crow(i, half)) * 33 + r]; O[d][i] = o; ss += o * o; }
                ss += __shfl_xor(ss, 32);
                const float rs = rsqrtf(ss * (1.0f / 128.0f) + 1e-5f) * (1.0f - lam_init);
#pragma unroll
                for (int d = 0; d < 4; ++d)
#pragma unroll
                    for (int ig = 0; ig < 4; ++ig) { const int dv0 = 32 * d + 8 * ig + 4 * half; const f32x4 gn = *(const f32x4*)(sg + dv0);
                        u32x2 w; w.x = mk_pk2(O[d][4 * ig + 0] * rs * gn[0], O[d][4 * ig + 1] * rs * gn[1]); w.y = mk_pk2(O[d][4 * ig + 2] * rs * gn[2], O[d][4 * ig + 3] * rs * gn[3]);
                        *(u32x2*)(OUTP + (size_t)qrow * 512 + h * 128 + dv0) = w; } }
            __syncthreads();
        }
    }
}

template <bool P2> DI void phase_ssm(const Params& p, int l, LAS unsigned char* lds, int lane, int wave, int G) {
    const bf16* DU = (const bf16*)(p.ws + WS_P + 7 * PBUF); bf16* YG = (bf16*)(p.ws + WS_YG); float* E = (float*)(p.ws + WS_E);
    const bf16* BB = (const bf16*)(p.ws + WS_BB) + (size_t)l * 32 * 128 * 16; const bf16* CM = (const bf16*)(p.ws + WS_CM) + (size_t)l * 32 * 16 * 128;
    const float* AP = (const float*)(p.ws + WS_AP) + (size_t)l * 32 * 64 * 8; const float* dsk = p.in[I_SSMD] + l * 512;
    const int r = lane & 31, half = lane >> 5, r16 = lane & 15, q4 = lane >> 4;
    constexpr int XRS = 272;
    LAS unsigned char* Xs = lds + wave * (64 * XRS);
    for (int it = blockIdx.x * 8 + wave; it < 16384; it += G * 8) {
        const int c = it & 63, g = (it >> 6) & 31, b = it >> 11, tok0 = b * SEQ + c * 64;
        f32x16 X[4][2];
        { bf16x8 Uf[2], Bf[4];
#pragma unroll
            for (int tt = 0; tt < 2; ++tt) { const int tau = 32 * ((r >> 2) & 1) + 16 * tt + (r & 3) + 4 * (r >> 3); Uf[tt] = *(const bf16x8*)(DU + (size_t)(tok0 + tau) * 512 + g * 16 + 8 * half); }
#pragma unroll
            for (int pt = 0; pt < 4; ++pt) Bf[pt] = *(const bf16x8*)(BB + ((size_t)g * 128 + 32 * pt + r) * 16 + 8 * half);
#pragma unroll
            for (int pt = 0; pt < 4; ++pt)
#pragma unroll
                for (int tt = 0; tt < 2; ++tt) X[pt][tt] = mfma32(Uf[tt], Bf[pt], zero16()); }
        asm volatile("s_nop 15\n\ts_nop 15" : "+v"(X[0][0]), "+v"(X[0][1]), "+v"(X[1][0]), "+v"(X[1][1]), "+v"(X[2][0]), "+v"(X[2][1]), "+v"(X[3][0]), "+v"(X[3][1]));
        float ar[2], ai[2], a32r[2], a32i[2], a64r[2], a64i[2];
#pragma unroll
        for (int s = 0; s < 2; ++s) { const float* ap = AP + ((size_t)g * 64 + 32 * s + r) * 8; const f32x4 v = *(const f32x4*)ap; ar[s] = v[0]; ai[s] = v[1]; a32r[s] = v[2]; a32i[s] = v[3]; a64r[s] = ap[4]; a64i[s] = ap[5]; }
        float xr[2] = {0.f, 0.f}, xi[2] = {0.f, 0.f};
        if (P2) {
            const float* e0 = E + (((size_t)(b * 32 + g) * 64) * 64 + r) * 2;
            float sr0 = 0.f, si0 = 0.f, sr1 = 0.f, si1 = 0.f;
#pragma unroll 4
            for (int j = 0; j < c; ++j) { const float2 ea = *(const float2*)(e0 + (size_t)j * 128), eb = *(const float2*)(e0 + (size_t)j * 128 + 64);
                const float t0 = a64r[0] * sr0 - a64i[0] * si0 + ea.x; si0 = a64r[0] * si0 + a64i[0] * sr0 + ea.y; sr0 = t0;
                const float t1 = a64r[1] * sr1 - a64i[1] * si1 + eb.x; si1 = a64r[1] * si1 + a64i[1] * sr1 + eb.y; sr1 = t1; }
            if (half == 0) { xr[0] = sr0; xi[0] = si0; xr[1] = sr1; xi[1] = si1; }
        }
#pragma unroll
        for (int s = 0; s < 2; ++s)
#pragma unroll
            for (int tt = 0; tt < 2; ++tt)
#pragma unroll
                for (int i = 0; i < 16; ++i) { const float nr = ar[s] * xr[s] - ai[s] * xi[s] + X[s][tt][i], ni = ar[s] * xi[s] + ai[s] * xr[s] + X[2 + s][tt][i]; X[s][tt][i] = nr; X[2 + s][tt][i] = ni; xr[s] = nr; xi[s] = ni; }
        float oxr[2], oxi[2];
#pragma unroll
        for (int s = 0; s < 2; ++s) { oxr[s] = __shfl_xor(xr[s], 32); oxi[s] = __shfl_xor(xi[s], 32); }
        if (!P2) {
            if (half == 1) {
#pragma unroll
                for (int s = 0; s < 2; ++s) { float2 e; e.x = xr[s] + a32r[s] * oxr[s] - a32i[s] * oxi[s]; e.y = xi[s] + a32r[s] * oxi[s] + a32i[s] * oxr[s];
                    *(float2*)(E + (((size_t)(b * 32 + g) * 64 + c) * 64 + 32 * s + r) * 2) = e; } }
        } else {
#pragma unroll
            for (int s = 0; s < 2; ++s) { float wr_ = half ? oxr[s] : 0.f, wi_ = half ? oxi[s] : 0.f;
#pragma unroll
                for (int tt = 0; tt < 2; ++tt)
#pragma unroll
                    for (int i = 0; i < 16; ++i) { const float t = ar[s] * wr_ - ai[s] * wi_; wi_ = ar[s] * wi_ + ai[s] * wr_; wr_ = t; X[s][tt][i] += wr_; X[2 + s][tt][i] += wi_; } }
#pragma unroll
            for (int pt = 0; pt < 4; ++pt)
#pragma unroll
                for (int tt = 0; tt < 2; ++tt)
#pragma unroll
                    for (int i = 0; i < 16; ++i) *(LAS unsigned short*)(Xs + (32 * half + 16 * tt + i) * XRS + (32 * pt + r) * 2) = f2bf(X[pt][tt][i]);
            LDS_WAIT();
            bf16x8 Cf[4];
#pragma unroll
            for (int ks = 0; ks < 4; ++ks) Cf[ks] = *(const bf16x8*)(CM + ((size_t)g * 16 + r16) * 128 + 32 * ks + 8 * q4);
            const int ch = g * 16 + r16; const float dk = dsk[ch];
#pragma unroll
            for (int mt = 0; mt < 4; ++mt) { f32x4 acc = {0.f, 0.f, 0.f, 0.f};
#pragma unroll
                for (int ks = 0; ks < 4; ++ks) { const bf16x8 A = *(const LAS bf16x8*)(Xs + (16 * mt + r16) * XRS + (32 * ks + 8 * q4) * 2); acc = mfma16(A, Cf[ks], acc); }
                asm volatile("s_nop 15" : "+v"(acc));
#pragma unroll
                for (int j = 0; j < 4; ++j) { const size_t o = (size_t)(tok0 + 16 * mt + 4 * q4 + j) * 512 + ch; const float y = acc[j] + dk * bf2f(DU[o]); YG[o] = f2bf(mk_gelu(y)); } }
            LDS_WAIT();
        }
    }
}

DI void phase_final(const Params& p, int tid, int G) {
    const float* rowss = (const float*)(p.ws + WS_ROWSS) + 4 * TOK; const float* gf = p.in[I_GFIN]; float* out = p.out;
    for (size_t i = (size_t)blockIdx.x * NTHR + tid; i < (size_t)TOK * 256; i += (size_t)G * NTHR) { const int row = (int)(i >> 8), c4 = (int)(i & 255);
        const float rs = pg8::rstd_of(rowss[row]); const f32x4 v = *((const f32x4*)out + i), gv = *((const f32x4*)gf + c4); *((f32x4*)out + i) = v * rs * gv; }
}

#define XB_TMO      128
#define XB_XCNT(j)  (256  + 64 * (j))
#define XB_XSUB(j)  (1280 + 64 * (j))
#define XB_XGEN(j)  (2304 + 64 * (j))
#define XB_TOP      3328
#define XB_TOPGEN   3392
#define XCD_BAR_WORDS 3456
#define XB_SPIN_CAP (1u << 18)

__device__ __forceinline__ unsigned xb_ld(unsigned* p)              { return __hip_atomic_load(p, __ATOMIC_RELAXED, __HIP_MEMORY_SCOPE_AGENT); }
__device__ __forceinline__ unsigned xb_add(unsigned* p, unsigned v) { return __hip_atomic_fetch_add(p, v, __ATOMIC_RELAXED, __HIP_MEMORY_SCOPE_AGENT); }
__device__ __forceinline__ unsigned xb_xcc_id() { return (unsigned)__builtin_amdgcn_s_getreg((3 << 11) | 20) & 0xFu; }
#define XB_SPIN(cond, bar) do { unsigned _sp = 0; while (cond) { __builtin_amdgcn_s_sleep(1); \
    if ((++_sp & 255u) == 0u) { if (xb_ld(&(bar)[XB_TMO])) break; if (_sp > XB_SPIN_CAP) { atomicAdd(&(bar)[XB_TMO], 1u); break; } } } } while (0)

struct XcdBarrier {
    unsigned* bar; unsigned x;
    volatile LAS unsigned* st;
};

__device__ __forceinline__ XcdBarrier xcd_barrier_post(unsigned* bar, volatile LAS unsigned* st) {
    XcdBarrier b; b.bar = bar; b.x = xb_xcc_id(); b.st = st;
    if (threadIdx.x == 0) (void)xb_add(&bar[XB_XCNT(b.x)], 1u);
    return b;
}
__device__ __forceinline__ void xcd_barrier_complete(unsigned* bar, unsigned x, unsigned& nloc, unsigned& nx) {
    const unsigned G = gridDim.x * gridDim.y * gridDim.z;
    unsigned sum, cnt, mine, sp = 0u;
    for (;;) {
        sum = 0u; cnt = 0u; mine = 0u;
#pragma unroll
        for (unsigned j = 0; j < 16; ++j) { const unsigned c = xb_ld(&bar[XB_XCNT(j)]); sum += c; cnt += (c > 0u) ? 1u : 0u; mine = (j == x) ? c : mine; }
        if (sum == G) break;
        __builtin_amdgcn_s_sleep(1);
        if ((++sp & 255u) == 0u) { if (xb_ld(&bar[XB_TMO])) break; if (sp > XB_SPIN_CAP) { atomicAdd(&bar[XB_TMO], 1u); break; } }
    }
    nloc = mine > 0u ? mine : 1u; nx = cnt > 0u ? cnt : 1u;
}

__device__ __forceinline__ void xcd_barrier(const XcdBarrier& b) {
    asm volatile("s_waitcnt vmcnt(0)" ::: "memory");
    __syncthreads();
    if (threadIdx.x == 0) {
        unsigned* bar = b.bar;
        __builtin_amdgcn_s_waitcnt(0);
        unsigned nloc = b.st[0], nx = b.st[1];
        if (nloc == 0u) { xcd_barrier_complete(bar, b.x, nloc, nx); b.st[0] = nloc; b.st[1] = nx; }
        const unsigned old = xb_add(&bar[XB_XSUB(b.x)], 1u);
        const unsigned gen = old / nloc;
        if (old + 1u == (gen + 1u) * nloc) {
            __builtin_amdgcn_fence(__ATOMIC_RELEASE, "agent");
            asm volatile("s_waitcnt vmcnt(0)" ::: "memory");
            const unsigned og = xb_add(&bar[XB_TOP], 1u);
            const unsigned tg = og / nx;
            if (og + 1u == (tg + 1u) * nx) xb_add(&bar[XB_TOPGEN], 1u);
            else XB_SPIN(xb_ld(&bar[XB_TOPGEN]) == tg, bar);
            __builtin_amdgcn_fence(__ATOMIC_ACQUIRE, "agent");
            xb_add(&bar[XB_XGEN(b.x)], 1u);
            asm volatile("s_waitcnt vmcnt(0)" ::: "memory");
        } else {
            XB_SPIN(xb_ld(&bar[XB_XGEN(b.x)]) == gen, bar);
            __builtin_amdgcn_fence(__ATOMIC_ACQUIRE, "agent");
            asm volatile("s_waitcnt vmcnt(0)" ::: "memory");
        }
    }
    __syncthreads();
}


__global__ void __launch_bounds__(NTHR) mega(Params p) {
    extern __shared__ __attribute__((aligned(16))) unsigned char lds_raw[];
    LAS unsigned char* lds = (LAS unsigned char*)lds_raw;
    const int G = gridDim.x;
#define LAUNDER() int tid = threadIdx.x; asm volatile("" : "+v"(tid)); const int lane = tid & 63, wave = __builtin_amdgcn_readfirstlane(tid >> 6); (void)lane; (void)wave
    const int lo = p.ph_lo, hi = p.ph_hi;
    unsigned char* ws = p.ws;
    int ph = 0;
    volatile LAS unsigned* xb_st = (volatile LAS unsigned*)(lds + 139264);
    XcdBarrier xbar; xbar.bar = (unsigned*)(ws + WS_BAR); xbar.x = 0; xbar.st = xb_st;
    if (ONE_LAUNCH) { if (threadIdx.x < 4) xb_st[threadIdx.x] = 0u; __syncthreads(); xbar = xcd_barrier_post((unsigned*)(ws + WS_BAR), xb_st); }
#ifndef ONLY_KIND
#define ONLY_KIND -1
#endif
#define KEN(k) (ONLY_KIND < 0 || ONLY_KIND == (k))
#ifndef DUP
#define DUP 0
#endif
#define REP(bit) _Pragma("unroll 1") for (int rep_ = 0; rep_ < ((DUP & (bit)) ? 2 : 1); ++rep_)
#define IN_PH() (lo <= ph && ph < hi)
#define END_PH() do { if (ONE_LAUNCH && lo <= ph && ph + 1 < hi) { if (ph == 0) cg::this_grid().sync(); else xcd_barrier(xbar); } ++ph; } while (0)
    if (IN_PH() && KEN(0)) REP(128) { LAUNDER(); phase_prep(p, lds, tid, lane, wave, G); }
    END_PH();
    bf16* XB = (bf16*)(ws + WS_XB); float* rowss = (float*)(ws + WS_ROWSS);
    for (int l = 0; l < 2; ++l) {
        unsigned char* wl = ws + WS_W + (size_t)l * WL_SIZE;
        const bf16* WinT = (const bf16*)(wl + WL_IN);
        bf16* P0 = (bf16*)(ws + WS_P);
        const float* rs_mix = rowss + (size_t)(2 * l) * TOK; float* rs_ffn = rowss + (size_t)(2 * l + 1) * TOK; float* rs_next = rowss + (size_t)(2 * l + 2) * TOK;
        pg8::StaticOrder S;
        if (IN_PH()) REP(1) {
            if (KEN(1)) { pg8::Gemm g{XB, WinT, TOK, 4096, 1024}; S.init(TOK, 4096, G, (int)blockIdx.x); pg8::EpiProj E{P0, rs_mix}; pg8::gemm_phase<pg8::EpiProj, pg8::StaticOrder>(lds, g, S, E, nullptr); }
            if (KEN(2)) { pg8::Gemm g{WinT + (size_t)4096 * 1024, XB, 512, TOK, 1024}; S.init(512, TOK, G, (int)blockIdx.x); pg8::EpiVT E{(bf16*)(ws + WS_P + 8 * PBUF), rs_mix}; pg8::gemm_phase<pg8::EpiVT, pg8::StaticOrder>(lds, g, S, E, nullptr); }
        }
        END_PH();
        if (IN_PH()) { if (KEN(20)) REP(4) { LAUNDER(); phase_attn(p, l, lds, tid, lane, wave, G, (DUP & 4) && rep_ == 0 ? (bf16*)(ws + WS_YG) : (bf16*)(ws + WS_P + 5 * PBUF)); } if (KEN(21)) { LAUNDER(); phase_branchB(p, l, lds, tid, lane, wave, G); } if (KEN(22)) REP(16) { LAUNDER(); phase_ssm<false>(p, l, lds, lane, wave, G); } if (KEN(23)) { LAUNDER(); phase_branchA(p, l, tid, G); } }
        END_PH();
        if (IN_PH() && KEN(3)) REP(16) { LAUNDER(); phase_ssm<true>(p, l, lds, lane, wave, G); }
        END_PH();
        if (IN_PH() && KEN(4)) REP(64) { pg8::Gemm g{(const bf16*)(ws + WS_YG), (const bf16*)(wl + WL_GLU), TOK, 512, 512}; S.init(TOK, 512, G, (int)blockIdx.x);
            pg8::EpiGlu E{(const bf16*)(ws + WS_YG), (bf16*)(ws + WS_P + 7 * PBUF), p.in[I_BGLU] + l * 512}; pg8::gemm_phase<pg8::EpiGlu, pg8::StaticOrder>(lds, g, S, E, nullptr); }
        END_PH();
        bf16* GS = (bf16*)(ws + WS_P + 1 * PBUF); bf16* MG = (bf16*)(ws + WS_P + 8 * PBUF);
        if (IN_PH() && KEN(5)) REP(8) {
#pragma unroll 1
            for (int b = 0; b < 4; ++b) {
                { pg8::Gemm g{XB, WinT + (size_t)(4608 + 1024 * b) * 1024, TOK, 1024, 1024}; S.init(TOK, 1024, G, (int)blockIdx.x); pg8::EpiGate E{GS, rs_mix}; pg8::gemm_phase<pg8::EpiGate, pg8::StaticOrder>(lds, g, S, E, nullptr); }
                const size_t yb = (b == 0) ? 0 : (b == 1) ? 3 : (b == 2) ? 5 : 7;
                pg8::Gemm g{(const bf16*)(ws + WS_P + yb * PBUF), (const bf16*)(wl + WL_BR) + (size_t)b * 1024 * 512, TOK, 1024, 512}; S.init(TOK, 1024, G, (int)blockIdx.x);
                if (b == 0) { pg8::EpiBr<true> E{GS, MG}; pg8::gemm_phase<pg8::EpiBr<true>, pg8::StaticOrder>(lds, g, S, E, nullptr); }
                else { pg8::EpiBr<false> E{GS, MG}; pg8::gemm_phase<pg8::EpiBr<false>, pg8::StaticOrder>(lds, g, S, E, nullptr); }
            }
        }
        END_PH();
        if (IN_PH() && KEN(6)) { pg8::Gemm g{MG, (const bf16*)(wl + WL_O), TOK, 1024, 1024}; S.init(TOK, 1024, G, (int)blockIdx.x);
            pg8::EpiResid E{l == 0 ? p.in[I_X] : (const float*)p.out, p.out, XB, rs_ffn}; pg8::gemm_phase<pg8::EpiResid, pg8::StaticOrder>(lds, g, S, E, nullptr); }
        END_PH();
        bf16* H = (bf16*)(ws + WS_P);
        if (IN_PH() && KEN(7)) REP(2) { pg8::Gemm g{XB, (const bf16*)(wl + WL_FF), TOK, 5632, 1024}; S.init(TOK, 5632, G, (int)blockIdx.x);
            pg8::EpiFfnUp E{H, rs_ffn}; pg8::gemm_phase<pg8::EpiFfnUp, pg8::StaticOrder>(lds, g, S, E, nullptr); }
        END_PH();
        if (IN_PH() && KEN(8)) { pg8::Gemm g{H, (const bf16*)(wl + WL_D), TOK, 1024, 2816}; S.init(TOK, 1024, G, (int)blockIdx.x);
            pg8::EpiResid E{(const float*)p.out, p.out, XB, rs_next}; pg8::gemm_phase<pg8::EpiResid, pg8::StaticOrder>(lds, g, S, E, nullptr); }
        END_PH();
    }
    if (IN_PH() && KEN(9)) { LAUNDER(); phase_final(p, tid, G); }
}
constexpr int N_PHASES = 18;
}

extern "C" void kernel_launch(void* const* d_in, const int* in_sizes, int n_in, void* d_out, int out_size, void* d_ws, size_t ws_size, hipStream_t stream) {
    static int grid = 0;
    if (grid == 0) {
        if (n_in != 28 || out_size != mk::TOK * mk::DM || ws_size < mk::WS_END) { fprintf(stderr, "kernel_launch: unexpected shapes (n_in %d out %d ws %zu need %zu)\n", n_in, out_size, ws_size, (size_t)mk::WS_END); grid = -1; return; }
        int dev = 0, cus = 0, per_cu = 0;
        hipGetDevice(&dev); hipDeviceGetAttribute(&cus, hipDeviceAttributeMultiprocessorCount, dev);
        if (hipFuncSetAttribute((const void*)mk::mega, hipFuncAttributeMaxDynamicSharedMemorySize, mk::LDS_BYTES) != hipSuccess) { fprintf(stderr, "kernel_launch: hipFuncSetAttribute failed\n"); grid = -1; return; }
        if (hipOccupancyMaxActiveBlocksPerMultiprocessor(&per_cu, (const void*)mk::mega, mk::NTHR, mk::LDS_BYTES) != hipSuccess || per_cu < 1) { fprintf(stderr, "kernel_launch: occupancy query says %d\n", per_cu); per_cu = 1; }
        (void)hipGetLastError();
        grid = cus * 1;
        if (grid <= 0) grid = 256;
    }
    if (grid < 0) return;
    mk::Params p{};
    for (int i = 0; i < 28; ++i) p.in[i] = (const float*)d_in[i];
    p.out = (float*)d_out; p.ws = (unsigned char*)d_ws;
#if ONE_LAUNCH
    if (hipMemsetAsync((unsigned char*)d_ws + mk::WS_BAR, 0, XCD_BAR_WORDS * sizeof(unsigned), stream) != hipSuccess) { fprintf(stderr, "kernel_launch: memset failed\n"); return; }
    p.ph_lo = 0; p.ph_hi = mk::N_PHASES;
    void* args[] = {&p};
    hipError_t e = hipLaunchCooperativeKernel((const void*)mk::mega, dim3(grid), dim3(mk::NTHR), args, mk::LDS_BYTES, stream);
    if (e != hipSuccess) fprintf(stderr, "cooperative launch failed: %s (grid %d)\n", hipGetErrorString(e), grid);
#else
    for (int ph = 0; ph < mk::N_PHASES; ++ph) { p.ph_lo = ph; p.ph_hi = ph + 1;
        hipLaunchKernelGGL(mk::mega, dim3(grid), dim3(mk::NTHR), mk::LDS_BYTES, stream, p); }
#endif
}
```

```cpp
#include <hip/hip_runtime.h>
#include <hip/hip_cooperative_groups.h>
#include <cstdio>
#include <cstdint>
#ifndef ONE_LAUNCH
#define ONE_LAUNCH 1
#endif
namespace cg = cooperative_groups;
typedef __bf16 mk_bf16x2_t __attribute__((ext_vector_type(2)));
typedef float mk_f32x2_t __attribute__((ext_vector_type(2)));
__device__ __forceinline__ unsigned mk_pk2(float lo, float hi) { mk_f32x2_t v = {lo, hi}; mk_bf16x2_t b = __builtin_convertvector(v, mk_bf16x2_t); return __builtin_bit_cast(unsigned, b); }
__device__ __forceinline__ float mk_lo(unsigned w) { return __uint_as_float(w << 16); }
__device__ __forceinline__ float mk_hi(unsigned w) { return __uint_as_float(w & 0xffff0000u); }
__device__ __forceinline__ float mk_sigm(float x) { return __builtin_amdgcn_rcpf(1.0f + __expf(-x)); }
__device__ __forceinline__ float mk_gelu(float x) { const float u = 1.5957691216f * (x + 0.044715f * x * x * x); return x * __builtin_amdgcn_rcpf(1.0f + __expf(-u)); }
namespace pg8 {
#define PG8_LAS __attribute__((address_space(3)))
typedef unsigned short bf16_t;
typedef short bf16x8 __attribute__((ext_vector_type(8)));
typedef float f32x4 __attribute__((ext_vector_type(4)));
typedef unsigned u32x4 __attribute__((ext_vector_type(4)));
constexpr int BM = 256, BK = 64, HALF = 128, HTB = HALF * BK * 2  , STAGE_BYTES = 8 * HTB, NXCD = 8, WGM = 8;

__host__ __device__ __forceinline__ int lds_byte(int r, int c) { const int st = (r >> 4) * 2 + (c >> 5), rr = r & 15, cc = c & 31, ob = rr * 64 + cc * 2; return st * 1024 + (ob ^ (((ob >> 9) & 1) << 5)); }
__host__ __device__ __forceinline__ void stage_rc(int b, int& R, int& C) { const int st = b / 1024, sb = b % 1024, swz = sb ^ (((sb >> 9) & 1) << 5); R = (st >> 1) * 16 + swz / 64; C = (st & 1) * 32 + (swz % 64) / 2; }
__host__ __device__ __forceinline__ int perm32(int rho) { const int n = rho >> 4, i = rho & 15; return 8 * (i >> 2) + 4 * n + (i & 3); }

struct Unit { int pm, pn; };
struct Gemm { const bf16_t* A; const bf16_t* Bt; int M, N, K; };

struct StaticOrder {
    int nM, nN, nwg, G, c;
    __host__ __device__ void init(int M, int N, int G_, int c_) { nM = M / BM; nN = N / BM; nwg = nM * nN; G = G_; c = c_; }
    __host__ __device__ bool next(int i, Unit& u) const {
        const long L = (long)i * G + c; if (L >= nwg) return false;
        int wgid = (int)L; { const int q = nwg / NXCD, r = nwg % NXCD, xcd = wgid % NXCD, off = wgid / NXCD; wgid = (xcd < r ? xcd * (q + 1) : r * (q + 1) + (xcd - r) * q) + off; }
        const int nig = WGM * nN, gid = wgid / nig, fm = gid * WGM, gsz = (nM - fm) < WGM ? (nM - fm) : WGM;
        u.pm = fm + ((wgid % nig) % gsz); u.pn = (wgid % nig) / gsz; return true;
    }
    __device__ __forceinline__ void a_ready(const Unit&) const {}
    __device__ __forceinline__ void done(const Unit&) const {}
};
typedef unsigned u32x2 __attribute__((ext_vector_type(2)));
constexpr int MK_TOK = 32768;
#define MK_EPI_LOOP_AM _Pragma("unroll") for (int ai = 0; ai < 2; ++ai) _Pragma("unroll") for (int m = 0; m < 4; ++m)
__device__ __forceinline__ u32x4 pack8(const f32x4 a, const f32x4 b) { u32x4 w; w.x = mk_pk2(a[0], a[1]); w.y = mk_pk2(a[2], a[3]); w.z = mk_pk2(b[0], b[1]); w.w = mk_pk2(b[2], b[3]); return w; }
__device__ __forceinline__ void unpack8(const u32x4 w, f32x4& a, f32x4& b) { a = (f32x4){mk_lo(w.x), mk_hi(w.x), mk_lo(w.y), mk_hi(w.y)}; b = (f32x4){mk_lo(w.z), mk_hi(w.z), mk_lo(w.w), mk_hi(w.w)}; }
__device__ __forceinline__ float rstd_of(float ss) { return rsqrtf(ss * (1.0f / 1024.0f) + 1e-6f); }

struct EpiProj { static constexpr bool PERM = true, AFTER_DRAIN = false; bf16_t* P; const float* rowss;
    __device__ __forceinline__ void operator()(const f32x4 (&acc)[2][2][4][2], const Unit& u, int wr, int wc, int fr, int fq) const {
        const int row0 = u.pm * BM + wr * 64 + fr;
        bf16_t* base = P + (size_t)(u.pn >> 1) * ((size_t)MK_TOK * 512) + (u.pn & 1) * 256 + wc * 32 + 8 * fq;
        MK_EPI_LOOP_AM { const int row = row0 + ai * HALF + m * 16; const float rs = rstd_of(rowss[row]); bf16_t* rp = base + (size_t)row * 512;
#pragma unroll
            for (int bj = 0; bj < 2; ++bj) *(u32x4*)(rp + bj * HALF) = pack8(acc[ai][bj][m][0] * rs, acc[ai][bj][m][1] * rs); }
    }
};
struct EpiVT { static constexpr bool PERM = true, AFTER_DRAIN = false; bf16_t* VT; const float* rowss;
    __device__ __forceinline__ void operator()(const f32x4 (&acc)[2][2][4][2], const Unit& u, int wr, int wc, int fr, int fq) const {
        const int row0 = u.pm * BM + wr * 64 + fr, col0 = u.pn * BM + wc * 32 + 8 * fq;
        f32x4 rs[2][2];
#pragma unroll
        for (int bj = 0; bj < 2; ++bj)
#pragma unroll
            for (int n = 0; n < 2; ++n) { const f32x4 s = *(const f32x4*)(rowss + col0 + bj * HALF + 4 * n); rs[bj][n] = (f32x4){rstd_of(s[0]), rstd_of(s[1]), rstd_of(s[2]), rstd_of(s[3])}; }
        MK_EPI_LOOP_AM { const int row = row0 + ai * HALF + m * 16; bf16_t* rp = VT + (size_t)row * MK_TOK + col0;
#pragma unroll
            for (int bj = 0; bj < 2; ++bj) *(u32x4*)(rp + bj * HALF) = pack8(acc[ai][bj][m][0] * rs[bj][0], acc[ai][bj][m][1] * rs[bj][1]); }
    }
};
struct EpiGlu { static constexpr bool PERM = true, AFTER_DRAIN = false; const bf16_t* YG; bf16_t* O; const float* bias;
    __device__ __forceinline__ void operator()(const f32x4 (&acc)[2][2][4][2], const Unit& u, int wr, int wc, int fr, int fq) const {
        const int row0 = u.pm * BM + wr * 64 + fr, col0 = u.pn * BM + wc * 32 + 8 * fq;
        f32x4 bv[2][2];
#pragma unroll
        for (int bj = 0; bj < 2; ++bj)
#pragma unroll
            for (int n = 0; n < 2; ++n) bv[bj][n] = *(const f32x4*)(bias + col0 + bj * HALF + 4 * n);
        MK_EPI_LOOP_AM { const int row = row0 + ai * HALF + m * 16; const size_t off = (size_t)row * 512 + col0;
#pragma unroll
            for (int bj = 0; bj < 2; ++bj) { f32x4 y0, y1; unpack8(*(const u32x4*)(YG + off + bj * HALF), y0, y1);
                f32x4 a0 = acc[ai][bj][m][0] + bv[bj][0], a1 = acc[ai][bj][m][1] + bv[bj][1];
#pragma unroll
                for (int j = 0; j < 4; ++j) { y0[j] *= mk_sigm(a0[j]); y1[j] *= mk_sigm(a1[j]); }
                *(u32x4*)(O + off + bj * HALF) = pack8(y0, y1); } }
    }
};
struct EpiGate { static constexpr bool PERM = true, AFTER_DRAIN = false; bf16_t* GS; const float* rowss;
    __device__ __forceinline__ void operator()(const f32x4 (&acc)[2][2][4][2], const Unit& u, int wr, int wc, int fr, int fq) const {
        const int row0 = u.pm * BM + wr * 64 + fr, col0 = u.pn * BM + wc * 32 + 8 * fq;
        MK_EPI_LOOP_AM { const int row = row0 + ai * HALF + m * 16; const float rs = rstd_of(rowss[row]); const size_t off = (size_t)row * 1024 + col0;
#pragma unroll
            for (int bj = 0; bj < 2; ++bj) { f32x4 a0 = acc[ai][bj][m][0] * rs, a1 = acc[ai][bj][m][1] * rs;
#pragma unroll
                for (int j = 0; j < 4; ++j) { a0[j] = mk_sigm(a0[j]); a1[j] = mk_sigm(a1[j]); }
                *(u32x4*)(GS + off + bj * HALF) = pack8(a0, a1); } }
    }
};
template <bool FIRST> struct EpiBr { static constexpr bool PERM = true, AFTER_DRAIN = false; const bf16_t* GS; bf16_t* MG;
    __device__ __forceinline__ void operator()(const f32x4 (&acc)[2][2][4][2], const Unit& u, int wr, int wc, int fr, int fq) const {
        const int row0 = u.pm * BM + wr * 64 + fr, col0 = u.pn * BM + wc * 32 + 8 * fq;
        MK_EPI_LOOP_AM { const int row = row0 + ai * HALF + m * 16; const size_t off = (size_t)row * 1024 + col0;
#pragma unroll
            for (int bj = 0; bj < 2; ++bj) { f32x4 g0, g1; unpack8(*(const u32x4*)(GS + off + bj * HALF), g0, g1);
                f32x4 v0 = g0 * acc[ai][bj][m][0], v1 = g1 * acc[ai][bj][m][1];
                if (!FIRST) { f32x4 p0, p1; unpack8(*(const u32x4*)(MG + off + bj * HALF), p0, p1); v0 += p0; v1 += p1; }
                *(u32x4*)(MG + off + bj * HALF) = pack8(v0, v1); } }
    }
};
struct EpiResid { static constexpr bool PERM = false, AFTER_DRAIN = false; const float* xold; float* out; bf16_t* xb; float* rowss_next;
    __device__ __forceinline__ void operator()(const f32x4 (&acc)[2][2][4][2], const Unit& u, int wr, int wc, int fr, int fq) const {
        const int row0 = u.pm * BM + wr * 64 + fr, col0 = u.pn * BM + wc * 32 + 4 * fq;
        MK_EPI_LOOP_AM { const int row = row0 + ai * HALF + m * 16; const size_t off = (size_t)row * 1024 + col0; float ss = 0.f;
#pragma unroll
            for (int bj = 0; bj < 2; ++bj)
#pragma unroll
                for (int n = 0; n < 2; ++n) { const size_t o = off + bj * HALF + n * 16; const f32x4 xn = *(const f32x4*)(xold + o) + acc[ai][bj][m][n];
                    *(f32x4*)(out + o) = xn; u32x2 w; w.x = mk_pk2(xn[0], xn[1]); w.y = mk_pk2(xn[2], xn[3]); *(u32x2*)(xb + o) = w;
                    ss += (xn[0] * xn[0] + xn[1] * xn[1]) + (xn[2] * xn[2] + xn[3] * xn[3]); }
            ss += __shfl_xor(ss, 16); ss += __shfl_xor(ss, 32);
            if (fq == 0) __hip_atomic_fetch_add(rowss_next + row, ss, __ATOMIC_RELAXED, __HIP_MEMORY_SCOPE_AGENT); }
    }
};
struct EpiFfnUp { static constexpr bool PERM = true, AFTER_DRAIN = false; bf16_t* H; const float* rowss;
    __device__ __forceinline__ void operator()(const f32x4 (&acc)[2][2][4][2], const Unit& u, int wr, int wc, int fr, int fq) const {
        const int row0 = u.pm * BM + wr * 64 + fr, col0 = u.pn * HALF + wc * 32 + 8 * fq;
        MK_EPI_LOOP_AM { const int row = row0 + ai * HALF + m * 16; const float rs = rstd_of(rowss[row]);
            f32x4 g0 = acc[ai][0][m][0] * rs, g1 = acc[ai][0][m][1] * rs, u0 = acc[ai][1][m][0] * rs, u1 = acc[ai][1][m][1] * rs;
#pragma unroll
            for (int j = 0; j < 4; ++j) { g0[j] = g0[j] * mk_sigm(g0[j]) * u0[j]; g1[j] = g1[j] * mk_sigm(g1[j]) * u1[j]; }
            *(u32x4*)(H + (size_t)row * 2816 + col0) = pack8(g0, g1); }
    }
};
template <class Epi, class Sched, bool ALIGN_EPI = true, bool SP2 = true>
__device__ __forceinline__ void gemm_phase(PG8_LAS unsigned char* lds, const Gemm g, const Sched& S, const Epi& E) {
    int tid_l = threadIdx.x; asm volatile("" : "+v"(tid_l)); const int tid = tid_l, wid = __builtin_amdgcn_readfirstlane(tid >> 6), lane = tid & 63, wr = wid >> 2, wc = wid & 3, fr = lane & 15, fq = lane >> 4;
    const int K = g.K, nt = K / BK;
    unsigned voffA[2], voffB[2];
#pragma unroll
    for (int i = 0; i < 2; ++i) { int R, C; stage_rc(tid * 16 + i * 8192, R, C); const int Rb = Epi::PERM ? ((R & ~31) + perm32(R & 31)) : R;
        voffA[i] = (unsigned)(R * K + C) * 2u; voffB[i] = (unsigned)(Rb * K + C) * 2u; }
    const size_t kstep = (size_t)(BK * 2);
    const size_t hstep = (size_t)HALF * K * 2;
    const size_t tstep = 2 * hstep;
    const unsigned ldsw = (unsigned)wid * 1024u;
    const int aoff = lds_byte(wr * 64 + fr, fq * 8), boff = lds_byte(wc * 32 + fr, fq * 8);
#define PG8_SA(b, h) (((b) * 2 + (h)) * HTB)
#define PG8_SB(b, h) ((4 + (b) * 2 + (h)) * HTB)
#define PG8_STAGE(bufoff, gbase, voff) do { _Pragma("unroll") for (int _i = 0; _i < 2; ++_i) \
        __builtin_amdgcn_global_load_lds((const unsigned*)((const char*)(gbase) + (voff)[_i]), (PG8_LAS unsigned*)(lds + (bufoff) + ldsw + _i * 8192), 16, 0, 0); } while (0)
#define PG8_LDA(dst, b, h) do { _Pragma("unroll") for (int m = 0; m < 4; ++m) _Pragma("unroll") for (int k = 0; k < 2; ++k) dst[m][k] = *(const PG8_LAS bf16x8*)(lds + PG8_SA(b, h) + aoff + m * 2048 + k * 1024); } while (0)
#define PG8_LDB(dst, b, h) do { _Pragma("unroll") for (int n = 0; n < 2; ++n) _Pragma("unroll") for (int k = 0; k < 2; ++k) dst[n][k] = *(const PG8_LAS bf16x8*)(lds + PG8_SB(b, h) + boff + n * 2048 + k * 1024); } while (0)
#define PG8_MMA(ai, bj, At, Bt) do { __builtin_amdgcn_s_setprio(1); _Pragma("unroll") for (int m = 0; m < 4; ++m) _Pragma("unroll") for (int n = 0; n < 2; ++n) _Pragma("unroll") for (int k = 0; k < 2; ++k) \
        acc[ai][bj][m][n] = __builtin_amdgcn_mfma_f32_16x16x32_bf16(Bt[n][k], At[m][k], acc[ai][bj][m][n], 0, 0, 0); __builtin_amdgcn_s_setprio(0); } while (0)
#define PG8_WAIT_V(n) asm volatile("s_waitcnt vmcnt(" #n ")" ::: "memory")
#define PG8_WAIT_L(n) asm volatile("s_waitcnt lgkmcnt(" #n ")" ::: "memory")
#define PG8_BAR __builtin_amdgcn_s_barrier()
#define PG8_SCHED __builtin_amdgcn_sched_barrier(0)
    Unit cur, nxt; int ui = 0;
    if (!S.next(0, cur)) return;
    f32x4 acc[2][2][4][2];
#pragma unroll
    for (int a = 0; a < 2; ++a)
#pragma unroll
        for (int b = 0; b < 2; ++b)
#pragma unroll
            for (int m = 0; m < 4; ++m)
#pragma unroll
                for (int n = 0; n < 2; ++n) acc[a][b][m][n] = (f32x4){0.f, 0.f, 0.f, 0.f};
    bf16x8 At[4][2], B0[2][2], B1[2][2];
    const char* cA = (const char*)g.A + (size_t)cur.pm * tstep; const char* cB = (const char*)g.Bt + (size_t)cur.pn * tstep;
    S.a_ready(cur);
    if constexpr (SP2) {
        PG8_STAGE(PG8_SB(0, 0), cB, voffB); PG8_STAGE(PG8_SB(0, 1), cB + hstep, voffB); PG8_STAGE(PG8_SA(0, 0), cA, voffA); PG8_STAGE(PG8_SA(0, 1), cA + hstep, voffA);
        if (wr == 1) PG8_BAR;
        PG8_WAIT_V(2); PG8_BAR;
        PG8_STAGE(PG8_SB(1, 0), cB + kstep, voffB); PG8_STAGE(PG8_SA(1, 0), cA + kstep, voffA); PG8_STAGE(PG8_SB(1, 1), cB + hstep + kstep, voffB);
        PG8_WAIT_V(6); PG8_BAR;
    } else {
        PG8_STAGE(PG8_SB(0, 0), cB, voffB); PG8_STAGE(PG8_SA(0, 0), cA, voffA); PG8_STAGE(PG8_SB(0, 1), cB + hstep, voffB); PG8_STAGE(PG8_SA(0, 1), cA + hstep, voffA);
        if (wr == 1) PG8_BAR;
        PG8_WAIT_V(4); PG8_BAR;
        PG8_STAGE(PG8_SB(1, 0), cB + kstep, voffB); PG8_STAGE(PG8_SA(1, 0), cA + kstep, voffA); PG8_STAGE(PG8_SB(1, 1), cB + hstep + kstep, voffB);
        PG8_WAIT_V(6); PG8_BAR;
    }
    for (;;) {
        const bool has_next = S.next(ui + 1, nxt);
        const char* nA = has_next ? (const char*)g.A + (size_t)nxt.pm * tstep : cA; const char* nB = has_next ? (const char*)g.Bt + (size_t)nxt.pn * tstep : cB;
        for (int t = 0; t < nt; t += 2) {
            const bool last = (t == nt - 2);
            const char* a1 = cA + (size_t)(t + 1) * kstep;
            const char* a2 = last ? nA : cA + (size_t)(t + 2) * kstep; const char* b2 = last ? nB : cB + (size_t)(t + 2) * kstep;
            const char* a3 = a2 + kstep; const char* b3 = b2 + kstep;
            if (last && has_next) S.a_ready(nxt);
            if constexpr (SP2) {
            PG8_LDB(B0, 0, 0); PG8_LDB(B1, 0, 1); PG8_SCHED; PG8_LDA(At, 0, 0); PG8_STAGE(PG8_SA(1, 1), a1 + hstep, voffA);
            PG8_WAIT_V(8); PG8_WAIT_L(0); PG8_BAR; PG8_MMA(0, 0, At, B0); PG8_MMA(0, 1, At, B1); PG8_BAR; PG8_SCHED;
            PG8_LDA(At, 0, 1); PG8_STAGE(PG8_SB(0, 0), b2, voffB); PG8_STAGE(PG8_SB(0, 1), b2 + hstep, voffB); PG8_STAGE(PG8_SA(0, 0), a2, voffA);
            PG8_WAIT_V(8); PG8_WAIT_L(0); PG8_BAR; PG8_MMA(1, 0, At, B0); PG8_MMA(1, 1, At, B1); PG8_BAR; PG8_SCHED;
            PG8_LDB(B0, 1, 0); PG8_LDB(B1, 1, 1); PG8_SCHED; PG8_LDA(At, 1, 0); PG8_STAGE(PG8_SA(0, 1), a2 + hstep, voffA);
            PG8_WAIT_V(8); PG8_WAIT_L(0); PG8_BAR; PG8_MMA(0, 0, At, B0); PG8_MMA(0, 1, At, B1); PG8_BAR; PG8_SCHED;
            PG8_LDA(At, 1, 1); PG8_STAGE(PG8_SB(1, 0), b3, voffB); PG8_STAGE(PG8_SB(1, 1), b3 + hstep, voffB); PG8_STAGE(PG8_SA(1, 0), a3, voffA);
            PG8_WAIT_V(8); PG8_WAIT_L(0); PG8_BAR; PG8_MMA(1, 0, At, B0); PG8_MMA(1, 1, At, B1); PG8_BAR; PG8_SCHED;
            } else {
            PG8_LDB(B0, 0, 0); PG8_SCHED; PG8_LDA(At, 0, 0); PG8_STAGE(PG8_SA(1, 1), a1 + hstep, voffA);
            PG8_WAIT_L(8); PG8_BAR; PG8_WAIT_L(0); PG8_MMA(0, 0, At, B0); PG8_BAR; PG8_SCHED;
            PG8_LDB(B1, 0, 1); PG8_STAGE(PG8_SB(0, 0), b2, voffB);
            PG8_BAR; PG8_WAIT_L(0); PG8_MMA(0, 1, At, B1); PG8_BAR;
            PG8_LDA(At, 0, 1); PG8_STAGE(PG8_SA(0, 0), a2, voffA);
            PG8_BAR; PG8_WAIT_L(0); PG8_MMA(1, 0, At, B0); PG8_BAR; PG8_SCHED;
            PG8_STAGE(PG8_SB(0, 1), b2 + hstep, voffB);
            PG8_WAIT_V(6); PG8_BAR; PG8_MMA(1, 1, At, B1); PG8_BAR;
            PG8_LDB(B0, 1, 0); PG8_SCHED; PG8_LDA(At, 1, 0); PG8_STAGE(PG8_SA(0, 1), a2 + hstep, voffA);
            PG8_WAIT_L(8); PG8_BAR; PG8_WAIT_L(0); PG8_MMA(0, 0, At, B0); PG8_BAR; PG8_SCHED;
            PG8_LDB(B1, 1, 1); PG8_STAGE(PG8_SB(1, 0), b3, voffB);
            PG8_BAR; PG8_WAIT_L(0); PG8_MMA(0, 1, At, B1); PG8_BAR;
            PG8_LDA(At, 1, 1); PG8_STAGE(PG8_SA(1, 0), a3, voffA);
            PG8_BAR; PG8_WAIT_L(0); PG8_MMA(1, 0, At, B0); PG8_BAR; PG8_SCHED;
            PG8_STAGE(PG8_SB(1, 1), b3 + hstep, voffB);
            PG8_WAIT_V(6); PG8_BAR; PG8_MMA(1, 1, At, B1); PG8_BAR;
            }
        }
        if constexpr (ALIGN_EPI) { if (wr == 0) PG8_BAR; }
        if constexpr (!Epi::AFTER_DRAIN) { E(acc, cur, wr, wc, fr, fq); S.done(cur); }
        if (!has_next) break;
#pragma unroll
        for (int a = 0; a < 2; ++a)
#pragma unroll
            for (int b = 0; b < 2; ++b)
#pragma unroll
                for (int m = 0; m < 4; ++m)
#pragma unroll
                    for (int n = 0; n < 2; ++n) acc[a][b][m][n] = (f32x4){0.f, 0.f, 0.f, 0.f};
        cur = nxt; cA = nA; cB = nB; ++ui;
        if constexpr (ALIGN_EPI) { if (wr == 1) PG8_BAR; }
    }
    PG8_WAIT_V(0);
    if constexpr (!ALIGN_EPI) { if (wr == 0) PG8_BAR; }
    PG8_BAR;
    if constexpr (Epi::AFTER_DRAIN) { E.fused(acc, cur, wr, wc, fr, fq, lds, wid, lane); S.done(cur); }
#undef PG8_SA
#undef PG8_SB
#undef PG8_STAGE
#undef PG8_LDA
#undef PG8_LDB
#undef PG8_MMA
#undef PG8_WAIT_V
#undef PG8_WAIT_L
#undef PG8_BAR
#undef PG8_SCHED
}
}

namespace mk {
#define LAS __attribute__((address_space(3)))
#define DI __device__ __forceinline__
typedef unsigned short bf16;
typedef pg8::bf16x8 bf16x8; typedef pg8::f32x4 f32x4; typedef pg8::u32x4 u32x4; typedef pg8::u32x2 u32x2;
typedef float f32x16 __attribute__((ext_vector_type(16)));
constexpr int TOK = 32768, DM = 1024, SEQ = 4096, BW = 512, FFH = 2816, NTHR = 512;
constexpr size_t MiB = 1024 * 1024;
constexpr size_t WS_ROWSS = 0;
constexpr size_t WS_BAR = 768 * 1024;
constexpr size_t WS_BB = 1 * MiB;
constexpr size_t WS_CM = WS_BB + 262144;
constexpr size_t WS_AP = WS_CM + 262144;
constexpr size_t WS_SGW = WS_AP + 131072;
constexpr size_t WS_E = 2 * MiB;
constexpr size_t WS_W = 10 * MiB;
constexpr size_t WL_IN = 0, WL_GLU = 17825792, WL_BR = WL_GLU + 524288, WL_O = WL_BR + 4194304, WL_FF = WL_O + 2097152, WL_D = WL_FF + 11534336, WL_SIZE = WL_D + 5767168;
static_assert(WL_SIZE == 40 * MiB, "weights per layer");
constexpr size_t WS_XB = 90 * MiB;
constexpr size_t WS_P = 154 * MiB;
constexpr size_t PBUF = 32 * MiB;
constexpr size_t WS_YG = WS_P + 9 * PBUF;
constexpr size_t WS_END = WS_YG + 32 * MiB;
constexpr int LDS_BYTES = 143360;

DI float bf2f(bf16 v) { return __uint_as_float(((unsigned)v) << 16); }
DI bf16 f2bf(float f) { return (bf16)(mk_pk2(f, 0.f) & 0xffffu); }
DI float wave_sum(float v) {
#pragma unroll
    for (int o = 1; o < 64; o <<= 1) v += __shfl_xor(v, o);
    return v; }
DI f32x16 mfma32(bf16x8 a, bf16x8 b, f32x16 c) { return __builtin_amdgcn_mfma_f32_32x32x16_bf16(a, b, c, 0, 0, 0); }
DI f32x4 mfma16(bf16x8 a, bf16x8 b, f32x4 c) { return __builtin_amdgcn_mfma_f32_16x16x32_bf16(a, b, c, 0, 0, 0); }
DI int crow(int i, int h) { return (i & 3) + 8 * (i >> 2) + 4 * h; }
DI f32x16 zero16() { f32x16 z;
#pragma unroll
    for (int i = 0; i < 16; ++i) z[i] = 0.f;
    return z; }
#define LDS_WAIT() asm volatile("s_waitcnt lgkmcnt(0)" ::: "memory")

struct Params { const float* in[28]; float* out; unsigned char* ws; int ph_lo, ph_hi; };
enum { I_X = 0, I_GMIX, I_WIN, I_CONVW, I_CONVB, I_SGW, I_SGB, I_LNG, I_LNB, I_LAMQK, I_SUBLN, I_ARE, I_AIM, I_LOGDT, I_BRE, I_BIM, I_CRE, I_CIM, I_SSMD, I_WGLU, I_BGLU, I_WBR, I_WO, I_GFFN, I_WFG, I_WFU, I_WFD, I_GFIN };

DI void tr_item(const float* W, int ldn, int k0, int n0, const float* gs, bf16* WT, int ldk, int drow0, LAS float* scr, int lane) {
    float tv[32];
#pragma unroll
    for (int i = 0; i < 32; ++i) { const int kk = 2 * i + (lane >> 5); tv[i] = W[(size_t)(k0 + kk) * ldn + n0 + (lane & 31)]; }
    if (gs) {
#pragma unroll
        for (int i = 0; i < 32; ++i) tv[i] *= gs[k0 + 2 * i + (lane >> 5)]; }
#pragma unroll
    for (int i = 0; i < 32; ++i) scr[(2 * i + (lane >> 5)) * 33 + (lane & 31)] = tv[i];
    LDS_WAIT();
    const int c = lane & 7;
#pragma unroll
    for (int j = 0; j < 4; ++j) { const int n = (lane >> 3) + 8 * j; const LAS float* s = scr + (8 * c) * 33 + n;
        u32x4 o; o.x = mk_pk2(s[0 * 33], s[1 * 33]); o.y = mk_pk2(s[2 * 33], s[3 * 33]); o.z = mk_pk2(s[4 * 33], s[5 * 33]); o.w = mk_pk2(s[6 * 33], s[7 * 33]);
        *(u32x4*)(WT + (size_t)(drow0 + n) * ldk + k0 + 8 * c) = o; }
    LDS_WAIT();
}
DI void dsincos(double x, double& s, double& c) {
    const double twopi = 6.283185307179586476925; const double k = rint(x / twopi); const double r = x - k * twopi, r2 = r * r;
    double ss = 1.0, cc = 1.0;
#pragma unroll
    for (int n = 13; n >= 1; --n) { ss = 1.0 - r2 * (1.0 / ((2.0 * n) * (2.0 * n + 1.0))) * ss; cc = 1.0 - r2 * (1.0 / ((2.0 * n - 1.0) * (2.0 * n))) * cc; }
    s = ss * r; c = cc;
}
DI void phase_prep(const Params& p, LAS unsigned char* lds, int tid, int lane, int wave, int G) {
    unsigned char* ws = p.ws;
    const int gw = blockIdx.x * 8 + wave, NGW = G * 8, gt = blockIdx.x * NTHR + tid, NGT = G * NTHR;
    LAS float* scr = (LAS float*)(lds + wave * 8704);
    for (int l = 0; l < 2; ++l) {
        unsigned char* wl = ws + WS_W + (size_t)l * WL_SIZE;
        for (int mi = 0; mi < 10; ++mi) {
            const float* src; int K, N; const float* gs = nullptr; bf16* dst; int map = 0;
            if (mi == 0) { src = p.in[I_WIN] + (size_t)l * 1024 * 8704; K = 1024; N = 8704; gs = p.in[I_GMIX] + l * 1024; dst = (bf16*)(wl + WL_IN); map = 1; }
            else if (mi == 1) { src = p.in[I_WGLU] + (size_t)l * 512 * 512; K = 512; N = 512; dst = (bf16*)(wl + WL_GLU); }
            else if (mi < 6) { const int b = mi - 2; src = p.in[I_WBR] + ((size_t)l * 4 + b) * 512 * 1024; K = 512; N = 1024; dst = (bf16*)(wl + WL_BR) + (size_t)b * 1024 * 512; }
            else if (mi == 6) { src = p.in[I_WO] + (size_t)l * 1024 * 1024; K = 1024; N = 1024; dst = (bf16*)(wl + WL_O); }
            else if (mi == 7) { src = p.in[I_WFG] + (size_t)l * 1024 * 2816; K = 1024; N = 2816; gs = p.in[I_GFFN] + l * 1024; dst = (bf16*)(wl + WL_FF); map = 2; }
            else if (mi == 8) { src = p.in[I_WFU] + (size_t)l * 1024 * 2816; K = 1024; N = 2816; gs = p.in[I_GFFN] + l * 1024; dst = (bf16*)(wl + WL_FF); map = 3; }
            else { src = p.in[I_WFD] + (size_t)l * 2816 * 1024; K = 2816; N = 1024; dst = (bf16*)(wl + WL_D); }
            const int nblk = N / 32, nit = (K / 64) * nblk;
            for (int it = gw; it < nit; it += NGW) {
                const int kb = it / nblk, nb = it % nblk, n0 = nb * 32; int dr = n0;
                if (map == 1) { if (n0 >= 3584 && n0 < 4096) dr = n0 + 512; else if (n0 >= 4096 && n0 < 4608) dr = n0 - 512; }
                else if (map == 2) dr = (n0 >> 7) * 256 + (n0 & 127);
                else if (map == 3) dr = (n0 >> 7) * 256 + 128 + (n0 & 127);
                tr_item(src, N, kb * 64, n0, gs, dst, K, dr, scr, lane);
            }
        }
    }
    { const float* x = p.in[I_X]; bf16* xb = (bf16*)(ws + WS_XB); float* rowss = (float*)(ws + WS_ROWSS);
        for (int row0 = gw * 4; row0 < TOK; row0 += NGW * 4) { f32x4 v[4][4];
#pragma unroll
            for (int q = 0; q < 4; ++q)
#pragma unroll
                for (int j = 0; j < 4; ++j) v[q][j] = *((const f32x4*)(x + (size_t)(row0 + q) * DM) + lane + 64 * j);
#pragma unroll
            for (int q = 0; q < 4; ++q) { float ss = 0.f;
#pragma unroll
                for (int j = 0; j < 4; ++j) { const f32x4 t = v[q][j]; ss += (t[0] * t[0] + t[1] * t[1]) + (t[2] * t[2] + t[3] * t[3]);
                    u32x2 w; w.x = mk_pk2(t[0], t[1]); w.y = mk_pk2(t[2], t[3]); *((u32x2*)(xb + (size_t)(row0 + q) * DM) + lane + 64 * j) = w; }
                ss = wave_sum(ss); if (lane == 0) rowss[row0 + q] = ss; } }
        for (int i = gt; i < 4 * TOK; i += NGT) rowss[TOK + i] = 0.f; }
    { const float* sgw = p.in[I_SGW]; bf16* o = (bf16*)(ws + WS_SGW);
        for (int i = gt; i < 2 * 4 * 128 * 128; i += NGT) { const int s = i & 127, t = (i >> 7) & 127; o[i] = f2bf(s <= t ? sgw[i] : 0.f); } }
    for (int i = gt; i < 2 * 32 * 64; i += NGT) {
        const int pp = i & 63, lg = i >> 6;
        const double dt = exp((double)p.in[I_LOGDT][lg]); const double are = p.in[I_ARE][i], aim = p.in[I_AIM][i];
        const double mag = exp(dt * are); double sn, cs; dsincos(dt * aim, sn, cs);
        const double abr = mag * cs, abi = mag * sn, den = are * are + aim * aim, nr = abr - 1.0, ni = abi;
        const double cr = (nr * are + ni * aim) / den, ci = (ni * are - nr * aim) / den;
        bf16* bb = (bf16*)(ws + WS_BB) + (size_t)lg * 128 * 16; const float* bre = p.in[I_BRE] + (size_t)i * 16; const float* bim = p.in[I_BIM] + (size_t)i * 16;
        for (int h = 0; h < 16; ++h) { const double br = bre[h], bi = bim[h]; bb[pp * 16 + h] = f2bf((float)(cr * br - ci * bi)); bb[(64 + pp) * 16 + h] = f2bf((float)(cr * bi + ci * br)); }
        bf16* cm = (bf16*)(ws + WS_CM) + (size_t)lg * 16 * 128; const float* cre = p.in[I_CRE] + (size_t)lg * 16 * 64; const float* cim = p.in[I_CIM] + (size_t)lg * 16 * 64;
        for (int h = 0; h < 16; ++h) { cm[h * 128 + pp] = f2bf(cre[h * 64 + pp]); cm[h * 128 + 64 + pp] = f2bf(-cim[h * 64 + pp]); }
        double pr = abr, pi = abi; float* ap = (float*)(ws + WS_AP) + (size_t)i * 8; ap[0] = (float)pr; ap[1] = (float)pi;
        for (int q = 0; q < 5; ++q) { const double t = pr * pr - pi * pi; pi = 2.0 * pr * pi; pr = t; }
        ap[2] = (float)pr; ap[3] = (float)pi;
        { const double t = pr * pr - pi * pi; pi = 2.0 * pr * pi; pr = t; }
        ap[4] = (float)pr; ap[5] = (float)pi; ap[6] = 0.f; ap[7] = 0.f;
    }
}

DI void phase_branchA(const Params& p, int l, int tid, int G) {
    bf16* AB = (bf16*)(p.ws + WS_P); const bf16* AC = (const bf16*)(p.ws + WS_P + PBUF); const bf16* AX = (const bf16*)(p.ws + WS_P + 2 * PBUF);
    const float* cw = p.in[I_CONVW] + l * 3 * 512; const float* cb = p.in[I_CONVB] + l * 512;
    for (int idx = blockIdx.x * NTHR + tid; idx < (TOK / 16) * 64; idx += G * NTHR) {
        const int cgp = idx & 63, run = idx >> 6, c0 = cgp * 8, t0 = run * 16;
        f32x4 w0[2], w1[2], w2[2], bb[2];
#pragma unroll
        for (int e = 0; e < 2; ++e) { w0[e] = *(const f32x4*)(cw + c0 + 4 * e); w1[e] = *(const f32x4*)(cw + 512 + c0 + 4 * e); w2[e] = *(const f32x4*)(cw + 1024 + c0 + 4 * e); bb[e] = *(const f32x4*)(cb + c0 + 4 * e); }
        f32x4 zm2[2] = {{0.f, 0.f, 0.f, 0.f}, {0.f, 0.f, 0.f, 0.f}}, zm1[2] = {{0.f, 0.f, 0.f, 0.f}, {0.f, 0.f, 0.f, 0.f}};
        if ((t0 & (SEQ - 1)) != 0) {
            f32x4 a0, a1, x0, x1;
            pg8::unpack8(*(const u32x4*)(AC + (size_t)(t0 - 2) * 512 + c0), a0, a1); pg8::unpack8(*(const u32x4*)(AX + (size_t)(t0 - 2) * 512 + c0), x0, x1); zm2[0] = a0 * x0; zm2[1] = a1 * x1;
            pg8::unpack8(*(const u32x4*)(AC + (size_t)(t0 - 1) * 512 + c0), a0, a1); pg8::unpack8(*(const u32x4*)(AX + (size_t)(t0 - 1) * 512 + c0), x0, x1); zm1[0] = a0 * x0; zm1[1] = a1 * x1;
        }
#pragma unroll 4
        for (int i = 0; i < 16; ++i) { const size_t off = (size_t)(t0 + i) * 512 + c0;
            f32x4 a0, a1, x0, x1, b0, b1; pg8::unpack8(*(const u32x4*)(AC + off), a0, a1); pg8::unpack8(*(const u32x4*)(AX + off), x0, x1); pg8::unpack8(*(const u32x4*)(AB + off), b0, b1);
            const f32x4 z0 = a0 * x0, z1 = a1 * x1;
            const f32x4 y0 = b0 * (w0[0] * zm2[0] + w1[0] * zm1[0] + w2[0] * z0 + bb[0]), y1 = b1 * (w0[1] * zm2[1] + w1[1] * zm1[1] + w2[1] * z1 + bb[1]);
            *(u32x4*)(AB + off) = pg8::pack8(y0, y1);
            zm2[0] = zm1[0]; zm2[1] = zm1[1]; zm1[0] = z0; zm1[1] = z1; }
    }
}

DI void phase_branchB(const Params& p, int l, LAS unsigned char* lds, int tid, int lane, int wave, int G) {
    bf16* BU = (bf16*)(p.ws + WS_P + 3 * PBUF); const bf16* BV = (const bf16*)(p.ws + WS_P + 4 * PBUF);
    const bf16* SGW = (const bf16*)(p.ws + WS_SGW) + (size_t)l * 4 * 128 * 128; const float* sgb = p.in[I_SGB] + l * 4 * 128;
    const float* lng = p.in[I_LNG] + l * 512 + lane * 8; const float* lnb = p.in[I_LNB] + l * 512 + lane * 8;
    constexpr int RS = 1040;
    const int r = lane & 31, half = lane >> 5;
    for (int item = blockIdx.x; item < TOK / 128; item += G) {
        const int tok0 = item * 128;
        { const f32x4 g0 = *(const f32x4*)lng, g1 = *(const f32x4*)(lng + 4), b0 = *(const f32x4*)lnb, b1 = *(const f32x4*)(lnb + 4);
            for (int tt = 0; tt < 16; ++tt) { const int s = wave * 16 + tt;
                f32x4 v0, v1; pg8::unpack8(*(const u32x4*)(BV + (size_t)(tok0 + s) * 512 + lane * 8), v0, v1);
#pragma unroll
                for (int j = 0; j < 4; ++j) { v0[j] = mk_gelu(v0[j]); v1[j] = mk_gelu(v1[j]); }
                const float mean = wave_sum((v0[0] + v0[1]) + (v0[2] + v0[3]) + (v1[0] + v1[1]) + (v1[2] + v1[3])) * (1.0f / 512.0f);
                v0 = v0 - mean; v1 = v1 - mean;
                const float var = wave_sum((v0[0] * v0[0] + v0[1] * v0[1]) + (v0[2] * v0[2] + v0[3] * v0[3]) + (v1[0] * v1[0] + v1[1] * v1[1]) + (v1[2] * v1[2] + v1[3] * v1[3])) * (1.0f / 512.0f);
                const float rstd = rsqrtf(var + 1e-5f);
                v0 = v0 * rstd * g0 + b0; v1 = v1 * rstd * g1 + b1;
                *(LAS u32x4*)(lds + s * RS + lane * 16) = pg8::pack8(v0, v1); } }
        __syncthreads();
        const int g = wave >> 1, dh = wave & 1;
        f32x16 acc[4][2];
#pragma unroll
        for (int a = 0; a < 4; ++a) { acc[a][0] = zero16(); acc[a][1] = zero16(); }
#pragma unroll
        for (int ks = 0; ks < 8; ++ks) {
            bf16x8 Vf[2];
#pragma unroll
            for (int dt = 0; dt < 2; ++dt) { const LAS unsigned short* vp = (const LAS unsigned short*)(lds + (16 * ks + 8 * half) * RS + (g * 128 + dh * 64 + dt * 32 + r) * 2);
#pragma unroll
                for (int j = 0; j < 8; ++j) Vf[dt][j] = (short)vp[j * (RS / 2)]; }
#pragma unroll
            for (int tt = ks >> 1; tt < 4; ++tt) { const bf16x8 Wf = *(const bf16x8*)(SGW + ((size_t)g * 128 + 32 * tt + r) * 128 + 16 * ks + 8 * half);
                acc[tt][0] = mfma32(Vf[0], Wf, acc[tt][0]); acc[tt][1] = mfma32(Vf[1], Wf, acc[tt][1]); }
        }
        asm volatile("s_nop 15\n\ts_nop 7" : "+v"(acc[0][0]), "+v"(acc[0][1]), "+v"(acc[1][0]), "+v"(acc[1][1]), "+v"(acc[2][0]), "+v"(acc[2][1]), "+v"(acc[3][0]), "+v"(acc[3][1]));
#pragma unroll
        for (int tt = 0; tt < 4; ++tt) { const int t = 32 * tt + r; const float bias = sgb[g * 128 + t];
#pragma unroll
            for (int dt = 0; dt < 2; ++dt)
#pragma unroll
                for (int ig = 0; ig < 4; ++ig) { bf16* up = BU + (size_t)(tok0 + t) * 512 + g * 128 + dh * 64 + dt * 32 + 8 * ig + 4 * half;
                    const u32x2 uw = *(const u32x2*)up;
                    const float y0 = mk_gelu(mk_lo(uw.x)) * (acc[tt][dt][4 * ig + 0] + bias), y1 = mk_gelu(mk_hi(uw.x)) * (acc[tt][dt][4 * ig + 1] + bias);
                    const float y2 = mk_gelu(mk_lo(uw.y)) * (acc[tt][dt][4 * ig + 2] + bias), y3 = mk_gelu(mk_hi(uw.y)) * (acc[tt][dt][4 * ig + 3] + bias);
                    u32x2 o; o.x = mk_pk2(y0, y1); o.y = mk_pk2(y2, y3); *(u32x2*)up = o; } }
        __syncthreads();
    }
}

DI void phase_attn(const Params& p, int l, LAS unsigned char* lds, int tid, int lane, int wave, int G, bf16* OUTP) {
    const bf16* CQ = (const bf16*)(p.ws + WS_P + 5 * PBUF); const bf16* CK = (const bf16*)(p.ws + WS_P + 6 * PBUF); const bf16* VT = (const bf16*)(p.ws + WS_P + 8 * PBUF);
    const float lam_init = 0.8f - 0.6f * expf(-0.3f * (float)l);
    const float* lq = p.in[I_LAMQK] + l * 256;
    const float lam = expf(wave_sum(lq[lane] * lq[64 + lane])) - expf(wave_sum(lq[128 + lane] * lq[192 + lane])) + lam_init;
    const float* sg = p.in[I_SUBLN] + l * 128;
    const int m = wave & 1, sub = wave >> 1, r = lane & 31, half = lane >> 5;
    constexpr int KROW = 144, KBYTES = 64 * KROW  , VOFF = 2 * KBYTES  , STAGE = VOFF + 128 * KROW  ;
    const float cs = 0.125f * 1.44269504089f;
    for (int pi = blockIdx.x; pi < 512; pi += G) {
#pragma unroll 1
        for (int uu = 0; uu < 2; ++uu) {
            const int bh = pi >> 4, jp = pi & 15, qb = uu ? 31 - jp : jp, b = bh >> 2, h = bh & 3;
            const int tokq0 = b * SEQ + qb * 128, qrow = tokq0 + 32 * sub + r;
            bf16x8 Qf[4];
#pragma unroll
            for (int ks = 0; ks < 4; ++ks) Qf[ks] = *(const bf16x8*)(CQ + (size_t)qrow * 512 + h * 128 + m * 64 + 16 * ks + 8 * half);
            const int nt = 2 * qb + 2, my_last = 2 * qb + (sub >> 1);
            const bf16* kg[2]; const bf16* vg[2]; int kl[2], vl[2];
#pragma unroll
            for (int i = 0; i < 2; ++i) { const int idx = tid + 512 * i; const int key = idx >> 4, c16 = idx & 15;
                kg[i] = CK + (size_t)(b * SEQ + key) * 512 + h * 128 + c16 * 8; kl[i] = (c16 >> 3) * KBYTES + key * KROW + (c16 & 7) * 16;
                const int dv = idx >> 3, c8 = idx & 7;
                vg[i] = VT + (size_t)(h * 128 + dv) * TOK + b * SEQ + c8 * 8; vl[i] = VOFF + dv * KROW + c8 * 16; }
            u32x4 st[4];
            st[0] = *(const u32x4*)kg[0]; st[1] = *(const u32x4*)kg[1]; st[2] = *(const u32x4*)vg[0]; st[3] = *(const u32x4*)vg[1];
            *(LAS u32x4*)(lds + kl[0]) = st[0]; *(LAS u32x4*)(lds + kl[1]) = st[1]; *(LAS u32x4*)(lds + vl[0]) = st[2]; *(LAS u32x4*)(lds + vl[1]) = st[3];
            __syncthreads();
            f32x16 O[4];
#pragma unroll
            for (int i = 0; i < 4; ++i) O[i] = zero16();
            float m_run = -INFINITY, l_run = 0.f;
#pragma unroll 1
            for (int kt = 0; kt < nt; ++kt) {
                const bool more = (kt + 1 < nt);
                if (more) { const size_t ko = (size_t)(kt + 1) * 64 * 512, vo = (size_t)(kt + 1) * 64;
                    st[0] = *(const u32x4*)(kg[0] + ko); st[1] = *(const u32x4*)(kg[1] + ko); st[2] = *(const u32x4*)(vg[0] + vo); st[3] = *(const u32x4*)(vg[1] + vo); }
                const LAS unsigned char* buf = lds + (kt & 1) * STAGE;
                if (kt <= my_last) {
                    f32x16 S[2];
#pragma unroll
                    for (int u = 0; u < 2; ++u) { S[u] = zero16();
#pragma unroll
                        for (int ks = 0; ks < 4; ++ks) { const bf16x8 A = *(const LAS bf16x8*)(buf + m * KBYTES + (32 * u + r) * KROW + (16 * ks + 8 * half) * 2); S[u] = mfma32(A, Qf[ks], S[u]); } }
                    asm volatile("s_nop 15\n\ts_nop 7" : "+v"(S[0]), "+v"(S[1]));
                    float mx = -INFINITY;
#pragma unroll
                    for (int u = 0; u < 2; ++u)
#pragma unroll
                        for (int i = 0; i < 16; ++i) mx = fmaxf(mx, S[u][i]);
                    mx = fmaxf(mx, __shfl_xor(mx, 32));
                    const float m_new = fmaxf(m_run, mx * cs), alpha = __builtin_amdgcn_exp2f(m_run - m_new);
                    float ps = 0.f;
#pragma unroll
                    for (int u = 0; u < 2; ++u)
#pragma unroll
                        for (int i = 0; i < 16; ++i) { const float e = __builtin_amdgcn_exp2f(S[u][i] * cs - m_new); S[u][i] = e; ps += e; }
                    ps += __shfl_xor(ps, 32);
                    l_run = l_run * alpha + ps; m_run = m_new;
#pragma unroll
                    for (int d = 0; d < 4; ++d)
#pragma unroll
                        for (int i = 0; i < 16; ++i) O[d][i] *= alpha;
                    bf16x8 Pf[2][2];
#pragma unroll
                    for (int u = 0; u < 2; ++u)
#pragma unroll
                        for (int s = 0; s < 2; ++s) { u32x4 w; w.x = mk_pk2(S[u][8 * s + 0], S[u][8 * s + 1]); w.y = mk_pk2(S[u][8 * s + 2], S[u][8 * s + 3]); w.z = mk_pk2(S[u][8 * s + 4], S[u][8 * s + 5]); w.w = mk_pk2(S[u][8 * s + 6], S[u][8 * s + 7]);
                            Pf[u][s] = __builtin_bit_cast(bf16x8, w); }
#pragma unroll
                    for (int d = 0; d < 4; ++d)
#pragma unroll
                        for (int u = 0; u < 2; ++u)
#pragma unroll
                            for (int s = 0; s < 2; ++s) { const LAS unsigned char* va = buf + VOFF + (32 * d + r) * KROW + (32 * u + 16 * s + 4 * half) * 2;
                                const u32x2 lo = *(const LAS u32x2*)va, hi = *(const LAS u32x2*)(va + 16);
                                u32x4 w; w.x = lo.x; w.y = lo.y; w.z = hi.x; w.w = hi.y;
                                O[d] = mfma32(__builtin_bit_cast(bf16x8, w), Pf[u][s], O[d]); }
                }
                if (more) { LAS unsigned char* nb = lds + ((kt + 1) & 1) * STAGE;
                    *(LAS u32x4*)(nb + kl[0]) = st[0]; *(LAS u32x4*)(nb + kl[1]) = st[1]; *(LAS u32x4*)(nb + vl[0]) = st[2]; *(LAS u32x4*)(nb + vl[1]) = st[3]; }
                __syncthreads();
            }
            asm volatile("s_nop 15\n\ts_nop 7" : "+v"(O[0]), "+v"(O[1]), "+v"(O[2]), "+v"(O[3]));
            const float inv = 1.0f / l_run;
            LAS float* Cb = (LAS float*)lds;
            if (m == 1) { const float f = inv * lam;
#pragma unroll
                for (int d = 0; d < 4; ++d)
#pragma unroll
                    for (int i = 0; i < 16; ++i) Cb[(sub * 128 + 32 * d + crow(i, half)) * 33 + r] = O[d][i] * f; }
            __syncthreads();
            if (m == 0) { float ss = 0.f;
#pragma unroll
                for (int d = 0; d < 4; ++d)
#pragma unroll
                    for (int i = 0; i < 16; ++i) { const float o = O[d][i] * inv - Cb[(sub * 128 + 32 * d + crow(i, half)) * 33 + r]; O[d][i] = o; ss += o * o; }
                ss += __shfl_xor(ss, 32);
                const float rs = rsqrtf(ss * (1.0f / 128.0f) + 1e-5f) * (1.0f - lam_init);
#pragma unroll
                for (int d = 0; d < 4; ++d)
#pragma unroll
                    for (int ig = 0; ig < 4; ++ig) { const int dv0 = 32 * d + 8 * ig + 4 * half; const f32x4 gn = *(const f32x4*)(sg + dv0);
                        u32x2 w; w.x = mk_pk2(O[d][4 * ig + 0] * rs * gn[0], O[d][4 * ig + 1] * rs * gn[1]); w.y = mk_pk2(O[d][4 * ig + 2] * rs * gn[2], O[d][4 * ig + 3] * rs * gn[3]);
                        *(u32x2*)(OUTP + (size_t)qrow * 512 + h * 128 + dv0) = w; } }
            __syncthreads();
        }
    }
}

template <bool P2> DI void phase_ssm(const Params& p, int l, LAS unsigned char* lds, int lane, int wave, int G) {
    const bf16* DU = (const bf16*)(p.ws + WS_P + 7 * PBUF); bf16* YG = (bf16*)(p.ws + WS_YG); float* E = (float*)(p.ws + WS_E);
    const bf16* BB = (const bf16*)(p.ws + WS_BB) + (size_t)l * 32 * 128 * 16; const bf16* CM = (const bf16*)(p.ws + WS_CM) + (size_t)l * 32 * 16 * 128;
    const float* AP = (const float*)(p.ws + WS_AP) + (size_t)l * 32 * 64 * 8; const float* dsk = p.in[I_SSMD] + l * 512;
    const int r = lane & 31, half = lane >> 5, r16 = lane & 15, q4 = lane >> 4;
    constexpr int XRS = 272;
    LAS unsigned char* Xs = lds + wave * (64 * XRS);
    for (int it = blockIdx.x * 8 + wave; it < 16384; it += G * 8) {
        const int c = it & 63, g = (it >> 6) & 31, b = it >> 11, tok0 = b * SEQ + c * 64;
        f32x16 X[4][2];
        { bf16x8 Uf[2], Bf[4];
#pragma unroll
            for (int tt = 0; tt < 2; ++tt) { const int tau = 32 * ((r >> 2) & 1) + 16 * tt + (r & 3) + 4 * (r >> 3); Uf[tt] = *(const bf16x8*)(DU + (size_t)(tok0 + tau) * 512 + g * 16 + 8 * half); }
#pragma unroll
            for (int pt = 0; pt < 4; ++pt) Bf[pt] = *(const bf16x8*)(BB + ((size_t)g * 128 + 32 * pt + r) * 16 + 8 * half);
#pragma unroll
            for (int pt = 0; pt < 4; ++pt)
#pragma unroll
                for (int tt = 0; tt < 2; ++tt) X[pt][tt] = mfma32(Uf[tt], Bf[pt], zero16()); }
        asm volatile("s_nop 15\n\ts_nop 15" : "+v"(X[0][0]), "+v"(X[0][1]), "+v"(X[1][0]), "+v"(X[1][1]), "+v"(X[2][0]), "+v"(X[2][1]), "+v"(X[3][0]), "+v"(X[3][1]));
        float ar[2], ai[2], a32r[2], a32i[2], a64r[2], a64i[2];
#pragma unroll
        for (int s = 0; s < 2; ++s) { const float* ap = AP + ((size_t)g * 64 + 32 * s + r) * 8; const f32x4 v = *(const f32x4*)ap; ar[s] = v[0]; ai[s] = v[1]; a32r[s] = v[2]; a32i[s] = v[3]; a64r[s] = ap[4]; a64i[s] = ap[5]; }
        float xr[2] = {0.f, 0.f}, xi[2] = {0.f, 0.f};
        if (P2) {
            const float* e0 = E + (((size_t)(b * 32 + g) * 64) * 64 + r) * 2;
            float sr0 = 0.f, si0 = 0.f, sr1 = 0.f, si1 = 0.f;
#pragma unroll 4
            for (int j = 0; j < c; ++j) { const float2 ea = *(const float2*)(e0 + (size_t)j * 128), eb = *(const float2*)(e0 + (size_t)j * 128 + 64);
                const float t0 = a64r[0] * sr0 - a64i[0] * si0 + ea.x; si0 = a64r[0] * si0 + a64i[0] * sr0 + ea.y; sr0 = t0;
                const float t1 = a64r[1] * sr1 - a64i[1] * si1 + eb.x; si1 = a64r[1] * si1 + a64i[1] * sr1 + eb.y; sr1 = t1; }
            if (half == 0) { xr[0] = sr0; xi[0] = si0; xr[1] = sr1; xi[1] = si1; }
        }
#pragma unroll
        for (int s = 0; s < 2; ++s)
#pragma unroll
            for (int tt = 0; tt < 2; ++tt)
#pragma unroll
                for (int i = 0; i < 16; ++i) { const float nr = ar[s] * xr[s] - ai[s] * xi[s] + X[s][tt][i], ni = ar[s] * xi[s] + ai[s] * xr[s] + X[2 + s][tt][i]; X[s][tt][i] = nr; X[2 + s][tt][i] = ni; xr[s] = nr; xi[s] = ni; }
        float oxr[2], oxi[2];
#pragma unroll
        for (int s = 0; s < 2; ++s) { oxr[s] = __shfl_xor(xr[s], 32); oxi[s] = __shfl_xor(xi[s], 32); }
        if (!P2) {
            if (half == 1) {
#pragma unroll
                for (int s = 0; s < 2; ++s) { float2 e; e.x = xr[s] + a32r[s] * oxr[s] - a32i[s] * oxi[s]; e.y = xi[s] + a32r[s] * oxi[s] + a32i[s] * oxr[s];
                    *(float2*)(E + (((size_t)(b * 32 + g) * 64 + c) * 64 + 32 * s + r) * 2) = e; } }
        } else {
#pragma unroll
            for (int s = 0; s < 2; ++s) { float wr_ = half ? oxr[s] : 0.f, wi_ = half ? oxi[s] : 0.f;
#pragma unroll
                for (int tt = 0; tt < 2; ++tt)
#pragma unroll
                    for (int i = 0; i < 16; ++i) { const float t = ar[s] * wr_ - ai[s] * wi_; wi_ = ar[s] * wi_ + ai[s] * wr_; wr_ = t; X[s][tt][i] += wr_; X[2 + s][tt][i] += wi_; } }
#pragma unroll
            for (int pt = 0; pt < 4; ++pt)
#pragma unroll
                for (int tt = 0; tt < 2; ++tt)
#pragma unroll
                    for (int i = 0; i < 16; ++i) *(LAS unsigned short*)(Xs + (32 * half + 16 * tt + i) * XRS + (32 * pt + r) * 2) = f2bf(X[pt][tt][i]);
            LDS_WAIT();
            bf16x8 Cf[4];
#pragma unroll
            for (int ks = 0; ks < 4; ++ks) Cf[ks] = *(const bf16x8*)(CM + ((size_t)g * 16 + r16) * 128 + 32 * ks + 8 * q4);
            const int ch = g * 16 + r16; const float dk = dsk[ch];
#pragma unroll
            for (int mt = 0; mt < 4; ++mt) { f32x4 acc = {0.f, 0.f, 0.f, 0.f};
#pragma unroll
                for (int ks = 0; ks < 4; ++ks) { const bf16x8 A = *(const LAS bf16x8*)(Xs + (16 * mt + r16) * XRS + (32 * ks + 8 * q4) * 2); acc = mfma16(A, Cf[ks], acc); }
                asm volatile("s_nop 15" : "+v"(acc));
#pragma unroll
                for (int j = 0; j < 4; ++j) { const size_t o = (size_t)(tok0 + 16 * mt + 4 * q4 + j) * 512 + ch; const float y = acc[j] + dk * bf2f(DU[o]); YG[o] = f2bf(mk_gelu(y)); } }
            LDS_WAIT();
        }
    }
}

DI void phase_final(const Params& p, int tid, int G) {
    const float* rowss = (const float*)(p.ws + WS_ROWSS) + 4 * TOK; const float* gf = p.in[I_GFIN]; float* out = p.out;
    for (size_t i = (size_t)blockIdx.x * NTHR + tid; i < (size_t)TOK * 256; i += (size_t)G * NTHR) { const int row = (int)(i >> 8), c4 = (int)(i & 255);
        const float rs = pg8::rstd_of(rowss[row]); const f32x4 v = *((const f32x4*)out + i), gv = *((const f32x4*)gf + c4); *((f32x4*)out + i) = v * rs * gv; }
}

#define XB_TMO      128
#define XB_XCNT(j)  (256  + 64 * (j))
#define XB_XSUB(j)  (1280 + 64 * (j))
#define XB_XGEN(j)  (2304 + 64 * (j))
#define XB_TOP      3328
#define XB_TOPGEN   3392
#define XCD_BAR_WORDS 3456
#define XB_SPIN_CAP (1u << 18)

__device__ __forceinline__ unsigned xb_ld(unsigned* p)              { return __hip_atomic_load(p, __ATOMIC_RELAXED, __HIP_MEMORY_SCOPE_AGENT); }
__device__ __forceinline__ unsigned xb_add(unsigned* p, unsigned v) { return __hip_atomic_fetch_add(p, v, __ATOMIC_RELAXED, __HIP_MEMORY_SCOPE_AGENT); }
__device__ __forceinline__ unsigned xb_xcc_id() { return (unsigned)__builtin_amdgcn_s_getreg((3 << 11) | 20) & 0xFu; }
#define XB_SPIN(cond, bar) do { unsigned _sp = 0; while (cond) { __builtin_amdgcn_s_sleep(1); \
    if ((++_sp & 255u) == 0u) { if (xb_ld(&(bar)[XB_TMO])) break; if (_sp > XB_SPIN_CAP) { atomicAdd(&(bar)[XB_TMO], 1u); break; } } } } while (0)

struct XcdBarrier {
    unsigned* bar; unsigned x;
    volatile LAS unsigned* st;
};

__device__ __forceinline__ XcdBarrier xcd_barrier_post(unsigned* bar, volatile LAS unsigned* st) {
    XcdBarrier b; b.bar = bar; b.x = xb_xcc_id(); b.st = st;
    if (threadIdx.x == 0) (void)xb_add(&bar[XB_XCNT(b.x)], 1u);
    return b;
}
__device__ __forceinline__ void xcd_barrier_complete(unsigned* bar, unsigned x, unsigned& nloc, unsigned& nx) {
    const unsigned G = gridDim.x * gridDim.y * gridDim.z;
    unsigned sum, cnt, mine, sp = 0u;
    for (;;) {
        sum = 0u; cnt = 0u; mine = 0u;
#pragma unroll
        for (unsigned j = 0; j < 16; ++j) { const unsigned c = xb_ld(&bar[XB_XCNT(j)]); sum += c; cnt += (c > 0u) ? 1u : 0u; mine = (j == x) ? c : mine; }
        if (sum == G) break;
        __builtin_amdgcn_s_sleep(1);
        if ((++sp & 255u) == 0u) { if (xb_ld(&bar[XB_TMO])) break; if (sp > XB_SPIN_CAP) { atomicAdd(&bar[XB_TMO], 1u); break; } }
    }
    nloc = mine > 0u ? mine : 1u; nx = cnt > 0u ? cnt : 1u;
}

__device__ __forceinline__ void xcd_barrier(const XcdBarrier& b) {
    asm volatile("s_waitcnt vmcnt(0)" ::: "memory");
    __syncthreads();
    if (threadIdx.x == 0) {
        unsigned* bar = b.bar;
        __builtin_amdgcn_s_waitcnt(0);
        unsigned nloc = b.st[0], nx = b.st[1];
        if (nloc == 0u) { xcd_barrier_complete(bar, b.x, nloc, nx); b.st[0] = nloc; b.st[1] = nx; }
        const unsigned old = xb_add(&bar[XB_XSUB(b.x)], 1u);
        const unsigned gen = old / nloc;
        if (old + 1u == (gen + 1u) * nloc) {
            __builtin_amdgcn_fence(__ATOMIC_RELEASE, "agent");
            asm volatile("s_waitcnt vmcnt(0)" ::: "memory");
            const unsigned og = xb_add(&bar[XB_TOP], 1u);
            const unsigned tg = og / nx;
            if (og + 1u == (tg + 1u) * nx) xb_add(&bar[XB_TOPGEN], 1u);
            else XB_SPIN(xb_ld(&bar[XB_TOPGEN]) == tg, bar);
            __builtin_amdgcn_fence(__ATOMIC_ACQUIRE, "agent");
            xb_add(&bar[XB_XGEN(b.x)], 1u);
            asm volatile("s_waitcnt vmcnt(0)" ::: "memory");
        } else {
            XB_SPIN(xb_ld(&bar[XB_XGEN(b.x)]) == gen, bar);
            __builtin_amdgcn_fence(__ATOMIC_ACQUIRE, "agent");
            asm volatile("s_waitcnt vmcnt(0)" ::: "memory");
        }
    }
    __syncthreads();
}


__global__ void __launch_bounds__(NTHR) mega(Params p) {
    extern __shared__ __attribute__((aligned(16))) unsigned char lds_raw[];
    LAS unsigned char* lds = (LAS unsigned char*)lds_raw;
    const int G = gridDim.x;
#define LAUNDER() int tid = threadIdx.x; asm volatile("" : "+v"(tid)); const int lane = tid & 63, wave = __builtin_amdgcn_readfirstlane(tid >> 6); (void)lane; (void)wave
    const int lo = p.ph_lo, hi = p.ph_hi;
    unsigned char* ws = p.ws;
    int ph = 0;
    volatile LAS unsigned* xb_st = (volatile LAS unsigned*)(lds + 139264);
    XcdBarrier xbar; xbar.bar = (unsigned*)(ws + WS_BAR); xbar.x = 0; xbar.st = xb_st;
    if (ONE_LAUNCH) { if (threadIdx.x < 4) xb_st[threadIdx.x] = 0u; __syncthreads(); xbar = xcd_barrier_post((unsigned*)(ws + WS_BAR), xb_st); }
#ifndef ONLY_KIND
#define ONLY_KIND -1
#endif
#define KEN(k) (ONLY_KIND < 0 || ONLY_KIND == (k))
#ifndef DUP
#define DUP 0
#endif
#define REP(bit) _Pragma("unroll 1") for (int rep_ = 0; rep_ < ((DUP & (bit)) ? 2 : 1); ++rep_)
#define IN_PH() (lo <= ph && ph < hi)
#define END_PH() do { if (ONE_LAUNCH && lo <= ph && ph + 1 < hi) { if (ph == 0) cg::this_grid().sync(); else xcd_barrier(xbar); } ++ph; } while (0)
    if (IN_PH() && KEN(0)) REP(128) { LAUNDER(); phase_prep(p, lds, tid, lane, wave, G); }
    END_PH();
    bf16* XB = (bf16*)(ws + WS_XB); float* rowss = (float*)(ws + WS_ROWSS);
    for (int l = 0; l < 2; ++l) {
        unsigned char* wl = ws + WS_W + (size_t)l * WL_SIZE;
        const bf16* WinT = (const bf16*)(wl + WL_IN);
        bf16* P0 = (bf16*)(ws + WS_P);
        const float* rs_mix = rowss + (size_t)(2 * l) * TOK; float* rs_ffn = rowss + (size_t)(2 * l + 1) * TOK; float* rs_next = rowss + (size_t)(2 * l + 2) * TOK;
        pg8::StaticOrder S;
        if (IN_PH()) REP(1) {
            if (KEN(1)) { pg8::Gemm g{XB, WinT, TOK, 4096, 1024}; S.init(TOK, 4096, G, (int)blockIdx.x); pg8::EpiProj E{P0, rs_mix}; pg8::gemm_phase<pg8::EpiProj, pg8::StaticOrder>(lds, g, S, E); }
            if (KEN(2)) { pg8::Gemm g{WinT + (size_t)4096 * 1024, XB, 512, TOK, 1024}; S.init(512, TOK, G, (int)blockIdx.x); pg8::EpiVT E{(bf16*)(ws + WS_P + 8 * PBUF), rs_mix}; pg8::gemm_phase<pg8::EpiVT, pg8::StaticOrder>(lds, g, S, E); }
        }
        END_PH();
        if (IN_PH()) { if (KEN(20)) REP(4) { LAUNDER(); phase_attn(p, l, lds, tid, lane, wave, G, (DUP & 4) && rep_ == 0 ? (bf16*)(ws + WS_YG) : (bf16*)(ws + WS_P + 5 * PBUF)); } if (KEN(21)) { LAUNDER(); phase_branchB(p, l, lds, tid, lane, wave, G); } if (KEN(22)) REP(16) { LAUNDER(); phase_ssm<false>(p, l, lds, lane, wave, G); } if (KEN(23)) { LAUNDER(); phase_branchA(p, l, tid, G); } }
        END_PH();
        if (IN_PH() && KEN(3)) REP(16) { LAUNDER(); phase_ssm<true>(p, l, lds, lane, wave, G); }
        END_PH();
        if (IN_PH() && KEN(4)) REP(64) { pg8::Gemm g{(const bf16*)(ws + WS_YG), (const bf16*)(wl + WL_GLU), TOK, 512, 512}; S.init(TOK, 512, G, (int)blockIdx.x);
            pg8::EpiGlu E{(const bf16*)(ws + WS_YG), (bf16*)(ws + WS_P + 7 * PBUF), p.in[I_BGLU] + l * 512}; pg8::gemm_phase<pg8::EpiGlu, pg8::StaticOrder>(lds, g, S, E); }
        END_PH();
        bf16* GS = (bf16*)(ws + WS_P + 1 * PBUF); bf16* MG = (bf16*)(ws + WS_P + 8 * PBUF);
        if (IN_PH() && KEN(5)) REP(8) {
#pragma unroll 1
            for (int b = 0; b < 4; ++b) {
                { pg8::Gemm g{XB, WinT + (size_t)(4608 + 1024 * b) * 1024, TOK, 1024, 1024}; S.init(TOK, 1024, G, (int)blockIdx.x); pg8::EpiGate E{GS, rs_mix}; pg8::gemm_phase<pg8::EpiGate, pg8::StaticOrder>(lds, g, S, E); }
                const size_t yb = (b == 0) ? 0 : (b == 1) ? 3 : (b == 2) ? 5 : 7;
                pg8::Gemm g{(const bf16*)(ws + WS_P + yb * PBUF), (const bf16*)(wl + WL_BR) + (size_t)b * 1024 * 512, TOK, 1024, 512}; S.init(TOK, 1024, G, (int)blockIdx.x);
                if (b == 0) { pg8::EpiBr<true> E{GS, MG}; pg8::gemm_phase<pg8::EpiBr<true>, pg8::StaticOrder>(lds, g, S, E); }
                else { pg8::EpiBr<false> E{GS, MG}; pg8::gemm_phase<pg8::EpiBr<false>, pg8::StaticOrder>(lds, g, S, E); }
            }
        }
        END_PH();
        if (IN_PH() && KEN(6)) { pg8::Gemm g{MG, (const bf16*)(wl + WL_O), TOK, 1024, 1024}; S.init(TOK, 1024, G, (int)blockIdx.x);
            pg8::EpiResid E{l == 0 ? p.in[I_X] : (const float*)p.out, p.out, XB, rs_ffn}; pg8::gemm_phase<pg8::EpiResid, pg8::StaticOrder>(lds, g, S, E); }
        END_PH();
        bf16* H = (bf16*)(ws + WS_P);
        if (IN_PH() && KEN(7)) REP(2) { pg8::Gemm g{XB, (const bf16*)(wl + WL_FF), TOK, 5632, 1024}; S.init(TOK, 5632, G, (int)blockIdx.x);
            pg8::EpiFfnUp E{H, rs_ffn}; pg8::gemm_phase<pg8::EpiFfnUp, pg8::StaticOrder>(lds, g, S, E); }
        END_PH();
        if (IN_PH() && KEN(8)) { pg8::Gemm g{H, (const bf16*)(wl + WL_D), TOK, 1024, 2816}; S.init(TOK, 1024, G, (int)blockIdx.x);
            pg8::EpiResid E{(const float*)p.out, p.out, XB, rs_next}; pg8::gemm_phase<pg8::EpiResid, pg8::StaticOrder>(lds, g, S, E); }
        END_PH();
    }
    if (IN_PH() && KEN(9)) { LAUNDER(); phase_final(p, tid, G); }
}
constexpr int N_PHASES = 18;
}

extern "C" void kernel_launch(void* const* d_in, const int* in_sizes, int n_in, void* d_out, int out_size, void* d_ws, size_t ws_size, hipStream_t stream) {
    static int grid = 0;
    if (grid == 0) {
        if (n_in != 28 || out_size != mk::TOK * mk::DM || ws_size < mk::WS_END) { fprintf(stderr, "kernel_launch: unexpected shapes (n_in %d out %d ws %zu need %zu)\n", n_in, out_size, ws_size, (size_t)mk::WS_END); grid = -1; return; }
        int dev = 0, cus = 0, per_cu = 0;
        hipGetDevice(&dev); hipDeviceGetAttribute(&cus, hipDeviceAttributeMultiprocessorCount, dev);
        if (hipFuncSetAttribute((const void*)mk::mega, hipFuncAttributeMaxDynamicSharedMemorySize, mk::LDS_BYTES) != hipSuccess) { fprintf(stderr, "kernel_launch: hipFuncSetAttribute failed\n"); grid = -1; return; }
        if (hipOccupancyMaxActiveBlocksPerMultiprocessor(&per_cu, (const void*)mk::mega, mk::NTHR, mk::LDS_BYTES) != hipSuccess || per_cu < 1) { fprintf(stderr, "kernel_launch: occupancy query says %d\n", per_cu); per_cu = 1; }
        (void)hipGetLastError();
        grid = cus * 1;
        if (grid <= 0) grid = 256;
    }
    if (grid < 0) return;
    mk::Params p{};
    for (int i = 0; i < 28; ++i) p.in[i] = (const float*)d_in[i];
    p.out = (float*)d_out; p.ws = (unsigned char*)d_ws;
#if ONE_LAUNCH
    if (hipMemsetAsync((unsigned char*)d_ws + mk::WS_BAR, 0, XCD_BAR_WORDS * sizeof(unsigned), stream) != hipSuccess) { fprintf(stderr, "kernel_launch: memset failed\n"); return; }
    p.ph_lo = 0; p.ph_hi = mk::N_PHASES;
    void* args[] = {&p};
    hipError_t e = hipLaunchCooperativeKernel((const void*)mk::mega, dim3(grid), dim3(mk::NTHR), args, mk::LDS_BYTES, stream);
    if (e != hipSuccess) fprintf(stderr, "cooperative launch failed: %s (grid %d)\n", hipGetErrorString(e), grid);
#else
    for (int ph = 0; ph < mk::N_PHASES; ++ph) { p.ph_lo = ph; p.ph_hi = ph + 1;
        hipLaunchKernelGGL(mk::mega, dim3(grid), dim3(mk::NTHR), mk::LDS_BYTES, stream, p); }
#endif
}
```

```cpp
#include <hip/hip_runtime.h>
#include <hip/hip_cooperative_groups.h>
#include <cstdio>
#include <cstdint>
#ifndef ONE_LAUNCH
#define ONE_LAUNCH 1
#endif
namespace cg = cooperative_groups;
typedef __bf16 mk_bf16x2_t __attribute__((ext_vector_type(2)));
typedef float mk_f32x2_t __attribute__((ext_vector_type(2)));
__device__ __forceinline__ unsigned mk_pk2(float lo, float hi) { mk_f32x2_t v = {lo, hi}; mk_bf16x2_t b = __builtin_convertvector(v, mk_bf16x2_t); return __builtin_bit_cast(unsigned, b); }
__device__ __forceinline__ float mk_lo(unsigned w) { return __uint_as_float(w << 16); }
__device__ __forceinline__ float mk_hi(unsigned w) { return __uint_as_float(w & 0xffff0000u); }
__device__ __forceinline__ float mk_sigm(float x) { return __builtin_amdgcn_rcpf(1.0f + __expf(-x)); }
__device__ __forceinline__ float mk_gelu(float x) { const float u = 1.5957691216f * (x + 0.044715f * x * x * x); return x * __builtin_amdgcn_rcpf(1.0f + __expf(-u)); }
namespace pg8 {
#define PG8_LAS __attribute__((address_space(3)))
typedef unsigned short bf16_t;
typedef short bf16x8 __attribute__((ext_vector_type(8)));
typedef float f32x4 __attribute__((ext_vector_type(4)));
typedef unsigned u32x4 __attribute__((ext_vector_type(4)));
constexpr int BM = 256, BK = 64, HALF = 128, HTB = HALF * BK * 2  , STAGE_BYTES = 8 * HTB, NXCD = 8, WGM = 8;

__host__ __device__ __forceinline__ int lds_byte(int r, int c) { const int st = (r >> 4) * 2 + (c >> 5), rr = r & 15, cc = c & 31, ob = rr * 64 + cc * 2; return st * 1024 + (ob ^ (((ob >> 9) & 1) << 5)); }
__host__ __device__ __forceinline__ void stage_rc(int b, int& R, int& C) { const int st = b / 1024, sb = b % 1024, swz = sb ^ (((sb >> 9) & 1) << 5); R = (st >> 1) * 16 + swz / 64; C = (st & 1) * 32 + (swz % 64) / 2; }
__host__ __device__ __forceinline__ int perm32(int rho) { const int n = rho >> 4, i = rho & 15; return 8 * (i >> 2) + 4 * n + (i & 3); }

struct Unit { int pm, pn; };
struct Gemm { const bf16_t* A; const bf16_t* Bt; int M, N, K; };

struct StaticOrder {
    int nM, nN, nwg, G, c;
    __host__ __device__ void init(int M, int N, int G_, int c_) { nM = M / BM; nN = N / BM; nwg = nM * nN; G = G_; c = c_; }
    __host__ __device__ bool next(int i, Unit& u) const {
        const long L = (long)i * G + c; if (L >= nwg) return false;
        int wgid = (int)L; { const int q = nwg / NXCD, r = nwg % NXCD, xcd = wgid % NXCD, off = wgid / NXCD; wgid = (xcd < r ? xcd * (q + 1) : r * (q + 1) + (xcd - r) * q) + off; }
        const int nig = WGM * nN, gid = wgid / nig, fm = gid * WGM, gsz = (nM - fm) < WGM ? (nM - fm) : WGM;
        u.pm = fm + ((wgid % nig) % gsz); u.pn = (wgid % nig) / gsz; return true;
    }
    __device__ __forceinline__ void a_ready(const Unit&) const {}
    __device__ __forceinline__ void done(const Unit&) const {}
};
typedef unsigned u32x2 __attribute__((ext_vector_type(2)));
constexpr int MK_TOK = 32768;
#define MK_EPI_LOOP_AM _Pragma("unroll") for (int ai = 0; ai < 2; ++ai) _Pragma("unroll") for (int m = 0; m < 4; ++m)
__device__ __forceinline__ u32x4 pack8(const f32x4 a, const f32x4 b) { u32x4 w; w.x = mk_pk2(a[0], a[1]); w.y = mk_pk2(a[2], a[3]); w.z = mk_pk2(b[0], b[1]); w.w = mk_pk2(b[2], b[3]); return w; }
__device__ __forceinline__ void unpack8(const u32x4 w, f32x4& a, f32x4& b) { a = (f32x4){mk_lo(w.x), mk_hi(w.x), mk_lo(w.y), mk_hi(w.y)}; b = (f32x4){mk_lo(w.z), mk_hi(w.z), mk_lo(w.w), mk_hi(w.w)}; }
__device__ __forceinline__ float rstd_of(float ss) { return rsqrtf(ss * (1.0f / 1024.0f) + 1e-6f); }

struct EpiProj { static constexpr bool PERM = true, AFTER_DRAIN = false; bf16_t* P; const float* rowss;
    __device__ __forceinline__ void operator()(const f32x4 (&acc)[2][2][4][2], const Unit& u, int wr, int wc, int fr, int fq) const {
        const int row0 = u.pm * BM + wr * 64 + fr;
        bf16_t* base = P + (size_t)(u.pn >> 1) * ((size_t)MK_TOK * 512) + (u.pn & 1) * 256 + wc * 32 + 8 * fq;
        MK_EPI_LOOP_AM { const int row = row0 + ai * HALF + m * 16; const float rs = rstd_of(rowss[row]); bf16_t* rp = base + (size_t)row * 512;
#pragma unroll
            for (int bj = 0; bj < 2; ++bj) *(u32x4*)(rp + bj * HALF) = pack8(acc[ai][bj][m][0] * rs, acc[ai][bj][m][1] * rs); }
    }
};
struct EpiVT { static constexpr bool PERM = true, AFTER_DRAIN = false; bf16_t* VT; const float* rowss;
    __device__ __forceinline__ void operator()(const f32x4 (&acc)[2][2][4][2], const Unit& u, int wr, int wc, int fr, int fq) const {
        const int row0 = u.pm * BM + wr * 64 + fr, col0 = u.pn * BM + wc * 32 + 8 * fq;
        f32x4 rs[2][2];
#pragma unroll
        for (int bj = 0; bj < 2; ++bj)
#pragma unroll
            for (int n = 0; n < 2; ++n) { const f32x4 s = *(const f32x4*)(rowss + col0 + bj * HALF + 4 * n); rs[bj][n] = (f32x4){rstd_of(s[0]), rstd_of(s[1]), rstd_of(s[2]), rstd_of(s[3])}; }
        MK_EPI_LOOP_AM { const int row = row0 + ai * HALF + m * 16; bf16_t* rp = VT + (size_t)row * MK_TOK + col0;
#pragma unroll
            for (int bj = 0; bj < 2; ++bj) *(u32x4*)(rp + bj * HALF) = pack8(acc[ai][bj][m][0] * rs[bj][0], acc[ai][bj][m][1] * rs[bj][1]); }
    }
};
struct EpiGlu { static constexpr bool PERM = true, AFTER_DRAIN = false; const bf16_t* YG; bf16_t* O; const float* bias;
    __device__ __forceinline__ void operator()(const f32x4 (&acc)[2][2][4][2], const Unit& u, int wr, int wc, int fr, int fq) const {
        const int row0 = u.pm * BM + wr * 64 + fr, col0 = u.pn * BM + wc * 32 + 8 * fq;
        f32x4 bv[2][2];
#pragma unroll
        for (int bj = 0; bj < 2; ++bj)
#pragma unroll
            for (int n = 0; n < 2; ++n) bv[bj][n] = *(const f32x4*)(bias + col0 + bj * HALF + 4 * n);
        MK_EPI_LOOP_AM { const int row = row0 + ai * HALF + m * 16; const size_t off = (size_t)row * 512 + col0;
#pragma unroll
            for (int bj = 0; bj < 2; ++bj) { f32x4 y0, y1; unpack8(*(const u32x4*)(YG + off + bj * HALF), y0, y1);
                f32x4 a0 = acc[ai][bj][m][0] + bv[bj][0], a1 = acc[ai][bj][m][1] + bv[bj][1];
#pragma unroll
                for (int j = 0; j < 4; ++j) { y0[j] *= mk_sigm(a0[j]); y1[j] *= mk_sigm(a1[j]); }
                *(u32x4*)(O + off + bj * HALF) = pack8(y0, y1); } }
    }
};
struct EpiGate { static constexpr bool PERM = true, AFTER_DRAIN = false; bf16_t* GS; const float* rowss;
    __device__ __forceinline__ void operator()(const f32x4 (&acc)[2][2][4][2], const Unit& u, int wr, int wc, int fr, int fq) const {
        const int row0 = u.pm * BM + wr * 64 + fr, col0 = u.pn * BM + wc * 32 + 8 * fq;
        MK_EPI_LOOP_AM { const int row = row0 + ai * HALF + m * 16; const float rs = rstd_of(rowss[row]); const size_t off = (size_t)row * 1024 + col0;
#pragma unroll
            for (int bj = 0; bj < 2; ++bj) { f32x4 a0 = acc[ai][bj][m][0] * rs, a1 = acc[ai][bj][m][1] * rs;
#pragma unroll
                for (int j = 0; j < 4; ++j) { a0[j] = mk_sigm(a0[j]); a1[j] = mk_sigm(a1[j]); }
                *(u32x4*)(GS + off + bj * HALF) = pack8(a0, a1); } }
    }
};
template <bool FIRST> struct EpiBr { static constexpr bool PERM = true, AFTER_DRAIN = false; const bf16_t* GS; bf16_t* MG;
    __device__ __forceinline__ void operator()(const f32x4 (&acc)[2][2][4][2], const Unit& u, int wr, int wc, int fr, int fq) const {
        const int row0 = u.pm * BM + wr * 64 + fr, col0 = u.pn * BM + wc * 32 + 8 * fq;
        MK_EPI_LOOP_AM { const int row = row0 + ai * HALF + m * 16; const size_t off = (size_t)row * 1024 + col0;
#pragma unroll
            for (int bj = 0; bj < 2; ++bj) { f32x4 g0, g1; unpack8(*(const u32x4*)(GS + off + bj * HALF), g0, g1);
                f32x4 v0 = g0 * acc[ai][bj][m][0], v1 = g1 * acc[ai][bj][m][1];
                if (!FIRST) { f32x4 p0, p1; unpack8(*(const u32x4*)(MG + off + bj * HALF), p0, p1); v0 += p0; v1 += p1; }
                *(u32x4*)(MG + off + bj * HALF) = pack8(v0, v1); } }
    }
};
struct EpiResid { static constexpr bool PERM = false, AFTER_DRAIN = false; const float* xold; float* out; bf16_t* xb; float* rowss_next;
    __device__ __forceinline__ void operator()(const f32x4 (&acc)[2][2][4][2], const Unit& u, int wr, int wc, int fr, int fq) const {
        const int row0 = u.pm * BM + wr * 64 + fr, col0 = u.pn * BM + wc * 32 + 4 * fq;
        MK_EPI_LOOP_AM { const int row = row0 + ai * HALF + m * 16; const size_t off = (size_t)row * 1024 + col0; float ss = 0.f;
#pragma unroll
            for (int bj = 0; bj < 2; ++bj)
#pragma unroll
                for (int n = 0; n < 2; ++n) { const size_t o = off + bj * HALF + n * 16; const f32x4 xn = *(const f32x4*)(xold + o) + acc[ai][bj][m][n];
                    *(f32x4*)(out + o) = xn; u32x2 w; w.x = mk_pk2(xn[0], xn[1]); w.y = mk_pk2(xn[2], xn[3]); *(u32x2*)(xb + o) = w;
                    ss += (xn[0] * xn[0] + xn[1] * xn[1]) + (xn[2] * xn[2] + xn[3] * xn[3]); }
            ss += __shfl_xor(ss, 16); ss += __shfl_xor(ss, 32);
            if (fq == 0) __hip_atomic_fetch_add(rowss_next + row, ss, __ATOMIC_RELAXED, __HIP_MEMORY_SCOPE_AGENT); }
    }
};
struct EpiFfnUp { static constexpr bool PERM = true, AFTER_DRAIN = false; bf16_t* H; const float* rowss;
    __device__ __forceinline__ void operator()(const f32x4 (&acc)[2][2][4][2], const Unit& u, int wr, int wc, int fr, int fq) const {
        const int row0 = u.pm * BM + wr * 64 + fr, col0 = u.pn * HALF + wc * 32 + 8 * fq;
        MK_EPI_LOOP_AM { const int row = row0 + ai * HALF + m * 16; const float rs = rstd_of(rowss[row]);
            f32x4 g0 = acc[ai][0][m][0] * rs, g1 = acc[ai][0][m][1] * rs, u0 = acc[ai][1][m][0] * rs, u1 = acc[ai][1][m][1] * rs;
#pragma unroll
            for (int j = 0; j < 4; ++j) { g0[j] = g0[j] * mk_sigm(g0[j]) * u0[j]; g1[j] = g1[j] * mk_sigm(g1[j]) * u1[j]; }
            *(u32x4*)(H + (size_t)row * 2816 + col0) = pack8(g0, g1); }
    }
};
template <class Epi, class Sched, bool ALIGN_EPI = true, bool SP2 = true>
__device__ __forceinline__ void gemm_phase(PG8_LAS unsigned char* lds, const Gemm g, const Sched& S, const Epi& E) {
    int tid_l = threadIdx.x; asm volatile("" : "+v"(tid_l)); const int tid = tid_l, wid = __builtin_amdgcn_readfirstlane(tid >> 6), lane = tid & 63, wr = wid >> 2, wc = wid & 3, fr = lane & 15, fq = lane >> 4;
    const int K = g.K, nt = K / BK;
    unsigned voffA[2], voffB[2];
#pragma unroll
    for (int i = 0; i < 2; ++i) { int R, C; stage_rc(tid * 16 + i * 8192, R, C); const int Rb = Epi::PERM ? ((R & ~31) + perm32(R & 31)) : R;
        voffA[i] = (unsigned)(R * K + C) * 2u; voffB[i] = (unsigned)(Rb * K + C) * 2u; }
    const size_t kstep = (size_t)(BK * 2);
    const size_t hstep = (size_t)HALF * K * 2;
    const size_t tstep = 2 * hstep;
    const unsigned ldsw = (unsigned)wid * 1024u;
    const int aoff = lds_byte(wr * 64 + fr, fq * 8), boff = lds_byte(wc * 32 + fr, fq * 8);
#define PG8_SA(b, h) (((b) * 2 + (h)) * HTB)
#define PG8_SB(b, h) ((4 + (b) * 2 + (h)) * HTB)
#define PG8_STAGE(bufoff, gbase, voff) do { _Pragma("unroll") for (int _i = 0; _i < 2; ++_i) \
        __builtin_amdgcn_global_load_lds((const unsigned*)((const char*)(gbase) + (voff)[_i]), (PG8_LAS unsigned*)(lds + (bufoff) + ldsw + _i * 8192), 16, 0, 0); } while (0)
#define PG8_LDA(dst, b, h) do { _Pragma("unroll") for (int m = 0; m < 4; ++m) _Pragma("unroll") for (int k = 0; k < 2; ++k) dst[m][k] = *(const PG8_LAS bf16x8*)(lds + PG8_SA(b, h) + aoff + m * 2048 + k * 1024); } while (0)
#define PG8_LDB(dst, b, h) do { _Pragma("unroll") for (int n = 0; n < 2; ++n) _Pragma("unroll") for (int k = 0; k < 2; ++k) dst[n][k] = *(const PG8_LAS bf16x8*)(lds + PG8_SB(b, h) + boff + n * 2048 + k * 1024); } while (0)
#define PG8_MMA(ai, bj, At, Bt) do { __builtin_amdgcn_s_setprio(1); _Pragma("unroll") for (int m = 0; m < 4; ++m) _Pragma("unroll") for (int n = 0; n < 2; ++n) _Pragma("unroll") for (int k = 0; k < 2; ++k) \
        acc[ai][bj][m][n] = __builtin_amdgcn_mfma_f32_16x16x32_bf16(Bt[n][k], At[m][k], acc[ai][bj][m][n], 0, 0, 0); __builtin_amdgcn_s_setprio(0); } while (0)
#define PG8_WAIT_V(n) asm volatile("s_waitcnt vmcnt(" #n ")" ::: "memory")
#define PG8_WAIT_L(n) asm volatile("s_waitcnt lgkmcnt(" #n ")" ::: "memory")
#define PG8_BAR __builtin_amdgcn_s_barrier()
#define PG8_SCHED __builtin_amdgcn_sched_barrier(0)
    Unit cur, nxt; int ui = 0;
    if (!S.next(0, cur)) return;
    f32x4 acc[2][2][4][2];
#pragma unroll
    for (int a = 0; a < 2; ++a)
#pragma unroll
        for (int b = 0; b < 2; ++b)
#pragma unroll
            for (int m = 0; m < 4; ++m)
#pragma unroll
                for (int n = 0; n < 2; ++n) acc[a][b][m][n] = (f32x4){0.f, 0.f, 0.f, 0.f};
    bf16x8 At[4][2], B0[2][2], B1[2][2];
    const char* cA = (const char*)g.A + (size_t)cur.pm * tstep; const char* cB = (const char*)g.Bt + (size_t)cur.pn * tstep;
    S.a_ready(cur);
    if constexpr (SP2) {
        PG8_STAGE(PG8_SB(0, 0), cB, voffB); PG8_STAGE(PG8_SB(0, 1), cB + hstep, voffB); PG8_STAGE(PG8_SA(0, 0), cA, voffA); PG8_STAGE(PG8_SA(0, 1), cA + hstep, voffA);
        if (wr == 1) PG8_BAR;
        PG8_WAIT_V(2); PG8_BAR;
        PG8_STAGE(PG8_SB(1, 0), cB + kstep, voffB); PG8_STAGE(PG8_SA(1, 0), cA + kstep, voffA); PG8_STAGE(PG8_SB(1, 1), cB + hstep + kstep, voffB);
        PG8_WAIT_V(6); PG8_BAR;
    } else {
        PG8_STAGE(PG8_SB(0, 0), cB, voffB); PG8_STAGE(PG8_SA(0, 0), cA, voffA); PG8_STAGE(PG8_SB(0, 1), cB + hstep, voffB); PG8_STAGE(PG8_SA(0, 1), cA + hstep, voffA);
        if (wr == 1) PG8_BAR;
        PG8_WAIT_V(4); PG8_BAR;
        PG8_STAGE(PG8_SB(1, 0), cB + kstep, voffB); PG8_STAGE(PG8_SA(1, 0), cA + kstep, voffA); PG8_STAGE(PG8_SB(1, 1), cB + hstep + kstep, voffB);
        PG8_WAIT_V(6); PG8_BAR;
    }
    for (;;) {
        const bool has_next = S.next(ui + 1, nxt);
        const char* nA = has_next ? (const char*)g.A + (size_t)nxt.pm * tstep : cA; const char* nB = has_next ? (const char*)g.Bt + (size_t)nxt.pn * tstep : cB;
        for (int t = 0; t < nt; t += 2) {
            const bool last = (t == nt - 2);
            const char* a1 = cA + (size_t)(t + 1) * kstep;
            const char* a2 = last ? nA : cA + (size_t)(t + 2) * kstep; const char* b2 = last ? nB : cB + (size_t)(t + 2) * kstep;
            const char* a3 = a2 + kstep; const char* b3 = b2 + kstep;
            if (last && has_next) S.a_ready(nxt);
            if constexpr (SP2) {
            PG8_LDB(B0, 0, 0); PG8_LDB(B1, 0, 1); PG8_SCHED; PG8_LDA(At, 0, 0); PG8_STAGE(PG8_SA(1, 1), a1 + hstep, voffA);
            PG8_WAIT_V(8); PG8_WAIT_L(0); PG8_BAR; PG8_MMA(0, 0, At, B0); PG8_MMA(0, 1, At, B1); PG8_BAR; PG8_SCHED;
            PG8_LDA(At, 0, 1); PG8_STAGE(PG8_SB(0, 0), b2, voffB); PG8_STAGE(PG8_SB(0, 1), b2 + hstep, voffB); PG8_STAGE(PG8_SA(0, 0), a2, voffA);
            PG8_WAIT_V(8); PG8_WAIT_L(0); PG8_BAR; PG8_MMA(1, 0, At, B0); PG8_MMA(1, 1, At, B1); PG8_BAR; PG8_SCHED;
            PG8_LDB(B0, 1, 0); PG8_LDB(B1, 1, 1); PG8_SCHED; PG8_LDA(At, 1, 0); PG8_STAGE(PG8_SA(0, 1), a2 + hstep, voffA);
            PG8_WAIT_V(8); PG8_WAIT_L(0); PG8_BAR; PG8_MMA(0, 0, At, B0); PG8_MMA(0, 1, At, B1); PG8_BAR; PG8_SCHED;
            PG8_LDA(At, 1, 1); PG8_STAGE(PG8_SB(1, 0), b3, voffB); PG8_STAGE(PG8_SB(1, 1), b3 + hstep, voffB); PG8_STAGE(PG8_SA(1, 0), a3, voffA);
            PG8_WAIT_V(8); PG8_WAIT_L(0); PG8_BAR; PG8_MMA(1, 0, At, B0); PG8_MMA(1, 1, At, B1); PG8_BAR; PG8_SCHED;
            } else {
            PG8_LDB(B0, 0, 0); PG8_SCHED; PG8_LDA(At, 0, 0); PG8_STAGE(PG8_SA(1, 1), a1 + hstep, voffA);
            PG8_WAIT_L(8); PG8_BAR; PG8_WAIT_L(0); PG8_MMA(0, 0, At, B0); PG8_BAR; PG8_SCHED;
            PG8_LDB(B1, 0, 1); PG8_STAGE(PG8_SB(0, 0), b2, voffB);
            PG8_BAR; PG8_WAIT_L(0); PG8_MMA(0, 1, At, B1); PG8_BAR;
            PG8_LDA(At, 0, 1); PG8_STAGE(PG8_SA(0, 0), a2, voffA);
            PG8_BAR; PG8_WAIT_L(0); PG8_MMA(1, 0, At, B0); PG8_BAR; PG8_SCHED;
            PG8_STAGE(PG8_SB(0, 1), b2 + hstep, voffB);
            PG8_WAIT_V(6); PG8_BAR; PG8_MMA(1, 1, At, B1); PG8_BAR;
            PG8_LDB(B0, 1, 0); PG8_SCHED; PG8_LDA(At, 1, 0); PG8_STAGE(PG8_SA(0, 1), a2 + hstep, voffA);
            PG8_WAIT_L(8); PG8_BAR; PG8_WAIT_L(0); PG8_MMA(0, 0, At, B0); PG8_BAR; PG8_SCHED;
            PG8_LDB(B1, 1, 1); PG8_STAGE(PG8_SB(1, 0), b3, voffB);
            PG8_BAR; PG8_WAIT_L(0); PG8_MMA(0, 1, At, B1); PG8_BAR;
            PG8_LDA(At, 1, 1); PG8_STAGE(PG8_SA(1, 0), a3, voffA);
            PG8_BAR; PG8_WAIT_L(0); PG8_MMA(1, 0, At, B0); PG8_BAR; PG8_SCHED;
            PG8_STAGE(PG8_SB(1, 1), b3 + hstep, voffB);
            PG8_WAIT_V(6); PG8_BAR; PG8_MMA(1, 1, At, B1); PG8_BAR;
            }
        }
        if constexpr (ALIGN_EPI) { if (wr == 0) PG8_BAR; }
        if constexpr (!Epi::AFTER_DRAIN) { E(acc, cur, wr, wc, fr, fq); S.done(cur); }
        if (!has_next) break;
#pragma unroll
        for (int a = 0; a < 2; ++a)
#pragma unroll
            for (int b = 0; b < 2; ++b)
#pragma unroll
                for (int m = 0; m < 4; ++m)
#pragma unroll
                    for (int n = 0; n < 2; ++n) acc[a][b][m][n] = (f32x4){0.f, 0.f, 0.f, 0.f};
        cur = nxt; cA = nA; cB = nB; ++ui;
        if constexpr (ALIGN_EPI) { if (wr == 1) PG8_BAR; }
    }
    PG8_WAIT_V(0);
    if constexpr (!ALIGN_EPI) { if (wr == 0) PG8_BAR; }
    PG8_BAR;
    if constexpr (Epi::AFTER_DRAIN) { E.fused(acc, cur, wr, wc, fr, fq, lds, wid, lane); S.done(cur); }
#undef PG8_SA
#undef PG8_SB
#undef PG8_STAGE
#undef PG8_LDA
#undef PG8_LDB
#undef PG8_MMA
#undef PG8_WAIT_V
#undef PG8_WAIT_L
#undef PG8_BAR
#undef PG8_SCHED
}
}

namespace mk {
#define LAS __attribute__((address_space(3)))
#define DI __device__ __forceinline__
typedef unsigned short bf16;
typedef pg8::bf16x8 bf16x8; typedef pg8::f32x4 f32x4; typedef pg8::u32x4 u32x4; typedef pg8::u32x2 u32x2;
typedef float f32x16 __attribute__((ext_vector_type(16)));
constexpr int TOK = 32768, DM = 1024, SEQ = 4096, BW = 512, FFH = 2816, NTHR = 512;
constexpr size_t MiB = 1024 * 1024;
constexpr size_t WS_ROWSS = 0;
constexpr size_t WS_BAR = 768 * 1024;
constexpr size_t WS_BB = 1 * MiB;
constexpr size_t WS_CM = WS_BB + 262144;
constexpr size_t WS_AP = WS_CM + 262144;
constexpr size_t WS_SGW = WS_AP + 131072;
constexpr size_t WS_E = 2 * MiB;
constexpr size_t WS_W = 10 * MiB;
constexpr size_t WL_IN = 0, WL_GLU = 17825792, WL_BR = WL_GLU + 524288, WL_O = WL_BR + 4194304, WL_FF = WL_O + 2097152, WL_D = WL_FF + 11534336, WL_SIZE = WL_D + 5767168;
static_assert(WL_SIZE == 40 * MiB, "weights per layer");
constexpr size_t WS_XB = 90 * MiB;
constexpr size_t WS_P = 154 * MiB;
constexpr size_t PBUF = 32 * MiB;
constexpr size_t WS_YG = WS_P + 9 * PBUF;
constexpr size_t WS_END = WS_YG + 32 * MiB;
constexpr int LDS_BYTES = 143360;

DI float bf2f(bf16 v) { return __uint_as_float(((unsigned)v) << 16); }
DI bf16 f2bf(float f) { return (bf16)(mk_pk2(f, 0.f) & 0xffffu); }
DI float wave_sum(float v) {
#pragma unroll
    for (int o = 1; o < 64; o <<= 1) v += __shfl_xor(v, o);
    return v; }
DI f32x16 mfma32(bf16x8 a, bf16x8 b, f32x16 c) { return __builtin_amdgcn_mfma_f32_32x32x16_bf16(a, b, c, 0, 0, 0); }
DI f32x4 mfma16(bf16x8 a, bf16x8 b, f32x4 c) { return __builtin_amdgcn_mfma_f32_16x16x32_bf16(a, b, c, 0, 0, 0); }
DI int crow(int i, int h) { return (i & 3) + 8 * (i >> 2) + 4 * h; }
DI f32x16 zero16() { f32x16 z;
#pragma unroll
    for (int i = 0; i < 16; ++i) z[i] = 0.f;
    return z; }
#define LDS_WAIT() asm volatile("s_waitcnt lgkmcnt(0)" ::: "memory")

struct Params { const float* in[28]; float* out; unsigned char* ws; int ph_lo, ph_hi; };
enum { I_X = 0, I_GMIX, I_WIN, I_CONVW, I_CONVB, I_SGW, I_SGB, I_LNG, I_LNB, I_LAMQK, I_SUBLN, I_ARE, I_AIM, I_LOGDT, I_BRE, I_BIM, I_CRE, I_CIM, I_SSMD, I_WGLU, I_BGLU, I_WBR, I_WO, I_GFFN, I_WFG, I_WFU, I_WFD, I_GFIN };

DI void tr_item(const float* W, int ldn, int k0, int n0, const float* gs, bf16* WT, int ldk, int drow0, LAS float* scr, int lane) {
    float tv[32];
#pragma unroll
    for (int i = 0; i < 32; ++i) { const int kk = 2 * i + (lane >> 5); tv[i] = W[(size_t)(k0 + kk) * ldn + n0 + (lane & 31)]; }
    if (gs) {
#pragma unroll
        for (int i = 0; i < 32; ++i) tv[i] *= gs[k0 + 2 * i + (lane >> 5)]; }
#pragma unroll
    for (int i = 0; i < 32; ++i) scr[(2 * i + (lane >> 5)) * 33 + (lane & 31)] = tv[i];
    LDS_WAIT();
    const int c = lane & 7;
#pragma unroll
    for (int j = 0; j < 4; ++j) { const int n = (lane >> 3) + 8 * j; const LAS float* s = scr + (8 * c) * 33 + n;
        u32x4 o; o.x = mk_pk2(s[0 * 33], s[1 * 33]); o.y = mk_pk2(s[2 * 33], s[3 * 33]); o.z = mk_pk2(s[4 * 33], s[5 * 33]); o.w = mk_pk2(s[6 * 33], s[7 * 33]);
        *(u32x4*)(WT + (size_t)(drow0 + n) * ldk + k0 + 8 * c) = o; }
    LDS_WAIT();
}
DI void dsincos(double x, double& s, double& c) {
    const double twopi = 6.283185307179586476925; const double k = rint(x / twopi); const double r = x - k * twopi, r2 = r * r;
    double ss = 1.0, cc = 1.0;
#pragma unroll
    for (int n = 13; n >= 1; --n) { ss = 1.0 - r2 * (1.0 / ((2.0 * n) * (2.0 * n + 1.0))) * ss; cc = 1.0 - r2 * (1.0 / ((2.0 * n - 1.0) * (2.0 * n))) * cc; }
    s = ss * r; c = cc;
}
DI void phase_prep(const Params& p, LAS unsigned char* lds, int tid, int lane, int wave, int G) {
    unsigned char* ws = p.ws;
    const int gw = blockIdx.x * 8 + wave, NGW = G * 8, gt = blockIdx.x * NTHR + tid, NGT = G * NTHR;
    LAS float* scr = (LAS float*)(lds + wave * 8704);
    for (int l = 0; l < 2; ++l) {
        unsigned char* wl = ws + WS_W + (size_t)l * WL_SIZE;
        for (int mi = 0; mi < 10; ++mi) {
            const float* src; int K, N; const float* gs = nullptr; bf16* dst; int map = 0;
            if (mi == 0) { src = p.in[I_WIN] + (size_t)l * 1024 * 8704; K = 1024; N = 8704; gs = p.in[I_GMIX] + l * 1024; dst = (bf16*)(wl + WL_IN); map = 1; }
            else if (mi == 1) { src = p.in[I_WGLU] + (size_t)l * 512 * 512; K = 512; N = 512; dst = (bf16*)(wl + WL_GLU); }
            else if (mi < 6) { const int b = mi - 2; src = p.in[I_WBR] + ((size_t)l * 4 + b) * 512 * 1024; K = 512; N = 1024; dst = (bf16*)(wl + WL_BR) + (size_t)b * 1024 * 512; }
            else if (mi == 6) { src = p.in[I_WO] + (size_t)l * 1024 * 1024; K = 1024; N = 1024; dst = (bf16*)(wl + WL_O); }
            else if (mi == 7) { src = p.in[I_WFG] + (size_t)l * 1024 * 2816; K = 1024; N = 2816; gs = p.in[I_GFFN] + l * 1024; dst = (bf16*)(wl + WL_FF); map = 2; }
            else if (mi == 8) { src = p.in[I_WFU] + (size_t)l * 1024 * 2816; K = 1024; N = 2816; gs = p.in[I_GFFN] + l * 1024; dst = (bf16*)(wl + WL_FF); map = 3; }
            else { src = p.in[I_WFD] + (size_t)l * 2816 * 1024; K = 2816; N = 1024; dst = (bf16*)(wl + WL_D); }
            const int nblk = N / 32, nit = (K / 64) * nblk;
            for (int it = gw; it < nit; it += NGW) {
                const int kb = it / nblk, nb = it % nblk, n0 = nb * 32; int dr = n0;
                if (map == 1) { if (n0 >= 3584 && n0 < 4096) dr = n0 + 512; else if (n0 >= 4096 && n0 < 4608) dr = n0 - 512; }
                else if (map == 2) dr = (n0 >> 7) * 256 + (n0 & 127);
                else if (map == 3) dr = (n0 >> 7) * 256 + 128 + (n0 & 127);
                tr_item(src, N, kb * 64, n0, gs, dst, K, dr, scr, lane);
            }
        }
    }
    { const float* x = p.in[I_X]; bf16* xb = (bf16*)(ws + WS_XB); float* rowss = (float*)(ws + WS_ROWSS);
        for (int row0 = gw * 4; row0 < TOK; row0 += NGW * 4) { f32x4 v[4][4];
#pragma unroll
            for (int q = 0; q < 4; ++q)
#pragma unroll
                for (int j = 0; j < 4; ++j) v[q][j] = *((const f32x4*)(x + (size_t)(row0 + q) * DM) + lane + 64 * j);
#pragma unroll
            for (int q = 0; q < 4; ++q) { float ss = 0.f;
#pragma unroll
                for (int j = 0; j < 4; ++j) { const f32x4 t = v[q][j]; ss += (t[0] * t[0] + t[1] * t[1]) + (t[2] * t[2] + t[3] * t[3]);
                    u32x2 w; w.x = mk_pk2(t[0], t[1]); w.y = mk_pk2(t[2], t[3]); *((u32x2*)(xb + (size_t)(row0 + q) * DM) + lane + 64 * j) = w; }
                ss = wave_sum(ss); if (lane == 0) rowss[row0 + q] = ss; } }
        for (int i = gt; i < 4 * TOK; i += NGT) rowss[TOK + i] = 0.f; }
    { const float* sgw = p.in[I_SGW]; bf16* o = (bf16*)(ws + WS_SGW);
        for (int i = gt; i < 2 * 4 * 128 * 128; i += NGT) { const int s = i & 127, t = (i >> 7) & 127; o[i] = f2bf(s <= t ? sgw[i] : 0.f); } }
    for (int i = gt; i < 2 * 32 * 64; i += NGT) {
        const int pp = i & 63, lg = i >> 6;
        const double dt = exp((double)p.in[I_LOGDT][lg]); const double are = p.in[I_ARE][i], aim = p.in[I_AIM][i];
        const double mag = exp(dt * are); double sn, cs; dsincos(dt * aim, sn, cs);
        const double abr = mag * cs, abi = mag * sn, den = are * are + aim * aim, nr = abr - 1.0, ni = abi;
        const double cr = (nr * are + ni * aim) / den, ci = (ni * are - nr * aim) / den;
        bf16* bb = (bf16*)(ws + WS_BB) + (size_t)lg * 128 * 16; const float* bre = p.in[I_BRE] + (size_t)i * 16; const float* bim = p.in[I_BIM] + (size_t)i * 16;
        for (int h = 0; h < 16; ++h) { const double br = bre[h], bi = bim[h]; bb[pp * 16 + h] = f2bf((float)(cr * br - ci * bi)); bb[(64 + pp) * 16 + h] = f2bf((float)(cr * bi + ci * br)); }
        bf16* cm = (bf16*)(ws + WS_CM) + (size_t)lg * 16 * 128; const float* cre = p.in[I_CRE] + (size_t)lg * 16 * 64; const float* cim = p.in[I_CIM] + (size_t)lg * 16 * 64;
        for (int h = 0; h < 16; ++h) { cm[h * 128 + pp] = f2bf(cre[h * 64 + pp]); cm[h * 128 + 64 + pp] = f2bf(-cim[h * 64 + pp]); }
        double pr = abr, pi = abi; float* ap = (float*)(ws + WS_AP) + (size_t)i * 8; ap[0] = (float)pr; ap[1] = (float)pi;
        for (int q = 0; q < 5; ++q) { const double t = pr * pr - pi * pi; pi = 2.0 * pr * pi; pr = t; }
        ap[2] = (float)pr; ap[3] = (float)pi;
        { const double t = pr * pr - pi * pi; pi = 2.0 * pr * pi; pr = t; }
        ap[4] = (float)pr; ap[5] = (float)pi; ap[6] = 0.f; ap[7] = 0.f;
    }
}

DI void phase_branchA(const Params& p, int l, int tid, int G) {
    bf16* AB = (bf16*)(p.ws + WS_P); const bf16* AC = (const bf16*)(p.ws + WS_P + PBUF); const bf16* AX = (const bf16*)(p.ws + WS_P + 2 * PBUF);
    const float* cw = p.in[I_CONVW] + l * 3 * 512; const float* cb = p.in[I_CONVB] + l * 512;
    for (int idx = blockIdx.x * NTHR + tid; idx < (TOK / 16) * 64; idx += G * NTHR) {
        const int cgp = idx & 63, run = idx >> 6, c0 = cgp * 8, t0 = run * 16;
        f32x4 w0[2], w1[2], w2[2], bb[2];
#pragma unroll
        for (int e = 0; e < 2; ++e) { w0[e] = *(const f32x4*)(cw + c0 + 4 * e); w1[e] = *(const f32x4*)(cw + 512 + c0 + 4 * e); w2[e] = *(const f32x4*)(cw + 1024 + c0 + 4 * e); bb[e] = *(const f32x4*)(cb + c0 + 4 * e); }
        f32x4 zm2[2] = {{0.f, 0.f, 0.f, 0.f}, {0.f, 0.f, 0.f, 0.f}}, zm1[2] = {{0.f, 0.f, 0.f, 0.f}, {0.f, 0.f, 0.f, 0.f}};
        if ((t0 & (SEQ - 1)) != 0) {
            f32x4 a0, a1, x0, x1;
            pg8::unpack8(*(const u32x4*)(AC + (size_t)(t0 - 2) * 512 + c0), a0, a1); pg8::unpack8(*(const u32x4*)(AX + (size_t)(t0 - 2) * 512 + c0), x0, x1); zm2[0] = a0 * x0; zm2[1] = a1 * x1;
            pg8::unpack8(*(const u32x4*)(AC + (size_t)(t0 - 1) * 512 + c0), a0, a1); pg8::unpack8(*(const u32x4*)(AX + (size_t)(t0 - 1) * 512 + c0), x0, x1); zm1[0] = a0 * x0; zm1[1] = a1 * x1;
        }
#pragma unroll 4
        for (int i = 0; i < 16; ++i) { const size_t off = (size_t)(t0 + i) * 512 + c0;
            f32x4 a0, a1, x0, x1, b0, b1; pg8::unpack8(*(const u32x4*)(AC + off), a0, a1); pg8::unpack8(*(const u32x4*)(AX + off), x0, x1); pg8::unpack8(*(const u32x4*)(AB + off), b0, b1);
            const f32x4 z0 = a0 * x0, z1 = a1 * x1;
            const f32x4 y0 = b0 * (w0[0] * zm2[0] + w1[0] * zm1[0] + w2[0] * z0 + bb[0]), y1 = b1 * (w0[1] * zm2[1] + w1[1] * zm1[1] + w2[1] * z1 + bb[1]);
            *(u32x4*)(AB + off) = pg8::pack8(y0, y1);
            zm2[0] = zm1[0]; zm2[1] = zm1[1]; zm1[0] = z0; zm1[1] = z1; }
    }
}

DI void phase_branchB(const Params& p, int l, LAS unsigned char* lds, int tid, int lane, int wave, int G) {
    bf16* BU = (bf16*)(p.ws + WS_P + 3 * PBUF); const bf16* BV = (const bf16*)(p.ws + WS_P + 4 * PBUF);
    const bf16* SGW = (const bf16*)(p.ws + WS_SGW) + (size_t)l * 4 * 128 * 128; const float* sgb = p.in[I_SGB] + l * 4 * 128;
    const float* lng = p.in[I_LNG] + l * 512 + lane * 8; const float* lnb = p.in[I_LNB] + l * 512 + lane * 8;
    constexpr int RS = 1040;
    const int r = lane & 31, half = lane >> 5;
    for (int item = blockIdx.x; item < TOK / 128; item += G) {
        const int tok0 = item * 128;
        { const f32x4 g0 = *(const f32x4*)lng, g1 = *(const f32x4*)(lng + 4), b0 = *(const f32x4*)lnb, b1 = *(const f32x4*)(lnb + 4);
            for (int tt = 0; tt < 16; ++tt) { const int s = wave * 16 + tt;
                f32x4 v0, v1; pg8::unpack8(*(const u32x4*)(BV + (size_t)(tok0 + s) * 512 + lane * 8), v0, v1);
#pragma unroll
                for (int j = 0; j < 4; ++j) { v0[j] = mk_gelu(v0[j]); v1[j] = mk_gelu(v1[j]); }
                const float mean = wave_sum((v0[0] + v0[1]) + (v0[2] + v0[3]) + (v1[0] + v1[1]) + (v1[2] + v1[3])) * (1.0f / 512.0f);
                v0 = v0 - mean; v1 = v1 - mean;
                const float var = wave_sum((v0[0] * v0[0] + v0[1] * v0[1]) + (v0[2] * v0[2] + v0[3] * v0[3]) + (v1[0] * v1[0] + v1[1] * v1[1]) + (v1[2] * v1[2] + v1[3] * v1[3])) * (1.0f / 512.0f);
                const float rstd = rsqrtf(var + 1e-5f);
                v0 = v0 * rstd * g0 + b0; v1 = v1 * rstd * g1 + b1;
                *(LAS u32x4*)(lds + s * RS + lane * 16) = pg8::pack8(v0, v1); } }
        __syncthreads();
        const int g = wave >> 1, dh = wave & 1;
        f32x16 acc[4][2];
#pragma unroll
        for (int a = 0; a < 4; ++a) { acc[a][0] = zero16(); acc[a][1] = zero16(); }
#pragma unroll
        for (int ks = 0; ks < 8; ++ks) {
            bf16x8 Vf[2];
#pragma unroll
            for (int dt = 0; dt < 2; ++dt) { const LAS unsigned short* vp = (const LAS unsigned short*)(lds + (16 * ks + 8 * half) * RS + (g * 128 + dh * 64 + dt * 32 + r) * 2);
#pragma unroll
                for (int j = 0; j < 8; ++j) Vf[dt][j] = (short)vp[j * (RS / 2)]; }
#pragma unroll
            for (int tt = ks >> 1; tt < 4; ++tt) { const bf16x8 Wf = *(const bf16x8*)(SGW + ((size_t)g * 128 + 32 * tt + r) * 128 + 16 * ks + 8 * half);
                acc[tt][0] = mfma32(Vf[0], Wf, acc[tt][0]); acc[tt][1] = mfma32(Vf[1], Wf, acc[tt][1]); }
        }
        asm volatile("s_nop 15\n\ts_nop 7" : "+v"(acc[0][0]), "+v"(acc[0][1]), "+v"(acc[1][0]), "+v"(acc[1][1]), "+v"(acc[2][0]), "+v"(acc[2][1]), "+v"(acc[3][0]), "+v"(acc[3][1]));
#pragma unroll
        for (int tt = 0; tt < 4; ++tt) { const int t = 32 * tt + r; const float bias = sgb[g * 128 + t];
#pragma unroll
            for (int dt = 0; dt < 2; ++dt)
#pragma unroll
                for (int ig = 0; ig < 4; ++ig) { bf16* up = BU + (size_t)(tok0 + t) * 512 + g * 128 + dh * 64 + dt * 32 + 8 * ig + 4 * half;
                    const u32x2 uw = *(const u32x2*)up;
                    const float y0 = mk_gelu(mk_lo(uw.x)) * (acc[tt][dt][4 * ig + 0] + bias), y1 = mk_gelu(mk_hi(uw.x)) * (acc[tt][dt][4 * ig + 1] + bias);
                    const float y2 = mk_gelu(mk_lo(uw.y)) * (acc[tt][dt][4 * ig + 2] + bias), y3 = mk_gelu(mk_hi(uw.y)) * (acc[tt][dt][4 * ig + 3] + bias);
                    u32x2 o; o.x = mk_pk2(y0, y1); o.y = mk_pk2(y2, y3); *(u32x2*)up = o; } }
        __syncthreads();
    }
}

DI void phase_attn(const Params& p, int l, LAS unsigned char* lds, int tid, int lane, int wave, int G, bf16* OUTP) {
    const bf16* CQ = (const bf16*)(p.ws + WS_P + 5 * PBUF); const bf16* CK = (const bf16*)(p.ws + WS_P + 6 * PBUF); const bf16* VT = (const bf16*)(p.ws + WS_P + 8 * PBUF);
    const float lam_init = 0.8f - 0.6f * expf(-0.3f * (float)l);
    const float* lq = p.in[I_LAMQK] + l * 256;
    const float lam = expf(wave_sum(lq[lane] * lq[64 + lane])) - expf(wave_sum(lq[128 + lane] * lq[192 + lane])) + lam_init;
    const float* sg = p.in[I_SUBLN] + l * 128;
    const int m = wave & 1, sub = wave >> 1, r = lane & 31, half = lane >> 5;
    constexpr int KROW = 144, VROW = 136, KBYTES = 64 * KROW  , VOFF = 2 * KBYTES  , STAGE = VOFF + 128 * KROW  ;
    const float cs = 0.125f * 1.44269504089f;
    for (int pi = blockIdx.x; pi < 512; pi += G) {
#pragma unroll 1
        for (int uu = 0; uu < 2; ++uu) {
            const int bh = pi >> 4, jp = pi & 15, qb = uu ? 31 - jp : jp, b = bh >> 2, h = bh & 3;
            const int tokq0 = b * SEQ + qb * 128, qrow = tokq0 + 32 * sub + r;
            bf16x8 Qf[4];
#pragma unroll
            for (int ks = 0; ks < 4; ++ks) Qf[ks] = *(const bf16x8*)(CQ + (size_t)qrow * 512 + h * 128 + m * 64 + 16 * ks + 8 * half);
            const int nt = 2 * qb + 2, my_last = 2 * qb + (sub >> 1);
            const bf16* kg[2]; const bf16* vg[2]; int kl[2], vl[2];
#pragma unroll
            for (int i = 0; i < 2; ++i) { const int idx = tid + 512 * i; const int key = idx >> 4, c16 = idx & 15;
                kg[i] = CK + (size_t)(b * SEQ + key) * 512 + h * 128 + c16 * 8; kl[i] = (c16 >> 3) * KBYTES + key * KROW + (c16 & 7) * 16;
                const int dv = idx >> 3, c8 = idx & 7;
                vg[i] = VT + (size_t)(h * 128 + dv) * TOK + b * SEQ + c8 * 8; vl[i] = VOFF + dv * VROW + c8 * 16; }
            u32x4 st[4];
            st[0] = *(const u32x4*)kg[0]; st[1] = *(const u32x4*)kg[1]; st[2] = *(const u32x4*)vg[0]; st[3] = *(const u32x4*)vg[1];
            *(LAS u32x4*)(lds + kl[0]) = st[0]; *(LAS u32x4*)(lds + kl[1]) = st[1]; *(LAS u32x2*)(lds + vl[0]) = (u32x2){st[2].x, st[2].y}; *(LAS u32x2*)(lds + vl[0] + 8) = (u32x2){st[2].z, st[2].w}; *(LAS u32x2*)(lds + vl[1]) = (u32x2){st[3].x, st[3].y}; *(LAS u32x2*)(lds + vl[1] + 8) = (u32x2){st[3].z, st[3].w};
            __syncthreads();
            f32x16 O[4];
#pragma unroll
            for (int i = 0; i < 4; ++i) O[i] = zero16();
            float m_run = -INFINITY, l_run = 0.f;
#pragma unroll 1
            for (int kt = 0; kt < nt; ++kt) {
                const bool more = (kt + 1 < nt);
                if (more) { const size_t ko = (size_t)(kt + 1) * 64 * 512, vo = (size_t)(kt + 1) * 64;
                    st[0] = *(const u32x4*)(kg[0] + ko); st[1] = *(const u32x4*)(kg[1] + ko); st[2] = *(const u32x4*)(vg[0] + vo); st[3] = *(const u32x4*)(vg[1] + vo); }
                const LAS unsigned char* buf = lds + (kt & 1) * STAGE;
                if (kt <= my_last) {
                    f32x16 S[2];
#pragma unroll
                    for (int u = 0; u < 2; ++u) { S[u] = zero16();
#pragma unroll
                        for (int ks = 0; ks < 4; ++ks) { const bf16x8 A = *(const LAS bf16x8*)(buf + m * KBYTES + (32 * u + r) * KROW + (16 * ks + 8 * half) * 2); S[u] = mfma32(A, Qf[ks], S[u]); } }
                    asm volatile("s_nop 15\n\ts_nop 7" : "+v"(S[0]), "+v"(S[1]));
                    float mx = -INFINITY;
#pragma unroll
                    for (int u = 0; u < 2; ++u)
#pragma unroll
                        for (int i = 0; i < 16; ++i) mx = fmaxf(mx, S[u][i]);
                    mx = fmaxf(mx, __shfl_xor(mx, 32));
                    const float m_new = fmaxf(m_run, mx * cs), alpha = __builtin_amdgcn_exp2f(m_run - m_new);
                    float ps = 0.f;
#pragma unroll
                    for (int u = 0; u < 2; ++u)
#pragma unroll
                        for (int i = 0; i < 16; ++i) { const float e = __builtin_amdgcn_exp2f(S[u][i] * cs - m_new); S[u][i] = e; ps += e; }
                    ps += __shfl_xor(ps, 32);
                    l_run = l_run * alpha + ps; m_run = m_new;
#pragma unroll
                    for (int d = 0; d < 4; ++d)
#pragma unroll
                        for (int i = 0; i < 16; ++i) O[d][i] *= alpha;
                    bf16x8 Pf[2][2];
#pragma unroll
                    for (int u = 0; u < 2; ++u)
#pragma unroll
                        for (int s = 0; s < 2; ++s) { u32x4 w; w.x = mk_pk2(S[u][8 * s + 0], S[u][8 * s + 1]); w.y = mk_pk2(S[u][8 * s + 2], S[u][8 * s + 3]); w.z = mk_pk2(S[u][8 * s + 4], S[u][8 * s + 5]); w.w = mk_pk2(S[u][8 * s + 6], S[u][8 * s + 7]);
                            Pf[u][s] = __builtin_bit_cast(bf16x8, w); }
#pragma unroll
                    for (int d = 0; d < 4; ++d)
#pragma unroll
                        for (int u = 0; u < 2; ++u)
#pragma unroll
                            for (int s = 0; s < 2; ++s) { const LAS unsigned char* va = buf + VOFF + (32 * d + r) * VROW + (32 * u + 16 * s + 4 * half) * 2;
                                const u32x2 lo = *(const LAS u32x2*)va, hi = *(const LAS u32x2*)(va + 16);
                                u32x4 w; w.x = lo.x; w.y = lo.y; w.z = hi.x; w.w = hi.y;
                                O[d] = mfma32(__builtin_bit_cast(bf16x8, w), Pf[u][s], O[d]); }
                }
                if (more) { LAS unsigned char* nb = lds + ((kt + 1) & 1) * STAGE;
                    *(LAS u32x4*)(nb + kl[0]) = st[0]; *(LAS u32x4*)(nb + kl[1]) = st[1]; *(LAS u32x2*)(nb + vl[0]) = (u32x2){st[2].x, st[2].y}; *(LAS u32x2*)(nb + vl[0] + 8) = (u32x2){st[2].z, st[2].w}; *(LAS u32x2*)(nb + vl[1]) = (u32x2){st[3].x, st[3].y}; *(LAS u32x2*)(nb + vl[1] + 8) = (u32x2){st[3].z, st[3].w}; }
                __syncthreads();
            }
            asm volatile("s_nop 15\n\ts_nop 7" : "+v"(O[0]), "+v"(O[1]), "+v"(O[2]), "+v"(O[3]));
            const float inv = 1.0f / l_run;
            LAS float* Cb = (LAS float*)lds;
            if (m == 1) { const float f = inv * lam;
#pragma unroll
                for (int d = 0; d < 4; ++d)
#pragma unroll
                    for (int i = 0; i < 16; ++i) Cb[(sub * 128 + 32 * d + crow(i, half)) * 33 + r] = O[d][i] * f; }
            __syncthreads();
            if (m == 0) { float ss = 0.f;
#pragma unroll
                for (int d = 0; d < 4; ++d)
#pragma unroll
                    for (int i = 0; i < 16; ++i) { const float o = O[d][i] * inv - Cb[(sub * 128 + 32 * d + crow(i, half)) * 33 + r]; O[d][i] = o; ss += o * o; }
                ss += __shfl_xor(ss, 32);
                const float rs = rsqrtf(ss * (1.0f / 128.0f) + 1e-5f) * (1.0f - lam_init);
#pragma unroll
                for (int d = 0; d < 4; ++d)
#pragma unroll
                    for (int ig = 0; ig < 4; ++ig) { const int dv0 = 32 * d + 8 * ig + 4 * half; const f32x4 gn = *(const f32x4*)(sg + dv0);
                        u32x2 w; w.x = mk_pk2(O[d][4 * ig + 0] * rs * gn[0], O[d][4 * ig + 1] * rs * gn[1]); w.y = mk_pk2(O[d][4 * ig + 2] * rs * gn[2], O[d][4 * ig + 3] * rs * gn[3]);
                        *(u32x2*)(OUTP + (size_t)qrow * 512 + h * 128 + dv0) = w; } }
            __syncthreads();
        }
    }
}

template <bool PRODUCER> DI void attn2_unit(const bf16* CQ, const bf16* CK, const bf16* VT, bf16* OUTP, const float* sg, float lam, float lam_init, LAS unsigned char* lds, int tid, int lane, int sub, int b, int h, int qb) {
    const int r = lane & 31, half = lane >> 5;
    constexpr int KROW = 144, VROW = 136, KB1 = 64 * KROW, KST = 2 * KB1  , VST = 128 * VROW  ;
    constexpr int OFF_K = 0, OFF_V = 2 * KST  , OFF_P = OFF_V + 2 * VST  , PST = 32768, OFF_A = OFF_P + 2 * PST  , AST = 1024, OFF_L = 139392;
    const float cs = 0.125f * 1.44269504089f;
            const int tokq0 = b * SEQ + qb * 128, qrow = tokq0 + 32 * sub + r;
            const int nt = 2 * qb + 2, my_last = 2 * qb + (sub >> 1);
            const bf16* kg[2]; const bf16* vg[2]; int kl[2], vl[2];
#pragma unroll
            for (int i = 0; i < 2; ++i) { const int idx = tid + 512 * i; const int key = idx >> 4, c16 = idx & 15;
                kg[i] = CK + (size_t)(b * SEQ + key) * 512 + h * 128 + c16 * 8; kl[i] = OFF_K + (c16 >> 3) * KB1 + key * KROW + (c16 & 7) * 16;
                const int dv = idx >> 3, c8 = idx & 7;
                vg[i] = VT + (size_t)(h * 128 + dv) * TOK + b * SEQ + c8 * 8; vl[i] = OFF_V + dv * VROW + c8 * 16; }
            bf16x8 Qf[2][4];
            f32x16 O[2][4];
            float m_run[2] = {-INFINITY, -INFINITY}, l_run[2] = {0.f, 0.f};
            if (PRODUCER) {
#pragma unroll
                for (int m = 0; m < 2; ++m)
#pragma unroll
                    for (int ks = 0; ks < 4; ++ks) Qf[m][ks] = *(const bf16x8*)(CQ + (size_t)qrow * 512 + h * 128 + m * 64 + 16 * ks + 8 * half);
            } else {
#pragma unroll
                for (int m = 0; m < 2; ++m)
#pragma unroll
                    for (int d = 0; d < 4; ++d) O[m][d] = zero16();
            }
            u32x4 sk[2], sv[2];
            sk[0] = *(const u32x4*)kg[0]; sk[1] = *(const u32x4*)kg[1];
            *(LAS u32x4*)(lds + kl[0]) = sk[0]; *(LAS u32x4*)(lds + kl[1]) = sk[1];
            __syncthreads();
#pragma unroll 1
            for (int i = 0; i <= nt; ++i) {
                const bool ldk = (i + 1 < nt), ldv = (i < nt);
                if (ldk) { const size_t ko = (size_t)(i + 1) * 64 * 512; sk[0] = *(const u32x4*)(kg[0] + ko); sk[1] = *(const u32x4*)(kg[1] + ko); }
                if (ldv) { const size_t vo = (size_t)i * 64; sv[0] = *(const u32x4*)(vg[0] + vo); sv[1] = *(const u32x4*)(vg[1] + vo); }
                if (PRODUCER) {
                    if (i < nt && i <= my_last) {
                        const LAS unsigned char* kb = lds + OFF_K + (i & 1) * KST;
                        LAS unsigned char* pb = lds + OFF_P + (i & 1) * PST + (sub * 2) * 4096 + lane * 16;
                        LAS float* ab = (LAS float*)(lds + OFF_A + (i & 1) * AST) + (sub * 2) * 32 + r;
#pragma unroll
                        for (int m = 0; m < 2; ++m) {
                            f32x16 S[2];
#pragma unroll
                            for (int u = 0; u < 2; ++u) { S[u] = zero16();
#pragma unroll
                                for (int ks = 0; ks < 4; ++ks) { const bf16x8 A = *(const LAS bf16x8*)(kb + m * KB1 + (32 * u + r) * KROW + (16 * ks + 8 * half) * 2); S[u] = mfma32(A, Qf[m][ks], S[u]); } }
                            asm volatile("s_nop 15\n\ts_nop 7" : "+v"(S[0]), "+v"(S[1]));
                            float mx = -INFINITY;
#pragma unroll
                            for (int u = 0; u < 2; ++u)
#pragma unroll
                                for (int k = 0; k < 16; ++k) mx = fmaxf(mx, S[u][k]);
                            mx = fmaxf(mx, __shfl_xor(mx, 32));
                            const float m_new = fmaxf(m_run[m], mx * cs), alpha = __builtin_amdgcn_exp2f(m_run[m] - m_new);
                            float ps = 0.f;
#pragma unroll
                            for (int u = 0; u < 2; ++u)
#pragma unroll
                                for (int k = 0; k < 16; ++k) { const float e = __builtin_amdgcn_exp2f(S[u][k] * cs - m_new); S[u][k] = e; ps += e; }
                            ps += __shfl_xor(ps, 32);
                            l_run[m] = l_run[m] * alpha + ps; m_run[m] = m_new;
                            if (half == 0) ab[m * 32] = alpha;
#pragma unroll
                            for (int u = 0; u < 2; ++u)
#pragma unroll
                                for (int s = 0; s < 2; ++s) { u32x4 w; w.x = mk_pk2(S[u][8 * s + 0], S[u][8 * s + 1]); w.y = mk_pk2(S[u][8 * s + 2], S[u][8 * s + 3]); w.z = mk_pk2(S[u][8 * s + 4], S[u][8 * s + 5]); w.w = mk_pk2(S[u][8 * s + 6], S[u][8 * s + 7]);
                                    *(LAS u32x4*)(pb + m * 4096 + (u * 2 + s) * 1024) = w; }
                        }
                    }
                } else {
                    const int j = i - 1;
                    if (j >= 0 && j <= my_last) {
                        const LAS unsigned char* vb = lds + OFF_V + (j & 1) * VST;
                        const LAS unsigned char* pb = lds + OFF_P + (j & 1) * PST + (sub * 2) * 4096 + lane * 16;
                        const LAS float* ab = (const LAS float*)(lds + OFF_A + (j & 1) * AST) + (sub * 2) * 32 + r;
                        const float a0 = ab[0], a1 = ab[32];
#pragma unroll
                        for (int d = 0; d < 4; ++d)
#pragma unroll
                            for (int k = 0; k < 16; ++k) { O[0][d][k] *= a0; O[1][d][k] *= a1; }
#pragma unroll
                        for (int q = 0; q < 4; ++q) { const bf16x8 P0 = *(const LAS bf16x8*)(pb + q * 1024), P1 = *(const LAS bf16x8*)(pb + 4096 + q * 1024);
#pragma unroll
                            for (int d = 0; d < 4; ++d) { const LAS unsigned char* va = vb + (32 * d + r) * VROW + (16 * q + 4 * half) * 2;
                                const u32x2 lo = *(const LAS u32x2*)va, hi = *(const LAS u32x2*)(va + 16);
                                u32x4 w; w.x = lo.x; w.y = lo.y; w.z = hi.x; w.w = hi.y; const bf16x8 Vf = __builtin_bit_cast(bf16x8, w);
                                O[0][d] = mfma32(Vf, P0, O[0][d]); O[1][d] = mfma32(Vf, P1, O[1][d]); } }
                    }
                }
                if (ldk) { LAS unsigned char* nb = lds + ((i + 1) & 1) * KST; *(LAS u32x4*)(nb + kl[0]) = sk[0]; *(LAS u32x4*)(nb + kl[1]) = sk[1]; }
                if (ldv) { LAS unsigned char* nb = lds + (i & 1) * VST;
                    *(LAS u32x2*)(nb + vl[0]) = (u32x2){sv[0].x, sv[0].y}; *(LAS u32x2*)(nb + vl[0] + 8) = (u32x2){sv[0].z, sv[0].w}; *(LAS u32x2*)(nb + vl[1]) = (u32x2){sv[1].x, sv[1].y}; *(LAS u32x2*)(nb + vl[1] + 8) = (u32x2){sv[1].z, sv[1].w}; }
                __syncthreads();
            }
            LAS float* Lb = (LAS float*)(lds + OFF_L) + (sub * 2) * 32 + r;
            if (PRODUCER && half == 0) { Lb[0] = l_run[0]; Lb[32] = l_run[1]; }
            __syncthreads();
            if (!PRODUCER) {
                asm volatile("s_nop 15\n\ts_nop 7" : "+v"(O[0][0]), "+v"(O[0][1]), "+v"(O[0][2]), "+v"(O[0][3]), "+v"(O[1][0]), "+v"(O[1][1]), "+v"(O[1][2]), "+v"(O[1][3]));
                const float inv0 = 1.0f / Lb[0], inv1 = lam / Lb[32];
                float ss = 0.f;
#pragma unroll
                for (int d = 0; d < 4; ++d)
#pragma unroll
                    for (int k = 0; k < 16; ++k) { const float o = O[0][d][k] * inv0 - O[1][d][k] * inv1; O[0][d][k] = o; ss += o * o; }
                ss += __shfl_xor(ss, 32);
                const float rs = rsqrtf(ss * (1.0f / 128.0f) + 1e-5f) * (1.0f - lam_init);
#pragma unroll
                for (int d = 0; d < 4; ++d)
#pragma unroll
                    for (int ig = 0; ig < 4; ++ig) { const int dv0 = 32 * d + 8 * ig + 4 * half; const f32x4 gn = *(const f32x4*)(sg + dv0);
                        u32x2 w; w.x = mk_pk2(O[0][d][4 * ig + 0] * rs * gn[0], O[0][d][4 * ig + 1] * rs * gn[1]); w.y = mk_pk2(O[0][d][4 * ig + 2] * rs * gn[2], O[0][d][4 * ig + 3] * rs * gn[3]);
                        *(u32x2*)(OUTP + (size_t)qrow * 512 + h * 128 + dv0) = w; }
            }
            __syncthreads();
}
DI void phase_attn2(const Params& p, int l, LAS unsigned char* lds, int tid, int lane, int wave, int G, bf16* OUTP) {
    const bf16* CQ = (const bf16*)(p.ws + WS_P + 5 * PBUF); const bf16* CK = (const bf16*)(p.ws + WS_P + 6 * PBUF); const bf16* VT = (const bf16*)(p.ws + WS_P + 8 * PBUF);
    const float lam_init = 0.8f - 0.6f * expf(-0.3f * (float)l);
    const float* lq = p.in[I_LAMQK] + l * 256;
    const float lam = expf(wave_sum(lq[lane] * lq[64 + lane])) - expf(wave_sum(lq[128 + lane] * lq[192 + lane])) + lam_init;
    const float* sg = p.in[I_SUBLN] + l * 128;
    const bool producer = wave < 4; const int sub = wave & 3;
    for (int pi0 = blockIdx.x; pi0 < 512; pi0 += G) {
        const int pi = (G == 256) ? (((int)blockIdx.x & 7) * 64 + (pi0 >> 8) * 32 + ((int)blockIdx.x >> 3)) : pi0;
#pragma unroll 1
        for (int uu = 0; uu < 2; ++uu) {
            const int bh = pi >> 4, jp = pi & 15, qb = uu ? 31 - jp : jp, b = bh >> 2, h = bh & 3;
            if (producer) attn2_unit<true>(CQ, CK, VT, OUTP, sg, lam, lam_init, lds, tid, lane, sub, b, h, qb);
            else attn2_unit<false>(CQ, CK, VT, OUTP, sg, lam, lam_init, lds, tid, lane, sub, b, h, qb);
        }
    }
}

template <bool P2> DI void phase_ssm(const Params& p, int l, LAS unsigned char* lds, int lane, int wave, int G) {
    const bf16* DU = (const bf16*)(p.ws + WS_P + 7 * PBUF); bf16* YG = (bf16*)(p.ws + WS_YG); float* E = (float*)(p.ws + WS_E);
    const bf16* BB = (const bf16*)(p.ws + WS_BB) + (size_t)l * 32 * 128 * 16; const bf16* CM = (const bf16*)(p.ws + WS_CM) + (size_t)l * 32 * 16 * 128;
    const float* AP = (const float*)(p.ws + WS_AP) + (size_t)l * 32 * 64 * 8; const float* dsk = p.in[I_SSMD] + l * 512;
    const int r = lane & 31, half = lane >> 5, r16 = lane & 15, q4 = lane >> 4;
    constexpr int XRS = 272;
    LAS unsigned char* Xs = lds + wave * (64 * XRS);
    for (int it = blockIdx.x * 8 + wave; it < 16384; it += G * 8) {
        const int c = it & 63, g = (it >> 6) & 31, b = it >> 11, tok0 = b * SEQ + c * 64;
        const int ch = g * 16 + r16; float dk = 0.f; bf16x8 Cf[4]; float uu[4][4];
        if (P2) { dk = dsk[ch];
#pragma unroll
            for (int mt = 0; mt < 4; ++mt)
#pragma unroll
                for (int j = 0; j < 4; ++j) uu[mt][j] = bf2f(DU[(size_t)(tok0 + 16 * mt + 4 * q4 + j) * 512 + ch]); }
        f32x16 X[4][2];
        { bf16x8 Uf[2], Bf[4];
#pragma unroll
            for (int tt = 0; tt < 2; ++tt) { const int tau = 32 * ((r >> 2) & 1) + 16 * tt + (r & 3) + 4 * (r >> 3); Uf[tt] = *(const bf16x8*)(DU + (size_t)(tok0 + tau) * 512 + g * 16 + 8 * half); }
#pragma unroll
            for (int pt = 0; pt < 4; ++pt) Bf[pt] = *(const bf16x8*)(BB + ((size_t)g * 128 + 32 * pt + r) * 16 + 8 * half);
#pragma unroll
            for (int pt = 0; pt < 4; ++pt)
#pragma unroll
                for (int tt = 0; tt < 2; ++tt) X[pt][tt] = mfma32(Uf[tt], Bf[pt], zero16()); }
        asm volatile("s_nop 15\n\ts_nop 15" : "+v"(X[0][0]), "+v"(X[0][1]), "+v"(X[1][0]), "+v"(X[1][1]), "+v"(X[2][0]), "+v"(X[2][1]), "+v"(X[3][0]), "+v"(X[3][1]));
        float ar[2], ai[2], a32r[2], a32i[2], a64r[2], a64i[2];
#pragma unroll
        for (int s = 0; s < 2; ++s) { const float* ap = AP + ((size_t)g * 64 + 32 * s + r) * 8; const f32x4 v = *(const f32x4*)ap; ar[s] = v[0]; ai[s] = v[1]; a32r[s] = v[2]; a32i[s] = v[3]; a64r[s] = ap[4]; a64i[s] = ap[5]; }
        float xr[2] = {0.f, 0.f}, xi[2] = {0.f, 0.f};
        if (P2) {
            const float* e0 = E + (((size_t)(b * 32 + g) * 64) * 64 + r) * 2;
            float sr0 = 0.f, si0 = 0.f, sr1 = 0.f, si1 = 0.f;
#pragma unroll 4
            for (int j = 0; j < c; ++j) { const float2 ea = *(const float2*)(e0 + (size_t)j * 128), eb = *(const float2*)(e0 + (size_t)j * 128 + 64);
                const float t0 = a64r[0] * sr0 - a64i[0] * si0 + ea.x; si0 = a64r[0] * si0 + a64i[0] * sr0 + ea.y; sr0 = t0;
                const float t1 = a64r[1] * sr1 - a64i[1] * si1 + eb.x; si1 = a64r[1] * si1 + a64i[1] * sr1 + eb.y; sr1 = t1; }
            if (half == 0) { xr[0] = sr0; xi[0] = si0; xr[1] = sr1; xi[1] = si1; }
        }
#pragma unroll
        for (int s = 0; s < 2; ++s)
#pragma unroll
            for (int tt = 0; tt < 2; ++tt)
#pragma unroll
                for (int i = 0; i < 16; ++i) { const float nr = ar[s] * xr[s] - ai[s] * xi[s] + X[s][tt][i], ni = ar[s] * xi[s] + ai[s] * xr[s] + X[2 + s][tt][i]; X[s][tt][i] = nr; X[2 + s][tt][i] = ni; xr[s] = nr; xi[s] = ni; }
        float oxr[2], oxi[2];
#pragma unroll
        for (int s = 0; s < 2; ++s) { oxr[s] = __shfl_xor(xr[s], 32); oxi[s] = __shfl_xor(xi[s], 32); }
        if (!P2) {
            if (half == 1) {
#pragma unroll
                for (int s = 0; s < 2; ++s) { float2 e; e.x = xr[s] + a32r[s] * oxr[s] - a32i[s] * oxi[s]; e.y = xi[s] + a32r[s] * oxi[s] + a32i[s] * oxr[s];
                    *(float2*)(E + (((size_t)(b * 32 + g) * 64 + c) * 64 + 32 * s + r) * 2) = e; } }
        } else {
#pragma unroll
            for (int s = 0; s < 2; ++s) { float wr_ = half ? oxr[s] : 0.f, wi_ = half ? oxi[s] : 0.f;
#pragma unroll
                for (int tt = 0; tt < 2; ++tt)
#pragma unroll
                    for (int i = 0; i < 16; ++i) { const float t = ar[s] * wr_ - ai[s] * wi_; wi_ = ar[s] * wi_ + ai[s] * wr_; wr_ = t; X[s][tt][i] += wr_; X[2 + s][tt][i] += wi_; } }
#pragma unroll
            for (int pt = 0; pt < 4; ++pt)
#pragma unroll
                for (int tt = 0; tt < 2; ++tt)
#pragma unroll
                    for (int i = 0; i < 16; ++i) *(LAS unsigned short*)(Xs + (32 * half + 16 * tt + i) * XRS + (32 * pt + r) * 2) = f2bf(X[pt][tt][i]);
#pragma unroll
            for (int ks = 0; ks < 4; ++ks) Cf[ks] = *(const bf16x8*)(CM + ((size_t)g * 16 + r16) * 128 + 32 * ks + 8 * q4);
            LDS_WAIT();
#pragma unroll
            for (int mt = 0; mt < 4; ++mt) { f32x4 acc = {0.f, 0.f, 0.f, 0.f};
#pragma unroll
                for (int ks = 0; ks < 4; ++ks) { const bf16x8 A = *(const LAS bf16x8*)(Xs + (16 * mt + r16) * XRS + (32 * ks + 8 * q4) * 2); acc = mfma16(A, Cf[ks], acc); }
                asm volatile("s_nop 15" : "+v"(acc));
#pragma unroll
                for (int j = 0; j < 4; ++j) { const size_t o = (size_t)(tok0 + 16 * mt + 4 * q4 + j) * 512 + ch; const float y = acc[j] + dk * uu[mt][j]; YG[o] = f2bf(mk_gelu(y)); } }
            LDS_WAIT();
        }
    }
}

DI void phase_final(const Params& p, int tid, int G) {
    const float* rowss = (const float*)(p.ws + WS_ROWSS) + 4 * TOK; const float* gf = p.in[I_GFIN]; float* out = p.out;
    for (size_t i = (size_t)blockIdx.x * NTHR + tid; i < (size_t)TOK * 256; i += (size_t)G * NTHR) { const int row = (int)(i >> 8), c4 = (int)(i & 255);
        const float rs = pg8::rstd_of(rowss[row]); const f32x4 v = *((const f32x4*)out + i), gv = *((const f32x4*)gf + c4); *((f32x4*)out + i) = v * rs * gv; }
}

#define XB_TMO      128
#define XB_XCNT(j)  (256  + 64 * (j))
#define XB_XSUB(j)  (1280 + 64 * (j))
#define XB_XGEN(j)  (2304 + 64 * (j))
#define XB_TOP      3328
#define XB_TOPGEN   3392
#define XCD_BAR_WORDS 3456
#define XB_SPIN_CAP (1u << 18)

__device__ __forceinline__ unsigned xb_ld(unsigned* p)              { return __hip_atomic_load(p, __ATOMIC_RELAXED, __HIP_MEMORY_SCOPE_AGENT); }
__device__ __forceinline__ unsigned xb_add(unsigned* p, unsigned v) { return __hip_atomic_fetch_add(p, v, __ATOMIC_RELAXED, __HIP_MEMORY_SCOPE_AGENT); }
__device__ __forceinline__ unsigned xb_xcc_id() { return (unsigned)__builtin_amdgcn_s_getreg((3 << 11) | 20) & 0xFu; }
#define XB_SPIN(cond, bar) do { unsigned _sp = 0; while (cond) { __builtin_amdgcn_s_sleep(1); \
    if ((++_sp & 255u) == 0u) { if (xb_ld(&(bar)[XB_TMO])) break; if (_sp > XB_SPIN_CAP) { atomicAdd(&(bar)[XB_TMO], 1u); break; } } } } while (0)

struct XcdBarrier {
    unsigned* bar; unsigned x;
    volatile LAS unsigned* st;
};

__device__ __forceinline__ XcdBarrier xcd_barrier_post(unsigned* bar, volatile LAS unsigned* st) {
    XcdBarrier b; b.bar = bar; b.x = xb_xcc_id(); b.st = st;
    if (threadIdx.x == 0) (void)xb_add(&bar[XB_XCNT(b.x)], 1u);
    return b;
}
__device__ __forceinline__ void xcd_barrier_complete(unsigned* bar, unsigned x, unsigned& nloc, unsigned& nx) {
    const unsigned G = gridDim.x * gridDim.y * gridDim.z;
    unsigned sum, cnt, mine, sp = 0u;
    for (;;) {
        sum = 0u; cnt = 0u; mine = 0u;
#pragma unroll
        for (unsigned j = 0; j < 16; ++j) { const unsigned c = xb_ld(&bar[XB_XCNT(j)]); sum += c; cnt += (c > 0u) ? 1u : 0u; mine = (j == x) ? c : mine; }
        if (sum == G) break;
        __builtin_amdgcn_s_sleep(1);
        if ((++sp & 255u) == 0u) { if (xb_ld(&bar[XB_TMO])) break; if (sp > XB_SPIN_CAP) { atomicAdd(&bar[XB_TMO], 1u); break; } }
    }
    nloc = mine > 0u ? mine : 1u; nx = cnt > 0u ? cnt : 1u;
}

__device__ __forceinline__ void xcd_barrier(const XcdBarrier& b) {
    asm volatile("s_waitcnt vmcnt(0)" ::: "memory");
    __syncthreads();
    if (threadIdx.x == 0) {
        unsigned* bar = b.bar;
        __builtin_amdgcn_s_waitcnt(0);
        unsigned nloc = b.st[0], nx = b.st[1];
        if (nloc == 0u) { xcd_barrier_complete(bar, b.x, nloc, nx); b.st[0] = nloc; b.st[1] = nx; }
        const unsigned old = xb_add(&bar[XB_XSUB(b.x)], 1u);
        const unsigned gen = old / nloc;
        if (old + 1u == (gen + 1u) * nloc) {
            __builtin_amdgcn_fence(__ATOMIC_RELEASE, "agent");
            asm volatile("s_waitcnt vmcnt(0)" ::: "memory");
            const unsigned og = xb_add(&bar[XB_TOP], 1u);
            const unsigned tg = og / nx;
            if (og + 1u == (tg + 1u) * nx) xb_add(&bar[XB_TOPGEN], 1u);
            else XB_SPIN(xb_ld(&bar[XB_TOPGEN]) == tg, bar);
            __builtin_amdgcn_fence(__ATOMIC_ACQUIRE, "agent");
            xb_add(&bar[XB_XGEN(b.x)], 1u);
            asm volatile("s_waitcnt vmcnt(0)" ::: "memory");
        } else {
            XB_SPIN(xb_ld(&bar[XB_XGEN(b.x)]) == gen, bar);
            __builtin_amdgcn_fence(__ATOMIC_ACQUIRE, "agent");
            asm volatile("s_waitcnt vmcnt(0)" ::: "memory");
        }
    }
    __syncthreads();
}


__global__ void __launch_bounds__(NTHR) mega(Params p) {
    extern __shared__ __attribute__((aligned(16))) unsigned char lds_raw[];
    LAS unsigned char* lds = (LAS unsigned char*)lds_raw;
    const int G = gridDim.x;
#define LAUNDER() int tid = threadIdx.x; asm volatile("" : "+v"(tid)); const int lane = tid & 63, wave = __builtin_amdgcn_readfirstlane(tid >> 6); (void)lane; (void)wave
    const int lo = p.ph_lo, hi = p.ph_hi;
    unsigned char* ws = p.ws;
    int ph = 0;
    volatile LAS unsigned* xb_st = (volatile LAS unsigned*)(lds + 139264);
    XcdBarrier xbar; xbar.bar = (unsigned*)(ws + WS_BAR); xbar.x = 0; xbar.st = xb_st;
    if (ONE_LAUNCH) { if (threadIdx.x < 4) xb_st[threadIdx.x] = 0u; __syncthreads(); xbar = xcd_barrier_post((unsigned*)(ws + WS_BAR), xb_st); }
#ifndef ONLY_KIND
#define ONLY_KIND -1
#endif
#define KEN(k) (ONLY_KIND < 0 || ONLY_KIND == (k))
#ifndef DUP
#define DUP 0
#endif
#define REP(bit) _Pragma("unroll 1") for (int rep_ = 0; rep_ < ((DUP & (bit)) ? 2 : 1); ++rep_)
#define IN_PH() (lo <= ph && ph < hi)
#define END_PH() do { if (ONE_LAUNCH && lo <= ph && ph + 1 < hi) { if (hi < 0) cg::this_grid().sync(); else xcd_barrier(xbar); } ++ph; } while (0)
    if (IN_PH() && KEN(0)) REP(128) { LAUNDER(); phase_prep(p, lds, tid, lane, wave, G); }
    END_PH();
    bf16* XB = (bf16*)(ws + WS_XB); float* rowss = (float*)(ws + WS_ROWSS);
    for (int l = 0; l < 2; ++l) {
        unsigned char* wl = ws + WS_W + (size_t)l * WL_SIZE;
        const bf16* WinT = (const bf16*)(wl + WL_IN);
        bf16* P0 = (bf16*)(ws + WS_P);
        const float* rs_mix = rowss + (size_t)(2 * l) * TOK; float* rs_ffn = rowss + (size_t)(2 * l + 1) * TOK; float* rs_next = rowss + (size_t)(2 * l + 2) * TOK;
        pg8::StaticOrder S;
        if (IN_PH()) REP(1) {
            if (KEN(1)) { pg8::Gemm g{XB, WinT, TOK, 4096, 1024}; S.init(TOK, 4096, G, (int)blockIdx.x); pg8::EpiProj E{P0, rs_mix}; pg8::gemm_phase<pg8::EpiProj, pg8::StaticOrder>(lds, g, S, E); }
            if (KEN(2)) { pg8::Gemm g{WinT + (size_t)4096 * 1024, XB, 512, TOK, 1024}; S.init(512, TOK, G, (int)blockIdx.x); pg8::EpiVT E{(bf16*)(ws + WS_P + 8 * PBUF), rs_mix}; pg8::gemm_phase<pg8::EpiVT, pg8::StaticOrder>(lds, g, S, E); }
        }
        END_PH();
        if (IN_PH()) { if (KEN(20)) REP(4) { LAUNDER(); phase_attn2(p, l, lds, tid, lane, wave, G, (DUP & 4) && rep_ == 0 ? (bf16*)(ws + WS_YG) : (bf16*)(ws + WS_P + 5 * PBUF)); } if (KEN(21)) { LAUNDER(); phase_branchB(p, l, lds, tid, lane, wave, G); } if (KEN(22)) REP(16) { LAUNDER(); phase_ssm<false>(p, l, lds, lane, wave, G); } if (KEN(23)) { LAUNDER(); phase_branchA(p, l, tid, G); } }
        END_PH();
        if (IN_PH() && KEN(3)) REP(16) { LAUNDER(); phase_ssm<true>(p, l, lds, lane, wave, G); }
        END_PH();
        if (IN_PH() && KEN(4)) REP(64) { pg8::Gemm g{(const bf16*)(ws + WS_YG), (const bf16*)(wl + WL_GLU), TOK, 512, 512}; S.init(TOK, 512, G, (int)blockIdx.x);
            pg8::EpiGlu E{(const bf16*)(ws + WS_YG), (bf16*)(ws + WS_P + 7 * PBUF), p.in[I_BGLU] + l * 512}; pg8::gemm_phase<pg8::EpiGlu, pg8::StaticOrder>(lds, g, S, E); }
        END_PH();
        bf16* GS = (bf16*)(ws + WS_P + 1 * PBUF); bf16* MG = (bf16*)(ws + WS_P + 8 * PBUF);
        if (IN_PH() && KEN(5)) REP(8) {
#pragma unroll 1
            for (int b = 0; b < 4; ++b) {
                { pg8::Gemm g{XB, WinT + (size_t)(4608 + 1024 * b) * 1024, TOK, 1024, 1024}; S.init(TOK, 1024, G, (int)blockIdx.x); pg8::EpiGate E{GS, rs_mix}; pg8::gemm_phase<pg8::EpiGate, pg8::StaticOrder>(lds, g, S, E); }
                const size_t yb = (b == 0) ? 0 : (b == 1) ? 3 : (b == 2) ? 5 : 7;
                pg8::Gemm g{(const bf16*)(ws + WS_P + yb * PBUF), (const bf16*)(wl + WL_BR) + (size_t)b * 1024 * 512, TOK, 1024, 512}; S.init(TOK, 1024, G, (int)blockIdx.x);
                if (b == 0) { pg8::EpiBr<true> E{GS, MG}; pg8::gemm_phase<pg8::EpiBr<true>, pg8::StaticOrder>(lds, g, S, E); }
                else { pg8::EpiBr<false> E{GS, MG}; pg8::gemm_phase<pg8::EpiBr<false>, pg8::StaticOrder>(lds, g, S, E); }
            }
        }
        END_PH();
        if (IN_PH() && KEN(6)) { pg8::Gemm g{MG, (const bf16*)(wl + WL_O), TOK, 1024, 1024}; S.init(TOK, 1024, G, (int)blockIdx.x);
            pg8::EpiResid E{l == 0 ? p.in[I_X] : (const float*)p.out, p.out, XB, rs_ffn}; pg8::gemm_phase<pg8::EpiResid, pg8::StaticOrder>(lds, g, S, E); }
        END_PH();
        bf16* H = (bf16*)(ws + WS_P);
        if (IN_PH() && KEN(7)) REP(2) { pg8::Gemm g{XB, (const bf16*)(wl + WL_FF), TOK, 5632, 1024}; S.init(TOK, 5632, G, (int)blockIdx.x);
            pg8::EpiFfnUp E{H, rs_ffn}; pg8::gemm_phase<pg8::EpiFfnUp, pg8::StaticOrder>(lds, g, S, E); }
        END_PH();
        if (IN_PH() && KEN(8)) { pg8::Gemm g{H, (const bf16*)(wl + WL_D), TOK, 1024, 2816}; S.init(TOK, 1024, G, (int)blockIdx.x);
            pg8::EpiResid E{(const float*)p.out, p.out, XB, rs_next}; pg8::gemm_phase<pg8::EpiResid, pg8::StaticOrder>(lds, g, S, E); }
        END_PH();
    }
    if (IN_PH() && KEN(9)) { LAUNDER(); phase_final(p, tid, G); }
}
constexpr int N_PHASES = 18;
}

extern "C" void kernel_launch(void* const* d_in, const int* in_sizes, int n_in, void* d_out, int out_size, void* d_ws, size_t ws_size, hipStream_t stream) {
    static int grid = 0;
    if (grid == 0) {
        if (n_in != 28 || out_size != mk::TOK * mk::DM || ws_size < mk::WS_END) { fprintf(stderr, "kernel_launch: unexpected shapes (n_in %d out %d ws %zu need %zu)\n", n_in, out_size, ws_size, (size_t)mk::WS_END); grid = -1; return; }
        int dev = 0, cus = 0, per_cu = 0;
        hipGetDevice(&dev); hipDeviceGetAttribute(&cus, hipDeviceAttributeMultiprocessorCount, dev);
        if (hipFuncSetAttribute((const void*)mk::mega, hipFuncAttributeMaxDynamicSharedMemorySize, mk::LDS_BYTES) != hipSuccess) { fprintf(stderr, "kernel_launch: hipFuncSetAttribute failed\n"); grid = -1; return; }
        if (hipOccupancyMaxActiveBlocksPerMultiprocessor(&per_cu, (const void*)mk::mega, mk::NTHR, mk::LDS_BYTES) != hipSuccess || per_cu < 1) { fprintf(stderr, "kernel_launch: occupancy query says %d\n", per_cu); per_cu = 1; }
        (void)hipGetLastError();
        grid = cus * 1;
        if (grid <= 0) grid = 256;
    }
    if (grid < 0) return;
    mk::Params p{};
    for (int i = 0; i < 28; ++i) p.in[i] = (const float*)d_in[i];
    p.out = (float*)d_out; p.ws = (unsigned char*)d_ws;
#if ONE_LAUNCH
    if (hipMemsetAsync((unsigned char*)d_ws + mk::WS_BAR, 0, XCD_BAR_WORDS * sizeof(unsigned), stream) != hipSuccess) { fprintf(stderr, "kernel_launch: memset failed\n"); return; }
    p.ph_lo = 0; p.ph_hi = mk::N_PHASES;
    void* args[] = {&p};
    hipError_t e = hipLaunchCooperativeKernel((const void*)mk::mega, dim3(grid), dim3(mk::NTHR), args, mk::LDS_BYTES, stream);
    if (e != hipSuccess) fprintf(stderr, "cooperative launch failed: %s (grid %d)\n", hipGetErrorString(e), grid);
#else
    for (int ph = 0; ph < mk::N_PHASES; ++ph) { p.ph_lo = ph; p.ph_hi = ph + 1;
        hipLaunchKernelGGL(mk::mega, dim3(grid), dim3(mk::NTHR), mk::LDS_BYTES, stream, p); }
#endif
}
```

```cpp
#include <hip/hip_runtime.h>
#include <hip/hip_cooperative_groups.h>
#include <cstdio>
#include <cstdint>
#ifndef ONE_LAUNCH
#define ONE_LAUNCH 1
#endif
namespace cg = cooperative_groups;
typedef __bf16 mk_bf16x2_t __attribute__((ext_vector_type(2)));
typedef float mk_f32x2_t __attribute__((ext_vector_type(2)));
__device__ __forceinline__ unsigned mk_pk2(float lo, float hi) { mk_f32x2_t v = {lo, hi}; mk_bf16x2_t b = __builtin_convertvector(v, mk_bf16x2_t); return __builtin_bit_cast(unsigned, b); }
__device__ __forceinline__ float mk_lo(unsigned w) { return __uint_as_float(w << 16); }
__device__ __forceinline__ float mk_hi(unsigned w) { return __uint_as_float(w & 0xffff0000u); }
__device__ __forceinline__ float mk_sigm(float x) { return __builtin_amdgcn_rcpf(1.0f + __expf(-x)); }
__device__ __forceinline__ float mk_gelu(float x) { const float u = 1.5957691216f * (x + 0.044715f * x * x * x); return x * __builtin_amdgcn_rcpf(1.0f + __expf(-u)); }
namespace pg8 {
#define PG8_LAS __attribute__((address_space(3)))
typedef unsigned short bf16_t;
typedef short bf16x8 __attribute__((ext_vector_type(8)));
typedef float f32x4 __attribute__((ext_vector_type(4)));
typedef unsigned u32x4 __attribute__((ext_vector_type(4)));
constexpr int BM = 256, BK = 64, HALF = 128, HTB = HALF * BK * 2  , STAGE_BYTES = 8 * HTB, NXCD = 8, WGM = 8;

__host__ __device__ __forceinline__ int lds_byte(int r, int c) { const int st = (r >> 4) * 2 + (c >> 5), rr = r & 15, cc = c & 31, ob = rr * 64 + cc * 2; return st * 1024 + (ob ^ (((ob >> 9) & 1) << 5)); }
__host__ __device__ __forceinline__ void stage_rc(int b, int& R, int& C) { const int st = b / 1024, sb = b % 1024, swz = sb ^ (((sb >> 9) & 1) << 5); R = (st >> 1) * 16 + swz / 64; C = (st & 1) * 32 + (swz % 64) / 2; }
__host__ __device__ __forceinline__ int perm32(int rho) { const int n = rho >> 4, i = rho & 15; return 8 * (i >> 2) + 4 * n + (i & 3); }

struct Unit { int pm, pn; };
struct Gemm { const bf16_t* A; const bf16_t* Bt; int M, N, K; };

struct StaticOrder {
    int nM, nN, nwg, G, c;
    __host__ __device__ void init(int M, int N, int G_, int c_) { nM = M / BM; nN = N / BM; nwg = nM * nN; G = G_; c = c_; }
    __host__ __device__ bool next(int i, Unit& u) const {
        const long L = (long)i * G + c; if (L >= nwg) return false;
        int wgid = (int)L; { const int q = nwg / NXCD, r = nwg % NXCD, xcd = wgid % NXCD, off = wgid / NXCD; wgid = (xcd < r ? xcd * (q + 1) : r * (q + 1) + (xcd - r) * q) + off; }
        const int nig = WGM * nN, gid = wgid / nig, fm = gid * WGM, gsz = (nM - fm) < WGM ? (nM - fm) : WGM;
        u.pm = fm + ((wgid % nig) % gsz); u.pn = (wgid % nig) / gsz; return true;
    }
    __device__ __forceinline__ void a_ready(const Unit&) const {}
    __device__ __forceinline__ void done(const Unit&) const {}
};
typedef unsigned u32x2 __attribute__((ext_vector_type(2)));
constexpr int MK_TOK = 32768;
#define MK_EPI_LOOP_AM _Pragma("unroll") for (int ai = 0; ai < 2; ++ai) _Pragma("unroll") for (int m = 0; m < 4; ++m)
__device__ __forceinline__ u32x4 pack8(const f32x4 a, const f32x4 b) { u32x4 w; w.x = mk_pk2(a[0], a[1]); w.y = mk_pk2(a[2], a[3]); w.z = mk_pk2(b[0], b[1]); w.w = mk_pk2(b[2], b[3]); return w; }
__device__ __forceinline__ void unpack8(const u32x4 w, f32x4& a, f32x4& b) { a = (f32x4){mk_lo(w.x), mk_hi(w.x), mk_lo(w.y), mk_hi(w.y)}; b = (f32x4){mk_lo(w.z), mk_hi(w.z), mk_lo(w.w), mk_hi(w.w)}; }
__device__ __forceinline__ float rstd_of(float ss) { return rsqrtf(ss * (1.0f / 1024.0f) + 1e-6f); }
typedef unsigned long long rowss_t;
__device__ __forceinline__ float rstd_row(const rowss_t* rowss, int row) { return rstd_of((float)rowss[row] * (1.0f / 4294967296.0f)); }

struct EpiProj { static constexpr bool PERM = true, AFTER_DRAIN = false; bf16_t* P; const rowss_t* rowss;
    __device__ __forceinline__ void operator()(const f32x4 (&acc)[2][2][4][2], const Unit& u, int wr, int wc, int fr, int fq) const {
        const int row0 = u.pm * BM + wr * 64 + fr;
        bf16_t* base = P + (size_t)(u.pn >> 1) * ((size_t)MK_TOK * 512) + (u.pn & 1) * 256 + wc * 32 + 8 * fq;
        MK_EPI_LOOP_AM { const int row = row0 + ai * HALF + m * 16; const float rs = rstd_row(rowss, row); bf16_t* rp = base + (size_t)row * 512;
#pragma unroll
            for (int bj = 0; bj < 2; ++bj) *(u32x4*)(rp + bj * HALF) = pack8(acc[ai][bj][m][0] * rs, acc[ai][bj][m][1] * rs); }
    }
};
struct EpiVT { static constexpr bool PERM = true, AFTER_DRAIN = false; bf16_t* VT; const rowss_t* rowss;
    __device__ __forceinline__ void operator()(const f32x4 (&acc)[2][2][4][2], const Unit& u, int wr, int wc, int fr, int fq) const {
        const int row0 = u.pm * BM + wr * 64 + fr, col0 = u.pn * BM + wc * 32 + 8 * fq;
        f32x4 rs[2][2];
#pragma unroll
        for (int bj = 0; bj < 2; ++bj)
#pragma unroll
            for (int n = 0; n < 2; ++n) { const int c_ = col0 + bj * HALF + 4 * n; rs[bj][n] = (f32x4){rstd_row(rowss, c_), rstd_row(rowss, c_ + 1), rstd_row(rowss, c_ + 2), rstd_row(rowss, c_ + 3)}; }
        MK_EPI_LOOP_AM { const int row = row0 + ai * HALF + m * 16; bf16_t* rp = VT + (size_t)row * MK_TOK + col0;
#pragma unroll
            for (int bj = 0; bj < 2; ++bj) *(u32x4*)(rp + bj * HALF) = pack8(acc[ai][bj][m][0] * rs[bj][0], acc[ai][bj][m][1] * rs[bj][1]); }
    }
};
struct EpiGlu { static constexpr bool PERM = true, AFTER_DRAIN = false; const bf16_t* YG; bf16_t* O; const float* bias;
    __device__ __forceinline__ void operator()(const f32x4 (&acc)[2][2][4][2], const Unit& u, int wr, int wc, int fr, int fq) const {
        const int row0 = u.pm * BM + wr * 64 + fr, col0 = u.pn * BM + wc * 32 + 8 * fq;
        f32x4 bv[2][2];
#pragma unroll
        for (int bj = 0; bj < 2; ++bj)
#pragma unroll
            for (int n = 0; n < 2; ++n) bv[bj][n] = *(const f32x4*)(bias + col0 + bj * HALF + 4 * n);
        MK_EPI_LOOP_AM { const int row = row0 + ai * HALF + m * 16; const size_t off = (size_t)row * 512 + col0;
#pragma unroll
            for (int bj = 0; bj < 2; ++bj) { f32x4 y0, y1; unpack8(*(const u32x4*)(YG + off + bj * HALF), y0, y1);
                f32x4 a0 = acc[ai][bj][m][0] + bv[bj][0], a1 = acc[ai][bj][m][1] + bv[bj][1];
#pragma unroll
                for (int j = 0; j < 4; ++j) { y0[j] *= mk_sigm(a0[j]); y1[j] *= mk_sigm(a1[j]); }
                *(u32x4*)(O + off + bj * HALF) = pack8(y0, y1); } }
    }
};
struct EpiGate { static constexpr bool PERM = true, AFTER_DRAIN = false; bf16_t* GS; const rowss_t* rowss;
    __device__ __forceinline__ void operator()(const f32x4 (&acc)[2][2][4][2], const Unit& u, int wr, int wc, int fr, int fq) const {
        const int row0 = u.pm * BM + wr * 64 + fr, col0 = u.pn * BM + wc * 32 + 8 * fq;
        MK_EPI_LOOP_AM { const int row = row0 + ai * HALF + m * 16; const float rs = rstd_row(rowss, row); const size_t off = (size_t)row * 1024 + col0;
#pragma unroll
            for (int bj = 0; bj < 2; ++bj) { f32x4 a0 = acc[ai][bj][m][0] * rs, a1 = acc[ai][bj][m][1] * rs;
#pragma unroll
                for (int j = 0; j < 4; ++j) { a0[j] = mk_sigm(a0[j]); a1[j] = mk_sigm(a1[j]); }
                *(u32x4*)(GS + off + bj * HALF) = pack8(a0, a1); } }
    }
};
template <bool FIRST> struct EpiBr { static constexpr bool PERM = true, AFTER_DRAIN = false; const bf16_t* GS; bf16_t* MG;
    __device__ __forceinline__ void operator()(const f32x4 (&acc)[2][2][4][2], const Unit& u, int wr, int wc, int fr, int fq) const {
        const int row0 = u.pm * BM + wr * 64 + fr, col0 = u.pn * BM + wc * 32 + 8 * fq;
        MK_EPI_LOOP_AM { const int row = row0 + ai * HALF + m * 16; const size_t off = (size_t)row * 1024 + col0;
#pragma unroll
            for (int bj = 0; bj < 2; ++bj) { f32x4 g0, g1; unpack8(*(const u32x4*)(GS + off + bj * HALF), g0, g1);
                f32x4 v0 = g0 * acc[ai][bj][m][0], v1 = g1 * acc[ai][bj][m][1];
                if (!FIRST) { f32x4 p0, p1; unpack8(*(const u32x4*)(MG + off + bj * HALF), p0, p1); v0 += p0; v1 += p1; }
                *(u32x4*)(MG + off + bj * HALF) = pack8(v0, v1); } }
    }
};
struct EpiResid { static constexpr bool PERM = false, AFTER_DRAIN = false; const float* xold; float* out; bf16_t* xb; rowss_t* rowss_next; int write_out;
    __device__ __forceinline__ void operator()(const f32x4 (&acc)[2][2][4][2], const Unit& u, int wr, int wc, int fr, int fq) const {
        const int row0 = u.pm * BM + wr * 64 + fr, col0 = u.pn * BM + wc * 32 + 4 * fq;
        MK_EPI_LOOP_AM { const int row = row0 + ai * HALF + m * 16; const size_t off = (size_t)row * 1024 + col0; float ss = 0.f;
#pragma unroll
            for (int bj = 0; bj < 2; ++bj)
#pragma unroll
                for (int n = 0; n < 2; ++n) { const size_t o = off + bj * HALF + n * 16; const f32x4 xn = *(const f32x4*)(xold + o) + acc[ai][bj][m][n];
                    if (write_out) *(f32x4*)(out + o) = xn; u32x2 w; w.x = mk_pk2(xn[0], xn[1]); w.y = mk_pk2(xn[2], xn[3]); *(u32x2*)(xb + o) = w;
                    ss += (xn[0] * xn[0] + xn[1] * xn[1]) + (xn[2] * xn[2] + xn[3] * xn[3]); }
            ss += __shfl_xor(ss, 16); ss += __shfl_xor(ss, 32);
            if (fq == 0) __hip_atomic_fetch_add(rowss_next + row, (rowss_t)(ss * 4294967296.0f), __ATOMIC_RELAXED, __HIP_MEMORY_SCOPE_AGENT); }
    }
};
struct EpiFfnUp { static constexpr bool PERM = true, AFTER_DRAIN = false; bf16_t* H; const rowss_t* rowss;
    __device__ __forceinline__ void operator()(const f32x4 (&acc)[2][2][4][2], const Unit& u, int wr, int wc, int fr, int fq) const {
        const int row0 = u.pm * BM + wr * 64 + fr, col0 = u.pn * HALF + wc * 32 + 8 * fq;
        MK_EPI_LOOP_AM { const int row = row0 + ai * HALF + m * 16; const float rs = rstd_row(rowss, row);
            f32x4 g0 = acc[ai][0][m][0] * rs, g1 = acc[ai][0][m][1] * rs, u0 = acc[ai][1][m][0] * rs, u1 = acc[ai][1][m][1] * rs;
#pragma unroll
            for (int j = 0; j < 4; ++j) { g0[j] = g0[j] * mk_sigm(g0[j]) * u0[j]; g1[j] = g1[j] * mk_sigm(g1[j]) * u1[j]; }
            *(u32x4*)(H + (size_t)row * 2816 + col0) = pack8(g0, g1); }
    }
};
template <class Epi, class Sched, bool ALIGN_EPI = true, bool SP2 = true>
__device__ __forceinline__ void gemm_phase(PG8_LAS unsigned char* lds, const Gemm g, const Sched& S, const Epi& E) {
    int tid_l = threadIdx.x; asm volatile("" : "+v"(tid_l)); const int tid = tid_l, wid = __builtin_amdgcn_readfirstlane(tid >> 6), lane = tid & 63, wr = wid >> 2, wc = wid & 3, fr = lane & 15, fq = lane >> 4;
    const int K = g.K, nt = K / BK;
    unsigned voffA[2], voffB[2];
#pragma unroll
    for (int i = 0; i < 2; ++i) { int R, C; stage_rc(tid * 16 + i * 8192, R, C); const int Rb = Epi::PERM ? ((R & ~31) + perm32(R & 31)) : R;
        voffA[i] = (unsigned)(R * K + C) * 2u; voffB[i] = (unsigned)(Rb * K + C) * 2u; }
    const size_t kstep = (size_t)(BK * 2);
    const size_t hstep = (size_t)HALF * K * 2;
    const size_t tstep = 2 * hstep;
    const unsigned ldsw = (unsigned)wid * 1024u;
    const int aoff = lds_byte(wr * 64 + fr, fq * 8), boff = lds_byte(wc * 32 + fr, fq * 8);
#define PG8_SA(b, h) (((b) * 2 + (h)) * HTB)
#define PG8_SB(b, h) ((4 + (b) * 2 + (h)) * HTB)
#define PG8_STAGE(bufoff, gbase, voff) do { _Pragma("unroll") for (int _i = 0; _i < 2; ++_i) \
        __builtin_amdgcn_global_load_lds((const unsigned*)((const char*)(gbase) + (voff)[_i]), (PG8_LAS unsigned*)(lds + (bufoff) + ldsw + _i * 8192), 16, 0, 0); } while (0)
#define PG8_LDA(dst, b, h) do { _Pragma("unroll") for (int m = 0; m < 4; ++m) _Pragma("unroll") for (int k = 0; k < 2; ++k) dst[m][k] = *(const PG8_LAS bf16x8*)(lds + PG8_SA(b, h) + aoff + m * 2048 + k * 1024); } while (0)
#define PG8_LDB(dst, b, h) do { _Pragma("unroll") for (int n = 0; n < 2; ++n) _Pragma("unroll") for (int k = 0; k < 2; ++k) dst[n][k] = *(const PG8_LAS bf16x8*)(lds + PG8_SB(b, h) + boff + n * 2048 + k * 1024); } while (0)
#define PG8_MMA(ai, bj, At, Bt) do { __builtin_amdgcn_s_setprio(1); _Pragma("unroll") for (int m = 0; m < 4; ++m) _Pragma("unroll") for (int n = 0; n < 2; ++n) _Pragma("unroll") for (int k = 0; k < 2; ++k) \
        acc[ai][bj][m][n] = __builtin_amdgcn_mfma_f32_16x16x32_bf16(Bt[n][k], At[m][k], acc[ai][bj][m][n], 0, 0, 0); __builtin_amdgcn_s_setprio(0); } while (0)
#define PG8_WAIT_V(n) asm volatile("s_waitcnt vmcnt(" #n ")" ::: "memory")
#define PG8_WAIT_L(n) asm volatile("s_waitcnt lgkmcnt(" #n ")" ::: "memory")
#define PG8_BAR __builtin_amdgcn_s_barrier()
#define PG8_SCHED __builtin_amdgcn_sched_barrier(0)
    Unit cur, nxt; int ui = 0;
    if (!S.next(0, cur)) return;
    f32x4 acc[2][2][4][2];
#pragma unroll
    for (int a = 0; a < 2; ++a)
#pragma unroll
        for (int b = 0; b < 2; ++b)
#pragma unroll
            for (int m = 0; m < 4; ++m)
#pragma unroll
                for (int n = 0; n < 2; ++n) acc[a][b][m][n] = (f32x4){0.f, 0.f, 0.f, 0.f};
    bf16x8 At[4][2], B0[2][2], B1[2][2];
    const char* cA = (const char*)g.A + (size_t)cur.pm * tstep; const char* cB = (const char*)g.Bt + (size_t)cur.pn * tstep;
    S.a_ready(cur);
    if constexpr (SP2) {
        PG8_STAGE(PG8_SB(0, 0), cB, voffB); PG8_STAGE(PG8_SB(0, 1), cB + hstep, voffB); PG8_STAGE(PG8_SA(0, 0), cA, voffA); PG8_STAGE(PG8_SA(0, 1), cA + hstep, voffA);
        if (wr == 1) PG8_BAR;
        PG8_WAIT_V(2); PG8_BAR;
        PG8_STAGE(PG8_SB(1, 0), cB + kstep, voffB); PG8_STAGE(PG8_SA(1, 0), cA + kstep, voffA); PG8_STAGE(PG8_SB(1, 1), cB + hstep + kstep, voffB);
        PG8_WAIT_V(6); PG8_BAR;
    } else {
        PG8_STAGE(PG8_SB(0, 0), cB, voffB); PG8_STAGE(PG8_SA(0, 0), cA, voffA); PG8_STAGE(PG8_SB(0, 1), cB + hstep, voffB); PG8_STAGE(PG8_SA(0, 1), cA + hstep, voffA);
        if (wr == 1) PG8_BAR;
        PG8_WAIT_V(4); PG8_BAR;
        PG8_STAGE(PG8_SB(1, 0), cB + kstep, voffB); PG8_STAGE(PG8_SA(1, 0), cA + kstep, voffA); PG8_STAGE(PG8_SB(1, 1), cB + hstep + kstep, voffB);
        PG8_WAIT_V(6); PG8_BAR;
    }
    for (;;) {
        const bool has_next = S.next(ui + 1, nxt);
        const char* nA = has_next ? (const char*)g.A + (size_t)nxt.pm * tstep : cA; const char* nB = has_next ? (const char*)g.Bt + (size_t)nxt.pn * tstep : cB;
        for (int t = 0; t < nt; t += 2) {
            const bool last = (t == nt - 2);
            const char* a1 = cA + (size_t)(t + 1) * kstep;
            const char* a2 = last ? nA : cA + (size_t)(t + 2) * kstep; const char* b2 = last ? nB : cB + (size_t)(t + 2) * kstep;
            const char* a3 = a2 + kstep; const char* b3 = b2 + kstep;
            if (last && has_next) S.a_ready(nxt);
            if constexpr (SP2) {
            PG8_LDB(B0, 0, 0); PG8_LDB(B1, 0, 1); PG8_SCHED; PG8_LDA(At, 0, 0); PG8_STAGE(PG8_SA(1, 1), a1 + hstep, voffA);
            PG8_WAIT_V(8); PG8_WAIT_L(0); PG8_BAR; PG8_MMA(0, 0, At, B0); PG8_MMA(0, 1, At, B1); PG8_BAR; PG8_SCHED;
            PG8_LDA(At, 0, 1); PG8_STAGE(PG8_SB(0, 0), b2, voffB); PG8_STAGE(PG8_SB(0, 1), b2 + hstep, voffB); PG8_STAGE(PG8_SA(0, 0), a2, voffA);
            PG8_WAIT_V(8); PG8_WAIT_L(0); PG8_BAR; PG8_MMA(1, 0, At, B0); PG8_MMA(1, 1, At, B1); PG8_BAR; PG8_SCHED;
            PG8_LDB(B0, 1, 0); PG8_LDB(B1, 1, 1); PG8_SCHED; PG8_LDA(At, 1, 0); PG8_STAGE(PG8_SA(0, 1), a2 + hstep, voffA);
            PG8_WAIT_V(8); PG8_WAIT_L(0); PG8_BAR; PG8_MMA(0, 0, At, B0); PG8_MMA(0, 1, At, B1); PG8_BAR; PG8_SCHED;
            PG8_LDA(At, 1, 1); PG8_STAGE(PG8_SB(1, 0), b3, voffB); PG8_STAGE(PG8_SB(1, 1), b3 + hstep, voffB); PG8_STAGE(PG8_SA(1, 0), a3, voffA);
            PG8_WAIT_V(8); PG8_WAIT_L(0); PG8_BAR; PG8_MMA(1, 0, At, B0); PG8_MMA(1, 1, At, B1); PG8_BAR; PG8_SCHED;
            } else {
            PG8_LDB(B0, 0, 0); PG8_SCHED; PG8_LDA(At, 0, 0); PG8_STAGE(PG8_SA(1, 1), a1 + hstep, voffA);
            PG8_WAIT_L(8); PG8_BAR; PG8_WAIT_L(0); PG8_MMA(0, 0, At, B0); PG8_BAR; PG8_SCHED;
            PG8_LDB(B1, 0, 1); PG8_STAGE(PG8_SB(0, 0), b2, voffB);
            PG8_BAR; PG8_WAIT_L(0); PG8_MMA(0, 1, At, B1); PG8_BAR;
            PG8_LDA(At, 0, 1); PG8_STAGE(PG8_SA(0, 0), a2, voffA);
            PG8_BAR; PG8_WAIT_L(0); PG8_MMA(1, 0, At, B0); PG8_BAR; PG8_SCHED;
            PG8_STAGE(PG8_SB(0, 1), b2 + hstep, voffB);
            PG8_WAIT_V(6); PG8_BAR; PG8_MMA(1, 1, At, B1); PG8_BAR;
            PG8_LDB(B0, 1, 0); PG8_SCHED; PG8_LDA(At, 1, 0); PG8_STAGE(PG8_SA(0, 1), a2 + hstep, voffA);
            PG8_WAIT_L(8); PG8_BAR; PG8_WAIT_L(0); PG8_MMA(0, 0, At, B0); PG8_BAR; PG8_SCHED;
            PG8_LDB(B1, 1, 1); PG8_STAGE(PG8_SB(1, 0), b3, voffB);
            PG8_BAR; PG8_WAIT_L(0); PG8_MMA(0, 1, At, B1); PG8_BAR;
            PG8_LDA(At, 1, 1); PG8_STAGE(PG8_SA(1, 0), a3, voffA);
            PG8_BAR; PG8_WAIT_L(0); PG8_MMA(1, 0, At, B0); PG8_BAR; PG8_SCHED;
            PG8_STAGE(PG8_SB(1, 1), b3 + hstep, voffB);
            PG8_WAIT_V(6); PG8_BAR; PG8_MMA(1, 1, At, B1); PG8_BAR;
            }
        }
        if constexpr (ALIGN_EPI) { if (wr == 0) PG8_BAR; }
        if constexpr (!Epi::AFTER_DRAIN) { E(acc, cur, wr, wc, fr, fq); S.done(cur); }
        if (!has_next) break;
#pragma unroll
        for (int a = 0; a < 2; ++a)
#pragma unroll
            for (int b = 0; b < 2; ++b)
#pragma unroll
                for (int m = 0; m < 4; ++m)
#pragma unroll
                    for (int n = 0; n < 2; ++n) acc[a][b][m][n] = (f32x4){0.f, 0.f, 0.f, 0.f};
        cur = nxt; cA = nA; cB = nB; ++ui;
        if constexpr (ALIGN_EPI) { if (wr == 1) PG8_BAR; }
    }
    PG8_WAIT_V(0);
    if constexpr (!ALIGN_EPI) { if (wr == 0) PG8_BAR; }
    PG8_BAR;
    if constexpr (Epi::AFTER_DRAIN) { E.fused(acc, cur, wr, wc, fr, fq, lds, wid, lane); S.done(cur); }
#undef PG8_SA
#undef PG8_SB
#undef PG8_STAGE
#undef PG8_LDA
#undef PG8_LDB
#undef PG8_MMA
#undef PG8_WAIT_V
#undef PG8_WAIT_L
#undef PG8_BAR
#undef PG8_SCHED
}
}

namespace mk {
#define LAS __attribute__((address_space(3)))
#define DI __device__ __forceinline__
typedef unsigned short bf16;
typedef pg8::bf16x8 bf16x8; typedef pg8::f32x4 f32x4; typedef pg8::u32x4 u32x4; typedef pg8::u32x2 u32x2;
typedef float f32x16 __attribute__((ext_vector_type(16)));
constexpr int TOK = 32768, DM = 1024, SEQ = 4096, BW = 512, FFH = 2816, NTHR = 512;
constexpr size_t MiB = 1024 * 1024;
constexpr size_t WS_ROWSS = 474 * MiB;
constexpr size_t WS_BAR = 768 * 1024;
constexpr size_t WS_BB = 1 * MiB;
constexpr size_t WS_CM = WS_BB + 262144;
constexpr size_t WS_AP = WS_CM + 262144;
constexpr size_t WS_SGW = WS_AP + 131072;
constexpr size_t WS_E = 2 * MiB;
constexpr size_t WS_W = 10 * MiB;
constexpr size_t WL_IN = 0, WL_GLU = 17825792, WL_BR = WL_GLU + 524288, WL_O = WL_BR + 4194304, WL_FF = WL_O + 2097152, WL_D = WL_FF + 11534336, WL_SIZE = WL_D + 5767168;
static_assert(WL_SIZE == 40 * MiB, "weights per layer");
constexpr size_t WS_XB = 90 * MiB;
constexpr size_t WS_P = 154 * MiB;
constexpr size_t PBUF = 32 * MiB;
constexpr size_t WS_YG = WS_P + 9 * PBUF;
constexpr size_t WS_END = WS_YG + 32 * MiB + 2 * MiB;
constexpr int LDS_BYTES = 143360;

DI float bf2f(bf16 v) { return __uint_as_float(((unsigned)v) << 16); }
DI bf16 f2bf(float f) { return (bf16)(mk_pk2(f, 0.f) & 0xffffu); }
DI float wave_sum(float v) {
#pragma unroll
    for (int o = 1; o < 64; o <<= 1) v += __shfl_xor(v, o);
    return v; }
DI f32x16 mfma32(bf16x8 a, bf16x8 b, f32x16 c) { return __builtin_amdgcn_mfma_f32_32x32x16_bf16(a, b, c, 0, 0, 0); }
DI f32x4 mfma16(bf16x8 a, bf16x8 b, f32x4 c) { return __builtin_amdgcn_mfma_f32_16x16x32_bf16(a, b, c, 0, 0, 0); }
DI int crow(int i, int h) { return (i & 3) + 8 * (i >> 2) + 4 * h; }
DI f32x16 zero16() { f32x16 z;
#pragma unroll
    for (int i = 0; i < 16; ++i) z[i] = 0.f;
    return z; }
#define LDS_WAIT() asm volatile("s_waitcnt lgkmcnt(0)" ::: "memory")

struct Params { const float* in[28]; float* out; unsigned char* ws; int ph_lo, ph_hi; };
enum { I_X = 0, I_GMIX, I_WIN, I_CONVW, I_CONVB, I_SGW, I_SGB, I_LNG, I_LNB, I_LAMQK, I_SUBLN, I_ARE, I_AIM, I_LOGDT, I_BRE, I_BIM, I_CRE, I_CIM, I_SSMD, I_WGLU, I_BGLU, I_WBR, I_WO, I_GFFN, I_WFG, I_WFU, I_WFD, I_GFIN };

DI void tr_item(const float* W, int ldn, int k0, int n0, const float* gs, bf16* WT, int ldk, int drow0, LAS float* scr, int lane) {
    float tv[32];
#pragma unroll
    for (int i = 0; i < 32; ++i) { const int kk = 2 * i + (lane >> 5); tv[i] = W[(size_t)(k0 + kk) * ldn + n0 + (lane & 31)]; }
    if (gs) {
#pragma unroll
        for (int i = 0; i < 32; ++i) tv[i] *= gs[k0 + 2 * i + (lane >> 5)]; }
#pragma unroll
    for (int i = 0; i < 32; ++i) scr[(2 * i + (lane >> 5)) * 33 + (lane & 31)] = tv[i];
    LDS_WAIT();
    const int c = lane & 7;
#pragma unroll
    for (int j = 0; j < 4; ++j) { const int n = (lane >> 3) + 8 * j; const LAS float* s = scr + (8 * c) * 33 + n;
        u32x4 o; o.x = mk_pk2(s[0 * 33], s[1 * 33]); o.y = mk_pk2(s[2 * 33], s[3 * 33]); o.z = mk_pk2(s[4 * 33], s[5 * 33]); o.w = mk_pk2(s[6 * 33], s[7 * 33]);
        *(u32x4*)(WT + (size_t)(drow0 + n) * ldk + k0 + 8 * c) = o; }
    LDS_WAIT();
}
DI void dsincos(double x, double& s, double& c) {
    const double twopi = 6.283185307179586476925; const double k = rint(x / twopi); const double r = x - k * twopi, r2 = r * r;
    double ss = 1.0, cc = 1.0;
#pragma unroll
    for (int n = 13; n >= 1; --n) { ss = 1.0 - r2 * (1.0 / ((2.0 * n) * (2.0 * n + 1.0))) * ss; cc = 1.0 - r2 * (1.0 / ((2.0 * n - 1.0) * (2.0 * n))) * cc; }
    s = ss * r; c = cc;
}
DI void phase_prep(const Params& p, LAS unsigned char* lds, int tid, int lane, int wave, int G) {
    unsigned char* ws = p.ws;
    const int gw = blockIdx.x * 8 + wave, NGW = G * 8, gt = blockIdx.x * NTHR + tid, NGT = G * NTHR;
    LAS float* scr = (LAS float*)(lds + wave * 8704);
    for (int l = 0; l < 2; ++l) {
        unsigned char* wl = ws + WS_W + (size_t)l * WL_SIZE;
        for (int mi = 0; mi < 10; ++mi) {
            const float* src; int K, N; const float* gs = nullptr; bf16* dst; int map = 0;
            if (mi == 0) { src = p.in[I_WIN] + (size_t)l * 1024 * 8704; K = 1024; N = 8704; gs = p.in[I_GMIX] + l * 1024; dst = (bf16*)(wl + WL_IN); map = 1; }
            else if (mi == 1) { src = p.in[I_WGLU] + (size_t)l * 512 * 512; K = 512; N = 512; dst = (bf16*)(wl + WL_GLU); }
            else if (mi < 6) { const int b = mi - 2; src = p.in[I_WBR] + ((size_t)l * 4 + b) * 512 * 1024; K = 512; N = 1024; dst = (bf16*)(wl + WL_BR) + (size_t)b * 1024 * 512; }
            else if (mi == 6) { src = p.in[I_WO] + (size_t)l * 1024 * 1024; K = 1024; N = 1024; dst = (bf16*)(wl + WL_O); }
            else if (mi == 7) { src = p.in[I_WFG] + (size_t)l * 1024 * 2816; K = 1024; N = 2816; gs = p.in[I_GFFN] + l * 1024; dst = (bf16*)(wl + WL_FF); map = 2; }
            else if (mi == 8) { src = p.in[I_WFU] + (size_t)l * 1024 * 2816; K = 1024; N = 2816; gs = p.in[I_GFFN] + l * 1024; dst = (bf16*)(wl + WL_FF); map = 3; }
            else { src = p.in[I_WFD] + (size_t)l * 2816 * 1024; K = 2816; N = 1024; dst = (bf16*)(wl + WL_D); }
            const int nblk = N / 32, nit = (K / 64) * nblk;
            for (int it = gw; it < nit; it += NGW) {
                const int kb = it / nblk, nb = it % nblk, n0 = nb * 32; int dr = n0;
                if (map == 1) { if (n0 >= 3584 && n0 < 4096) dr = n0 + 512; else if (n0 >= 4096 && n0 < 4608) dr = n0 - 512; }
                else if (map == 2) dr = (n0 >> 7) * 256 + (n0 & 127);
                else if (map == 3) dr = (n0 >> 7) * 256 + 128 + (n0 & 127);
                tr_item(src, N, kb * 64, n0, gs, dst, K, dr, scr, lane);
            }
        }
    }
    { const float* x = p.in[I_X]; bf16* xb = (bf16*)(ws + WS_XB); pg8::rowss_t* rowss = (pg8::rowss_t*)(ws + WS_ROWSS);
        for (int row0 = gw * 4; row0 < TOK; row0 += NGW * 4) { f32x4 v[4][4];
#pragma unroll
            for (int q = 0; q < 4; ++q)
#pragma unroll
                for (int j = 0; j < 4; ++j) v[q][j] = *((const f32x4*)(x + (size_t)(row0 + q) * DM) + lane + 64 * j);
#pragma unroll
            for (int q = 0; q < 4; ++q) { float ss = 0.f;
#pragma unroll
                for (int j = 0; j < 4; ++j) { const f32x4 t = v[q][j]; ss += (t[0] * t[0] + t[1] * t[1]) + (t[2] * t[2] + t[3] * t[3]);
                    u32x2 w; w.x = mk_pk2(t[0], t[1]); w.y = mk_pk2(t[2], t[3]); *((u32x2*)(xb + (size_t)(row0 + q) * DM) + lane + 64 * j) = w; }
                ss = wave_sum(ss); if (lane == 0) rowss[row0 + q] = (pg8::rowss_t)(ss * 4294967296.0f); } }
        for (int i = gt; i < 4 * TOK; i += NGT) rowss[TOK + i] = 0ull; }
    { const float* sgw = p.in[I_SGW]; bf16* o = (bf16*)(ws + WS_SGW);
        for (int i = gt; i < 2 * 4 * 128 * 128; i += NGT) { const int s = i & 127, t = (i >> 7) & 127; o[i] = f2bf(s <= t ? sgw[i] : 0.f); } }
    for (int i = gt; i < 2 * 32 * 64; i += NGT) {
        const int pp = i & 63, lg = i >> 6;
        const double dt = exp((double)p.in[I_LOGDT][lg]); const double are = p.in[I_ARE][i], aim = p.in[I_AIM][i];
        const double mag = exp(dt * are); double sn, cs; dsincos(dt * aim, sn, cs);
        const double abr = mag * cs, abi = mag * sn, den = are * are + aim * aim, nr = abr - 1.0, ni = abi;
        const double cr = (nr * are + ni * aim) / den, ci = (ni * are - nr * aim) / den;
        bf16* bb = (bf16*)(ws + WS_BB) + (size_t)lg * 128 * 16; const float* bre = p.in[I_BRE] + (size_t)i * 16; const float* bim = p.in[I_BIM] + (size_t)i * 16;
        for (int h = 0; h < 16; ++h) { const double br = bre[h], bi = bim[h]; bb[pp * 16 + h] = f2bf((float)(cr * br - ci * bi)); bb[(64 + pp) * 16 + h] = f2bf((float)(cr * bi + ci * br)); }
        bf16* cm = (bf16*)(ws + WS_CM) + (size_t)lg * 16 * 128; const float* cre = p.in[I_CRE] + (size_t)lg * 16 * 64; const float* cim = p.in[I_CIM] + (size_t)lg * 16 * 64;
        for (int h = 0; h < 16; ++h) { cm[h * 128 + pp] = f2bf(cre[h * 64 + pp]); cm[h * 128 + 64 + pp] = f2bf(-cim[h * 64 + pp]); }
        double pr = abr, pi = abi; float* ap = (float*)(ws + WS_AP) + (size_t)i * 8; ap[0] = (float)pr; ap[1] = (float)pi;
        for (int q = 0; q < 5; ++q) { const double t = pr * pr - pi * pi; pi = 2.0 * pr * pi; pr = t; }
        ap[2] = (float)pr; ap[3] = (float)pi;
        { const double t = pr * pr - pi * pi; pi = 2.0 * pr * pi; pr = t; }
        ap[4] = (float)pr; ap[5] = (float)pi; ap[6] = 0.f; ap[7] = 0.f;
    }
}

DI void phase_branchA(const Params& p, int l, int tid, int G) {
    bf16* AB = (bf16*)(p.ws + WS_P); const bf16* AC = (const bf16*)(p.ws + WS_P + PBUF); const bf16* AX = (const bf16*)(p.ws + WS_P + 2 * PBUF);
    const float* cw = p.in[I_CONVW] + l * 3 * 512; const float* cb = p.in[I_CONVB] + l * 512;
    for (int idx = blockIdx.x * NTHR + tid; idx < (TOK / 16) * 64; idx += G * NTHR) {
        const int cgp = idx & 63, run = idx >> 6, c0 = cgp * 8, t0 = run * 16;
        f32x4 w0[2], w1[2], w2[2], bb[2];
#pragma unroll
        for (int e = 0; e < 2; ++e) { w0[e] = *(const f32x4*)(cw + c0 + 4 * e); w1[e] = *(const f32x4*)(cw + 512 + c0 + 4 * e); w2[e] = *(const f32x4*)(cw + 1024 + c0 + 4 * e); bb[e] = *(const f32x4*)(cb + c0 + 4 * e); }
        f32x4 zm2[2] = {{0.f, 0.f, 0.f, 0.f}, {0.f, 0.f, 0.f, 0.f}}, zm1[2] = {{0.f, 0.f, 0.f, 0.f}, {0.f, 0.f, 0.f, 0.f}};
        if ((t0 & (SEQ - 1)) != 0) {
            f32x4 a0, a1, x0, x1;
            pg8::unpack8(*(const u32x4*)(AC + (size_t)(t0 - 2) * 512 + c0), a0, a1); pg8::unpack8(*(const u32x4*)(AX + (size_t)(t0 - 2) * 512 + c0), x0, x1); zm2[0] = a0 * x0; zm2[1] = a1 * x1;
            pg8::unpack8(*(const u32x4*)(AC + (size_t)(t0 - 1) * 512 + c0), a0, a1); pg8::unpack8(*(const u32x4*)(AX + (size_t)(t0 - 1) * 512 + c0), x0, x1); zm1[0] = a0 * x0; zm1[1] = a1 * x1;
        }
#pragma unroll 4
        for (int i = 0; i < 16; ++i) { const size_t off = (size_t)(t0 + i) * 512 + c0;
            f32x4 a0, a1, x0, x1, b0, b1; pg8::unpack8(*(const u32x4*)(AC + off), a0, a1); pg8::unpack8(*(const u32x4*)(AX + off), x0, x1); pg8::unpack8(*(const u32x4*)(AB + off), b0, b1);
            const f32x4 z0 = a0 * x0, z1 = a1 * x1;
            const f32x4 y0 = b0 * (w0[0] * zm2[0] + w1[0] * zm1[0] + w2[0] * z0 + bb[0]), y1 = b1 * (w0[1] * zm2[1] + w1[1] * zm1[1] + w2[1] * z1 + bb[1]);
            *(u32x4*)(AB + off) = pg8::pack8(y0, y1);
            zm2[0] = zm1[0]; zm2[1] = zm1[1]; zm1[0] = z0; zm1[1] = z1; }
    }
}

DI void phase_branchB(const Params& p, int l, LAS unsigned char* lds, int tid, int lane, int wave, int G) {
    bf16* BU = (bf16*)(p.ws + WS_P + 3 * PBUF); const bf16* BV = (const bf16*)(p.ws + WS_P + 4 * PBUF);
    const bf16* SGW = (const bf16*)(p.ws + WS_SGW) + (size_t)l * 4 * 128 * 128; const float* sgb = p.in[I_SGB] + l * 4 * 128;
    const float* lng = p.in[I_LNG] + l * 512 + lane * 8; const float* lnb = p.in[I_LNB] + l * 512 + lane * 8;
    constexpr int RS = 1040;
    const int r = lane & 31, half = lane >> 5;
    for (int item = blockIdx.x; item < TOK / 128; item += G) {
        const int tok0 = item * 128;
        { const f32x4 g0 = *(const f32x4*)lng, g1 = *(const f32x4*)(lng + 4), b0 = *(const f32x4*)lnb, b1 = *(const f32x4*)(lnb + 4);
            for (int tt = 0; tt < 16; ++tt) { const int s = wave * 16 + tt;
                f32x4 v0, v1; pg8::unpack8(*(const u32x4*)(BV + (size_t)(tok0 + s) * 512 + lane * 8), v0, v1);
#pragma unroll
                for (int j = 0; j < 4; ++j) { v0[j] = mk_gelu(v0[j]); v1[j] = mk_gelu(v1[j]); }
                const float mean = wave_sum((v0[0] + v0[1]) + (v0[2] + v0[3]) + (v1[0] + v1[1]) + (v1[2] + v1[3])) * (1.0f / 512.0f);
                v0 = v0 - mean; v1 = v1 - mean;
                const float var = wave_sum((v0[0] * v0[0] + v0[1] * v0[1]) + (v0[2] * v0[2] + v0[3] * v0[3]) + (v1[0] * v1[0] + v1[1] * v1[1]) + (v1[2] * v1[2] + v1[3] * v1[3])) * (1.0f / 512.0f);
                const float rstd = rsqrtf(var + 1e-5f);
                v0 = v0 * rstd * g0 + b0; v1 = v1 * rstd * g1 + b1;
                *(LAS u32x4*)(lds + s * RS + lane * 16) = pg8::pack8(v0, v1); } }
        __syncthreads();
        const int g = wave >> 1, dh = wave & 1;
        f32x16 acc[4][2];
#pragma unroll
        for (int a = 0; a < 4; ++a) { acc[a][0] = zero16(); acc[a][1] = zero16(); }
#pragma unroll
        for (int ks = 0; ks < 8; ++ks) {
            bf16x8 Vf[2];
#pragma unroll
            for (int dt = 0; dt < 2; ++dt) { const LAS unsigned short* vp = (const LAS unsigned short*)(lds + (16 * ks + 8 * half) * RS + (g * 128 + dh * 64 + dt * 32 + r) * 2);
#pragma unroll
                for (int j = 0; j < 8; ++j) Vf[dt][j] = (short)vp[j * (RS / 2)]; }
#pragma unroll
            for (int tt = ks >> 1; tt < 4; ++tt) { const bf16x8 Wf = *(const bf16x8*)(SGW + ((size_t)g * 128 + 32 * tt + r) * 128 + 16 * ks + 8 * half);
                acc[tt][0] = mfma32(Vf[0], Wf, acc[tt][0]); acc[tt][1] = mfma32(Vf[1], Wf, acc[tt][1]); }
        }
        asm volatile("s_nop 15\n\ts_nop 7" : "+v"(acc[0][0]), "+v"(acc[0][1]), "+v"(acc[1][0]), "+v"(acc[1][1]), "+v"(acc[2][0]), "+v"(acc[2][1]), "+v"(acc[3][0]), "+v"(acc[3][1]));
#pragma unroll
        for (int tt = 0; tt < 4; ++tt) { const int t = 32 * tt + r; const float bias = sgb[g * 128 + t];
#pragma unroll
            for (int dt = 0; dt < 2; ++dt)
#pragma unroll
                for (int ig = 0; ig < 4; ++ig) { bf16* up = BU + (size_t)(tok0 + t) * 512 + g * 128 + dh * 64 + dt * 32 + 8 * ig + 4 * half;
                    const u32x2 uw = *(const u32x2*)up;
                    const float y0 = mk_gelu(mk_lo(uw.x)) * (acc[tt][dt][4 * ig + 0] + bias), y1 = mk_gelu(mk_hi(uw.x)) * (acc[tt][dt][4 * ig + 1] + bias);
                    const float y2 = mk_gelu(mk_lo(uw.y)) * (acc[tt][dt][4 * ig + 2] + bias), y3 = mk_gelu(mk_hi(uw.y)) * (acc[tt][dt][4 * ig + 3] + bias);
                    u32x2 o; o.x = mk_pk2(y0, y1); o.y = mk_pk2(y2, y3); *(u32x2*)up = o; } }
        __syncthreads();
    }
}

DI void phase_attn(const Params& p, int l, LAS unsigned char* lds, int tid, int lane, int wave, int G, bf16* OUTP) {
    const bf16* CQ = (const bf16*)(p.ws + WS_P + 5 * PBUF); const bf16* CK = (const bf16*)(p.ws + WS_P + 6 * PBUF); const bf16* VT = (const bf16*)(p.ws + WS_P + 8 * PBUF);
    const float lam_init = 0.8f - 0.6f * expf(-0.3f * (float)l);
    const float* lq = p.in[I_LAMQK] + l * 256;
    const float lam = expf(wave_sum(lq[lane] * lq[64 + lane])) - expf(wave_sum(lq[128 + lane] * lq[192 + lane])) + lam_init;
    const float* sg = p.in[I_SUBLN] + l * 128;
    const int m = wave & 1, sub = wave >> 1, r = lane & 31, half = lane >> 5;
    constexpr int KROW = 144, VROW = 136, KBYTES = 64 * KROW  , VOFF = 2 * KBYTES  , STAGE = VOFF + 128 * KROW  ;
    const float cs = 0.125f * 1.44269504089f;
    for (int pi = blockIdx.x; pi < 512; pi += G) {
#pragma unroll 1
        for (int uu = 0; uu < 2; ++uu) {
            const int bh = pi >> 4, jp = pi & 15, qb = uu ? 31 - jp : jp, b = bh >> 2, h = bh & 3;
            const int tokq0 = b * SEQ + qb * 128, qrow = tokq0 + 32 * sub + r;
            bf16x8 Qf[4];
#pragma unroll
            for (int ks = 0; ks < 4; ++ks) Qf[ks] = *(const bf16x8*)(CQ + (size_t)qrow * 512 + h * 128 + m * 64 + 16 * ks + 8 * half);
            const int nt = 2 * qb + 2, my_last = 2 * qb + (sub >> 1);
            const bf16* kg[2]; const bf16* vg[2]; int kl[2], vl[2];
#pragma unroll
            for (int i = 0; i < 2; ++i) { const int idx = tid + 512 * i; const int key = idx >> 4, c16 = idx & 15;
                kg[i] = CK + (size_t)(b * SEQ + key) * 512 + h * 128 + c16 * 8; kl[i] = (c16 >> 3) * KBYTES + key * KROW + (c16 & 7) * 16;
                const int dv = idx >> 3, c8 = idx & 7;
                vg[i] = VT + (size_t)(h * 128 + dv) * TOK + b * SEQ + c8 * 8; vl[i] = VOFF + dv * VROW + c8 * 16; }
            u32x4 st[4];
            st[0] = *(const u32x4*)kg[0]; st[1] = *(const u32x4*)kg[1]; st[2] = *(const u32x4*)vg[0]; st[3] = *(const u32x4*)vg[1];
            *(LAS u32x4*)(lds + kl[0]) = st[0]; *(LAS u32x4*)(lds + kl[1]) = st[1]; *(LAS u32x2*)(lds + vl[0]) = (u32x2){st[2].x, st[2].y}; *(LAS u32x2*)(lds + vl[0] + 8) = (u32x2){st[2].z, st[2].w}; *(LAS u32x2*)(lds + vl[1]) = (u32x2){st[3].x, st[3].y}; *(LAS u32x2*)(lds + vl[1] + 8) = (u32x2){st[3].z, st[3].w};
            __syncthreads();
            f32x16 O[4];
#pragma unroll
            for (int i = 0; i < 4; ++i) O[i] = zero16();
            float m_run = -INFINITY, l_run = 0.f;
#pragma unroll 1
            for (int kt = 0; kt < nt; ++kt) {
                const bool more = (kt + 1 < nt);
                if (more) { const size_t ko = (size_t)(kt + 1) * 64 * 512, vo = (size_t)(kt + 1) * 64;
                    st[0] = *(const u32x4*)(kg[0] + ko); st[1] = *(const u32x4*)(kg[1] + ko); st[2] = *(const u32x4*)(vg[0] + vo); st[3] = *(const u32x4*)(vg[1] + vo); }
                const LAS unsigned char* buf = lds + (kt & 1) * STAGE;
                if (kt <= my_last) {
                    f32x16 S[2];
#pragma unroll
                    for (int u = 0; u < 2; ++u) { S[u] = zero16();
#pragma unroll
                        for (int ks = 0; ks < 4; ++ks) { const bf16x8 A = *(const LAS bf16x8*)(buf + m * KBYTES + (32 * u + r) * KROW + (16 * ks + 8 * half) * 2); S[u] = mfma32(A, Qf[ks], S[u]); } }
                    asm volatile("s_nop 15\n\ts_nop 7" : "+v"(S[0]), "+v"(S[1]));
                    float mx = -INFINITY;
#pragma unroll
                    for (int u = 0; u < 2; ++u)
#pragma unroll
                        for (int i = 0; i < 16; ++i) mx = fmaxf(mx, S[u][i]);
                    mx = fmaxf(mx, __shfl_xor(mx, 32));
                    const float m_new = fmaxf(m_run, mx * cs), alpha = __builtin_amdgcn_exp2f(m_run - m_new);
                    float ps = 0.f;
#pragma unroll
                    for (int u = 0; u < 2; ++u)
#pragma unroll
                        for (int i = 0; i < 16; ++i) { const float e = __builtin_amdgcn_exp2f(S[u][i] * cs - m_new); S[u][i] = e; ps += e; }
                    ps += __shfl_xor(ps, 32);
                    l_run = l_run * alpha + ps; m_run = m_new;
#pragma unroll
                    for (int d = 0; d < 4; ++d)
#pragma unroll
                        for (int i = 0; i < 16; ++i) O[d][i] *= alpha;
                    bf16x8 Pf[2][2];
#pragma unroll
                    for (int u = 0; u < 2; ++u)
#pragma unroll
                        for (int s = 0; s < 2; ++s) { u32x4 w; w.x = mk_pk2(S[u][8 * s + 0], S[u][8 * s + 1]); w.y = mk_pk2(S[u][8 * s + 2], S[u][8 * s + 3]); w.z = mk_pk2(S[u][8 * s + 4], S[u][8 * s + 5]); w.w = mk_pk2(S[u][8 * s + 6], S[u][8 * s + 7]);
                            Pf[u][s] = __builtin_bit_cast(bf16x8, w); }
#pragma unroll
                    for (int d = 0; d < 4; ++d)
#pragma unroll
                        for (int u = 0; u < 2; ++u)
#pragma unroll
                            for (int s = 0; s < 2; ++s) { const LAS unsigned char* va = buf + VOFF + (32 * d + r) * VROW + (32 * u + 16 * s + 4 * half) * 2;
                                const u32x2 lo = *(const LAS u32x2*)va, hi = *(const LAS u32x2*)(va + 16);
                                u32x4 w; w.x = lo.x; w.y = lo.y; w.z = hi.x; w.w = hi.y;
                                O[d] = mfma32(__builtin_bit_cast(bf16x8, w), Pf[u][s], O[d]); }
                }
                if (more) { LAS unsigned char* nb = lds + ((kt + 1) & 1) * STAGE;
                    *(LAS u32x4*)(nb + kl[0]) = st[0]; *(LAS u32x4*)(nb + kl[1]) = st[1]; *(LAS u32x2*)(nb + vl[0]) = (u32x2){st[2].x, st[2].y}; *(LAS u32x2*)(nb + vl[0] + 8) = (u32x2){st[2].z, st[2].w}; *(LAS u32x2*)(nb + vl[1]) = (u32x2){st[3].x, st[3].y}; *(LAS u32x2*)(nb + vl[1] + 8) = (u32x2){st[3].z, st[3].w}; }
                __syncthreads();
            }
            asm volatile("s_nop 15\n\ts_nop 7" : "+v"(O[0]), "+v"(O[1]), "+v"(O[2]), "+v"(O[3]));
            const float inv = 1.0f / l_run;
            LAS float* Cb = (LAS float*)lds;
            if (m == 1) { const float f = inv * lam;
#pragma unroll
                for (int d = 0; d < 4; ++d)
#pragma unroll
                    for (int i = 0; i < 16; ++i) Cb[(sub * 128 + 32 * d + crow(i, half)) * 33 + r] = O[d][i] * f; }
            __syncthreads();
            if (m == 0) { float ss = 0.f;
#pragma unroll
                for (int d = 0; d < 4; ++d)
#pragma unroll
                    for (int i = 0; i < 16; ++i) { const float o = O[d][i] * inv - Cb[(sub * 128 + 32 * d + crow(i, half)) * 33 + r]; O[d][i] = o; ss += o * o; }
                ss += __shfl_xor(ss, 32);
                const float rs = rsqrtf(ss * (1.0f / 128.0f) + 1e-5f) * (1.0f - lam_init);
#pragma unroll
                for (int d = 0; d < 4; ++d)
#pragma unroll
                    for (int ig = 0; ig < 4; ++ig) { const int dv0 = 32 * d + 8 * ig + 4 * half; const f32x4 gn = *(const f32x4*)(sg + dv0);
                        u32x2 w; w.x = mk_pk2(O[d][4 * ig + 0] * rs * gn[0], O[d][4 * ig + 1] * rs * gn[1]); w.y = mk_pk2(O[d][4 * ig + 2] * rs * gn[2], O[d][4 * ig + 3] * rs * gn[3]);
                        *(u32x2*)(OUTP + (size_t)qrow * 512 + h * 128 + dv0) = w; } }
            __syncthreads();
        }
    }
}

template <bool PRODUCER> DI void attn2_unit(const bf16* CQ, const bf16* CK, const bf16* VT, bf16* OUTP, const float* sg, float lam, float lam_init, LAS unsigned char* lds, int tid, int lane, int sub, int b, int h, int qb) {
    const int r = lane & 31, half = lane >> 5;
    constexpr int KROW = 144, VROW = 136, KB1 = 64 * KROW, KST = 2 * KB1  , VST = 128 * VROW  ;
    constexpr int OFF_K = 0, OFF_V = 2 * KST  , OFF_P = OFF_V + 2 * VST  , PST = 32768, OFF_A = OFF_P + 2 * PST  , AST = 1024, OFF_L = 139392;
    const float cs = 0.125f * 1.44269504089f;
            const int tokq0 = b * SEQ + qb * 128, qrow = tokq0 + 32 * sub + r;
            const int nt = 2 * qb + 2, my_last = 2 * qb + (sub >> 1);
            const bf16* kg[2]; const bf16* vg[2]; int kl[2], vl[2];
#pragma unroll
            for (int i = 0; i < 2; ++i) { const int idx = tid + 512 * i; const int key = idx >> 4, c16 = idx & 15;
                kg[i] = CK + (size_t)(b * SEQ + key) * 512 + h * 128 + c16 * 8; kl[i] = OFF_K + (c16 >> 3) * KB1 + key * KROW + (c16 & 7) * 16;
                const int dv = idx >> 3, c8 = idx & 7;
                vg[i] = VT + (size_t)(h * 128 + dv) * TOK + b * SEQ + c8 * 8; vl[i] = OFF_V + dv * VROW + c8 * 16; }
            bf16x8 Qf[2][4];
            f32x16 O[2][4];
            float m_run[2] = {-INFINITY, -INFINITY}, l_run[2] = {0.f, 0.f};
            if (PRODUCER) {
#pragma unroll
                for (int m = 0; m < 2; ++m)
#pragma unroll
                    for (int ks = 0; ks < 4; ++ks) Qf[m][ks] = *(const bf16x8*)(CQ + (size_t)qrow * 512 + h * 128 + m * 64 + 16 * ks + 8 * half);
            } else {
#pragma unroll
                for (int m = 0; m < 2; ++m)
#pragma unroll
                    for (int d = 0; d < 4; ++d) O[m][d] = zero16();
            }
            u32x4 sk[2], sv[2];
            sk[0] = *(const u32x4*)kg[0]; sk[1] = *(const u32x4*)kg[1];
            *(LAS u32x4*)(lds + kl[0]) = sk[0]; *(LAS u32x4*)(lds + kl[1]) = sk[1];
            __syncthreads();
#pragma unroll 1
            for (int i = 0; i <= nt; ++i) {
                const bool ldk = (i + 1 < nt), ldv = (i < nt);
                if (ldk) { const size_t ko = (size_t)(i + 1) * 64 * 512; sk[0] = *(const u32x4*)(kg[0] + ko); sk[1] = *(const u32x4*)(kg[1] + ko); }
                if (ldv) { const size_t vo = (size_t)i * 64; sv[0] = *(const u32x4*)(vg[0] + vo); sv[1] = *(const u32x4*)(vg[1] + vo); }
                if (PRODUCER) {
                    if (i < nt && i <= my_last) {
                        const LAS unsigned char* kb = lds + OFF_K + (i & 1) * KST;
                        LAS unsigned char* pb = lds + OFF_P + (i & 1) * PST + (sub * 2) * 4096 + lane * 16;
                        LAS float* ab = (LAS float*)(lds + OFF_A + (i & 1) * AST) + (sub * 2) * 32 + r;
#pragma unroll
                        for (int m = 0; m < 2; ++m) {
                            f32x16 S[2];
#pragma unroll
                            for (int u = 0; u < 2; ++u) { S[u] = zero16();
#pragma unroll
                                for (int ks = 0; ks < 4; ++ks) { const bf16x8 A = *(const LAS bf16x8*)(kb + m * KB1 + (32 * u + r) * KROW + (16 * ks + 8 * half) * 2); S[u] = mfma32(A, Qf[m][ks], S[u]); } }
                            asm volatile("s_nop 15\n\ts_nop 7" : "+v"(S[0]), "+v"(S[1]));
                            float mx = -INFINITY;
#pragma unroll
                            for (int u = 0; u < 2; ++u)
#pragma unroll
                                for (int k = 0; k < 16; ++k) mx = fmaxf(mx, S[u][k]);
                            mx = fmaxf(mx, __shfl_xor(mx, 32));
                            const float m_new = fmaxf(m_run[m], mx * cs), alpha = __builtin_amdgcn_exp2f(m_run[m] - m_new);
                            float ps = 0.f;
#pragma unroll
                            for (int u = 0; u < 2; ++u)
#pragma unroll
                                for (int k = 0; k < 16; ++k) { const float e = __builtin_amdgcn_exp2f(S[u][k] * cs - m_new); S[u][k] = e; ps += e; }
                            ps += __shfl_xor(ps, 32);
                            l_run[m] = l_run[m] * alpha + ps; m_run[m] = m_new;
                            if (half == 0) ab[m * 32] = alpha;
#pragma unroll
                            for (int u = 0; u < 2; ++u)
#pragma unroll
                                for (int s = 0; s < 2; ++s) { u32x4 w; w.x = mk_pk2(S[u][8 * s + 0], S[u][8 * s + 1]); w.y = mk_pk2(S[u][8 * s + 2], S[u][8 * s + 3]); w.z = mk_pk2(S[u][8 * s + 4], S[u][8 * s + 5]); w.w = mk_pk2(S[u][8 * s + 6], S[u][8 * s + 7]);
                                    *(LAS u32x4*)(pb + m * 4096 + (u * 2 + s) * 1024) = w; }
                        }
                    }
                } else {
                    const int j = i - 1;
                    if (j >= 0 && j <= my_last) {
                        const LAS unsigned char* vb = lds + OFF_V + (j & 1) * VST;
                        const LAS unsigned char* pb = lds + OFF_P + (j & 1) * PST + (sub * 2) * 4096 + lane * 16;
                        const LAS float* ab = (const LAS float*)(lds + OFF_A + (j & 1) * AST) + (sub * 2) * 32 + r;
                        const float a0 = ab[0], a1 = ab[32];
#pragma unroll
                        for (int d = 0; d < 4; ++d)
#pragma unroll
                            for (int k = 0; k < 16; ++k) { O[0][d][k] *= a0; O[1][d][k] *= a1; }
#pragma unroll
                        for (int q = 0; q < 4; ++q) { const bf16x8 P0 = *(const LAS bf16x8*)(pb + q * 1024), P1 = *(const LAS bf16x8*)(pb + 4096 + q * 1024);
#pragma unroll
                            for (int d = 0; d < 4; ++d) { const LAS unsigned char* va = vb + (32 * d + r) * VROW + (16 * q + 4 * half) * 2;
                                const u32x2 lo = *(const LAS u32x2*)va, hi = *(const LAS u32x2*)(va + 16);
                                u32x4 w; w.x = lo.x; w.y = lo.y; w.z = hi.x; w.w = hi.y; const bf16x8 Vf = __builtin_bit_cast(bf16x8, w);
                                O[0][d] = mfma32(Vf, P0, O[0][d]); O[1][d] = mfma32(Vf, P1, O[1][d]); } }
                    }
                }
                if (ldk) { LAS unsigned char* nb = lds + ((i + 1) & 1) * KST; *(LAS u32x4*)(nb + kl[0]) = sk[0]; *(LAS u32x4*)(nb + kl[1]) = sk[1]; }
                if (ldv) { LAS unsigned char* nb = lds + (i & 1) * VST;
                    *(LAS u32x2*)(nb + vl[0]) = (u32x2){sv[0].x, sv[0].y}; *(LAS u32x2*)(nb + vl[0] + 8) = (u32x2){sv[0].z, sv[0].w}; *(LAS u32x2*)(nb + vl[1]) = (u32x2){sv[1].x, sv[1].y}; *(LAS u32x2*)(nb + vl[1] + 8) = (u32x2){sv[1].z, sv[1].w}; }
                __syncthreads();
            }
            LAS float* Lb = (LAS float*)(lds + OFF_L) + (sub * 2) * 32 + r;
            if (PRODUCER && half == 0) { Lb[0] = l_run[0]; Lb[32] = l_run[1]; }
            __syncthreads();
            if (!PRODUCER) {
                asm volatile("s_nop 15\n\ts_nop 7" : "+v"(O[0][0]), "+v"(O[0][1]), "+v"(O[0][2]), "+v"(O[0][3]), "+v"(O[1][0]), "+v"(O[1][1]), "+v"(O[1][2]), "+v"(O[1][3]));
                const float inv0 = 1.0f / Lb[0], inv1 = lam / Lb[32];
                float ss = 0.f;
#pragma unroll
                for (int d = 0; d < 4; ++d)
#pragma unroll
                    for (int k = 0; k < 16; ++k) { const float o = O[0][d][k] * inv0 - O[1][d][k] * inv1; O[0][d][k] = o; ss += o * o; }
                ss += __shfl_xor(ss, 32);
                const float rs = rsqrtf(ss * (1.0f / 128.0f) + 1e-5f) * (1.0f - lam_init);
#pragma unroll
                for (int d = 0; d < 4; ++d)
#pragma unroll
                    for (int ig = 0; ig < 4; ++ig) { const int dv0 = 32 * d + 8 * ig + 4 * half; const f32x4 gn = *(const f32x4*)(sg + dv0);
                        u32x2 w; w.x = mk_pk2(O[0][d][4 * ig + 0] * rs * gn[0], O[0][d][4 * ig + 1] * rs * gn[1]); w.y = mk_pk2(O[0][d][4 * ig + 2] * rs * gn[2], O[0][d][4 * ig + 3] * rs * gn[3]);
                        *(u32x2*)(OUTP + (size_t)qrow * 512 + h * 128 + dv0) = w; }
            }
            __syncthreads();
}
DI void phase_attn2(const Params& p, int l, LAS unsigned char* lds, int tid, int lane, int wave, int G, bf16* OUTP) {
    const bf16* CQ = (const bf16*)(p.ws + WS_P + 5 * PBUF); const bf16* CK = (const bf16*)(p.ws + WS_P + 6 * PBUF); const bf16* VT = (const bf16*)(p.ws + WS_P + 8 * PBUF);
    const float lam_init = 0.8f - 0.6f * expf(-0.3f * (float)l);
    const float* lq = p.in[I_LAMQK] + l * 256;
    const float lam = expf(wave_sum(lq[lane] * lq[64 + lane])) - expf(wave_sum(lq[128 + lane] * lq[192 + lane])) + lam_init;
    const float* sg = p.in[I_SUBLN] + l * 128;
    const bool producer = wave < 4; const int sub = wave & 3;
    for (int pi0 = blockIdx.x; pi0 < 512; pi0 += G) {
        const int pi = (G == 256) ? (((int)blockIdx.x & 7) * 64 + (pi0 >> 8) * 32 + ((int)blockIdx.x >> 3)) : pi0;
#pragma unroll 1
        for (int uu = 0; uu < 2; ++uu) {
            const int bh = pi >> 4, jp = pi & 15, qb = uu ? 31 - jp : jp, b = bh >> 2, h = bh & 3;
            if (producer) attn2_unit<true>(CQ, CK, VT, OUTP, sg, lam, lam_init, lds, tid, lane, sub, b, h, qb);
            else attn2_unit<false>(CQ, CK, VT, OUTP, sg, lam, lam_init, lds, tid, lane, sub, b, h, qb);
        }
    }
}

template <bool P2> DI void phase_ssm(const Params& p, int l, LAS unsigned char* lds, int lane, int wave, int G) {
    const bf16* DU = (const bf16*)(p.ws + WS_P + 7 * PBUF); bf16* YG = (bf16*)(p.ws + WS_YG); float* E = (float*)(p.ws + WS_E);
    const bf16* BB = (const bf16*)(p.ws + WS_BB) + (size_t)l * 32 * 128 * 16; const bf16* CM = (const bf16*)(p.ws + WS_CM) + (size_t)l * 32 * 16 * 128;
    const float* AP = (const float*)(p.ws + WS_AP) + (size_t)l * 32 * 64 * 8; const float* dsk = p.in[I_SSMD] + l * 512;
    const int r = lane & 31, half = lane >> 5, r16 = lane & 15, q4 = lane >> 4;
    constexpr int XRS = 272;
    LAS unsigned char* Xs = lds + wave * (64 * XRS);
    for (int it = blockIdx.x * 8 + wave; it < 16384; it += G * 8) {
        const int c = it & 63, g = (it >> 6) & 31, b = it >> 11, tok0 = b * SEQ + c * 64;
        const int ch = g * 16 + r16; float dk = 0.f; bf16x8 Cf[4]; float uu[4][4];
        if (P2) { dk = dsk[ch];
#pragma unroll
            for (int mt = 0; mt < 4; ++mt)
#pragma unroll
                for (int j = 0; j < 4; ++j) uu[mt][j] = bf2f(DU[(size_t)(tok0 + 16 * mt + 4 * q4 + j) * 512 + ch]); }
        f32x16 X[4][2];
        { bf16x8 Uf[2], Bf[4];
#pragma unroll
            for (int tt = 0; tt < 2; ++tt) { const int tau = 32 * ((r >> 2) & 1) + 16 * tt + (r & 3) + 4 * (r >> 3); Uf[tt] = *(const bf16x8*)(DU + (size_t)(tok0 + tau) * 512 + g * 16 + 8 * half); }
#pragma unroll
            for (int pt = 0; pt < 4; ++pt) Bf[pt] = *(const bf16x8*)(BB + ((size_t)g * 128 + 32 * pt + r) * 16 + 8 * half);
#pragma unroll
            for (int pt = 0; pt < 4; ++pt)
#pragma unroll
                for (int tt = 0; tt < 2; ++tt) X[pt][tt] = mfma32(Uf[tt], Bf[pt], zero16()); }
        asm volatile("s_nop 15\n\ts_nop 15" : "+v"(X[0][0]), "+v"(X[0][1]), "+v"(X[1][0]), "+v"(X[1][1]), "+v"(X[2][0]), "+v"(X[2][1]), "+v"(X[3][0]), "+v"(X[3][1]));
        float ar[2], ai[2], a32r[2], a32i[2], a64r[2], a64i[2];
#pragma unroll
        for (int s = 0; s < 2; ++s) { const float* ap = AP + ((size_t)g * 64 + 32 * s + r) * 8; const f32x4 v = *(const f32x4*)ap; ar[s] = v[0]; ai[s] = v[1]; a32r[s] = v[2]; a32i[s] = v[3]; a64r[s] = ap[4]; a64i[s] = ap[5]; }
        float xr[2] = {0.f, 0.f}, xi[2] = {0.f, 0.f};
        if (P2) {
            const float* e0 = E + (((size_t)(b * 32 + g) * 64) * 64 + r) * 2;
            float sr0 = 0.f, si0 = 0.f, sr1 = 0.f, si1 = 0.f;
#pragma unroll 4
            for (int j = 0; j < c; ++j) { const float2 ea = *(const float2*)(e0 + (size_t)j * 128), eb = *(const float2*)(e0 + (size_t)j * 128 + 64);
                const float t0 = a64r[0] * sr0 - a64i[0] * si0 + ea.x; si0 = a64r[0] * si0 + a64i[0] * sr0 + ea.y; sr0 = t0;
                const float t1 = a64r[1] * sr1 - a64i[1] * si1 + eb.x; si1 = a64r[1] * si1 + a64i[1] * sr1 + eb.y; sr1 = t1; }
            if (half == 0) { xr[0] = sr0; xi[0] = si0; xr[1] = sr1; xi[1] = si1; }
        }
#pragma unroll
        for (int s = 0; s < 2; ++s)
#pragma unroll
            for (int tt = 0; tt < 2; ++tt)
#pragma unroll
                for (int i = 0; i < 16; ++i) { const float nr = ar[s] * xr[s] - ai[s] * xi[s] + X[s][tt][i], ni = ar[s] * xi[s] + ai[s] * xr[s] + X[2 + s][tt][i]; X[s][tt][i] = nr; X[2 + s][tt][i] = ni; xr[s] = nr; xi[s] = ni; }
        float oxr[2], oxi[2];
#pragma unroll
        for (int s = 0; s < 2; ++s) { oxr[s] = __shfl_xor(xr[s], 32); oxi[s] = __shfl_xor(xi[s], 32); }
        if (!P2) {
            if (half == 1) {
#pragma unroll
                for (int s = 0; s < 2; ++s) { float2 e; e.x = xr[s] + a32r[s] * oxr[s] - a32i[s] * oxi[s]; e.y = xi[s] + a32r[s] * oxi[s] + a32i[s] * oxr[s];
                    *(float2*)(E + (((size_t)(b * 32 + g) * 64 + c) * 64 + 32 * s + r) * 2) = e; } }
        } else {
#pragma unroll
            for (int s = 0; s < 2; ++s) { float wr_ = half ? oxr[s] : 0.f, wi_ = half ? oxi[s] : 0.f;
#pragma unroll
                for (int tt = 0; tt < 2; ++tt)
#pragma unroll
                    for (int i = 0; i < 16; ++i) { const float t = ar[s] * wr_ - ai[s] * wi_; wi_ = ar[s] * wi_ + ai[s] * wr_; wr_ = t; X[s][tt][i] += wr_; X[2 + s][tt][i] += wi_; } }
#pragma unroll
            for (int pt = 0; pt < 4; ++pt)
#pragma unroll
                for (int tt = 0; tt < 2; ++tt)
#pragma unroll
                    for (int i = 0; i < 16; ++i) *(LAS unsigned short*)(Xs + (32 * half + 16 * tt + i) * XRS + (32 * pt + r) * 2) = f2bf(X[pt][tt][i]);
#pragma unroll
            for (int ks = 0; ks < 4; ++ks) Cf[ks] = *(const bf16x8*)(CM + ((size_t)g * 16 + r16) * 128 + 32 * ks + 8 * q4);
            LDS_WAIT();
#pragma unroll
            for (int mt = 0; mt < 4; ++mt) { f32x4 acc = {0.f, 0.f, 0.f, 0.f};
#pragma unroll
                for (int ks = 0; ks < 4; ++ks) { const bf16x8 A = *(const LAS bf16x8*)(Xs + (16 * mt + r16) * XRS + (32 * ks + 8 * q4) * 2); acc = mfma16(A, Cf[ks], acc); }
                asm volatile("s_nop 15" : "+v"(acc));
#pragma unroll
                for (int j = 0; j < 4; ++j) { const size_t o = (size_t)(tok0 + 16 * mt + 4 * q4 + j) * 512 + ch; const float y = acc[j] + dk * uu[mt][j]; YG[o] = f2bf(mk_gelu(y)); } }
            LDS_WAIT();
        }
    }
}

DI void phase_ssm1(const Params& p, int l, int lane, int wave, int G) {
    const bf16* DU = (const bf16*)(p.ws + WS_P + 7 * PBUF); float* E = (float*)(p.ws + WS_E);
    const bf16* BB = (const bf16*)(p.ws + WS_BB) + (size_t)l * 32 * 128 * 16;
    const float* AP = (const float*)(p.ws + WS_AP) + (size_t)l * 32 * 64 * 8;
    const int r = lane & 31, half = lane >> 5;
    const int tau0 = 32 * ((r >> 2) & 1) + (r & 3) + 4 * (r >> 3);
    const int step = G * 8; int it = blockIdx.x * 8 + wave;
    bf16x8 Uf[2], Bf[4]; f32x4 apv[2];
#define SSM1_LOAD(IT) do { const int c_ = (IT) & 63, g_ = ((IT) >> 6) & 31, b_ = (IT) >> 11; const size_t t0_ = (size_t)(b_ * SEQ + c_ * 64 + tau0) * 512 + g_ * 16 + 8 * half; \
        Uf[0] = *(const bf16x8*)(DU + t0_); Uf[1] = *(const bf16x8*)(DU + t0_ + (size_t)16 * 512); \
        _Pragma("unroll") for (int pt = 0; pt < 4; ++pt) Bf[pt] = *(const bf16x8*)(BB + ((size_t)g_ * 128 + 32 * pt + r) * 16 + 8 * half); \
        _Pragma("unroll") for (int s = 0; s < 2; ++s) apv[s] = *(const f32x4*)(AP + ((size_t)g_ * 64 + 32 * s + r) * 8); } while (0)
    if (it < 16384) SSM1_LOAD(it);
    for (; it < 16384; it += step) {
        const int c = it & 63, g = (it >> 6) & 31, b = it >> 11;
        f32x16 X[4][2];
#pragma unroll
        for (int pt = 0; pt < 4; ++pt)
#pragma unroll
            for (int tt = 0; tt < 2; ++tt) X[pt][tt] = mfma32(Uf[tt], Bf[pt], zero16());
        float ar[2], ai[2], a32r[2], a32i[2];
#pragma unroll
        for (int s = 0; s < 2; ++s) { ar[s] = apv[s][0]; ai[s] = apv[s][1]; a32r[s] = apv[s][2]; a32i[s] = apv[s][3]; }
        asm volatile("s_nop 15\n\ts_nop 15" : "+v"(X[0][0]), "+v"(X[0][1]), "+v"(X[1][0]), "+v"(X[1][1]), "+v"(X[2][0]), "+v"(X[2][1]), "+v"(X[3][0]), "+v"(X[3][1]));
        if (it + step < 16384) SSM1_LOAD(it + step);
#pragma unroll
        for (int s = 0; s < 2; ++s) { float xr = 0.f, xi = 0.f;
#pragma unroll
            for (int tt = 0; tt < 2; ++tt)
#pragma unroll
                for (int k = 0; k < 16; ++k) { const float nr = ar[s] * xr - ai[s] * xi + X[s][tt][k], ni = ar[s] * xi + ai[s] * xr + X[2 + s][tt][k]; xr = nr; xi = ni; }
            const float oxr = __shfl_xor(xr, 32), oxi = __shfl_xor(xi, 32);
            if (half == 1) { float2 e; e.x = xr + a32r[s] * oxr - a32i[s] * oxi; e.y = xi + a32r[s] * oxi + a32i[s] * oxr;
                *(float2*)(E + (((size_t)(b * 32 + g) * 64 + c) * 64 + 32 * s + r) * 2) = e; } }
    }
#undef SSM1_LOAD
}

DI void phase_final(const Params& p, int tid, int G) {
    const pg8::rowss_t* rowss = (const pg8::rowss_t*)(p.ws + WS_ROWSS) + (size_t)4 * TOK; const float* gf = p.in[I_GFIN]; float* out = p.out; const bf16* xb = (const bf16*)(p.ws + WS_XB);
    for (size_t i = (size_t)blockIdx.x * NTHR + tid; i < (size_t)TOK * 128; i += (size_t)G * NTHR) { const int row = (int)(i >> 7), c8 = (int)(i & 127);
        const float rs = pg8::rstd_row(rowss, row); f32x4 v0, v1; pg8::unpack8(*((const u32x4*)xb + i), v0, v1);
        const f32x4 g0 = *((const f32x4*)gf + 2 * c8), g1 = *((const f32x4*)gf + 2 * c8 + 1);
        *((f32x4*)out + 2 * i) = v0 * rs * g0; *((f32x4*)out + 2 * i + 1) = v1 * rs * g1; }
}

#define XB_TMO      128
#define XB_XCNT(j)  (256  + 64 * (j))
#define XB_XSUB(j)  (1280 + 64 * (j))
#define XB_XGEN(j)  (2304 + 64 * (j))
#define XB_TOP      3328
#define XB_TOPGEN   3392
#define XCD_BAR_WORDS 3456
#define XB_SPIN_CAP (1u << 18)

__device__ __forceinline__ unsigned xb_ld(unsigned* p)              { return __hip_atomic_load(p, __ATOMIC_RELAXED, __HIP_MEMORY_SCOPE_AGENT); }
__device__ __forceinline__ unsigned xb_add(unsigned* p, unsigned v) { return __hip_atomic_fetch_add(p, v, __ATOMIC_RELAXED, __HIP_MEMORY_SCOPE_AGENT); }
__device__ __forceinline__ unsigned xb_xcc_id() { return (unsigned)__builtin_amdgcn_s_getreg((3 << 11) | 20) & 0xFu; }
#define XB_SPIN(cond, bar) do { unsigned _sp = 0; while (cond) { __builtin_amdgcn_s_sleep(1); \
    if ((++_sp & 255u) == 0u) { if (xb_ld(&(bar)[XB_TMO])) break; if (_sp > XB_SPIN_CAP) { atomicAdd(&(bar)[XB_TMO], 1u); break; } } } } while (0)

struct XcdBarrier {
    unsigned* bar; unsigned x;
    volatile LAS unsigned* st;
};

__device__ __forceinline__ XcdBarrier xcd_barrier_post(unsigned* bar, volatile LAS unsigned* st) {
    XcdBarrier b; b.bar = bar; b.x = xb_xcc_id(); b.st = st;
    if (threadIdx.x == 0) (void)xb_add(&bar[XB_XCNT(b.x)], 1u);
    return b;
}
__device__ __forceinline__ void xcd_barrier_complete(unsigned* bar, unsigned x, unsigned& nloc, unsigned& nx) {
    const unsigned G = gridDim.x * gridDim.y * gridDim.z;
    unsigned sum, cnt, mine, sp = 0u;
    for (;;) {
        sum = 0u; cnt = 0u; mine = 0u;
#pragma unroll
        for (unsigned j = 0; j < 16; ++j) { const unsigned c = xb_ld(&bar[XB_XCNT(j)]); sum += c; cnt += (c > 0u) ? 1u : 0u; mine = (j == x) ? c : mine; }
        if (sum == G) break;
        __builtin_amdgcn_s_sleep(1);
        if ((++sp & 255u) == 0u) { if (xb_ld(&bar[XB_TMO])) break; if (sp > XB_SPIN_CAP) { atomicAdd(&bar[XB_TMO], 1u); break; } }
    }
    nloc = mine > 0u ? mine : 1u; nx = cnt > 0u ? cnt : 1u;
}

__device__ __forceinline__ void xcd_barrier(const XcdBarrier& b) {
    asm volatile("s_waitcnt vmcnt(0)" ::: "memory");
    __syncthreads();
    if (threadIdx.x == 0) {
        unsigned* bar = b.bar;
        __builtin_amdgcn_s_waitcnt(0);
        unsigned nloc = b.st[0], nx = b.st[1];
        if (nloc == 0u) { xcd_barrier_complete(bar, b.x, nloc, nx); b.st[0] = nloc; b.st[1] = nx; }
        const unsigned old = xb_add(&bar[XB_XSUB(b.x)], 1u);
        const unsigned gen = old / nloc;
        if (old + 1u == (gen + 1u) * nloc) {
            __builtin_amdgcn_fence(__ATOMIC_RELEASE, "agent");
            asm volatile("s_waitcnt vmcnt(0)" ::: "memory");
            const unsigned og = xb_add(&bar[XB_TOP], 1u);
            const unsigned tg = og / nx;
            if (og + 1u == (tg + 1u) * nx) xb_add(&bar[XB_TOPGEN], 1u);
            else XB_SPIN(xb_ld(&bar[XB_TOPGEN]) == tg, bar);
            __builtin_amdgcn_fence(__ATOMIC_ACQUIRE, "agent");
            xb_add(&bar[XB_XGEN(b.x)], 1u);
            asm volatile("s_waitcnt vmcnt(0)" ::: "memory");
        } else {
            XB_SPIN(xb_ld(&bar[XB_XGEN(b.x)]) == gen, bar);
            __builtin_amdgcn_fence(__ATOMIC_ACQUIRE, "agent");
            asm volatile("s_waitcnt vmcnt(0)" ::: "memory");
        }
    }
    __syncthreads();
}


__global__ void __launch_bounds__(NTHR) mega(Params p) {
    extern __shared__ __attribute__((aligned(16))) unsigned char lds_raw[];
    LAS unsigned char* lds = (LAS unsigned char*)lds_raw;
    const int G = gridDim.x;
#define LAUNDER() int tid = threadIdx.x; asm volatile("" : "+v"(tid)); const int lane = tid & 63, wave = __builtin_amdgcn_readfirstlane(tid >> 6); (void)lane; (void)wave
    const int lo = p.ph_lo, hi = p.ph_hi;
    unsigned char* ws = p.ws;
    int ph = 0;
    volatile LAS unsigned* xb_st = (volatile LAS unsigned*)(lds + 139264);
    XcdBarrier xbar; xbar.bar = (unsigned*)(ws + WS_BAR); xbar.x = 0; xbar.st = xb_st;
    if (ONE_LAUNCH) { if (threadIdx.x < 4) xb_st[threadIdx.x] = 0u; __syncthreads(); xbar = xcd_barrier_post((unsigned*)(ws + WS_BAR), xb_st); }
#ifndef ONLY_KIND
#define ONLY_KIND -1
#endif
#define KEN(k) (ONLY_KIND < 0 || ONLY_KIND == (k))
#ifndef DUP
#define DUP 0
#endif
#define REP(bit) _Pragma("unroll 1") for (int rep_ = 0; rep_ < ((DUP & (bit)) ? 2 : 1); ++rep_)
#define IN_PH() (lo <= ph && ph < hi)
#define END_PH() do { if (ONE_LAUNCH && lo <= ph && ph + 1 < hi) { if (hi < 0) cg::this_grid().sync(); else xcd_barrier(xbar); } ++ph; } while (0)
    if (IN_PH() && KEN(0)) REP(128) { LAUNDER(); phase_prep(p, lds, tid, lane, wave, G); }
    END_PH();
    bf16* XB = (bf16*)(ws + WS_XB); pg8::rowss_t* rowss = (pg8::rowss_t*)(ws + WS_ROWSS);
    for (int l = 0; l < 2; ++l) {
        unsigned char* wl = ws + WS_W + (size_t)l * WL_SIZE;
        const bf16* WinT = (const bf16*)(wl + WL_IN);
        bf16* P0 = (bf16*)(ws + WS_P);
        const pg8::rowss_t* rs_mix = rowss + (size_t)(2 * l) * TOK; pg8::rowss_t* rs_ffn = rowss + (size_t)(2 * l + 1) * TOK; pg8::rowss_t* rs_next = rowss + (size_t)(2 * l + 2) * TOK;
        pg8::StaticOrder S;
        if (IN_PH()) REP(1) {
            if (KEN(1)) { pg8::Gemm g{XB, WinT, TOK, 4096, 1024}; S.init(TOK, 4096, G, (int)blockIdx.x); pg8::EpiProj E{P0, rs_mix}; pg8::gemm_phase<pg8::EpiProj, pg8::StaticOrder>(lds, g, S, E); }
            if (KEN(2)) { pg8::Gemm g{WinT + (size_t)4096 * 1024, XB, 512, TOK, 1024}; S.init(512, TOK, G, (int)blockIdx.x); pg8::EpiVT E{(bf16*)(ws + WS_P + 8 * PBUF), rs_mix}; pg8::gemm_phase<pg8::EpiVT, pg8::StaticOrder>(lds, g, S, E); }
        }
        END_PH();
        if (IN_PH()) { if (KEN(20)) REP(4) { LAUNDER(); phase_attn2(p, l, lds, tid, lane, wave, G, (DUP & 4) && rep_ == 0 ? (bf16*)(ws + WS_YG) : (bf16*)(ws + WS_P + 5 * PBUF)); } if (KEN(21)) { LAUNDER(); phase_branchB(p, l, lds, tid, lane, wave, G); } if (KEN(22)) REP(16) { LAUNDER(); phase_ssm1(p, l, lane, wave, G); } if (KEN(23)) { LAUNDER(); phase_branchA(p, l, tid, G); } }
        END_PH();
        if (IN_PH() && KEN(3)) REP(16) { LAUNDER(); phase_ssm<true>(p, l, lds, lane, wave, G); }
        END_PH();
        if (IN_PH() && KEN(4)) REP(64) { pg8::Gemm g{(const bf16*)(ws + WS_YG), (const bf16*)(wl + WL_GLU), TOK, 512, 512}; S.init(TOK, 512, G, (int)blockIdx.x);
            pg8::EpiGlu E{(const bf16*)(ws + WS_YG), (bf16*)(ws + WS_P + 7 * PBUF), p.in[I_BGLU] + l * 512}; pg8::gemm_phase<pg8::EpiGlu, pg8::StaticOrder>(lds, g, S, E); }
        END_PH();
        bf16* GS = (bf16*)(ws + WS_P + 1 * PBUF); bf16* MG = (bf16*)(ws + WS_P + 8 * PBUF);
        if (IN_PH() && KEN(5)) REP(8) {
#pragma unroll 1
            for (int b = 0; b < 4; ++b) {
                { pg8::Gemm g{XB, WinT + (size_t)(4608 + 1024 * b) * 1024, TOK, 1024, 1024}; S.init(TOK, 1024, G, (int)blockIdx.x); pg8::EpiGate E{GS, rs_mix}; pg8::gemm_phase<pg8::EpiGate, pg8::StaticOrder>(lds, g, S, E); }
                const size_t yb = (b == 0) ? 0 : (b == 1) ? 3 : (b == 2) ? 5 : 7;
                pg8::Gemm g{(const bf16*)(ws + WS_P + yb * PBUF), (const bf16*)(wl + WL_BR) + (size_t)b * 1024 * 512, TOK, 1024, 512}; S.init(TOK, 1024, G, (int)blockIdx.x);
                if (b == 0) { pg8::EpiBr<true> E{GS, MG}; pg8::gemm_phase<pg8::EpiBr<true>, pg8::StaticOrder>(lds, g, S, E); }
                else { pg8::EpiBr<false> E{GS, MG}; pg8::gemm_phase<pg8::EpiBr<false>, pg8::StaticOrder>(lds, g, S, E); }
            }
        }
        END_PH();
        if (IN_PH() && KEN(6)) { pg8::Gemm g{MG, (const bf16*)(wl + WL_O), TOK, 1024, 1024}; S.init(TOK, 1024, G, (int)blockIdx.x);
            pg8::EpiResid E{l == 0 ? p.in[I_X] : (const float*)p.out, p.out, XB, rs_ffn, 1}; pg8::gemm_phase<pg8::EpiResid, pg8::StaticOrder>(lds, g, S, E); }
        END_PH();
        bf16* H = (bf16*)(ws + WS_P);
        if (IN_PH() && KEN(7)) REP(2) { pg8::Gemm g{XB, (const bf16*)(wl + WL_FF), TOK, 5632, 1024}; S.init(TOK, 5632, G, (int)blockIdx.x);
            pg8::EpiFfnUp E{H, rs_ffn}; pg8::gemm_phase<pg8::EpiFfnUp, pg8::StaticOrder>(lds, g, S, E); }
        END_PH();
        if (IN_PH() && KEN(8)) { pg8::Gemm g{H, (const bf16*)(wl + WL_D), TOK, 1024, 2816}; S.init(TOK, 1024, G, (int)blockIdx.x);
            pg8::EpiResid E{(const float*)p.out, p.out, XB, rs_next, l == 0 ? 1 : 0}; pg8::gemm_phase<pg8::EpiResid, pg8::StaticOrder>(lds, g, S, E); }
        END_PH();
    }
    if (IN_PH() && KEN(9)) { LAUNDER(); phase_final(p, tid, G); }
}
constexpr int N_PHASES = 18;
}

extern "C" void kernel_launch(void* const* d_in, const int* in_sizes, int n_in, void* d_out, int out_size, void* d_ws, size_t ws_size, hipStream_t stream) {
    static int grid = 0;
    if (grid == 0) {
        if (n_in != 28 || out_size != mk::TOK * mk::DM || ws_size < mk::WS_END) { fprintf(stderr, "kernel_launch: unexpected shapes (n_in %d out %d ws %zu need %zu)\n", n_in, out_size, ws_size, (size_t)mk::WS_END); grid = -1; return; }
        int dev = 0, cus = 0, per_cu = 0;
        hipGetDevice(&dev); hipDeviceGetAttribute(&cus, hipDeviceAttributeMultiprocessorCount, dev);
        if (hipFuncSetAttribute((const void*)mk::mega, hipFuncAttributeMaxDynamicSharedMemorySize, mk::LDS_BYTES) != hipSuccess) { fprintf(stderr, "kernel_launch: hipFuncSetAttribute failed\n"); grid = -1; return; }
        if (hipOccupancyMaxActiveBlocksPerMultiprocessor(&per_cu, (const void*)mk::mega, mk::NTHR, mk::LDS_BYTES) != hipSuccess || per_cu < 1) { fprintf(stderr, "kernel_launch: occupancy query says %d\n", per_cu); per_cu = 1; }
        (void)hipGetLastError();
        grid = cus * 1;
        if (grid <= 0) grid = 256;
    }
    if (grid < 0) return;
    mk::Params p{};
    for (int i = 0; i < 28; ++i) p.in[i] = (const float*)d_in[i];
    p.out = (float*)d_out; p.ws = (unsigned char*)d_ws;
#if ONE_LAUNCH
    if (hipMemsetAsync((unsigned char*)d_ws + mk::WS_BAR, 0, XCD_BAR_WORDS * sizeof(unsigned), stream) != hipSuccess) { fprintf(stderr, "kernel_launch: memset failed\n"); return; }
    p.ph_lo = 0; p.ph_hi = mk::N_PHASES;
    void* args[] = {&p};
    hipError_t e = hipLaunchCooperativeKernel((const void*)mk::mega, dim3(grid), dim3(mk::NTHR), args, mk::LDS_BYTES, stream);
    if (e != hipSuccess) fprintf(stderr, "cooperative launch failed: %s (grid %d)\n", hipGetErrorString(e), grid);
#else
    for (int ph = 0; ph < mk::N_PHASES; ++ph) { p.ph_lo = ph; p.ph_hi = ph + 1;
        hipLaunchKernelGGL(mk::mega, dim3(grid), dim3(mk::NTHR), mk::LDS_BYTES, stream, p); }
#endif
}
```

```cpp
#include <hip/hip_runtime.h>
#include <hip/hip_cooperative_groups.h>
#include <cstdio>
#include <cstdint>
#ifndef ONE_LAUNCH
#define ONE_LAUNCH 1
#endif
namespace cg = cooperative_groups;
typedef __bf16 mk_bf16x2_t __attribute__((ext_vector_type(2)));
typedef float mk_f32x2_t __attribute__((ext_vector_type(2)));
__device__ __forceinline__ unsigned mk_pk2(float lo, float hi) { mk_f32x2_t v = {lo, hi}; mk_bf16x2_t b = __builtin_convertvector(v, mk_bf16x2_t); return __builtin_bit_cast(unsigned, b); }
__device__ __forceinline__ float mk_lo(unsigned w) { return __uint_as_float(w << 16); }
__device__ __forceinline__ float mk_hi(unsigned w) { return __uint_as_float(w & 0xffff0000u); }
__device__ __forceinline__ float mk_sigm(float x) { return __builtin_amdgcn_rcpf(1.0f + __expf(-x)); }
__device__ __forceinline__ float mk_gelu(float x) { const float u = 1.5957691216f * (x + 0.044715f * x * x * x); return x * __builtin_amdgcn_rcpf(1.0f + __expf(-u)); }
namespace pg8 {
#define PG8_LAS __attribute__((address_space(3)))
typedef unsigned short bf16_t;
typedef short bf16x8 __attribute__((ext_vector_type(8)));
typedef float f32x4 __attribute__((ext_vector_type(4)));
typedef unsigned u32x4 __attribute__((ext_vector_type(4)));
constexpr int BM = 256, BK = 64, HALF = 128, HTB = HALF * BK * 2  , STAGE_BYTES = 8 * HTB, NXCD = 8, WGM = 8;

__host__ __device__ __forceinline__ int lds_byte(int r, int c) { const int st = (r >> 4) * 2 + (c >> 5), rr = r & 15, cc = c & 31, ob = rr * 64 + cc * 2; return st * 1024 + (ob ^ (((ob >> 9) & 1) << 5)); }
__host__ __device__ __forceinline__ void stage_rc(int b, int& R, int& C) { const int st = b / 1024, sb = b % 1024, swz = sb ^ (((sb >> 9) & 1) << 5); R = (st >> 1) * 16 + swz / 64; C = (st & 1) * 32 + (swz % 64) / 2; }
__host__ __device__ __forceinline__ int perm32(int rho) { const int n = rho >> 4, i = rho & 15; return 8 * (i >> 2) + 4 * n + (i & 3); }

struct Unit { int pm, pn; };
struct Gemm { const bf16_t* A; const bf16_t* Bt; int M, N, K; };

struct StaticOrder {
    int nM, nN, nwg, G, c;
    __host__ __device__ void init(int M, int N, int G_, int c_) { nM = M / BM; nN = N / BM; nwg = nM * nN; G = G_; c = c_; }
    __host__ __device__ bool next(int i, Unit& u) const {
        const long L = (long)i * G + c; if (L >= nwg) return false;
        int wgid = (int)L; { const int q = nwg / NXCD, r = nwg % NXCD, xcd = wgid % NXCD, off = wgid / NXCD; wgid = (xcd < r ? xcd * (q + 1) : r * (q + 1) + (xcd - r) * q) + off; }
        const int nig = WGM * nN, gid = wgid / nig, fm = gid * WGM, gsz = (nM - fm) < WGM ? (nM - fm) : WGM;
        u.pm = fm + ((wgid % nig) % gsz); u.pn = (wgid % nig) / gsz; return true;
    }
    __device__ __forceinline__ void a_ready(const Unit&) const {}
    __device__ __forceinline__ void done(const Unit&) const {}
};
typedef unsigned u32x2 __attribute__((ext_vector_type(2)));
constexpr int MK_TOK = 32768;
#define MK_EPI_LOOP_AM _Pragma("unroll") for (int ai = 0; ai < 2; ++ai) _Pragma("unroll") for (int m = 0; m < 4; ++m)
__device__ __forceinline__ u32x4 pack8(const f32x4 a, const f32x4 b) { u32x4 w; w.x = mk_pk2(a[0], a[1]); w.y = mk_pk2(a[2], a[3]); w.z = mk_pk2(b[0], b[1]); w.w = mk_pk2(b[2], b[3]); return w; }
__device__ __forceinline__ void unpack8(const u32x4 w, f32x4& a, f32x4& b) { a = (f32x4){mk_lo(w.x), mk_hi(w.x), mk_lo(w.y), mk_hi(w.y)}; b = (f32x4){mk_lo(w.z), mk_hi(w.z), mk_lo(w.w), mk_hi(w.w)}; }
__device__ __forceinline__ float rstd_of(float ss) { return rsqrtf(ss * (1.0f / 1024.0f) + 1e-6f); }
typedef unsigned long long rowss_t;
__device__ __forceinline__ float rstd_row(const rowss_t* rowss, int row) { return rstd_of((float)rowss[row] * (1.0f / 4294967296.0f)); }

struct EpiProj { static constexpr bool PERM = true, AFTER_DRAIN = false; bf16_t* P; const rowss_t* rowss;
    __device__ __forceinline__ void operator()(const f32x4 (&acc)[2][2][4][2], const Unit& u, int wr, int wc, int fr, int fq) const {
        const int row0 = u.pm * BM + wr * 64 + fr;
        bf16_t* base = P + (size_t)(u.pn >> 1) * ((size_t)MK_TOK * 512) + (u.pn & 1) * 256 + wc * 32 + 8 * fq;
        MK_EPI_LOOP_AM { const int row = row0 + ai * HALF + m * 16; const float rs = rstd_row(rowss, row); bf16_t* rp = base + (size_t)row * 512;
#pragma unroll
            for (int bj = 0; bj < 2; ++bj) *(u32x4*)(rp + bj * HALF) = pack8(acc[ai][bj][m][0] * rs, acc[ai][bj][m][1] * rs); }
    }
};
struct EpiVT { static constexpr bool PERM = true, AFTER_DRAIN = false; bf16_t* VT; const rowss_t* rowss;
    __device__ __forceinline__ void operator()(const f32x4 (&acc)[2][2][4][2], const Unit& u, int wr, int wc, int fr, int fq) const {
        const int row0 = u.pm * BM + wr * 64 + fr, col0 = u.pn * BM + wc * 32 + 8 * fq;
        f32x4 rs[2][2];
#pragma unroll
        for (int bj = 0; bj < 2; ++bj)
#pragma unroll
            for (int n = 0; n < 2; ++n) { const int c_ = col0 + bj * HALF + 4 * n; rs[bj][n] = (f32x4){rstd_row(rowss, c_), rstd_row(rowss, c_ + 1), rstd_row(rowss, c_ + 2), rstd_row(rowss, c_ + 3)}; }
        MK_EPI_LOOP_AM { const int row = row0 + ai * HALF + m * 16; bf16_t* rp = VT + (size_t)row * MK_TOK + col0;
#pragma unroll
            for (int bj = 0; bj < 2; ++bj) *(u32x4*)(rp + bj * HALF) = pack8(acc[ai][bj][m][0] * rs[bj][0], acc[ai][bj][m][1] * rs[bj][1]); }
    }
};
struct EpiGlu { static constexpr bool PERM = true, AFTER_DRAIN = false; const bf16_t* YG; bf16_t* O; const float* bias;
    __device__ __forceinline__ void operator()(const f32x4 (&acc)[2][2][4][2], const Unit& u, int wr, int wc, int fr, int fq) const {
        const int row0 = u.pm * BM + wr * 64 + fr, col0 = u.pn * BM + wc * 32 + 8 * fq;
        f32x4 bv[2][2];
#pragma unroll
        for (int bj = 0; bj < 2; ++bj)
#pragma unroll
            for (int n = 0; n < 2; ++n) bv[bj][n] = *(const f32x4*)(bias + col0 + bj * HALF + 4 * n);
        MK_EPI_LOOP_AM { const int row = row0 + ai * HALF + m * 16; const size_t off = (size_t)row * 512 + col0;
#pragma unroll
            for (int bj = 0; bj < 2; ++bj) { f32x4 y0, y1; unpack8(*(const u32x4*)(YG + off + bj * HALF), y0, y1);
                f32x4 a0 = acc[ai][bj][m][0] + bv[bj][0], a1 = acc[ai][bj][m][1] + bv[bj][1];
#pragma unroll
                for (int j = 0; j < 4; ++j) { y0[j] *= mk_sigm(a0[j]); y1[j] *= mk_sigm(a1[j]); }
                *(u32x4*)(O + off + bj * HALF) = pack8(y0, y1); } }
    }
};
struct EpiGate { static constexpr bool PERM = true, AFTER_DRAIN = false; bf16_t* GS; const rowss_t* rowss;
    __device__ __forceinline__ void operator()(const f32x4 (&acc)[2][2][4][2], const Unit& u, int wr, int wc, int fr, int fq) const {
        const int row0 = u.pm * BM + wr * 64 + fr, col0 = u.pn * BM + wc * 32 + 8 * fq;
        MK_EPI_LOOP_AM { const int row = row0 + ai * HALF + m * 16; const float rs = rstd_row(rowss, row); const size_t off = (size_t)row * 1024 + col0;
#pragma unroll
            for (int bj = 0; bj < 2; ++bj) { f32x4 a0 = acc[ai][bj][m][0] * rs, a1 = acc[ai][bj][m][1] * rs;
#pragma unroll
                for (int j = 0; j < 4; ++j) { a0[j] = mk_sigm(a0[j]); a1[j] = mk_sigm(a1[j]); }
                *(u32x4*)(GS + off + bj * HALF) = pack8(a0, a1); } }
    }
};
template <bool FIRST> struct EpiBr { static constexpr bool PERM = true, AFTER_DRAIN = false; const bf16_t* GS; bf16_t* MG;
    __device__ __forceinline__ void operator()(const f32x4 (&acc)[2][2][4][2], const Unit& u, int wr, int wc, int fr, int fq) const {
        const int row0 = u.pm * BM + wr * 64 + fr, col0 = u.pn * BM + wc * 32 + 8 * fq;
        MK_EPI_LOOP_AM { const int row = row0 + ai * HALF + m * 16; const size_t off = (size_t)row * 1024 + col0;
#pragma unroll
            for (int bj = 0; bj < 2; ++bj) { f32x4 g0, g1; unpack8(*(const u32x4*)(GS + off + bj * HALF), g0, g1);
                f32x4 v0 = g0 * acc[ai][bj][m][0], v1 = g1 * acc[ai][bj][m][1];
                if (!FIRST) { f32x4 p0, p1; unpack8(*(const u32x4*)(MG + off + bj * HALF), p0, p1); v0 += p0; v1 += p1; }
                *(u32x4*)(MG + off + bj * HALF) = pack8(v0, v1); } }
    }
};
template <bool F32IN> struct EpiResidT { static constexpr bool PERM = false, AFTER_DRAIN = false; const float* xin; bf16_t* xb; rowss_t* rowss_next;
    __device__ __forceinline__ void operator()(const f32x4 (&acc)[2][2][4][2], const Unit& u, int wr, int wc, int fr, int fq) const {
        const int row0 = u.pm * BM + wr * 64 + fr, col0 = u.pn * BM + wc * 32 + 4 * fq;
        MK_EPI_LOOP_AM { const int row = row0 + ai * HALF + m * 16; const size_t off = (size_t)row * 1024 + col0; float ss = 0.f;
#pragma unroll
            for (int bj = 0; bj < 2; ++bj)
#pragma unroll
                for (int n = 0; n < 2; ++n) { const size_t o = off + bj * HALF + n * 16; f32x4 xo;
                    if (F32IN) xo = *(const f32x4*)(xin + o); else { const u32x2 w0 = *(const u32x2*)(xb + o); xo = (f32x4){mk_lo(w0.x), mk_hi(w0.x), mk_lo(w0.y), mk_hi(w0.y)}; }
                    const f32x4 xn = xo + acc[ai][bj][m][n];
                    u32x2 w; w.x = mk_pk2(xn[0], xn[1]); w.y = mk_pk2(xn[2], xn[3]); *(u32x2*)(xb + o) = w;
                    ss += (xn[0] * xn[0] + xn[1] * xn[1]) + (xn[2] * xn[2] + xn[3] * xn[3]); }
            ss += __shfl_xor(ss, 16); ss += __shfl_xor(ss, 32);
            if (fq == 0) __hip_atomic_fetch_add(rowss_next + row, (rowss_t)(ss * 4294967296.0f), __ATOMIC_RELAXED, __HIP_MEMORY_SCOPE_AGENT); }
    }
};
struct EpiFfnUp { static constexpr bool PERM = true, AFTER_DRAIN = false; bf16_t* H; const rowss_t* rowss;
    __device__ __forceinline__ void operator()(const f32x4 (&acc)[2][2][4][2], const Unit& u, int wr, int wc, int fr, int fq) const {
        const int row0 = u.pm * BM + wr * 64 + fr, col0 = u.pn * HALF + wc * 32 + 8 * fq;
        MK_EPI_LOOP_AM { const int row = row0 + ai * HALF + m * 16; const float rs = rstd_row(rowss, row);
            f32x4 g0 = acc[ai][0][m][0] * rs, g1 = acc[ai][0][m][1] * rs, u0 = acc[ai][1][m][0] * rs, u1 = acc[ai][1][m][1] * rs;
#pragma unroll
            for (int j = 0; j < 4; ++j) { g0[j] = g0[j] * mk_sigm(g0[j]) * u0[j]; g1[j] = g1[j] * mk_sigm(g1[j]) * u1[j]; }
            *(u32x4*)(H + (size_t)row * 2816 + col0) = pack8(g0, g1); }
    }
};
template <class Epi, class Sched, bool ALIGN_EPI = true, bool SP2 = true>
__device__ __forceinline__ void gemm_phase(PG8_LAS unsigned char* lds, const Gemm g, const Sched& S, const Epi& E) {
    int tid_l = threadIdx.x; asm volatile("" : "+v"(tid_l)); const int tid = tid_l, wid = __builtin_amdgcn_readfirstlane(tid >> 6), lane = tid & 63, wr = wid >> 2, wc = wid & 3, fr = lane & 15, fq = lane >> 4;
    const int K = g.K, nt = K / BK;
    unsigned voffA[2], voffB[2];
#pragma unroll
    for (int i = 0; i < 2; ++i) { int R, C; stage_rc(tid * 16 + i * 8192, R, C); const int Rb = Epi::PERM ? ((R & ~31) + perm32(R & 31)) : R;
        voffA[i] = (unsigned)(R * K + C) * 2u; voffB[i] = (unsigned)(Rb * K + C) * 2u; }
    const size_t kstep = (size_t)(BK * 2);
    const size_t hstep = (size_t)HALF * K * 2;
    const size_t tstep = 2 * hstep;
    const unsigned ldsw = (unsigned)wid * 1024u;
    const int aoff = lds_byte(wr * 64 + fr, fq * 8), boff = lds_byte(wc * 32 + fr, fq * 8);
#define PG8_SA(b, h) (((b) * 2 + (h)) * HTB)
#define PG8_SB(b, h) ((4 + (b) * 2 + (h)) * HTB)
#define PG8_STAGE(bufoff, gbase, voff) do { _Pragma("unroll") for (int _i = 0; _i < 2; ++_i) \
        __builtin_amdgcn_global_load_lds((const unsigned*)((const char*)(gbase) + (voff)[_i]), (PG8_LAS unsigned*)(lds + (bufoff) + ldsw + _i * 8192), 16, 0, 0); } while (0)
#define PG8_LDA(dst, b, h) do { _Pragma("unroll") for (int m = 0; m < 4; ++m) _Pragma("unroll") for (int k = 0; k < 2; ++k) dst[m][k] = *(const PG8_LAS bf16x8*)(lds + PG8_SA(b, h) + aoff + m * 2048 + k * 1024); } while (0)
#define PG8_LDB(dst, b, h) do { _Pragma("unroll") for (int n = 0; n < 2; ++n) _Pragma("unroll") for (int k = 0; k < 2; ++k) dst[n][k] = *(const PG8_LAS bf16x8*)(lds + PG8_SB(b, h) + boff + n * 2048 + k * 1024); } while (0)
#define PG8_MMA(ai, bj, At, Bt) do { __builtin_amdgcn_s_setprio(1); _Pragma("unroll") for (int m = 0; m < 4; ++m) _Pragma("unroll") for (int n = 0; n < 2; ++n) _Pragma("unroll") for (int k = 0; k < 2; ++k) \
        acc[ai][bj][m][n] = __builtin_amdgcn_mfma_f32_16x16x32_bf16(Bt[n][k], At[m][k], acc[ai][bj][m][n], 0, 0, 0); __builtin_amdgcn_s_setprio(0); } while (0)
#define PG8_WAIT_V(n) asm volatile("s_waitcnt vmcnt(" #n ")" ::: "memory")
#define PG8_WAIT_L(n) asm volatile("s_waitcnt lgkmcnt(" #n ")" ::: "memory")
#define PG8_BAR __builtin_amdgcn_s_barrier()
#define PG8_SCHED __builtin_amdgcn_sched_barrier(0)
    Unit cur, nxt; int ui = 0;
    if (!S.next(0, cur)) return;
    f32x4 acc[2][2][4][2];
#pragma unroll
    for (int a = 0; a < 2; ++a)
#pragma unroll
        for (int b = 0; b < 2; ++b)
#pragma unroll
            for (int m = 0; m < 4; ++m)
#pragma unroll
                for (int n = 0; n < 2; ++n) acc[a][b][m][n] = (f32x4){0.f, 0.f, 0.f, 0.f};
    bf16x8 At[4][2], B0[2][2], B1[2][2];
    const char* cA = (const char*)g.A + (size_t)cur.pm * tstep; const char* cB = (const char*)g.Bt + (size_t)cur.pn * tstep;
    S.a_ready(cur);
    if constexpr (SP2) {
        PG8_STAGE(PG8_SB(0, 0), cB, voffB); PG8_STAGE(PG8_SB(0, 1), cB + hstep, voffB); PG8_STAGE(PG8_SA(0, 0), cA, voffA); PG8_STAGE(PG8_SA(0, 1), cA + hstep, voffA);
        if (wr == 1) PG8_BAR;
        PG8_WAIT_V(2); PG8_BAR;
        PG8_STAGE(PG8_SB(1, 0), cB + kstep, voffB); PG8_STAGE(PG8_SA(1, 0), cA + kstep, voffA); PG8_STAGE(PG8_SB(1, 1), cB + hstep + kstep, voffB);
        PG8_WAIT_V(6); PG8_BAR;
    } else {
        PG8_STAGE(PG8_SB(0, 0), cB, voffB); PG8_STAGE(PG8_SA(0, 0), cA, voffA); PG8_STAGE(PG8_SB(0, 1), cB + hstep, voffB); PG8_STAGE(PG8_SA(0, 1), cA + hstep, voffA);
        if (wr == 1) PG8_BAR;
        PG8_WAIT_V(4); PG8_BAR;
        PG8_STAGE(PG8_SB(1, 0), cB + kstep, voffB); PG8_STAGE(PG8_SA(1, 0), cA + kstep, voffA); PG8_STAGE(PG8_SB(1, 1), cB + hstep + kstep, voffB);
        PG8_WAIT_V(6); PG8_BAR;
    }
    for (;;) {
        const bool has_next = S.next(ui + 1, nxt);
        const char* nA = has_next ? (const char*)g.A + (size_t)nxt.pm * tstep : cA; const char* nB = has_next ? (const char*)g.Bt + (size_t)nxt.pn * tstep : cB;
        for (int t = 0; t < nt; t += 2) {
            const bool last = (t == nt - 2);
            const char* a1 = cA + (size_t)(t + 1) * kstep;
            const char* a2 = last ? nA : cA + (size_t)(t + 2) * kstep; const char* b2 = last ? nB : cB + (size_t)(t + 2) * kstep;
            const char* a3 = a2 + kstep; const char* b3 = b2 + kstep;
            if (last && has_next) S.a_ready(nxt);
            if constexpr (SP2) {
            PG8_LDB(B0, 0, 0); PG8_LDB(B1, 0, 1); PG8_SCHED; PG8_LDA(At, 0, 0); PG8_STAGE(PG8_SA(1, 1), a1 + hstep, voffA);
            PG8_WAIT_V(8); PG8_WAIT_L(0); PG8_BAR; PG8_MMA(0, 0, At, B0); PG8_MMA(0, 1, At, B1); PG8_BAR; PG8_SCHED;
            PG8_LDA(At, 0, 1); PG8_STAGE(PG8_SB(0, 0), b2, voffB); PG8_STAGE(PG8_SB(0, 1), b2 + hstep, voffB); PG8_STAGE(PG8_SA(0, 0), a2, voffA);
            PG8_WAIT_V(8); PG8_WAIT_L(0); PG8_BAR; PG8_MMA(1, 0, At, B0); PG8_MMA(1, 1, At, B1); PG8_BAR; PG8_SCHED;
            PG8_LDB(B0, 1, 0); PG8_LDB(B1, 1, 1); PG8_SCHED; PG8_LDA(At, 1, 0); PG8_STAGE(PG8_SA(0, 1), a2 + hstep, voffA);
            PG8_WAIT_V(8); PG8_WAIT_L(0); PG8_BAR; PG8_MMA(0, 0, At, B0); PG8_MMA(0, 1, At, B1); PG8_BAR; PG8_SCHED;
            PG8_LDA(At, 1, 1); PG8_STAGE(PG8_SB(1, 0), b3, voffB); PG8_STAGE(PG8_SB(1, 1), b3 + hstep, voffB); PG8_STAGE(PG8_SA(1, 0), a3, voffA);
            PG8_WAIT_V(8); PG8_WAIT_L(0); PG8_BAR; PG8_MMA(1, 0, At, B0); PG8_MMA(1, 1, At, B1); PG8_BAR; PG8_SCHED;
            } else {
            PG8_LDB(B0, 0, 0); PG8_SCHED; PG8_LDA(At, 0, 0); PG8_STAGE(PG8_SA(1, 1), a1 + hstep, voffA);
            PG8_WAIT_L(8); PG8_BAR; PG8_WAIT_L(0); PG8_MMA(0, 0, At, B0); PG8_BAR; PG8_SCHED;
            PG8_LDB(B1, 0, 1); PG8_STAGE(PG8_SB(0, 0), b2, voffB);
            PG8_BAR; PG8_WAIT_L(0); PG8_MMA(0, 1, At, B1); PG8_BAR;
            PG8_LDA(At, 0, 1); PG8_STAGE(PG8_SA(0, 0), a2, voffA);
            PG8_BAR; PG8_WAIT_L(0); PG8_MMA(1, 0, At, B0); PG8_BAR; PG8_SCHED;
            PG8_STAGE(PG8_SB(0, 1), b2 + hstep, voffB);
            PG8_WAIT_V(6); PG8_BAR; PG8_MMA(1, 1, At, B1); PG8_BAR;
            PG8_LDB(B0, 1, 0); PG8_SCHED; PG8_LDA(At, 1, 0); PG8_STAGE(PG8_SA(0, 1), a2 + hstep, voffA);
            PG8_WAIT_L(8); PG8_BAR; PG8_WAIT_L(0); PG8_MMA(0, 0, At, B0); PG8_BAR; PG8_SCHED;
            PG8_LDB(B1, 1, 1); PG8_STAGE(PG8_SB(1, 0), b3, voffB);
            PG8_BAR; PG8_WAIT_L(0); PG8_MMA(0, 1, At, B1); PG8_BAR;
            PG8_LDA(At, 1, 1); PG8_STAGE(PG8_SA(1, 0), a3, voffA);
            PG8_BAR; PG8_WAIT_L(0); PG8_MMA(1, 0, At, B0); PG8_BAR; PG8_SCHED;
            PG8_STAGE(PG8_SB(1, 1), b3 + hstep, voffB);
            PG8_WAIT_V(6); PG8_BAR; PG8_MMA(1, 1, At, B1); PG8_BAR;
            }
        }
        if constexpr (ALIGN_EPI) { if (wr == 0) PG8_BAR; }
        if constexpr (!Epi::AFTER_DRAIN) { E(acc, cur, wr, wc, fr, fq); S.done(cur); }
        if (!has_next) break;
#pragma unroll
        for (int a = 0; a < 2; ++a)
#pragma unroll
            for (int b = 0; b < 2; ++b)
#pragma unroll
                for (int m = 0; m < 4; ++m)
#pragma unroll
                    for (int n = 0; n < 2; ++n) acc[a][b][m][n] = (f32x4){0.f, 0.f, 0.f, 0.f};
        cur = nxt; cA = nA; cB = nB; ++ui;
        if constexpr (ALIGN_EPI) { if (wr == 1) PG8_BAR; }
    }
    PG8_WAIT_V(0);
    if constexpr (!ALIGN_EPI) { if (wr == 0) PG8_BAR; }
    PG8_BAR;
    if constexpr (Epi::AFTER_DRAIN) { E.fused(acc, cur, wr, wc, fr, fq, lds, wid, lane); S.done(cur); }
#undef PG8_SA
#undef PG8_SB
#undef PG8_STAGE
#undef PG8_LDA
#undef PG8_LDB
#undef PG8_MMA
#undef PG8_WAIT_V
#undef PG8_WAIT_L
#undef PG8_BAR
#undef PG8_SCHED
}
}

namespace mk {
#define LAS __attribute__((address_space(3)))
#define DI __device__ __forceinline__
typedef unsigned short bf16;
typedef pg8::bf16x8 bf16x8; typedef pg8::f32x4 f32x4; typedef pg8::u32x4 u32x4; typedef pg8::u32x2 u32x2;
typedef float f32x16 __attribute__((ext_vector_type(16)));
constexpr int TOK = 32768, DM = 1024, SEQ = 4096, BW = 512, FFH = 2816, NTHR = 512;
constexpr size_t MiB = 1024 * 1024;
constexpr size_t WS_ROWSS = 474 * MiB;
constexpr size_t WS_BAR = 768 * 1024;
constexpr size_t WS_BB = 1 * MiB;
constexpr size_t WS_CM = WS_BB + 262144;
constexpr size_t WS_AP = WS_CM + 262144;
constexpr size_t WS_SGW = WS_AP + 131072;
constexpr size_t WS_E = 2 * MiB;
constexpr size_t WS_W = 10 * MiB;
constexpr size_t WL_IN = 0, WL_GLU = 17825792, WL_BR = WL_GLU + 524288, WL_O = WL_BR + 4194304, WL_FF = WL_O + 2097152, WL_D = WL_FF + 11534336, WL_SIZE = WL_D + 5767168;
static_assert(WL_SIZE == 40 * MiB, "weights per layer");
constexpr size_t WS_XB = 90 * MiB;
constexpr size_t WS_P = 154 * MiB;
constexpr size_t PBUF = 32 * MiB;
constexpr size_t WS_YG = WS_P + 9 * PBUF;
constexpr size_t WS_END = WS_YG + 32 * MiB + 2 * MiB;
constexpr int LDS_BYTES = 143360;

DI float bf2f(bf16 v) { return __uint_as_float(((unsigned)v) << 16); }
DI bf16 f2bf(float f) { return (bf16)(mk_pk2(f, 0.f) & 0xffffu); }
DI float wave_sum(float v) {
#pragma unroll
    for (int o = 1; o < 64; o <<= 1) v += __shfl_xor(v, o);
    return v; }
DI f32x16 mfma32(bf16x8 a, bf16x8 b, f32x16 c) { return __builtin_amdgcn_mfma_f32_32x32x16_bf16(a, b, c, 0, 0, 0); }
DI f32x4 mfma16(bf16x8 a, bf16x8 b, f32x4 c) { return __builtin_amdgcn_mfma_f32_16x16x32_bf16(a, b, c, 0, 0, 0); }
DI int crow(int i, int h) { return (i & 3) + 8 * (i >> 2) + 4 * h; }
DI f32x16 zero16() { f32x16 z;
#pragma unroll
    for (int i = 0; i < 16; ++i) z[i] = 0.f;
    return z; }
#define LDS_WAIT() asm volatile("s_waitcnt lgkmcnt(0)" ::: "memory")

struct Params { const float* in[28]; float* out; unsigned char* ws; int ph_lo, ph_hi; };
enum { I_X = 0, I_GMIX, I_WIN, I_CONVW, I_CONVB, I_SGW, I_SGB, I_LNG, I_LNB, I_LAMQK, I_SUBLN, I_ARE, I_AIM, I_LOGDT, I_BRE, I_BIM, I_CRE, I_CIM, I_SSMD, I_WGLU, I_BGLU, I_WBR, I_WO, I_GFFN, I_WFG, I_WFU, I_WFD, I_GFIN };

DI void tr_item(const float* W, int ldn, int k0, int n0, const float* gs, bf16* WT, int ldk, int drow0, LAS float* scr, int lane) {
    float tv[32];
#pragma unroll
    for (int i = 0; i < 32; ++i) { const int kk = 2 * i + (lane >> 5); tv[i] = W[(size_t)(k0 + kk) * ldn + n0 + (lane & 31)]; }
    if (gs) {
#pragma unroll
        for (int i = 0; i < 32; ++i) tv[i] *= gs[k0 + 2 * i + (lane >> 5)]; }
#pragma unroll
    for (int i = 0; i < 32; ++i) scr[(2 * i + (lane >> 5)) * 33 + (lane & 31)] = tv[i];
    LDS_WAIT();
    const int c = lane & 7;
#pragma unroll
    for (int j = 0; j < 4; ++j) { const int n = (lane >> 3) + 8 * j; const LAS float* s = scr + (8 * c) * 33 + n;
        u32x4 o; o.x = mk_pk2(s[0 * 33], s[1 * 33]); o.y = mk_pk2(s[2 * 33], s[3 * 33]); o.z = mk_pk2(s[4 * 33], s[5 * 33]); o.w = mk_pk2(s[6 * 33], s[7 * 33]);
        *(u32x4*)(WT + (size_t)(drow0 + n) * ldk + k0 + 8 * c) = o; }
    LDS_WAIT();
}
DI void dsincos(double x, double& s, double& c) {
    const double twopi = 6.283185307179586476925; const double k = rint(x / twopi); const double r = x - k * twopi, r2 = r * r;
    double ss = 1.0, cc = 1.0;
#pragma unroll
    for (int n = 13; n >= 1; --n) { ss = 1.0 - r2 * (1.0 / ((2.0 * n) * (2.0 * n + 1.0))) * ss; cc = 1.0 - r2 * (1.0 / ((2.0 * n - 1.0) * (2.0 * n))) * cc; }
    s = ss * r; c = cc;
}
DI void phase_prep(const Params& p, LAS unsigned char* lds, int tid, int lane, int wave, int G) {
    unsigned char* ws = p.ws;
    const int gw = blockIdx.x * 8 + wave, NGW = G * 8, gt = blockIdx.x * NTHR + tid, NGT = G * NTHR;
    LAS float* scr = (LAS float*)(lds + wave * 8704);
    for (int l = 0; l < 2; ++l) {
        unsigned char* wl = ws + WS_W + (size_t)l * WL_SIZE;
        for (int mi = 0; mi < 10; ++mi) {
            const float* src; int K, N; const float* gs = nullptr; bf16* dst; int map = 0;
            if (mi == 0) { src = p.in[I_WIN] + (size_t)l * 1024 * 8704; K = 1024; N = 8704; gs = p.in[I_GMIX] + l * 1024; dst = (bf16*)(wl + WL_IN); map = 1; }
            else if (mi == 1) { src = p.in[I_WGLU] + (size_t)l * 512 * 512; K = 512; N = 512; dst = (bf16*)(wl + WL_GLU); }
            else if (mi < 6) { const int b = mi - 2; src = p.in[I_WBR] + ((size_t)l * 4 + b) * 512 * 1024; K = 512; N = 1024; dst = (bf16*)(wl + WL_BR) + (size_t)b * 1024 * 512; }
            else if (mi == 6) { src = p.in[I_WO] + (size_t)l * 1024 * 1024; K = 1024; N = 1024; dst = (bf16*)(wl + WL_O); }
            else if (mi == 7) { src = p.in[I_WFG] + (size_t)l * 1024 * 2816; K = 1024; N = 2816; gs = p.in[I_GFFN] + l * 1024; dst = (bf16*)(wl + WL_FF); map = 2; }
            else if (mi == 8) { src = p.in[I_WFU] + (size_t)l * 1024 * 2816; K = 1024; N = 2816; gs = p.in[I_GFFN] + l * 1024; dst = (bf16*)(wl + WL_FF); map = 3; }
            else { src = p.in[I_WFD] + (size_t)l * 2816 * 1024; K = 2816; N = 1024; dst = (bf16*)(wl + WL_D); }
            const int nblk = N / 32, nit = (K / 64) * nblk;
            for (int it = gw; it < nit; it += NGW) {
                const int kb = it / nblk, nb = it % nblk, n0 = nb * 32; int dr = n0;
                if (map == 1) { if (n0 >= 3584 && n0 < 4096) dr = n0 + 512; else if (n0 >= 4096 && n0 < 4608) dr = n0 - 512; }
                else if (map == 2) dr = (n0 >> 7) * 256 + (n0 & 127);
                else if (map == 3) dr = (n0 >> 7) * 256 + 128 + (n0 & 127);
                tr_item(src, N, kb * 64, n0, gs, dst, K, dr, scr, lane);
            }
        }
    }
    { const float* x = p.in[I_X]; bf16* xb = (bf16*)(ws + WS_XB); pg8::rowss_t* rowss = (pg8::rowss_t*)(ws + WS_ROWSS);
        for (int row0 = gw * 4; row0 < TOK; row0 += NGW * 4) { f32x4 v[4][4];
#pragma unroll
            for (int q = 0; q < 4; ++q)
#pragma unroll
                for (int j = 0; j < 4; ++j) v[q][j] = *((const f32x4*)(x + (size_t)(row0 + q) * DM) + lane + 64 * j);
#pragma unroll
            for (int q = 0; q < 4; ++q) { float ss = 0.f;
#pragma unroll
                for (int j = 0; j < 4; ++j) { const f32x4 t = v[q][j]; ss += (t[0] * t[0] + t[1] * t[1]) + (t[2] * t[2] + t[3] * t[3]);
                    u32x2 w; w.x = mk_pk2(t[0], t[1]); w.y = mk_pk2(t[2], t[3]); *((u32x2*)(xb + (size_t)(row0 + q) * DM) + lane + 64 * j) = w; }
                ss = wave_sum(ss); if (lane == 0) rowss[row0 + q] = (pg8::rowss_t)(ss * 4294967296.0f); } }
        for (int i = gt; i < 4 * TOK; i += NGT) rowss[TOK + i] = 0ull; }
    { const float* sgw = p.in[I_SGW]; bf16* o = (bf16*)(ws + WS_SGW);
        for (int i = gt; i < 2 * 4 * 128 * 128; i += NGT) { const int s = i & 127, t = (i >> 7) & 127; o[i] = f2bf(s <= t ? sgw[i] : 0.f); } }
    for (int i = gt; i < 2 * 32 * 64; i += NGT) {
        const int pp = i & 63, lg = i >> 6;
        const double dt = exp((double)p.in[I_LOGDT][lg]); const double are = p.in[I_ARE][i], aim = p.in[I_AIM][i];
        const double mag = exp(dt * are); double sn, cs; dsincos(dt * aim, sn, cs);
        const double abr = mag * cs, abi = mag * sn, den = are * are + aim * aim, nr = abr - 1.0, ni = abi;
        const double cr = (nr * are + ni * aim) / den, ci = (ni * are - nr * aim) / den;
        bf16* bb = (bf16*)(ws + WS_BB) + (size_t)lg * 128 * 16; const float* bre = p.in[I_BRE] + (size_t)i * 16; const float* bim = p.in[I_BIM] + (size_t)i * 16;
        for (int h = 0; h < 16; ++h) { const double br = bre[h], bi = bim[h]; bb[pp * 16 + h] = f2bf((float)(cr * br - ci * bi)); bb[(64 + pp) * 16 + h] = f2bf((float)(cr * bi + ci * br)); }
        bf16* cm = (bf16*)(ws + WS_CM) + (size_t)lg * 16 * 128; const float* cre = p.in[I_CRE] + (size_t)lg * 16 * 64; const float* cim = p.in[I_CIM] + (size_t)lg * 16 * 64;
        for (int h = 0; h < 16; ++h) { cm[h * 128 + pp] = f2bf(cre[h * 64 + pp]); cm[h * 128 + 64 + pp] = f2bf(-cim[h * 64 + pp]); }
        double pr = abr, pi = abi; float* ap = (float*)(ws + WS_AP) + (size_t)i * 8; ap[0] = (float)pr; ap[1] = (float)pi;
        for (int q = 0; q < 5; ++q) { const double t = pr * pr - pi * pi; pi = 2.0 * pr * pi; pr = t; }
        ap[2] = (float)pr; ap[3] = (float)pi;
        { const double t = pr * pr - pi * pi; pi = 2.0 * pr * pi; pr = t; }
        ap[4] = (float)pr; ap[5] = (float)pi; ap[6] = 0.f; ap[7] = 0.f;
    }
}

DI void phase_branchA(const Params& p, int l, int tid, int G) {
    bf16* AB = (bf16*)(p.ws + WS_P); const bf16* AC = (const bf16*)(p.ws + WS_P + PBUF); const bf16* AX = (const bf16*)(p.ws + WS_P + 2 * PBUF);
    const float* cw = p.in[I_CONVW] + l * 3 * 512; const float* cb = p.in[I_CONVB] + l * 512;
    for (int idx = blockIdx.x * NTHR + tid; idx < (TOK / 16) * 64; idx += G * NTHR) {
        const int cgp = idx & 63, run = idx >> 6, c0 = cgp * 8, t0 = run * 16;
        f32x4 w0[2], w1[2], w2[2], bb[2];
#pragma unroll
        for (int e = 0; e < 2; ++e) { w0[e] = *(const f32x4*)(cw + c0 + 4 * e); w1[e] = *(const f32x4*)(cw + 512 + c0 + 4 * e); w2[e] = *(const f32x4*)(cw + 1024 + c0 + 4 * e); bb[e] = *(const f32x4*)(cb + c0 + 4 * e); }
        f32x4 zm2[2] = {{0.f, 0.f, 0.f, 0.f}, {0.f, 0.f, 0.f, 0.f}}, zm1[2] = {{0.f, 0.f, 0.f, 0.f}, {0.f, 0.f, 0.f, 0.f}};
        if ((t0 & (SEQ - 1)) != 0) {
            f32x4 a0, a1, x0, x1;
            pg8::unpack8(*(const u32x4*)(AC + (size_t)(t0 - 2) * 512 + c0), a0, a1); pg8::unpack8(*(const u32x4*)(AX + (size_t)(t0 - 2) * 512 + c0), x0, x1); zm2[0] = a0 * x0; zm2[1] = a1 * x1;
            pg8::unpack8(*(const u32x4*)(AC + (size_t)(t0 - 1) * 512 + c0), a0, a1); pg8::unpack8(*(const u32x4*)(AX + (size_t)(t0 - 1) * 512 + c0), x0, x1); zm1[0] = a0 * x0; zm1[1] = a1 * x1;
        }
#pragma unroll 4
        for (int i = 0; i < 16; ++i) { const size_t off = (size_t)(t0 + i) * 512 + c0;
            f32x4 a0, a1, x0, x1, b0, b1; pg8::unpack8(*(const u32x4*)(AC + off), a0, a1); pg8::unpack8(*(const u32x4*)(AX + off), x0, x1); pg8::unpack8(*(const u32x4*)(AB + off), b0, b1);
            const f32x4 z0 = a0 * x0, z1 = a1 * x1;
            const f32x4 y0 = b0 * (w0[0] * zm2[0] + w1[0] * zm1[0] + w2[0] * z0 + bb[0]), y1 = b1 * (w0[1] * zm2[1] + w1[1] * zm1[1] + w2[1] * z1 + bb[1]);
            *(u32x4*)(AB + off) = pg8::pack8(y0, y1);
            zm2[0] = zm1[0]; zm2[1] = zm1[1]; zm1[0] = z0; zm1[1] = z1; }
    }
}

DI void phase_branchB(const Params& p, int l, LAS unsigned char* lds, int tid, int lane, int wave, int G) {
    bf16* BU = (bf16*)(p.ws + WS_P + 3 * PBUF); const bf16* BV = (const bf16*)(p.ws + WS_P + 4 * PBUF);
    const bf16* SGW = (const bf16*)(p.ws + WS_SGW) + (size_t)l * 4 * 128 * 128; const float* sgb = p.in[I_SGB] + l * 4 * 128;
    const float* lng = p.in[I_LNG] + l * 512 + lane * 8; const float* lnb = p.in[I_LNB] + l * 512 + lane * 8;
    constexpr int RS = 1040;
    const int r = lane & 31, half = lane >> 5;
    for (int item = blockIdx.x; item < TOK / 128; item += G) {
        const int tok0 = item * 128;
        { const f32x4 g0 = *(const f32x4*)lng, g1 = *(const f32x4*)(lng + 4), b0 = *(const f32x4*)lnb, b1 = *(const f32x4*)(lnb + 4);
            for (int tt = 0; tt < 16; ++tt) { const int s = wave * 16 + tt;
                f32x4 v0, v1; pg8::unpack8(*(const u32x4*)(BV + (size_t)(tok0 + s) * 512 + lane * 8), v0, v1);
#pragma unroll
                for (int j = 0; j < 4; ++j) { v0[j] = mk_gelu(v0[j]); v1[j] = mk_gelu(v1[j]); }
                const float mean = wave_sum((v0[0] + v0[1]) + (v0[2] + v0[3]) + (v1[0] + v1[1]) + (v1[2] + v1[3])) * (1.0f / 512.0f);
                v0 = v0 - mean; v1 = v1 - mean;
                const float var = wave_sum((v0[0] * v0[0] + v0[1] * v0[1]) + (v0[2] * v0[2] + v0[3] * v0[3]) + (v1[0] * v1[0] + v1[1] * v1[1]) + (v1[2] * v1[2] + v1[3] * v1[3])) * (1.0f / 512.0f);
                const float rstd = rsqrtf(var + 1e-5f);
                v0 = v0 * rstd * g0 + b0; v1 = v1 * rstd * g1 + b1;
                *(LAS u32x4*)(lds + s * RS + lane * 16) = pg8::pack8(v0, v1); } }
        __syncthreads();
        const int g = wave >> 1, dh = wave & 1;
        f32x16 acc[4][2];
#pragma unroll
        for (int a = 0; a < 4; ++a) { acc[a][0] = zero16(); acc[a][1] = zero16(); }
#pragma unroll
        for (int ks = 0; ks < 8; ++ks) {
            bf16x8 Vf[2];
#pragma unroll
            for (int dt = 0; dt < 2; ++dt) { const LAS unsigned short* vp = (const LAS unsigned short*)(lds + (16 * ks + 8 * half) * RS + (g * 128 + dh * 64 + dt * 32 + r) * 2);
#pragma unroll
                for (int j = 0; j < 8; ++j) Vf[dt][j] = (short)vp[j * (RS / 2)]; }
#pragma unroll
            for (int tt = ks >> 1; tt < 4; ++tt) { const bf16x8 Wf = *(const bf16x8*)(SGW + ((size_t)g * 128 + 32 * tt + r) * 128 + 16 * ks + 8 * half);
                acc[tt][0] = mfma32(Vf[0], Wf, acc[tt][0]); acc[tt][1] = mfma32(Vf[1], Wf, acc[tt][1]); }
        }
        asm volatile("s_nop 15\n\ts_nop 7" : "+v"(acc[0][0]), "+v"(acc[0][1]), "+v"(acc[1][0]), "+v"(acc[1][1]), "+v"(acc[2][0]), "+v"(acc[2][1]), "+v"(acc[3][0]), "+v"(acc[3][1]));
#pragma unroll
        for (int tt = 0; tt < 4; ++tt) { const int t = 32 * tt + r; const float bias = sgb[g * 128 + t];
#pragma unroll
            for (int dt = 0; dt < 2; ++dt)
#pragma unroll
                for (int ig = 0; ig < 4; ++ig) { bf16* up = BU + (size_t)(tok0 + t) * 512 + g * 128 + dh * 64 + dt * 32 + 8 * ig + 4 * half;
                    const u32x2 uw = *(const u32x2*)up;
                    const float y0 = mk_gelu(mk_lo(uw.x)) * (acc[tt][dt][4 * ig + 0] + bias), y1 = mk_gelu(mk_hi(uw.x)) * (acc[tt][dt][4 * ig + 1] + bias);
                    const float y2 = mk_gelu(mk_lo(uw.y)) * (acc[tt][dt][4 * ig + 2] + bias), y3 = mk_gelu(mk_hi(uw.y)) * (acc[tt][dt][4 * ig + 3] + bias);
                    u32x2 o; o.x = mk_pk2(y0, y1); o.y = mk_pk2(y2, y3); *(u32x2*)up = o; } }
        __syncthreads();
    }
}

DI void phase_attn(const Params& p, int l, LAS unsigned char* lds, int tid, int lane, int wave, int G, bf16* OUTP) {
    const bf16* CQ = (const bf16*)(p.ws + WS_P + 5 * PBUF); const bf16* CK = (const bf16*)(p.ws + WS_P + 6 * PBUF); const bf16* VT = (const bf16*)(p.ws + WS_P + 8 * PBUF);
    const float lam_init = 0.8f - 0.6f * expf(-0.3f * (float)l);
    const float* lq = p.in[I_LAMQK] + l * 256;
    const float lam = expf(wave_sum(lq[lane] * lq[64 + lane])) - expf(wave_sum(lq[128 + lane] * lq[192 + lane])) + lam_init;
    const float* sg = p.in[I_SUBLN] + l * 128;
    const int m = wave & 1, sub = wave >> 1, r = lane & 31, half = lane >> 5;
    constexpr int KROW = 144, VROW = 136, KBYTES = 64 * KROW  , VOFF = 2 * KBYTES  , STAGE = VOFF + 128 * KROW  ;
    const float cs = 0.125f * 1.44269504089f;
    for (int pi = blockIdx.x; pi < 512; pi += G) {
#pragma unroll 1
        for (int uu = 0; uu < 2; ++uu) {
            const int bh = pi >> 4, jp = pi & 15, qb = uu ? 31 - jp : jp, b = bh >> 2, h = bh & 3;
            const int tokq0 = b * SEQ + qb * 128, qrow = tokq0 + 32 * sub + r;
            bf16x8 Qf[4];
#pragma unroll
            for (int ks = 0; ks < 4; ++ks) Qf[ks] = *(const bf16x8*)(CQ + (size_t)qrow * 512 + h * 128 + m * 64 + 16 * ks + 8 * half);
            const int nt = 2 * qb + 2, my_last = 2 * qb + (sub >> 1);
            const bf16* kg[2]; const bf16* vg[2]; int kl[2], vl[2];
#pragma unroll
            for (int i = 0; i < 2; ++i) { const int idx = tid + 512 * i; const int key = idx >> 4, c16 = idx & 15;
                kg[i] = CK + (size_t)(b * SEQ + key) * 512 + h * 128 + c16 * 8; kl[i] = (c16 >> 3) * KBYTES + key * KROW + (c16 & 7) * 16;
                const int dv = idx >> 3, c8 = idx & 7;
                vg[i] = VT + (size_t)(h * 128 + dv) * TOK + b * SEQ + c8 * 8; vl[i] = VOFF + dv * VROW + c8 * 16; }
            u32x4 st[4];
            st[0] = *(const u32x4*)kg[0]; st[1] = *(const u32x4*)kg[1]; st[2] = *(const u32x4*)vg[0]; st[3] = *(const u32x4*)vg[1];
            *(LAS u32x4*)(lds + kl[0]) = st[0]; *(LAS u32x4*)(lds + kl[1]) = st[1]; *(LAS u32x2*)(lds + vl[0]) = (u32x2){st[2].x, st[2].y}; *(LAS u32x2*)(lds + vl[0] + 8) = (u32x2){st[2].z, st[2].w}; *(LAS u32x2*)(lds + vl[1]) = (u32x2){st[3].x, st[3].y}; *(LAS u32x2*)(lds + vl[1] + 8) = (u32x2){st[3].z, st[3].w};
            __syncthreads();
            f32x16 O[4];
#pragma unroll
            for (int i = 0; i < 4; ++i) O[i] = zero16();
            float m_run = -INFINITY, l_run = 0.f;
#pragma unroll 1
            for (int kt = 0; kt < nt; ++kt) {
                const bool more = (kt + 1 < nt);
                if (more) { const size_t ko = (size_t)(kt + 1) * 64 * 512, vo = (size_t)(kt + 1) * 64;
                    st[0] = *(const u32x4*)(kg[0] + ko); st[1] = *(const u32x4*)(kg[1] + ko); st[2] = *(const u32x4*)(vg[0] + vo); st[3] = *(const u32x4*)(vg[1] + vo); }
                const LAS unsigned char* buf = lds + (kt & 1) * STAGE;
                if (kt <= my_last) {
                    f32x16 S[2];
#pragma unroll
                    for (int u = 0; u < 2; ++u) { S[u] = zero16();
#pragma unroll
                        for (int ks = 0; ks < 4; ++ks) { const bf16x8 A = *(const LAS bf16x8*)(buf + m * KBYTES + (32 * u + r) * KROW + (16 * ks + 8 * half) * 2); S[u] = mfma32(A, Qf[ks], S[u]); } }
                    asm volatile("s_nop 15\n\ts_nop 7" : "+v"(S[0]), "+v"(S[1]));
                    float mx = -INFINITY;
#pragma unroll
                    for (int u = 0; u < 2; ++u)
#pragma unroll
                        for (int i = 0; i < 16; ++i) mx = fmaxf(mx, S[u][i]);
                    mx = fmaxf(mx, __shfl_xor(mx, 32));
                    const float m_new = fmaxf(m_run, mx * cs), alpha = __builtin_amdgcn_exp2f(m_run - m_new);
                    float ps = 0.f;
#pragma unroll
                    for (int u = 0; u < 2; ++u)
#pragma unroll
                        for (int i = 0; i < 16; ++i) { const float e = __builtin_amdgcn_exp2f(S[u][i] * cs - m_new); S[u][i] = e; ps += e; }
                    ps += __shfl_xor(ps, 32);
                    l_run = l_run * alpha + ps; m_run = m_new;
#pragma unroll
                    for (int d = 0; d < 4; ++d)
#pragma unroll
                        for (int i = 0; i < 16; ++i) O[d][i] *= alpha;
                    bf16x8 Pf[2][2];
#pragma unroll
                    for (int u = 0; u < 2; ++u)
#pragma unroll
                        for (int s = 0; s < 2; ++s) { u32x4 w; w.x = mk_pk2(S[u][8 * s + 0], S[u][8 * s + 1]); w.y = mk_pk2(S[u][8 * s + 2], S[u][8 * s + 3]); w.z = mk_pk2(S[u][8 * s + 4], S[u][8 * s + 5]); w.w = mk_pk2(S[u][8 * s + 6], S[u][8 * s + 7]);
                            Pf[u][s] = __builtin_bit_cast(bf16x8, w); }
#pragma unroll
                    for (int d = 0; d < 4; ++d)
#pragma unroll
                        for (int u = 0; u < 2; ++u)
#pragma unroll
                            for (int s = 0; s < 2; ++s) { const LAS unsigned char* va = buf + VOFF + (32 * d + r) * VROW + (32 * u + 16 * s + 4 * half) * 2;
                                const u32x2 lo = *(const LAS u32x2*)va, hi = *(const LAS u32x2*)(va + 16);
                                u32x4 w; w.x = lo.x; w.y = lo.y; w.z = hi.x; w.w = hi.y;
                                O[d] = mfma32(__builtin_bit_cast(bf16x8, w), Pf[u][s], O[d]); }
                }
                if (more) { LAS unsigned char* nb = lds + ((kt + 1) & 1) * STAGE;
                    *(LAS u32x4*)(nb + kl[0]) = st[0]; *(LAS u32x4*)(nb + kl[1]) = st[1]; *(LAS u32x2*)(nb + vl[0]) = (u32x2){st[2].x, st[2].y}; *(LAS u32x2*)(nb + vl[0] + 8) = (u32x2){st[2].z, st[2].w}; *(LAS u32x2*)(nb + vl[1]) = (u32x2){st[3].x, st[3].y}; *(LAS u32x2*)(nb + vl[1] + 8) = (u32x2){st[3].z, st[3].w}; }
                __syncthreads();
            }
            asm volatile("s_nop 15\n\ts_nop 7" : "+v"(O[0]), "+v"(O[1]), "+v"(O[2]), "+v"(O[3]));
            const float inv = 1.0f / l_run;
            LAS float* Cb = (LAS float*)lds;
            if (m == 1) { const float f = inv * lam;
#pragma unroll
                for (int d = 0; d < 4; ++d)
#pragma unroll
                    for (int i = 0; i < 16; ++i) Cb[(sub * 128 + 32 * d + crow(i, half)) * 33 + r] = O[d][i] * f; }
            __syncthreads();
            if (m == 0) { float ss = 0.f;
#pragma unroll
                for (int d = 0; d < 4; ++d)
#pragma unroll
                    for (int i = 0; i < 16; ++i) { const float o = O[d][i] * inv - Cb[(sub * 128 + 32 * d + crow(i, half)) * 33 + r]; O[d][i] = o; ss += o * o; }
                ss += __shfl_xor(ss, 32);
                const float rs = rsqrtf(ss * (1.0f / 128.0f) + 1e-5f) * (1.0f - lam_init);
#pragma unroll
                for (int d = 0; d < 4; ++d)
#pragma unroll
                    for (int ig = 0; ig < 4; ++ig) { const int dv0 = 32 * d + 8 * ig + 4 * half; const f32x4 gn = *(const f32x4*)(sg + dv0);
                        u32x2 w; w.x = mk_pk2(O[d][4 * ig + 0] * rs * gn[0], O[d][4 * ig + 1] * rs * gn[1]); w.y = mk_pk2(O[d][4 * ig + 2] * rs * gn[2], O[d][4 * ig + 3] * rs * gn[3]);
                        *(u32x2*)(OUTP + (size_t)qrow * 512 + h * 128 + dv0) = w; } }
            __syncthreads();
        }
    }
}

template <bool PRODUCER> DI void attn2_unit(const bf16* CQ, const bf16* CK, const bf16* VT, bf16* OUTP, const float* sg, float lam, float lam_init, LAS unsigned char* lds, int tid, int lane, int sub, int b, int h, int qb) {
    const int r = lane & 31, half = lane >> 5;
    constexpr int KROW = 144, VROW = 136, KB1 = 64 * KROW, KST = 2 * KB1  , VST = 128 * VROW  ;
    constexpr int OFF_K = 0, OFF_V = 2 * KST  , OFF_P = OFF_V + 2 * VST  , PST = 32768, OFF_A = OFF_P + 2 * PST  , AST = 1024, OFF_L = 139392;
    const float cs = 0.125f * 1.44269504089f;
            const int tokq0 = b * SEQ + qb * 128, qrow = tokq0 + 32 * sub + r;
            const int nt = 2 * qb + 2, my_last = 2 * qb + (sub >> 1);
            const bf16* kg[2]; const bf16* vg[2]; int kl[2], vl[2];
#pragma unroll
            for (int i = 0; i < 2; ++i) { const int idx = tid + 512 * i; const int key = idx >> 4, c16 = idx & 15;
                kg[i] = CK + (size_t)(b * SEQ + key) * 512 + h * 128 + c16 * 8; kl[i] = OFF_K + (c16 >> 3) * KB1 + key * KROW + (c16 & 7) * 16;
                const int dv = idx >> 3, c8 = idx & 7;
                vg[i] = VT + (size_t)(h * 128 + dv) * TOK + b * SEQ + c8 * 8; vl[i] = OFF_V + dv * VROW + c8 * 16; }
            bf16x8 Qf[2][4];
            f32x16 O[2][4];
            float m_run[2] = {-INFINITY, -INFINITY}, l_run[2] = {0.f, 0.f};
            if (PRODUCER) {
#pragma unroll
                for (int m = 0; m < 2; ++m)
#pragma unroll
                    for (int ks = 0; ks < 4; ++ks) Qf[m][ks] = *(const bf16x8*)(CQ + (size_t)qrow * 512 + h * 128 + m * 64 + 16 * ks + 8 * half);
            } else {
#pragma unroll
                for (int m = 0; m < 2; ++m)
#pragma unroll
                    for (int d = 0; d < 4; ++d) O[m][d] = zero16();
            }
            u32x4 sk[2], sv[2];
            sk[0] = *(const u32x4*)kg[0]; sk[1] = *(const u32x4*)kg[1];
            *(LAS u32x4*)(lds + kl[0]) = sk[0]; *(LAS u32x4*)(lds + kl[1]) = sk[1];
            __syncthreads();
#pragma unroll 1
            for (int i = 0; i <= nt; ++i) {
                const bool ldk = (i + 1 < nt), ldv = (i < nt);
                if (ldk) { const size_t ko = (size_t)(i + 1) * 64 * 512; sk[0] = *(const u32x4*)(kg[0] + ko); sk[1] = *(const u32x4*)(kg[1] + ko); }
                if (ldv) { const size_t vo = (size_t)i * 64; sv[0] = *(const u32x4*)(vg[0] + vo); sv[1] = *(const u32x4*)(vg[1] + vo); }
                if (PRODUCER) {
                    if (i < nt && i <= my_last) {
                        const LAS unsigned char* kb = lds + OFF_K + (i & 1) * KST;
                        LAS unsigned char* pb = lds + OFF_P + (i & 1) * PST + (sub * 2) * 4096 + lane * 16;
                        LAS float* ab = (LAS float*)(lds + OFF_A + (i & 1) * AST) + (sub * 2) * 32 + r;
#pragma unroll
                        for (int m = 0; m < 2; ++m) {
                            f32x16 S[2];
#pragma unroll
                            for (int u = 0; u < 2; ++u) { S[u] = zero16();
#pragma unroll
                                for (int ks = 0; ks < 4; ++ks) { const bf16x8 A = *(const LAS bf16x8*)(kb + m * KB1 + (32 * u + r) * KROW + (16 * ks + 8 * half) * 2); S[u] = mfma32(A, Qf[m][ks], S[u]); } }
                            asm volatile("s_nop 15\n\ts_nop 7" : "+v"(S[0]), "+v"(S[1]));
                            float mx = -INFINITY;
#pragma unroll
                            for (int u = 0; u < 2; ++u)
#pragma unroll
                                for (int k = 0; k < 16; ++k) mx = fmaxf(mx, S[u][k]);
                            mx = fmaxf(mx, __shfl_xor(mx, 32));
                            const float m_new = fmaxf(m_run[m], mx * cs), alpha = __builtin_amdgcn_exp2f(m_run[m] - m_new);
                            float ps = 0.f;
#pragma unroll
                            for (int u = 0; u < 2; ++u)
#pragma unroll
                                for (int k = 0; k < 16; ++k) { const float e = __builtin_amdgcn_exp2f(S[u][k] * cs - m_new); S[u][k] = e; ps += e; }
                            ps += __shfl_xor(ps, 32);
                            l_run[m] = l_run[m] * alpha + ps; m_run[m] = m_new;
                            if (half == 0) ab[m * 32] = alpha;
#pragma unroll
                            for (int u = 0; u < 2; ++u)
#pragma unroll
                                for (int s = 0; s < 2; ++s) { u32x4 w; w.x = mk_pk2(S[u][8 * s + 0], S[u][8 * s + 1]); w.y = mk_pk2(S[u][8 * s + 2], S[u][8 * s + 3]); w.z = mk_pk2(S[u][8 * s + 4], S[u][8 * s + 5]); w.w = mk_pk2(S[u][8 * s + 6], S[u][8 * s + 7]);
                                    *(LAS u32x4*)(pb + m * 4096 + (u * 2 + s) * 1024) = w; }
                        }
                    }
                } else {
                    const int j = i - 1;
                    if (j >= 0 && j <= my_last) {
                        const LAS unsigned char* vb = lds + OFF_V + (j & 1) * VST;
                        const LAS unsigned char* pb = lds + OFF_P + (j & 1) * PST + (sub * 2) * 4096 + lane * 16;
                        const LAS float* ab = (const LAS float*)(lds + OFF_A + (j & 1) * AST) + (sub * 2) * 32 + r;
                        const float a0 = ab[0], a1 = ab[32];
#pragma unroll
                        for (int d = 0; d < 4; ++d)
#pragma unroll
                            for (int k = 0; k < 16; ++k) { O[0][d][k] *= a0; O[1][d][k] *= a1; }
#pragma unroll
                        for (int q = 0; q < 4; ++q) { const bf16x8 P0 = *(const LAS bf16x8*)(pb + q * 1024), P1 = *(const LAS bf16x8*)(pb + 4096 + q * 1024);
#pragma unroll
                            for (int d = 0; d < 4; ++d) { const LAS unsigned char* va = vb + (32 * d + r) * VROW + (16 * q + 4 * half) * 2;
                                const u32x2 lo = *(const LAS u32x2*)va, hi = *(const LAS u32x2*)(va + 16);
                                u32x4 w; w.x = lo.x; w.y = lo.y; w.z = hi.x; w.w = hi.y; const bf16x8 Vf = __builtin_bit_cast(bf16x8, w);
                                O[0][d] = mfma32(Vf, P0, O[0][d]); O[1][d] = mfma32(Vf, P1, O[1][d]); } }
                    }
                }
                if (ldk) { LAS unsigned char* nb = lds + ((i + 1) & 1) * KST; *(LAS u32x4*)(nb + kl[0]) = sk[0]; *(LAS u32x4*)(nb + kl[1]) = sk[1]; }
                if (ldv) { LAS unsigned char* nb = lds + (i & 1) * VST;
                    *(LAS u32x2*)(nb + vl[0]) = (u32x2){sv[0].x, sv[0].y}; *(LAS u32x2*)(nb + vl[0] + 8) = (u32x2){sv[0].z, sv[0].w}; *(LAS u32x2*)(nb + vl[1]) = (u32x2){sv[1].x, sv[1].y}; *(LAS u32x2*)(nb + vl[1] + 8) = (u32x2){sv[1].z, sv[1].w}; }
                __syncthreads();
            }
            LAS float* Lb = (LAS float*)(lds + OFF_L) + (sub * 2) * 32 + r;
            if (PRODUCER && half == 0) { Lb[0] = l_run[0]; Lb[32] = l_run[1]; }
            __syncthreads();
            if (!PRODUCER) {
                asm volatile("s_nop 15\n\ts_nop 7" : "+v"(O[0][0]), "+v"(O[0][1]), "+v"(O[0][2]), "+v"(O[0][3]), "+v"(O[1][0]), "+v"(O[1][1]), "+v"(O[1][2]), "+v"(O[1][3]));
                const float inv0 = 1.0f / Lb[0], inv1 = lam / Lb[32];
                float ss = 0.f;
#pragma unroll
                for (int d = 0; d < 4; ++d)
#pragma unroll
                    for (int k = 0; k < 16; ++k) { const float o = O[0][d][k] * inv0 - O[1][d][k] * inv1; O[0][d][k] = o; ss += o * o; }
                ss += __shfl_xor(ss, 32);
                const float rs = rsqrtf(ss * (1.0f / 128.0f) + 1e-5f) * (1.0f - lam_init);
#pragma unroll
                for (int d = 0; d < 4; ++d)
#pragma unroll
                    for (int ig = 0; ig < 4; ++ig) { const int dv0 = 32 * d + 8 * ig + 4 * half; const f32x4 gn = *(const f32x4*)(sg + dv0);
                        u32x2 w; w.x = mk_pk2(O[0][d][4 * ig + 0] * rs * gn[0], O[0][d][4 * ig + 1] * rs * gn[1]); w.y = mk_pk2(O[0][d][4 * ig + 2] * rs * gn[2], O[0][d][4 * ig + 3] * rs * gn[3]);
                        *(u32x2*)(OUTP + (size_t)qrow * 512 + h * 128 + dv0) = w; }
            }
            __syncthreads();
}
DI void phase_attn2(const Params& p, int l, LAS unsigned char* lds, int tid, int lane, int wave, int G, bf16* OUTP) {
    const bf16* CQ = (const bf16*)(p.ws + WS_P + 5 * PBUF); const bf16* CK = (const bf16*)(p.ws + WS_P + 6 * PBUF); const bf16* VT = (const bf16*)(p.ws + WS_P + 8 * PBUF);
    const float lam_init = 0.8f - 0.6f * expf(-0.3f * (float)l);
    const float* lq = p.in[I_LAMQK] + l * 256;
    const float lam = expf(wave_sum(lq[lane] * lq[64 + lane])) - expf(wave_sum(lq[128 + lane] * lq[192 + lane])) + lam_init;
    const float* sg = p.in[I_SUBLN] + l * 128;
    const bool producer = wave < 4; const int sub = wave & 3;
    for (int pi0 = blockIdx.x; pi0 < 512; pi0 += G) {
        const int pi = (G == 256) ? (((int)blockIdx.x & 7) * 64 + (pi0 >> 8) * 32 + ((int)blockIdx.x >> 3)) : pi0;
#pragma unroll 1
        for (int uu = 0; uu < 2; ++uu) {
            const int bh = pi >> 4, jp = pi & 15, qb = uu ? 31 - jp : jp, b = bh >> 2, h = bh & 3;
            if (producer) attn2_unit<true>(CQ, CK, VT, OUTP, sg, lam, lam_init, lds, tid, lane, sub, b, h, qb);
            else attn2_unit<false>(CQ, CK, VT, OUTP, sg, lam, lam_init, lds, tid, lane, sub, b, h, qb);
        }
    }
}

template <bool P2> DI void phase_ssm(const Params& p, int l, LAS unsigned char* lds, int lane, int wave, int G) {
    const bf16* DU = (const bf16*)(p.ws + WS_P + 7 * PBUF); bf16* YG = (bf16*)(p.ws + WS_YG); float* E = (float*)(p.ws + WS_E);
    const bf16* BB = (const bf16*)(p.ws + WS_BB) + (size_t)l * 32 * 128 * 16; const bf16* CM = (const bf16*)(p.ws + WS_CM) + (size_t)l * 32 * 16 * 128;
    const float* AP = (const float*)(p.ws + WS_AP) + (size_t)l * 32 * 64 * 8; const float* dsk = p.in[I_SSMD] + l * 512;
    const int r = lane & 31, half = lane >> 5, r16 = lane & 15, q4 = lane >> 4;
    constexpr int XRS = 272;
    LAS unsigned char* Xs = lds + wave * (64 * XRS);
    for (int it = blockIdx.x * 8 + wave; it < 16384; it += G * 8) {
        const int c = it & 63, g = (it >> 6) & 31, b = it >> 11, tok0 = b * SEQ + c * 64;
        const int ch = g * 16 + r16; float dk = 0.f; bf16x8 Cf[4]; float uu[4][4];
        if (P2) { dk = dsk[ch];
#pragma unroll
            for (int mt = 0; mt < 4; ++mt)
#pragma unroll
                for (int j = 0; j < 4; ++j) uu[mt][j] = bf2f(DU[(size_t)(tok0 + 16 * mt + 4 * q4 + j) * 512 + ch]); }
        f32x16 X[4][2];
        { bf16x8 Uf[2], Bf[4];
#pragma unroll
            for (int tt = 0; tt < 2; ++tt) { const int tau = 32 * ((r >> 2) & 1) + 16 * tt + (r & 3) + 4 * (r >> 3); Uf[tt] = *(const bf16x8*)(DU + (size_t)(tok0 + tau) * 512 + g * 16 + 8 * half); }
#pragma unroll
            for (int pt = 0; pt < 4; ++pt) Bf[pt] = *(const bf16x8*)(BB + ((size_t)g * 128 + 32 * pt + r) * 16 + 8 * half);
#pragma unroll
            for (int pt = 0; pt < 4; ++pt)
#pragma unroll
                for (int tt = 0; tt < 2; ++tt) X[pt][tt] = mfma32(Uf[tt], Bf[pt], zero16()); }
        asm volatile("s_nop 15\n\ts_nop 15" : "+v"(X[0][0]), "+v"(X[0][1]), "+v"(X[1][0]), "+v"(X[1][1]), "+v"(X[2][0]), "+v"(X[2][1]), "+v"(X[3][0]), "+v"(X[3][1]));
        float ar[2], ai[2], a32r[2], a32i[2], a64r[2], a64i[2];
#pragma unroll
        for (int s = 0; s < 2; ++s) { const float* ap = AP + ((size_t)g * 64 + 32 * s + r) * 8; const f32x4 v = *(const f32x4*)ap; ar[s] = v[0]; ai[s] = v[1]; a32r[s] = v[2]; a32i[s] = v[3]; a64r[s] = ap[4]; a64i[s] = ap[5]; }
        float xr[2] = {0.f, 0.f}, xi[2] = {0.f, 0.f};
        if (P2) {
            const float* e0 = E + (((size_t)(b * 32 + g) * 64) * 64 + r) * 2;
            float sr0 = 0.f, si0 = 0.f, sr1 = 0.f, si1 = 0.f;
#pragma unroll 4
            for (int j = 0; j < c; ++j) { const float2 ea = *(const float2*)(e0 + (size_t)j * 128), eb = *(const float2*)(e0 + (size_t)j * 128 + 64);
                const float t0 = a64r[0] * sr0 - a64i[0] * si0 + ea.x; si0 = a64r[0] * si0 + a64i[0] * sr0 + ea.y; sr0 = t0;
                const float t1 = a64r[1] * sr1 - a64i[1] * si1 + eb.x; si1 = a64r[1] * si1 + a64i[1] * sr1 + eb.y; sr1 = t1; }
            if (half == 0) { xr[0] = sr0; xi[0] = si0; xr[1] = sr1; xi[1] = si1; }
        }
#pragma unroll
        for (int s = 0; s < 2; ++s)
#pragma unroll
            for (int tt = 0; tt < 2; ++tt)
#pragma unroll
                for (int i = 0; i < 16; ++i) { const float nr = ar[s] * xr[s] - ai[s] * xi[s] + X[s][tt][i], ni = ar[s] * xi[s] + ai[s] * xr[s] + X[2 + s][tt][i]; X[s][tt][i] = nr; X[2 + s][tt][i] = ni; xr[s] = nr; xi[s] = ni; }
        float oxr[2], oxi[2];
#pragma unroll
        for (int s = 0; s < 2; ++s) { oxr[s] = __shfl_xor(xr[s], 32); oxi[s] = __shfl_xor(xi[s], 32); }
        if (!P2) {
            if (half == 1) {
#pragma unroll
                for (int s = 0; s < 2; ++s) { float2 e; e.x = xr[s] + a32r[s] * oxr[s] - a32i[s] * oxi[s]; e.y = xi[s] + a32r[s] * oxi[s] + a32i[s] * oxr[s];
                    *(float2*)(E + (((size_t)(b * 32 + g) * 64 + c) * 64 + 32 * s + r) * 2) = e; } }
        } else {
#pragma unroll
            for (int s = 0; s < 2; ++s) { float wr_ = half ? oxr[s] : 0.f, wi_ = half ? oxi[s] : 0.f;
#pragma unroll
                for (int tt = 0; tt < 2; ++tt)
#pragma unroll
                    for (int i = 0; i < 16; ++i) { const float t = ar[s] * wr_ - ai[s] * wi_; wi_ = ar[s] * wi_ + ai[s] * wr_; wr_ = t; X[s][tt][i] += wr_; X[2 + s][tt][i] += wi_; } }
#pragma unroll
            for (int pt = 0; pt < 4; ++pt)
#pragma unroll
                for (int tt = 0; tt < 2; ++tt)
#pragma unroll
                    for (int i = 0; i < 16; ++i) *(LAS unsigned short*)(Xs + (32 * half + 16 * tt + i) * XRS + (32 * pt + r) * 2) = f2bf(X[pt][tt][i]);
#pragma unroll
            for (int ks = 0; ks < 4; ++ks) Cf[ks] = *(const bf16x8*)(CM + ((size_t)g * 16 + r16) * 128 + 32 * ks + 8 * q4);
            LDS_WAIT();
#pragma unroll
            for (int mt = 0; mt < 4; ++mt) { f32x4 acc = {0.f, 0.f, 0.f, 0.f};
#pragma unroll
                for (int ks = 0; ks < 4; ++ks) { const bf16x8 A = *(const LAS bf16x8*)(Xs + (16 * mt + r16) * XRS + (32 * ks + 8 * q4) * 2); acc = mfma16(A, Cf[ks], acc); }
                asm volatile("s_nop 15" : "+v"(acc));
#pragma unroll
                for (int j = 0; j < 4; ++j) { const size_t o = (size_t)(tok0 + 16 * mt + 4 * q4 + j) * 512 + ch; const float y = acc[j] + dk * uu[mt][j]; YG[o] = f2bf(mk_gelu(y)); } }
            LDS_WAIT();
        }
    }
}

DI void phase_ssm1(const Params& p, int l, int lane, int wave, int G) {
    const bf16* DU = (const bf16*)(p.ws + WS_P + 7 * PBUF); float* E = (float*)(p.ws + WS_E);
    const bf16* BB = (const bf16*)(p.ws + WS_BB) + (size_t)l * 32 * 128 * 16;
    const float* AP = (const float*)(p.ws + WS_AP) + (size_t)l * 32 * 64 * 8;
    const int r = lane & 31, half = lane >> 5;
    const int tau0 = 32 * ((r >> 2) & 1) + (r & 3) + 4 * (r >> 3);
    const int step = G * 8; int it = blockIdx.x * 8 + wave;
    bf16x8 Uf[2], Bf[4]; f32x4 apv[2];
#define SSM1_LOAD(IT) do { const int c_ = (IT) & 63, g_ = ((IT) >> 6) & 31, b_ = (IT) >> 11; const size_t t0_ = (size_t)(b_ * SEQ + c_ * 64 + tau0) * 512 + g_ * 16 + 8 * half; \
        Uf[0] = *(const bf16x8*)(DU + t0_); Uf[1] = *(const bf16x8*)(DU + t0_ + (size_t)16 * 512); \
        _Pragma("unroll") for (int pt = 0; pt < 4; ++pt) Bf[pt] = *(const bf16x8*)(BB + ((size_t)g_ * 128 + 32 * pt + r) * 16 + 8 * half); \
        _Pragma("unroll") for (int s = 0; s < 2; ++s) apv[s] = *(const f32x4*)(AP + ((size_t)g_ * 64 + 32 * s + r) * 8); } while (0)
    if (it < 16384) SSM1_LOAD(it);
    for (; it < 16384; it += step) {
        const int c = it & 63, g = (it >> 6) & 31, b = it >> 11;
        f32x16 X[4][2];
#pragma unroll
        for (int pt = 0; pt < 4; ++pt)
#pragma unroll
            for (int tt = 0; tt < 2; ++tt) X[pt][tt] = mfma32(Uf[tt], Bf[pt], zero16());
        float ar[2], ai[2], a32r[2], a32i[2];
#pragma unroll
        for (int s = 0; s < 2; ++s) { ar[s] = apv[s][0]; ai[s] = apv[s][1]; a32r[s] = apv[s][2]; a32i[s] = apv[s][3]; }
        asm volatile("s_nop 15\n\ts_nop 15" : "+v"(X[0][0]), "+v"(X[0][1]), "+v"(X[1][0]), "+v"(X[1][1]), "+v"(X[2][0]), "+v"(X[2][1]), "+v"(X[3][0]), "+v"(X[3][1]));
        if (it + step < 16384) SSM1_LOAD(it + step);
#pragma unroll
        for (int s = 0; s < 2; ++s) { float xr = 0.f, xi = 0.f;
#pragma unroll
            for (int tt = 0; tt < 2; ++tt)
#pragma unroll
                for (int k = 0; k < 16; ++k) { const float nr = ar[s] * xr - ai[s] * xi + X[s][tt][k], ni = ar[s] * xi + ai[s] * xr + X[2 + s][tt][k]; xr = nr; xi = ni; }
            const float oxr = __shfl_xor(xr, 32), oxi = __shfl_xor(xi, 32);
            if (half == 1) { float2 e; e.x = xr + a32r[s] * oxr - a32i[s] * oxi; e.y = xi + a32r[s] * oxi + a32i[s] * oxr;
                *(float2*)(E + (((size_t)(b * 32 + g) * 64 + c) * 64 + 32 * s + r) * 2) = e; } }
    }
#undef SSM1_LOAD
}

DI void phase_final(const Params& p, int tid, int G) {
    const pg8::rowss_t* rowss = (const pg8::rowss_t*)(p.ws + WS_ROWSS) + (size_t)4 * TOK; const float* gf = p.in[I_GFIN]; float* out = p.out; const bf16* xb = (const bf16*)(p.ws + WS_XB);
    for (size_t i = (size_t)blockIdx.x * NTHR + tid; i < (size_t)TOK * 128; i += (size_t)G * NTHR) { const int row = (int)(i >> 7), c8 = (int)(i & 127);
        const float rs = pg8::rstd_row(rowss, row); f32x4 v0, v1; pg8::unpack8(*((const u32x4*)xb + i), v0, v1);
        const f32x4 g0 = *((const f32x4*)gf + 2 * c8), g1 = *((const f32x4*)gf + 2 * c8 + 1);
        *((f32x4*)out + 2 * i) = v0 * rs * g0; *((f32x4*)out + 2 * i + 1) = v1 * rs * g1; }
}

#define XB_TMO      128
#define XB_XCNT(j)  (256  + 64 * (j))
#define XB_XSUB(j)  (1280 + 64 * (j))
#define XB_XGEN(j)  (2304 + 64 * (j))
#define XB_TOP      3328
#define XB_TOPGEN   3392
#define XCD_BAR_WORDS 3456
#define XB_SPIN_CAP (1u << 18)

__device__ __forceinline__ unsigned xb_ld(unsigned* p)              { return __hip_atomic_load(p, __ATOMIC_RELAXED, __HIP_MEMORY_SCOPE_AGENT); }
__device__ __forceinline__ unsigned xb_add(unsigned* p, unsigned v) { return __hip_atomic_fetch_add(p, v, __ATOMIC_RELAXED, __HIP_MEMORY_SCOPE_AGENT); }
__device__ __forceinline__ unsigned xb_xcc_id() { return (unsigned)__builtin_amdgcn_s_getreg((3 << 11) | 20) & 0xFu; }
#define XB_SPIN(cond, bar) do { unsigned _sp = 0; while (cond) { __builtin_amdgcn_s_sleep(1); \
    if ((++_sp & 255u) == 0u) { if (xb_ld(&(bar)[XB_TMO])) break; if (_sp > XB_SPIN_CAP) { atomicAdd(&(bar)[XB_TMO], 1u); break; } } } } while (0)

struct XcdBarrier {
    unsigned* bar; unsigned x;
    volatile LAS unsigned* st;
};

__device__ __forceinline__ XcdBarrier xcd_barrier_post(unsigned* bar, volatile LAS unsigned* st) {
    XcdBarrier b; b.bar = bar; b.x = xb_xcc_id(); b.st = st;
    if (threadIdx.x == 0) (void)xb_add(&bar[XB_XCNT(b.x)], 1u);
    return b;
}
__device__ __forceinline__ void xcd_barrier_complete(unsigned* bar, unsigned x, unsigned& nloc, unsigned& nx) {
    const unsigned G = gridDim.x * gridDim.y * gridDim.z;
    unsigned sum, cnt, mine, sp = 0u;
    for (;;) {
        sum = 0u; cnt = 0u; mine = 0u;
#pragma unroll
        for (unsigned j = 0; j < 16; ++j) { const unsigned c = xb_ld(&bar[XB_XCNT(j)]); sum += c; cnt += (c > 0u) ? 1u : 0u; mine = (j == x) ? c : mine; }
        if (sum == G) break;
        __builtin_amdgcn_s_sleep(1);
        if ((++sp & 255u) == 0u) { if (xb_ld(&bar[XB_TMO])) break; if (sp > XB_SPIN_CAP) { atomicAdd(&bar[XB_TMO], 1u); break; } }
    }
    nloc = mine > 0u ? mine : 1u; nx = cnt > 0u ? cnt : 1u;
}

__device__ __forceinline__ void xcd_barrier(const XcdBarrier& b) {
    asm volatile("s_waitcnt vmcnt(0)" ::: "memory");
    __syncthreads();
    if (threadIdx.x == 0) {
        unsigned* bar = b.bar;
        __builtin_amdgcn_s_waitcnt(0);
        unsigned nloc = b.st[0], nx = b.st[1];
        if (nloc == 0u) { xcd_barrier_complete(bar, b.x, nloc, nx); b.st[0] = nloc; b.st[1] = nx; }
        const unsigned old = xb_add(&bar[XB_XSUB(b.x)], 1u);
        const unsigned gen = old / nloc;
        if (old + 1u == (gen + 1u) * nloc) {
            __builtin_amdgcn_fence(__ATOMIC_RELEASE, "agent");
            asm volatile("s_waitcnt vmcnt(0)" ::: "memory");
            const unsigned og = xb_add(&bar[XB_TOP], 1u);
            const unsigned tg = og / nx;
            if (og + 1u == (tg + 1u) * nx) xb_add(&bar[XB_TOPGEN], 1u);
            else XB_SPIN(xb_ld(&bar[XB_TOPGEN]) == tg, bar);
            __builtin_amdgcn_fence(__ATOMIC_ACQUIRE, "agent");
            xb_add(&bar[XB_XGEN(b.x)], 1u);
            asm volatile("s_waitcnt vmcnt(0)" ::: "memory");
        } else {
            XB_SPIN(xb_ld(&bar[XB_XGEN(b.x)]) == gen, bar);
            __builtin_amdgcn_fence(__ATOMIC_ACQUIRE, "agent");
            asm volatile("s_waitcnt vmcnt(0)" ::: "memory");
        }
    }
    __syncthreads();
}


__global__ void __launch_bounds__(NTHR) mega(Params p) {
    extern __shared__ __attribute__((aligned(16))) unsigned char lds_raw[];
    LAS unsigned char* lds = (LAS unsigned char*)lds_raw;
    const int G = gridDim.x;
#define LAUNDER() int tid = threadIdx.x; asm volatile("" : "+v"(tid)); const int lane = tid & 63, wave = __builtin_amdgcn_readfirstlane(tid >> 6); (void)lane; (void)wave
    const int lo = p.ph_lo, hi = p.ph_hi;
    unsigned char* ws = p.ws;
    int ph = 0;
    volatile LAS unsigned* xb_st = (volatile LAS unsigned*)(lds + 139264);
    XcdBarrier xbar; xbar.bar = (unsigned*)(ws + WS_BAR); xbar.x = 0; xbar.st = xb_st;
    if (ONE_LAUNCH) { if (threadIdx.x < 4) xb_st[threadIdx.x] = 0u; __syncthreads(); xbar = xcd_barrier_post((unsigned*)(ws + WS_BAR), xb_st); }
#ifndef ONLY_KIND
#define ONLY_KIND -1
#endif
#define KEN(k) (ONLY_KIND < 0 || ONLY_KIND == (k))
#ifndef DUP
#define DUP 0
#endif
#define REP(bit) _Pragma("unroll 1") for (int rep_ = 0; rep_ < ((DUP & (bit)) ? 2 : 1); ++rep_)
#define IN_PH() (lo <= ph && ph < hi)
#define END_PH() do { if (ONE_LAUNCH && lo <= ph && ph + 1 < hi) { if (hi < 0) cg::this_grid().sync(); else xcd_barrier(xbar); } ++ph; } while (0)
    if (IN_PH() && KEN(0)) REP(128) { LAUNDER(); phase_prep(p, lds, tid, lane, wave, G); }
    END_PH();
    bf16* XB = (bf16*)(ws + WS_XB); pg8::rowss_t* rowss = (pg8::rowss_t*)(ws + WS_ROWSS);
    for (int l = 0; l < 2; ++l) {
        unsigned char* wl = ws + WS_W + (size_t)l * WL_SIZE;
        const bf16* WinT = (const bf16*)(wl + WL_IN);
        bf16* P0 = (bf16*)(ws + WS_P);
        const pg8::rowss_t* rs_mix = rowss + (size_t)(2 * l) * TOK; pg8::rowss_t* rs_ffn = rowss + (size_t)(2 * l + 1) * TOK; pg8::rowss_t* rs_next = rowss + (size_t)(2 * l + 2) * TOK;
        pg8::StaticOrder S;
        if (IN_PH()) REP(1) {
            if (KEN(1)) { pg8::Gemm g{XB, WinT, TOK, 4096, 1024}; S.init(TOK, 4096, G, (int)blockIdx.x); pg8::EpiProj E{P0, rs_mix}; pg8::gemm_phase<pg8::EpiProj, pg8::StaticOrder>(lds, g, S, E); }
            if (KEN(2)) { pg8::Gemm g{WinT + (size_t)4096 * 1024, XB, 512, TOK, 1024}; S.init(512, TOK, G, (int)blockIdx.x); pg8::EpiVT E{(bf16*)(ws + WS_P + 8 * PBUF), rs_mix}; pg8::gemm_phase<pg8::EpiVT, pg8::StaticOrder>(lds, g, S, E); }
        }
        END_PH();
        if (IN_PH()) { if (KEN(20)) REP(4) { LAUNDER(); phase_attn2(p, l, lds, tid, lane, wave, G, (DUP & 4) && rep_ == 0 ? (bf16*)(ws + WS_YG) : (bf16*)(ws + WS_P + 5 * PBUF)); } if (KEN(21)) { LAUNDER(); phase_branchB(p, l, lds, tid, lane, wave, G); } if (KEN(22)) REP(16) { LAUNDER(); phase_ssm1(p, l, lane, wave, G); } if (KEN(23)) { LAUNDER(); phase_branchA(p, l, tid, G); } }
        END_PH();
        if (IN_PH() && KEN(3)) REP(16) { LAUNDER(); phase_ssm<true>(p, l, lds, lane, wave, G); }
        END_PH();
        if (IN_PH() && KEN(4)) REP(64) { pg8::Gemm g{(const bf16*)(ws + WS_YG), (const bf16*)(wl + WL_GLU), TOK, 512, 512}; S.init(TOK, 512, G, (int)blockIdx.x);
            pg8::EpiGlu E{(const bf16*)(ws + WS_YG), (bf16*)(ws + WS_P + 7 * PBUF), p.in[I_BGLU] + l * 512}; pg8::gemm_phase<pg8::EpiGlu, pg8::StaticOrder>(lds, g, S, E); }
        END_PH();
        bf16* GS = (bf16*)(ws + WS_P + 1 * PBUF); bf16* MG = (bf16*)(ws + WS_P + 8 * PBUF);
        if (IN_PH() && KEN(5)) REP(8) {
#pragma unroll 1
            for (int b = 0; b < 4; ++b) {
                { pg8::Gemm g{XB, WinT + (size_t)(4608 + 1024 * b) * 1024, TOK, 1024, 1024}; S.init(TOK, 1024, G, (int)blockIdx.x); pg8::EpiGate E{GS, rs_mix}; pg8::gemm_phase<pg8::EpiGate, pg8::StaticOrder>(lds, g, S, E); }
                const size_t yb = (b == 0) ? 0 : (b == 1) ? 3 : (b == 2) ? 5 : 7;
                pg8::Gemm g{(const bf16*)(ws + WS_P + yb * PBUF), (const bf16*)(wl + WL_BR) + (size_t)b * 1024 * 512, TOK, 1024, 512}; S.init(TOK, 1024, G, (int)blockIdx.x);
                if (b == 0) { pg8::EpiBr<true> E{GS, MG}; pg8::gemm_phase<pg8::EpiBr<true>, pg8::StaticOrder>(lds, g, S, E); }
                else { pg8::EpiBr<false> E{GS, MG}; pg8::gemm_phase<pg8::EpiBr<false>, pg8::StaticOrder>(lds, g, S, E); }
            }
        }
        END_PH();
        if (IN_PH() && KEN(6)) { pg8::Gemm g{MG, (const bf16*)(wl + WL_O), TOK, 1024, 1024}; S.init(TOK, 1024, G, (int)blockIdx.x);
            if (l == 0) { pg8::EpiResidT<true> E{p.in[I_X], XB, rs_ffn}; pg8::gemm_phase<pg8::EpiResidT<true>, pg8::StaticOrder>(lds, g, S, E); }
            else { pg8::EpiResidT<false> E{nullptr, XB, rs_ffn}; pg8::gemm_phase<pg8::EpiResidT<false>, pg8::StaticOrder>(lds, g, S, E); } }
        END_PH();
        bf16* H = (bf16*)(ws + WS_P);
        if (IN_PH() && KEN(7)) REP(2) { pg8::Gemm g{XB, (const bf16*)(wl + WL_FF), TOK, 5632, 1024}; S.init(TOK, 5632, G, (int)blockIdx.x);
            pg8::EpiFfnUp E{H, rs_ffn}; pg8::gemm_phase<pg8::EpiFfnUp, pg8::StaticOrder>(lds, g, S, E); }
        END_PH();
        if (IN_PH() && KEN(8)) { pg8::Gemm g{H, (const bf16*)(wl + WL_D), TOK, 1024, 2816}; S.init(TOK, 1024, G, (int)blockIdx.x);
            pg8::EpiResidT<false> E{nullptr, XB, rs_next}; pg8::gemm_phase<pg8::EpiResidT<false>, pg8::StaticOrder>(lds, g, S, E); }
        END_PH();
    }
    if (IN_PH() && KEN(9)) { LAUNDER(); phase_final(p, tid, G); }
}
constexpr int N_PHASES = 18;
}

extern "C" void kernel_launch(void* const* d_in, const int* in_sizes, int n_in, void* d_out, int out_size, void* d_ws, size_t ws_size, hipStream_t stream) {
    static int grid = 0;
    if (grid == 0) {
        if (n_in != 28 || out_size != mk::TOK * mk::DM || ws_size < mk::WS_END) { fprintf(stderr, "kernel_launch: unexpected shapes (n_in %d out %d ws %zu need %zu)\n", n_in, out_size, ws_size, (size_t)mk::WS_END); grid = -1; return; }
        int dev = 0, cus = 0, per_cu = 0;
        hipGetDevice(&dev); hipDeviceGetAttribute(&cus, hipDeviceAttributeMultiprocessorCount, dev);
        if (hipFuncSetAttribute((const void*)mk::mega, hipFuncAttributeMaxDynamicSharedMemorySize, mk::LDS_BYTES) != hipSuccess) { fprintf(stderr, "kernel_launch: hipFuncSetAttribute failed\n"); grid = -1; return; }
        if (hipOccupancyMaxActiveBlocksPerMultiprocessor(&per_cu, (const void*)mk::mega, mk::NTHR, mk::LDS_BYTES) != hipSuccess || per_cu < 1) { fprintf(stderr, "kernel_launch: occupancy query says %d\n", per_cu); per_cu = 1; }
        (void)hipGetLastError();
        grid = cus * 1;
        if (grid <= 0) grid = 256;
    }
    if (grid < 0) return;
    mk::Params p{};
    for (int i = 0; i < 28; ++i) p.in[i] = (const float*)d_in[i];
    p.out = (float*)d_out; p.ws = (unsigned char*)d_ws;
#if ONE_LAUNCH
    if (hipMemsetAsync((unsigned char*)d_ws + mk::WS_BAR, 0, XCD_BAR_WORDS * sizeof(unsigned), stream) != hipSuccess) { fprintf(stderr, "kernel_launch: memset failed\n"); return; }
    p.ph_lo = 0; p.ph_hi = mk::N_PHASES;
    void* args[] = {&p};
    hipError_t e = hipLaunchCooperativeKernel((const void*)mk::mega, dim3(grid), dim3(mk::NTHR), args, mk::LDS_BYTES, stream);
    if (e != hipSuccess) fprintf(stderr, "cooperative launch failed: %s (grid %d)\n", hipGetErrorString(e), grid);
#else
    for (int ph = 0; ph < mk::N_PHASES; ++ph) { p.ph_lo = ph; p.ph_hi = ph + 1;
        hipLaunchKernelGGL(mk::mega, dim3(grid), dim3(mk::NTHR), mk::LDS_BYTES, stream, p); }
#endif
}
```

```cpp
#include <hip/hip_runtime.h>
#include <hip/hip_cooperative_groups.h>
#include <cstdio>
#include <cstdint>
#ifndef ONE_LAUNCH
#define ONE_LAUNCH 1
#endif
namespace cg = cooperative_groups;
typedef __bf16 mk_bf16x2_t __attribute__((ext_vector_type(2)));
typedef float mk_f32x2_t __attribute__((ext_vector_type(2)));
__device__ __forceinline__ unsigned mk_pk2(float lo, float hi) { mk_f32x2_t v = {lo, hi}; mk_bf16x2_t b = __builtin_convertvector(v, mk_bf16x2_t); return __builtin_bit_cast(unsigned, b); }
__device__ __forceinline__ float mk_lo(unsigned w) { return __uint_as_float(w << 16); }
__device__ __forceinline__ float mk_hi(unsigned w) { return __uint_as_float(w & 0xffff0000u); }
__device__ __forceinline__ float mk_sigm(float x) { return __builtin_amdgcn_rcpf(1.0f + __expf(-x)); }
__device__ __forceinline__ float mk_gelu(float x) { const float u = 1.5957691216f * (x + 0.044715f * x * x * x); return x * __builtin_amdgcn_rcpf(1.0f + __expf(-u)); }
namespace pg8 {
#define PG8_LAS __attribute__((address_space(3)))
typedef unsigned short bf16_t;
typedef short bf16x8 __attribute__((ext_vector_type(8)));
typedef float f32x4 __attribute__((ext_vector_type(4)));
typedef unsigned u32x4 __attribute__((ext_vector_type(4)));
constexpr int BM = 256, BK = 64, HALF = 128, HTB = HALF * BK * 2  , STAGE_BYTES = 8 * HTB, NXCD = 8, WGM = 8;

__host__ __device__ __forceinline__ int lds_byte(int r, int c) { const int st = (r >> 4) * 2 + (c >> 5), rr = r & 15, cc = c & 31, ob = rr * 64 + cc * 2; return st * 1024 + (ob ^ (((ob >> 9) & 1) << 5)); }
__host__ __device__ __forceinline__ void stage_rc(int b, int& R, int& C) { const int st = b / 1024, sb = b % 1024, swz = sb ^ (((sb >> 9) & 1) << 5); R = (st >> 1) * 16 + swz / 64; C = (st & 1) * 32 + (swz % 64) / 2; }
__host__ __device__ __forceinline__ int perm32(int rho) { const int n = rho >> 4, i = rho & 15; return 8 * (i >> 2) + 4 * n + (i & 3); }

struct Unit { int pm, pn; };
struct Gemm { const bf16_t* A; const bf16_t* Bt; int M, N, K; };

struct StaticOrder {
    int nM, nN, nwg, G, c;
    __host__ __device__ void init(int M, int N, int G_, int c_) { nM = M / BM; nN = N / BM; nwg = nM * nN; G = G_; c = c_; }
    __host__ __device__ bool next(int i, Unit& u) const {
        const long L = (long)i * G + c; if (L >= nwg) return false;
        int wgid = (int)L; { const int q = nwg / NXCD, r = nwg % NXCD, xcd = wgid % NXCD, off = wgid / NXCD; wgid = (xcd < r ? xcd * (q + 1) : r * (q + 1) + (xcd - r) * q) + off; }
        const int nig = WGM * nN, gid = wgid / nig, fm = gid * WGM, gsz = (nM - fm) < WGM ? (nM - fm) : WGM;
        u.pm = fm + ((wgid % nig) % gsz); u.pn = (wgid % nig) / gsz; return true;
    }
    __device__ __forceinline__ void a_ready(const Unit&) const {}
    __device__ __forceinline__ void done(const Unit&) const {}
};
typedef unsigned u32x2 __attribute__((ext_vector_type(2)));
constexpr int MK_TOK = 32768;
#define MK_EPI_LOOP_AM _Pragma("unroll") for (int ai = 0; ai < 2; ++ai) _Pragma("unroll") for (int m = 0; m < 4; ++m)
__device__ __forceinline__ u32x4 pack8(const f32x4 a, const f32x4 b) { u32x4 w; w.x = mk_pk2(a[0], a[1]); w.y = mk_pk2(a[2], a[3]); w.z = mk_pk2(b[0], b[1]); w.w = mk_pk2(b[2], b[3]); return w; }
__device__ __forceinline__ void unpack8(const u32x4 w, f32x4& a, f32x4& b) { a = (f32x4){mk_lo(w.x), mk_hi(w.x), mk_lo(w.y), mk_hi(w.y)}; b = (f32x4){mk_lo(w.z), mk_hi(w.z), mk_lo(w.w), mk_hi(w.w)}; }
__device__ __forceinline__ float rstd_of(float ss) { return rsqrtf(ss * (1.0f / 1024.0f) + 1e-6f); }
typedef unsigned long long rowss_t;
__device__ __forceinline__ float rstd_row(const rowss_t* rowss, int row) { return rstd_of((float)rowss[row] * (1.0f / 4294967296.0f)); }

struct EpiProj { static constexpr bool PERM = true, AFTER_DRAIN = false; bf16_t* P; const rowss_t* rowss;
    __device__ __forceinline__ void operator()(const f32x4 (&acc)[2][2][4][2], const Unit& u, int wr, int wc, int fr, int fq) const {
        const int row0 = u.pm * BM + wr * 64 + fr;
        bf16_t* base = P + (size_t)(u.pn >> 1) * ((size_t)MK_TOK * 512) + (u.pn & 1) * 256 + wc * 32 + 8 * fq;
        MK_EPI_LOOP_AM { const int row = row0 + ai * HALF + m * 16; const float rs = rstd_row(rowss, row); bf16_t* rp = base + (size_t)row * 512;
#pragma unroll
            for (int bj = 0; bj < 2; ++bj) *(u32x4*)(rp + bj * HALF) = pack8(acc[ai][bj][m][0] * rs, acc[ai][bj][m][1] * rs); }
    }
};
struct EpiVT { static constexpr bool PERM = true, AFTER_DRAIN = false; bf16_t* VT; const rowss_t* rowss;
    __device__ __forceinline__ void operator()(const f32x4 (&acc)[2][2][4][2], const Unit& u, int wr, int wc, int fr, int fq) const {
        const int row0 = u.pm * BM + wr * 64 + fr, col0 = u.pn * BM + wc * 32 + 8 * fq;
        f32x4 rs[2][2];
#pragma unroll
        for (int bj = 0; bj < 2; ++bj)
#pragma unroll
            for (int n = 0; n < 2; ++n) { const int c_ = col0 + bj * HALF + 4 * n; rs[bj][n] = (f32x4){rstd_row(rowss, c_), rstd_row(rowss, c_ + 1), rstd_row(rowss, c_ + 2), rstd_row(rowss, c_ + 3)}; }
        MK_EPI_LOOP_AM { const int row = row0 + ai * HALF + m * 16; bf16_t* rp = VT + (size_t)row * MK_TOK + col0;
#pragma unroll
            for (int bj = 0; bj < 2; ++bj) *(u32x4*)(rp + bj * HALF) = pack8(acc[ai][bj][m][0] * rs[bj][0], acc[ai][bj][m][1] * rs[bj][1]); }
    }
};
struct EpiGlu { static constexpr bool PERM = true, AFTER_DRAIN = false; const bf16_t* YG; bf16_t* O; const float* bias;
    __device__ __forceinline__ void operator()(const f32x4 (&acc)[2][2][4][2], const Unit& u, int wr, int wc, int fr, int fq) const {
        const int row0 = u.pm * BM + wr * 64 + fr, col0 = u.pn * BM + wc * 32 + 8 * fq;
        f32x4 bv[2][2];
#pragma unroll
        for (int bj = 0; bj < 2; ++bj)
#pragma unroll
            for (int n = 0; n < 2; ++n) bv[bj][n] = *(const f32x4*)(bias + col0 + bj * HALF + 4 * n);
        MK_EPI_LOOP_AM { const int row = row0 + ai * HALF + m * 16; const size_t off = (size_t)row * 512 + col0;
#pragma unroll
            for (int bj = 0; bj < 2; ++bj) { f32x4 y0, y1; unpack8(*(const u32x4*)(YG + off + bj * HALF), y0, y1);
                f32x4 a0 = acc[ai][bj][m][0] + bv[bj][0], a1 = acc[ai][bj][m][1] + bv[bj][1];
#pragma unroll
                for (int j = 0; j < 4; ++j) { y0[j] *= mk_sigm(a0[j]); y1[j] *= mk_sigm(a1[j]); }
                *(u32x4*)(O + off + bj * HALF) = pack8(y0, y1); } }
    }
};
__device__ __forceinline__ unsigned gate_q4(const f32x4 g) { return (unsigned)(g[0] * 255.0f + 0.5f) | ((unsigned)(g[1] * 255.0f + 0.5f) << 8) | ((unsigned)(g[2] * 255.0f + 0.5f) << 16) | ((unsigned)(g[3] * 255.0f + 0.5f) << 24); }
__device__ __forceinline__ f32x4 gate_dq4(unsigned w) { return (f32x4){(float)(w & 255u), (float)((w >> 8) & 255u), (float)((w >> 16) & 255u), (float)(w >> 24)} * (1.0f / 255.0f); }
struct EpiGate { static constexpr bool PERM = true, AFTER_DRAIN = false; unsigned char* GS; const rowss_t* rowss;
    __device__ __forceinline__ void operator()(const f32x4 (&acc)[2][2][4][2], const Unit& u, int wr, int wc, int fr, int fq) const {
        const int row0 = u.pm * BM + wr * 64 + fr, col0 = u.pn * BM + wc * 32 + 8 * fq;
        MK_EPI_LOOP_AM { const int row = row0 + ai * HALF + m * 16; const float rs = rstd_row(rowss, row); const size_t off = (size_t)row * 1024 + col0;
#pragma unroll
            for (int bj = 0; bj < 2; ++bj) { f32x4 a0 = acc[ai][bj][m][0] * rs, a1 = acc[ai][bj][m][1] * rs;
#pragma unroll
                for (int j = 0; j < 4; ++j) { a0[j] = mk_sigm(a0[j]); a1[j] = mk_sigm(a1[j]); }
                u32x2 w; w.x = gate_q4(a0); w.y = gate_q4(a1); *(u32x2*)(GS + off + bj * HALF) = w; } }
    }
};
template <bool FIRST> struct EpiBr { static constexpr bool PERM = true, AFTER_DRAIN = false; const unsigned char* GS; bf16_t* MG;
    __device__ __forceinline__ void operator()(const f32x4 (&acc)[2][2][4][2], const Unit& u, int wr, int wc, int fr, int fq) const {
        const int row0 = u.pm * BM + wr * 64 + fr, col0 = u.pn * BM + wc * 32 + 8 * fq;
        MK_EPI_LOOP_AM { const int row = row0 + ai * HALF + m * 16; const size_t off = (size_t)row * 1024 + col0;
#pragma unroll
            for (int bj = 0; bj < 2; ++bj) { const u32x2 gw = *(const u32x2*)(GS + off + bj * HALF);
                f32x4 v0 = gate_dq4(gw.x) * acc[ai][bj][m][0], v1 = gate_dq4(gw.y) * acc[ai][bj][m][1];
                if (!FIRST) { f32x4 p0, p1; unpack8(*(const u32x4*)(MG + off + bj * HALF), p0, p1); v0 += p0; v1 += p1; }
                *(u32x4*)(MG + off + bj * HALF) = pack8(v0, v1); } }
    }
};
template <bool F32IN> struct EpiResidT { static constexpr bool PERM = false, AFTER_DRAIN = false; const float* xin; bf16_t* xb; rowss_t* rowss_next;
    __device__ __forceinline__ void operator()(const f32x4 (&acc)[2][2][4][2], const Unit& u, int wr, int wc, int fr, int fq) const {
        const int row0 = u.pm * BM + wr * 64 + fr, col0 = u.pn * BM + wc * 32 + 4 * fq;
        MK_EPI_LOOP_AM { const int row = row0 + ai * HALF + m * 16; const size_t off = (size_t)row * 1024 + col0; float ss = 0.f;
#pragma unroll
            for (int bj = 0; bj < 2; ++bj)
#pragma unroll
                for (int n = 0; n < 2; ++n) { const size_t o = off + bj * HALF + n * 16; f32x4 xo;
                    if (F32IN) xo = *(const f32x4*)(xin + o); else { const u32x2 w0 = *(const u32x2*)(xb + o); xo = (f32x4){mk_lo(w0.x), mk_hi(w0.x), mk_lo(w0.y), mk_hi(w0.y)}; }
                    const f32x4 xn = xo + acc[ai][bj][m][n];
                    u32x2 w; w.x = mk_pk2(xn[0], xn[1]); w.y = mk_pk2(xn[2], xn[3]); *(u32x2*)(xb + o) = w;
                    ss += (xn[0] * xn[0] + xn[1] * xn[1]) + (xn[2] * xn[2] + xn[3] * xn[3]); }
            ss += __shfl_xor(ss, 16); ss += __shfl_xor(ss, 32);
            if (fq == 0) __hip_atomic_fetch_add(rowss_next + row, (rowss_t)(ss * 4294967296.0f), __ATOMIC_RELAXED, __HIP_MEMORY_SCOPE_AGENT); }
    }
};
struct EpiFfnUp { static constexpr bool PERM = true, AFTER_DRAIN = false; bf16_t* H; const rowss_t* rowss;
    __device__ __forceinline__ void operator()(const f32x4 (&acc)[2][2][4][2], const Unit& u, int wr, int wc, int fr, int fq) const {
        const int row0 = u.pm * BM + wr * 64 + fr, col0 = u.pn * HALF + wc * 32 + 8 * fq;
        MK_EPI_LOOP_AM { const int row = row0 + ai * HALF + m * 16; const float rs = rstd_row(rowss, row);
            f32x4 g0 = acc[ai][0][m][0] * rs, g1 = acc[ai][0][m][1] * rs, u0 = acc[ai][1][m][0] * rs, u1 = acc[ai][1][m][1] * rs;
#pragma unroll
            for (int j = 0; j < 4; ++j) { g0[j] = g0[j] * mk_sigm(g0[j]) * u0[j]; g1[j] = g1[j] * mk_sigm(g1[j]) * u1[j]; }
            *(u32x4*)(H + (size_t)row * 2816 + col0) = pack8(g0, g1); }
    }
};
template <class Epi, class Sched, bool ALIGN_EPI = true, bool SP2 = true>
__device__ __forceinline__ void gemm_phase(PG8_LAS unsigned char* lds, const Gemm g, const Sched& S, const Epi& E) {
    int tid_l = threadIdx.x; asm volatile("" : "+v"(tid_l)); const int tid = tid_l, wid = __builtin_amdgcn_readfirstlane(tid >> 6), lane = tid & 63, wr = wid >> 2, wc = wid & 3, fr = lane & 15, fq = lane >> 4;
    const int K = g.K, nt = K / BK;
    unsigned voffA[2], voffB[2];
#pragma unroll
    for (int i = 0; i < 2; ++i) { int R, C; stage_rc(tid * 16 + i * 8192, R, C); const int Rb = Epi::PERM ? ((R & ~31) + perm32(R & 31)) : R;
        voffA[i] = (unsigned)(R * K + C) * 2u; voffB[i] = (unsigned)(Rb * K + C) * 2u; }
    const size_t kstep = (size_t)(BK * 2);
    const size_t hstep = (size_t)HALF * K * 2;
    const size_t tstep = 2 * hstep;
    const unsigned ldsw = (unsigned)wid * 1024u;
    const int aoff = lds_byte(wr * 64 + fr, fq * 8), boff = lds_byte(wc * 32 + fr, fq * 8);
#define PG8_SA(b, h) (((b) * 2 + (h)) * HTB)
#define PG8_SB(b, h) ((4 + (b) * 2 + (h)) * HTB)
#define PG8_STAGE(bufoff, gbase, voff) do { _Pragma("unroll") for (int _i = 0; _i < 2; ++_i) \
        __builtin_amdgcn_global_load_lds((const unsigned*)((const char*)(gbase) + (voff)[_i]), (PG8_LAS unsigned*)(lds + (bufoff) + ldsw + _i * 8192), 16, 0, 0); } while (0)
#define PG8_LDA(dst, b, h) do { _Pragma("unroll") for (int m = 0; m < 4; ++m) _Pragma("unroll") for (int k = 0; k < 2; ++k) dst[m][k] = *(const PG8_LAS bf16x8*)(lds + PG8_SA(b, h) + aoff + m * 2048 + k * 1024); } while (0)
#define PG8_LDB(dst, b, h) do { _Pragma("unroll") for (int n = 0; n < 2; ++n) _Pragma("unroll") for (int k = 0; k < 2; ++k) dst[n][k] = *(const PG8_LAS bf16x8*)(lds + PG8_SB(b, h) + boff + n * 2048 + k * 1024); } while (0)
#define PG8_MMA(ai, bj, At, Bt) do { __builtin_amdgcn_s_setprio(1); _Pragma("unroll") for (int m = 0; m < 4; ++m) _Pragma("unroll") for (int n = 0; n < 2; ++n) _Pragma("unroll") for (int k = 0; k < 2; ++k) \
        acc[ai][bj][m][n] = __builtin_amdgcn_mfma_f32_16x16x32_bf16(Bt[n][k], At[m][k], acc[ai][bj][m][n], 0, 0, 0); __builtin_amdgcn_s_setprio(0); } while (0)
#define PG8_WAIT_V(n) asm volatile("s_waitcnt vmcnt(" #n ")" ::: "memory")
#define PG8_WAIT_L(n) asm volatile("s_waitcnt lgkmcnt(" #n ")" ::: "memory")
#define PG8_BAR __builtin_amdgcn_s_barrier()
#define PG8_SCHED __builtin_amdgcn_sched_barrier(0)
    Unit cur, nxt; int ui = 0;
    if (!S.next(0, cur)) return;
    f32x4 acc[2][2][4][2];
#pragma unroll
    for (int a = 0; a < 2; ++a)
#pragma unroll
        for (int b = 0; b < 2; ++b)
#pragma unroll
            for (int m = 0; m < 4; ++m)
#pragma unroll
                for (int n = 0; n < 2; ++n) acc[a][b][m][n] = (f32x4){0.f, 0.f, 0.f, 0.f};
    bf16x8 At[4][2], B0[2][2], B1[2][2];
    const char* cA = (const char*)g.A + (size_t)cur.pm * tstep; const char* cB = (const char*)g.Bt + (size_t)cur.pn * tstep;
    S.a_ready(cur);
    if constexpr (SP2) {
        PG8_STAGE(PG8_SB(0, 0), cB, voffB); PG8_STAGE(PG8_SB(0, 1), cB + hstep, voffB); PG8_STAGE(PG8_SA(0, 0), cA, voffA); PG8_STAGE(PG8_SA(0, 1), cA + hstep, voffA);
        if (wr == 1) PG8_BAR;
        PG8_WAIT_V(2); PG8_BAR;
        PG8_STAGE(PG8_SB(1, 0), cB + kstep, voffB); PG8_STAGE(PG8_SA(1, 0), cA + kstep, voffA); PG8_STAGE(PG8_SB(1, 1), cB + hstep + kstep, voffB);
        PG8_WAIT_V(6); PG8_BAR;
    } else {
        PG8_STAGE(PG8_SB(0, 0), cB, voffB); PG8_STAGE(PG8_SA(0, 0), cA, voffA); PG8_STAGE(PG8_SB(0, 1), cB + hstep, voffB); PG8_STAGE(PG8_SA(0, 1), cA + hstep, voffA);
        if (wr == 1) PG8_BAR;
        PG8_WAIT_V(4); PG8_BAR;
        PG8_STAGE(PG8_SB(1, 0), cB + kstep, voffB); PG8_STAGE(PG8_SA(1, 0), cA + kstep, voffA); PG8_STAGE(PG8_SB(1, 1), cB + hstep + kstep, voffB);
        PG8_WAIT_V(6); PG8_BAR;
    }
    for (;;) {
        const bool has_next = S.next(ui + 1, nxt);
        const char* nA = has_next ? (const char*)g.A + (size_t)nxt.pm * tstep : cA; const char* nB = has_next ? (const char*)g.Bt + (size_t)nxt.pn * tstep : cB;
        for (int t = 0; t < nt; t += 2) {
            const bool last = (t == nt - 2);
            const char* a1 = cA + (size_t)(t + 1) * kstep;
            const char* a2 = last ? nA : cA + (size_t)(t + 2) * kstep; const char* b2 = last ? nB : cB + (size_t)(t + 2) * kstep;
            const char* a3 = a2 + kstep; const char* b3 = b2 + kstep;
            if (last && has_next) S.a_ready(nxt);
            if constexpr (SP2) {
            PG8_LDB(B0, 0, 0); PG8_LDB(B1, 0, 1); PG8_SCHED; PG8_LDA(At, 0, 0); PG8_STAGE(PG8_SA(1, 1), a1 + hstep, voffA);
            PG8_WAIT_V(8); PG8_WAIT_L(0); PG8_BAR; PG8_MMA(0, 0, At, B0); PG8_MMA(0, 1, At, B1); PG8_BAR; PG8_SCHED;
            PG8_LDA(At, 0, 1); PG8_STAGE(PG8_SB(0, 0), b2, voffB); PG8_STAGE(PG8_SB(0, 1), b2 + hstep, voffB); PG8_STAGE(PG8_SA(0, 0), a2, voffA);
            PG8_WAIT_V(8); PG8_WAIT_L(0); PG8_BAR; PG8_MMA(1, 0, At, B0); PG8_MMA(1, 1, At, B1); PG8_BAR; PG8_SCHED;
            PG8_LDB(B0, 1, 0); PG8_LDB(B1, 1, 1); PG8_SCHED; PG8_LDA(At, 1, 0); PG8_STAGE(PG8_SA(0, 1), a2 + hstep, voffA);
            PG8_WAIT_V(8); PG8_WAIT_L(0); PG8_BAR; PG8_MMA(0, 0, At, B0); PG8_MMA(0, 1, At, B1); PG8_BAR; PG8_SCHED;
            PG8_LDA(At, 1, 1); PG8_STAGE(PG8_SB(1, 0), b3, voffB); PG8_STAGE(PG8_SB(1, 1), b3 + hstep, voffB); PG8_STAGE(PG8_SA(1, 0), a3, voffA);
            PG8_WAIT_V(8); PG8_WAIT_L(0); PG8_BAR; PG8_MMA(1, 0, At, B0); PG8_MMA(1, 1, At, B1); PG8_BAR; PG8_SCHED;
            } else {
            PG8_LDB(B0, 0, 0); PG8_SCHED; PG8_LDA(At, 0, 0); PG8_STAGE(PG8_SA(1, 1), a1 + hstep, voffA);
            PG8_WAIT_L(8); PG8_BAR; PG8_WAIT_L(0); PG8_MMA(0, 0, At, B0); PG8_BAR; PG8_SCHED;
            PG8_LDB(B1, 0, 1); PG8_STAGE(PG8_SB(0, 0), b2, voffB);
            PG8_BAR; PG8_WAIT_L(0); PG8_MMA(0, 1, At, B1); PG8_BAR;
            PG8_LDA(At, 0, 1); PG8_STAGE(PG8_SA(0, 0), a2, voffA);
            PG8_BAR; PG8_WAIT_L(0); PG8_MMA(1, 0, At, B0); PG8_BAR; PG8_SCHED;
            PG8_STAGE(PG8_SB(0, 1), b2 + hstep, voffB);
            PG8_WAIT_V(6); PG8_BAR; PG8_MMA(1, 1, At, B1); PG8_BAR;
            PG8_LDB(B0, 1, 0); PG8_SCHED; PG8_LDA(At, 1, 0); PG8_STAGE(PG8_SA(0, 1), a2 + hstep, voffA);
            PG8_WAIT_L(8); PG8_BAR; PG8_WAIT_L(0); PG8_MMA(0, 0, At, B0); PG8_BAR; PG8_SCHED;
            PG8_LDB(B1, 1, 1); PG8_STAGE(PG8_SB(1, 0), b3, voffB);
            PG8_BAR; PG8_WAIT_L(0); PG8_MMA(0, 1, At, B1); PG8_BAR;
            PG8_LDA(At, 1, 1); PG8_STAGE(PG8_SA(1, 0), a3, voffA);
            PG8_BAR; PG8_WAIT_L(0); PG8_MMA(1, 0, At, B0); PG8_BAR; PG8_SCHED;
            PG8_STAGE(PG8_SB(1, 1), b3 + hstep, voffB);
            PG8_WAIT_V(6); PG8_BAR; PG8_MMA(1, 1, At, B1); PG8_BAR;
            }
        }
        if constexpr (ALIGN_EPI) { if (wr == 0) PG8_BAR; }
        if constexpr (!Epi::AFTER_DRAIN) { E(acc, cur, wr, wc, fr, fq); S.done(cur); }
        if (!has_next) break;
#pragma unroll
        for (int a = 0; a < 2; ++a)
#pragma unroll
            for (int b = 0; b < 2; ++b)
#pragma unroll
                for (int m = 0; m < 4; ++m)
#pragma unroll
                    for (int n = 0; n < 2; ++n) acc[a][b][m][n] = (f32x4){0.f, 0.f, 0.f, 0.f};
        cur = nxt; cA = nA; cB = nB; ++ui;
        if constexpr (ALIGN_EPI) { if (wr == 1) PG8_BAR; }
    }
    PG8_WAIT_V(0);
    if constexpr (!ALIGN_EPI) { if (wr == 0) PG8_BAR; }
    PG8_BAR;
    if constexpr (Epi::AFTER_DRAIN) { E.fused(acc, cur, wr, wc, fr, fq, lds, wid, lane); S.done(cur); }
#undef PG8_SA
#undef PG8_SB
#undef PG8_STAGE
#undef PG8_LDA
#undef PG8_LDB
#undef PG8_MMA
#undef PG8_WAIT_V
#undef PG8_WAIT_L
#undef PG8_BAR
#undef PG8_SCHED
}
}

namespace mk {
#define LAS __attribute__((address_space(3)))
#define DI __device__ __forceinline__
typedef unsigned short bf16;
typedef pg8::bf16x8 bf16x8; typedef pg8::f32x4 f32x4; typedef pg8::u32x4 u32x4; typedef pg8::u32x2 u32x2;
typedef float f32x16 __attribute__((ext_vector_type(16)));
constexpr int TOK = 32768, DM = 1024, SEQ = 4096, BW = 512, FFH = 2816, NTHR = 512;
constexpr size_t MiB = 1024 * 1024;
constexpr size_t WS_ROWSS = 474 * MiB;
constexpr size_t WS_BAR = 768 * 1024;
constexpr size_t WS_BB = 1 * MiB;
constexpr size_t WS_CM = WS_BB + 262144;
constexpr size_t WS_AP = WS_CM + 262144;
constexpr size_t WS_SGW = WS_AP + 131072;
constexpr size_t WS_E = 2 * MiB;
constexpr size_t WS_W = 10 * MiB;
constexpr size_t WL_IN = 0, WL_GLU = 17825792, WL_BR = WL_GLU + 524288, WL_O = WL_BR + 4194304, WL_FF = WL_O + 2097152, WL_D = WL_FF + 11534336, WL_SIZE = WL_D + 5767168;
static_assert(WL_SIZE == 40 * MiB, "weights per layer");
constexpr size_t WS_XB = 90 * MiB;
constexpr size_t WS_P = 154 * MiB;
constexpr size_t PBUF = 32 * MiB;
constexpr size_t WS_YG = WS_P + 9 * PBUF;
constexpr size_t WS_END = WS_YG + 32 * MiB + 2 * MiB;
constexpr int LDS_BYTES = 143360;

DI float bf2f(bf16 v) { return __uint_as_float(((unsigned)v) << 16); }
DI bf16 f2bf(float f) { return (bf16)(mk_pk2(f, 0.f) & 0xffffu); }
DI float wave_sum(float v) {
#pragma unroll
    for (int o = 1; o < 64; o <<= 1) v += __shfl_xor(v, o);
    return v; }
DI f32x16 mfma32(bf16x8 a, bf16x8 b, f32x16 c) { return __builtin_amdgcn_mfma_f32_32x32x16_bf16(a, b, c, 0, 0, 0); }
DI f32x4 mfma16(bf16x8 a, bf16x8 b, f32x4 c) { return __builtin_amdgcn_mfma_f32_16x16x32_bf16(a, b, c, 0, 0, 0); }
DI int crow(int i, int h) { return (i & 3) + 8 * (i >> 2) + 4 * h; }
DI f32x16 zero16() { f32x16 z;
#pragma unroll
    for (int i = 0; i < 16; ++i) z[i] = 0.f;
    return z; }
#define LDS_WAIT() asm volatile("s_waitcnt lgkmcnt(0)" ::: "memory")

struct Params { const float* in[28]; float* out; unsigned char* ws; int ph_lo, ph_hi; };
enum { I_X = 0, I_GMIX, I_WIN, I_CONVW, I_CONVB, I_SGW, I_SGB, I_LNG, I_LNB, I_LAMQK, I_SUBLN, I_ARE, I_AIM, I_LOGDT, I_BRE, I_BIM, I_CRE, I_CIM, I_SSMD, I_WGLU, I_BGLU, I_WBR, I_WO, I_GFFN, I_WFG, I_WFU, I_WFD, I_GFIN };

DI void tr_item(const float* W, int ldn, int k0, int n0, const float* gs, bf16* WT, int ldk, int drow0, LAS float* scr, int lane) {
    float tv[32];
#pragma unroll
    for (int i = 0; i < 32; ++i) { const int kk = 2 * i + (lane >> 5); tv[i] = W[(size_t)(k0 + kk) * ldn + n0 + (lane & 31)]; }
    if (gs) {
#pragma unroll
        for (int i = 0; i < 32; ++i) tv[i] *= gs[k0 + 2 * i + (lane >> 5)]; }
#pragma unroll
    for (int i = 0; i < 32; ++i) scr[(2 * i + (lane >> 5)) * 33 + (lane & 31)] = tv[i];
    LDS_WAIT();
    const int c = lane & 7;
#pragma unroll
    for (int j = 0; j < 4; ++j) { const int n = (lane >> 3) + 8 * j; const LAS float* s = scr + (8 * c) * 33 + n;
        u32x4 o; o.x = mk_pk2(s[0 * 33], s[1 * 33]); o.y = mk_pk2(s[2 * 33], s[3 * 33]); o.z = mk_pk2(s[4 * 33], s[5 * 33]); o.w = mk_pk2(s[6 * 33], s[7 * 33]);
        *(u32x4*)(WT + (size_t)(drow0 + n) * ldk + k0 + 8 * c) = o; }
    LDS_WAIT();
}
DI void dsincos(double x, double& s, double& c) {
    const double twopi = 6.283185307179586476925; const double k = rint(x / twopi); const double r = x - k * twopi, r2 = r * r;
    double ss = 1.0, cc = 1.0;
#pragma unroll
    for (int n = 13; n >= 1; --n) { ss = 1.0 - r2 * (1.0 / ((2.0 * n) * (2.0 * n + 1.0))) * ss; cc = 1.0 - r2 * (1.0 / ((2.0 * n - 1.0) * (2.0 * n))) * cc; }
    s = ss * r; c = cc;
}
DI void phase_prep(const Params& p, LAS unsigned char* lds, int tid, int lane, int wave, int G) {
    unsigned char* ws = p.ws;
    const int gw = blockIdx.x * 8 + wave, NGW = G * 8, gt = blockIdx.x * NTHR + tid, NGT = G * NTHR;
    LAS float* scr = (LAS float*)(lds + wave * 8704);
    for (int l = 0; l < 2; ++l) {
        unsigned char* wl = ws + WS_W + (size_t)l * WL_SIZE;
        for (int mi = 0; mi < 10; ++mi) {
            const float* src; int K, N; const float* gs = nullptr; bf16* dst; int map = 0;
            if (mi == 0) { src = p.in[I_WIN] + (size_t)l * 1024 * 8704; K = 1024; N = 8704; gs = p.in[I_GMIX] + l * 1024; dst = (bf16*)(wl + WL_IN); map = 1; }
            else if (mi == 1) { src = p.in[I_WGLU] + (size_t)l * 512 * 512; K = 512; N = 512; dst = (bf16*)(wl + WL_GLU); }
            else if (mi < 6) { const int b = mi - 2; src = p.in[I_WBR] + ((size_t)l * 4 + b) * 512 * 1024; K = 512; N = 1024; dst = (bf16*)(wl + WL_BR) + (size_t)b * 1024 * 512; }
            else if (mi == 6) { src = p.in[I_WO] + (size_t)l * 1024 * 1024; K = 1024; N = 1024; dst = (bf16*)(wl + WL_O); }
            else if (mi == 7) { src = p.in[I_WFG] + (size_t)l * 1024 * 2816; K = 1024; N = 2816; gs = p.in[I_GFFN] + l * 1024; dst = (bf16*)(wl + WL_FF); map = 2; }
            else if (mi == 8) { src = p.in[I_WFU] + (size_t)l * 1024 * 2816; K = 1024; N = 2816; gs = p.in[I_GFFN] + l * 1024; dst = (bf16*)(wl + WL_FF); map = 3; }
            else { src = p.in[I_WFD] + (size_t)l * 2816 * 1024; K = 2816; N = 1024; dst = (bf16*)(wl + WL_D); }
            const int nblk = N / 32, nit = (K / 64) * nblk;
            for (int it = gw; it < nit; it += NGW) {
                const int kb = it / nblk, nb = it % nblk, n0 = nb * 32; int dr = n0;
                if (map == 1) { if (n0 >= 3584 && n0 < 4096) dr = n0 + 512; else if (n0 >= 4096 && n0 < 4608) dr = n0 - 512; }
                else if (map == 2) dr = (n0 >> 7) * 256 + (n0 & 127);
                else if (map == 3) dr = (n0 >> 7) * 256 + 128 + (n0 & 127);
                tr_item(src, N, kb * 64, n0, gs, dst, K, dr, scr, lane);
            }
        }
    }
    { const float* x = p.in[I_X]; bf16* xb = (bf16*)(ws + WS_XB); pg8::rowss_t* rowss = (pg8::rowss_t*)(ws + WS_ROWSS);
        for (int row0 = gw * 4; row0 < TOK; row0 += NGW * 4) { f32x4 v[4][4];
#pragma unroll
            for (int q = 0; q < 4; ++q)
#pragma unroll
                for (int j = 0; j < 4; ++j) v[q][j] = *((const f32x4*)(x + (size_t)(row0 + q) * DM) + lane + 64 * j);
#pragma unroll
            for (int q = 0; q < 4; ++q) { float ss = 0.f;
#pragma unroll
                for (int j = 0; j < 4; ++j) { const f32x4 t = v[q][j]; ss += (t[0] * t[0] + t[1] * t[1]) + (t[2] * t[2] + t[3] * t[3]);
                    u32x2 w; w.x = mk_pk2(t[0], t[1]); w.y = mk_pk2(t[2], t[3]); *((u32x2*)(xb + (size_t)(row0 + q) * DM) + lane + 64 * j) = w; }
                ss = wave_sum(ss); if (lane == 0) rowss[row0 + q] = (pg8::rowss_t)(ss * 4294967296.0f); } }
        for (int i = gt; i < 4 * TOK; i += NGT) rowss[TOK + i] = 0ull; }
    { const float* sgw = p.in[I_SGW]; bf16* o = (bf16*)(ws + WS_SGW);
        for (int i = gt; i < 2 * 4 * 128 * 128; i += NGT) { const int s = i & 127, t = (i >> 7) & 127; o[i] = f2bf(s <= t ? sgw[i] : 0.f); } }
    for (int i = gt; i < 2 * 32 * 64; i += NGT) {
        const int pp = i & 63, lg = i >> 6;
        const double dt = exp((double)p.in[I_LOGDT][lg]); const double are = p.in[I_ARE][i], aim = p.in[I_AIM][i];
        const double mag = exp(dt * are); double sn, cs; dsincos(dt * aim, sn, cs);
        const double abr = mag * cs, abi = mag * sn, den = are * are + aim * aim, nr = abr - 1.0, ni = abi;
        const double cr = (nr * are + ni * aim) / den, ci = (ni * are - nr * aim) / den;
        bf16* bb = (bf16*)(ws + WS_BB) + (size_t)lg * 128 * 16; const float* bre = p.in[I_BRE] + (size_t)i * 16; const float* bim = p.in[I_BIM] + (size_t)i * 16;
        for (int h = 0; h < 16; ++h) { const double br = bre[h], bi = bim[h]; bb[pp * 16 + h] = f2bf((float)(cr * br - ci * bi)); bb[(64 + pp) * 16 + h] = f2bf((float)(cr * bi + ci * br)); }
        bf16* cm = (bf16*)(ws + WS_CM) + (size_t)lg * 16 * 128; const float* cre = p.in[I_CRE] + (size_t)lg * 16 * 64; const float* cim = p.in[I_CIM] + (size_t)lg * 16 * 64;
        for (int h = 0; h < 16; ++h) { cm[h * 128 + pp] = f2bf(cre[h * 64 + pp]); cm[h * 128 + 64 + pp] = f2bf(-cim[h * 64 + pp]); }
        double pr = abr, pi = abi; float* ap = (float*)(ws + WS_AP) + (size_t)i * 8; ap[0] = (float)pr; ap[1] = (float)pi;
        for (int q = 0; q < 5; ++q) { const double t = pr * pr - pi * pi; pi = 2.0 * pr * pi; pr = t; }
        ap[2] = (float)pr; ap[3] = (float)pi;
        { const double t = pr * pr - pi * pi; pi = 2.0 * pr * pi; pr = t; }
        ap[4] = (float)pr; ap[5] = (float)pi; ap[6] = 0.f; ap[7] = 0.f;
    }
}

DI void phase_branchA(const Params& p, int l, int tid, int G) {
    bf16* AB = (bf16*)(p.ws + WS_P); const bf16* AC = (const bf16*)(p.ws + WS_P + PBUF); const bf16* AX = (const bf16*)(p.ws + WS_P + 2 * PBUF);
    const float* cw = p.in[I_CONVW] + l * 3 * 512; const float* cb = p.in[I_CONVB] + l * 512;
    for (int idx = blockIdx.x * NTHR + tid; idx < (TOK / 16) * 64; idx += G * NTHR) {
        const int cgp = idx & 63, run = idx >> 6, c0 = cgp * 8, t0 = run * 16;
        f32x4 w0[2], w1[2], w2[2], bb[2];
#pragma unroll
        for (int e = 0; e < 2; ++e) { w0[e] = *(const f32x4*)(cw + c0 + 4 * e); w1[e] = *(const f32x4*)(cw + 512 + c0 + 4 * e); w2[e] = *(const f32x4*)(cw + 1024 + c0 + 4 * e); bb[e] = *(const f32x4*)(cb + c0 + 4 * e); }
        f32x4 zm2[2] = {{0.f, 0.f, 0.f, 0.f}, {0.f, 0.f, 0.f, 0.f}}, zm1[2] = {{0.f, 0.f, 0.f, 0.f}, {0.f, 0.f, 0.f, 0.f}};
        if ((t0 & (SEQ - 1)) != 0) {
            f32x4 a0, a1, x0, x1;
            pg8::unpack8(*(const u32x4*)(AC + (size_t)(t0 - 2) * 512 + c0), a0, a1); pg8::unpack8(*(const u32x4*)(AX + (size_t)(t0 - 2) * 512 + c0), x0, x1); zm2[0] = a0 * x0; zm2[1] = a1 * x1;
            pg8::unpack8(*(const u32x4*)(AC + (size_t)(t0 - 1) * 512 + c0), a0, a1); pg8::unpack8(*(const u32x4*)(AX + (size_t)(t0 - 1) * 512 + c0), x0, x1); zm1[0] = a0 * x0; zm1[1] = a1 * x1;
        }
#pragma unroll 4
        for (int i = 0; i < 16; ++i) { const size_t off = (size_t)(t0 + i) * 512 + c0;
            f32x4 a0, a1, x0, x1, b0, b1; pg8::unpack8(*(const u32x4*)(AC + off), a0, a1); pg8::unpack8(*(const u32x4*)(AX + off), x0, x1); pg8::unpack8(*(const u32x4*)(AB + off), b0, b1);
            const f32x4 z0 = a0 * x0, z1 = a1 * x1;
            const f32x4 y0 = b0 * (w0[0] * zm2[0] + w1[0] * zm1[0] + w2[0] * z0 + bb[0]), y1 = b1 * (w0[1] * zm2[1] + w1[1] * zm1[1] + w2[1] * z1 + bb[1]);
            *(u32x4*)(AB + off) = pg8::pack8(y0, y1);
            zm2[0] = zm1[0]; zm2[1] = zm1[1]; zm1[0] = z0; zm1[1] = z1; }
    }
}

DI void phase_branchB(const Params& p, int l, LAS unsigned char* lds, int tid, int lane, int wave, int G) {
    bf16* BU = (bf16*)(p.ws + WS_P + 3 * PBUF); const bf16* BV = (const bf16*)(p.ws + WS_P + 4 * PBUF);
    const bf16* SGW = (const bf16*)(p.ws + WS_SGW) + (size_t)l * 4 * 128 * 128; const float* sgb = p.in[I_SGB] + l * 4 * 128;
    const float* lng = p.in[I_LNG] + l * 512 + lane * 8; const float* lnb = p.in[I_LNB] + l * 512 + lane * 8;
    constexpr int RS = 1040;
    const int r = lane & 31, half = lane >> 5;
    for (int item = blockIdx.x; item < TOK / 128; item += G) {
        const int tok0 = item * 128;
        { const f32x4 g0 = *(const f32x4*)lng, g1 = *(const f32x4*)(lng + 4), b0 = *(const f32x4*)lnb, b1 = *(const f32x4*)(lnb + 4);
            for (int tt = 0; tt < 16; ++tt) { const int s = wave * 16 + tt;
                f32x4 v0, v1; pg8::unpack8(*(const u32x4*)(BV + (size_t)(tok0 + s) * 512 + lane * 8), v0, v1);
#pragma unroll
                for (int j = 0; j < 4; ++j) { v0[j] = mk_gelu(v0[j]); v1[j] = mk_gelu(v1[j]); }
                const float mean = wave_sum((v0[0] + v0[1]) + (v0[2] + v0[3]) + (v1[0] + v1[1]) + (v1[2] + v1[3])) * (1.0f / 512.0f);
                v0 = v0 - mean; v1 = v1 - mean;
                const float var = wave_sum((v0[0] * v0[0] + v0[1] * v0[1]) + (v0[2] * v0[2] + v0[3] * v0[3]) + (v1[0] * v1[0] + v1[1] * v1[1]) + (v1[2] * v1[2] + v1[3] * v1[3])) * (1.0f / 512.0f);
                const float rstd = rsqrtf(var + 1e-5f);
                v0 = v0 * rstd * g0 + b0; v1 = v1 * rstd * g1 + b1;
                *(LAS u32x4*)(lds + s * RS + lane * 16) = pg8::pack8(v0, v1); } }
        __syncthreads();
        const int g = wave >> 1, dh = wave & 1;
        f32x16 acc[4][2];
#pragma unroll
        for (int a = 0; a < 4; ++a) { acc[a][0] = zero16(); acc[a][1] = zero16(); }
#pragma unroll
        for (int ks = 0; ks < 8; ++ks) {
            bf16x8 Vf[2];
#pragma unroll
            for (int dt = 0; dt < 2; ++dt) { const LAS unsigned short* vp = (const LAS unsigned short*)(lds + (16 * ks + 8 * half) * RS + (g * 128 + dh * 64 + dt * 32 + r) * 2);
#pragma unroll
                for (int j = 0; j < 8; ++j) Vf[dt][j] = (short)vp[j * (RS / 2)]; }
#pragma unroll
            for (int tt = ks >> 1; tt < 4; ++tt) { const bf16x8 Wf = *(const bf16x8*)(SGW + ((size_t)g * 128 + 32 * tt + r) * 128 + 16 * ks + 8 * half);
                acc[tt][0] = mfma32(Vf[0], Wf, acc[tt][0]); acc[tt][1] = mfma32(Vf[1], Wf, acc[tt][1]); }
        }
        asm volatile("s_nop 15\n\ts_nop 7" : "+v"(acc[0][0]), "+v"(acc[0][1]), "+v"(acc[1][0]), "+v"(acc[1][1]), "+v"(acc[2][0]), "+v"(acc[2][1]), "+v"(acc[3][0]), "+v"(acc[3][1]));
#pragma unroll
        for (int tt = 0; tt < 4; ++tt) { const int t = 32 * tt + r; const float bias = sgb[g * 128 + t];
#pragma unroll
            for (int dt = 0; dt < 2; ++dt)
#pragma unroll
                for (int ig = 0; ig < 4; ++ig) { bf16* up = BU + (size_t)(tok0 + t) * 512 + g * 128 + dh * 64 + dt * 32 + 8 * ig + 4 * half;
                    const u32x2 uw = *(const u32x2*)up;
                    const float y0 = mk_gelu(mk_lo(uw.x)) * (acc[tt][dt][4 * ig + 0] + bias), y1 = mk_gelu(mk_hi(uw.x)) * (acc[tt][dt][4 * ig + 1] + bias);
                    const float y2 = mk_gelu(mk_lo(uw.y)) * (acc[tt][dt][4 * ig + 2] + bias), y3 = mk_gelu(mk_hi(uw.y)) * (acc[tt][dt][4 * ig + 3] + bias);
                    u32x2 o; o.x = mk_pk2(y0, y1); o.y = mk_pk2(y2, y3); *(u32x2*)up = o; } }
        __syncthreads();
    }
}

DI void phase_attn(const Params& p, int l, LAS unsigned char* lds, int tid, int lane, int wave, int G, bf16* OUTP) {
    const bf16* CQ = (const bf16*)(p.ws + WS_P + 5 * PBUF); const bf16* CK = (const bf16*)(p.ws + WS_P + 6 * PBUF); const bf16* VT = (const bf16*)(p.ws + WS_P + 8 * PBUF);
    const float lam_init = 0.8f - 0.6f * expf(-0.3f * (float)l);
    const float* lq = p.in[I_LAMQK] + l * 256;
    const float lam = expf(wave_sum(lq[lane] * lq[64 + lane])) - expf(wave_sum(lq[128 + lane] * lq[192 + lane])) + lam_init;
    const float* sg = p.in[I_SUBLN] + l * 128;
    const int m = wave & 1, sub = wave >> 1, r = lane & 31, half = lane >> 5;
    constexpr int KROW = 144, VROW = 136, KBYTES = 64 * KROW  , VOFF = 2 * KBYTES  , STAGE = VOFF + 128 * KROW  ;
    const float cs = 0.125f * 1.44269504089f;
    for (int pi = blockIdx.x; pi < 512; pi += G) {
#pragma unroll 1
        for (int uu = 0; uu < 2; ++uu) {
            const int bh = pi >> 4, jp = pi & 15, qb = uu ? 31 - jp : jp, b = bh >> 2, h = bh & 3;
            const int tokq0 = b * SEQ + qb * 128, qrow = tokq0 + 32 * sub + r;
            bf16x8 Qf[4];
#pragma unroll
            for (int ks = 0; ks < 4; ++ks) Qf[ks] = *(const bf16x8*)(CQ + (size_t)qrow * 512 + h * 128 + m * 64 + 16 * ks + 8 * half);
            const int nt = 2 * qb + 2, my_last = 2 * qb + (sub >> 1);
            const bf16* kg[2]; const bf16* vg[2]; int kl[2], vl[2];
#pragma unroll
            for (int i = 0; i < 2; ++i) { const int idx = tid + 512 * i; const int key = idx >> 4, c16 = idx & 15;
                kg[i] = CK + (size_t)(b * SEQ + key) * 512 + h * 128 + c16 * 8; kl[i] = (c16 >> 3) * KBYTES + key * KROW + (c16 & 7) * 16;
                const int dv = idx >> 3, c8 = idx & 7;
                vg[i] = VT + (size_t)(h * 128 + dv) * TOK + b * SEQ + c8 * 8; vl[i] = VOFF + dv * VROW + c8 * 16; }
            u32x4 st[4];
            st[0] = *(const u32x4*)kg[0]; st[1] = *(const u32x4*)kg[1]; st[2] = *(const u32x4*)vg[0]; st[3] = *(const u32x4*)vg[1];
            *(LAS u32x4*)(lds + kl[0]) = st[0]; *(LAS u32x4*)(lds + kl[1]) = st[1]; *(LAS u32x2*)(lds + vl[0]) = (u32x2){st[2].x, st[2].y}; *(LAS u32x2*)(lds + vl[0] + 8) = (u32x2){st[2].z, st[2].w}; *(LAS u32x2*)(lds + vl[1]) = (u32x2){st[3].x, st[3].y}; *(LAS u32x2*)(lds + vl[1] + 8) = (u32x2){st[3].z, st[3].w};
            __syncthreads();
            f32x16 O[4];
#pragma unroll
            for (int i = 0; i < 4; ++i) O[i] = zero16();
            float m_run = -INFINITY, l_run = 0.f;
#pragma unroll 1
            for (int kt = 0; kt < nt; ++kt) {
                const bool more = (kt + 1 < nt);
                if (more) { const size_t ko = (size_t)(kt + 1) * 64 * 512, vo = (size_t)(kt + 1) * 64;
                    st[0] = *(const u32x4*)(kg[0] + ko); st[1] = *(const u32x4*)(kg[1] + ko); st[2] = *(const u32x4*)(vg[0] + vo); st[3] = *(const u32x4*)(vg[1] + vo); }
                const LAS unsigned char* buf = lds + (kt & 1) * STAGE;
                if (kt <= my_last) {
                    f32x16 S[2];
#pragma unroll
                    for (int u = 0; u < 2; ++u) { S[u] = zero16();
#pragma unroll
                        for (int ks = 0; ks < 4; ++ks) { const bf16x8 A = *(const LAS bf16x8*)(buf + m * KBYTES + (32 * u + r) * KROW + (16 * ks + 8 * half) * 2); S[u] = mfma32(A, Qf[ks], S[u]); } }
                    asm volatile("s_nop 15\n\ts_nop 7" : "+v"(S[0]), "+v"(S[1]));
                    float mx = -INFINITY;
#pragma unroll
                    for (int u = 0; u < 2; ++u)
#pragma unroll
                        for (int i = 0; i < 16; ++i) mx = fmaxf(mx, S[u][i]);
                    mx = fmaxf(mx, __shfl_xor(mx, 32));
                    const float m_new = fmaxf(m_run, mx * cs), alpha = __builtin_amdgcn_exp2f(m_run - m_new);
                    float ps = 0.f;
#pragma unroll
                    for (int u = 0; u < 2; ++u)
#pragma unroll
                        for (int i = 0; i < 16; ++i) { const float e = __builtin_amdgcn_exp2f(S[u][i] * cs - m_new); S[u][i] = e; ps += e; }
                    ps += __shfl_xor(ps, 32);
                    l_run = l_run * alpha + ps; m_run = m_new;
#pragma unroll
                    for (int d = 0; d < 4; ++d)
#pragma unroll
                        for (int i = 0; i < 16; ++i) O[d][i] *= alpha;
                    bf16x8 Pf[2][2];
#pragma unroll
                    for (int u = 0; u < 2; ++u)
#pragma unroll
                        for (int s = 0; s < 2; ++s) { u32x4 w; w.x = mk_pk2(S[u][8 * s + 0], S[u][8 * s + 1]); w.y = mk_pk2(S[u][8 * s + 2], S[u][8 * s + 3]); w.z = mk_pk2(S[u][8 * s + 4], S[u][8 * s + 5]); w.w = mk_pk2(S[u][8 * s + 6], S[u][8 * s + 7]);
                            Pf[u][s] = __builtin_bit_cast(bf16x8, w); }
#pragma unroll
                    for (int d = 0; d < 4; ++d)
#pragma unroll
                        for (int u = 0; u < 2; ++u)
#pragma unroll
                            for (int s = 0; s < 2; ++s) { const LAS unsigned char* va = buf + VOFF + (32 * d + r) * VROW + (32 * u + 16 * s + 4 * half) * 2;
                                const u32x2 lo = *(const LAS u32x2*)va, hi = *(const LAS u32x2*)(va + 16);
                                u32x4 w; w.x = lo.x; w.y = lo.y; w.z = hi.x; w.w = hi.y;
                                O[d] = mfma32(__builtin_bit_cast(bf16x8, w), Pf[u][s], O[d]); }
                }
                if (more) { LAS unsigned char* nb = lds + ((kt + 1) & 1) * STAGE;
                    *(LAS u32x4*)(nb + kl[0]) = st[0]; *(LAS u32x4*)(nb + kl[1]) = st[1]; *(LAS u32x2*)(nb + vl[0]) = (u32x2){st[2].x, st[2].y}; *(LAS u32x2*)(nb + vl[0] + 8) = (u32x2){st[2].z, st[2].w}; *(LAS u32x2*)(nb + vl[1]) = (u32x2){st[3].x, st[3].y}; *(LAS u32x2*)(nb + vl[1] + 8) = (u32x2){st[3].z, st[3].w}; }
                __syncthreads();
            }
            asm volatile("s_nop 15\n\ts_nop 7" : "+v"(O[0]), "+v"(O[1]), "+v"(O[2]), "+v"(O[3]));
            const float inv = 1.0f / l_run;
            LAS float* Cb = (LAS float*)lds;
            if (m == 1) { const float f = inv * lam;
#pragma unroll
                for (int d = 0; d < 4; ++d)
#pragma unroll
                    for (int i = 0; i < 16; ++i) Cb[(sub * 128 + 32 * d + crow(i, half)) * 33 + r] = O[d][i] * f; }
            __syncthreads();
            if (m == 0) { float ss = 0.f;
#pragma unroll
                for (int d = 0; d < 4; ++d)
#pragma unroll
                    for (int i = 0; i < 16; ++i) { const float o = O[d][i] * inv - Cb[(sub * 128 + 32 * d + crow(i, half)) * 33 + r]; O[d][i] = o; ss += o * o; }
                ss += __shfl_xor(ss, 32);
                const float rs = rsqrtf(ss * (1.0f / 128.0f) + 1e-5f) * (1.0f - lam_init);
#pragma unroll
                for (int d = 0; d < 4; ++d)
#pragma unroll
                    for (int ig = 0; ig < 4; ++ig) { const int dv0 = 32 * d + 8 * ig + 4 * half; const f32x4 gn = *(const f32x4*)(sg + dv0);
                        u32x2 w; w.x = mk_pk2(O[d][4 * ig + 0] * rs * gn[0], O[d][4 * ig + 1] * rs * gn[1]); w.y = mk_pk2(O[d][4 * ig + 2] * rs * gn[2], O[d][4 * ig + 3] * rs * gn[3]);
                        *(u32x2*)(OUTP + (size_t)qrow * 512 + h * 128 + dv0) = w; } }
            __syncthreads();
        }
    }
}

template <bool PRODUCER> DI void attn2_unit(const bf16* CQ, const bf16* CK, const bf16* VT, bf16* OUTP, const float* sg, float lam, float lam_init, LAS unsigned char* lds, int tid, int lane, int sub, int b, int h, int qb) {
    const int r = lane & 31, half = lane >> 5;
    constexpr int KROW = 144, VROW = 136, KB1 = 64 * KROW, KST = 2 * KB1  , VST = 128 * VROW  ;
    constexpr int OFF_K = 0, OFF_V = 2 * KST  , OFF_P = OFF_V + 2 * VST  , PST = 32768, OFF_A = OFF_P + 2 * PST  , AST = 1024, OFF_L = 139392;
    const float cs = 0.125f * 1.44269504089f;
            const int tokq0 = b * SEQ + qb * 128, qrow = tokq0 + 32 * sub + r;
            const int nt = 2 * qb + 2, my_last = 2 * qb + (sub >> 1);
            const bf16* kg[2]; const bf16* vg[2]; int kl[2], vl[2];
#pragma unroll
            for (int i = 0; i < 2; ++i) { const int idx = tid + 512 * i; const int key = idx >> 4, c16 = idx & 15;
                kg[i] = CK + (size_t)(b * SEQ + key) * 512 + h * 128 + c16 * 8; kl[i] = OFF_K + (c16 >> 3) * KB1 + key * KROW + (c16 & 7) * 16;
                const int dv = idx >> 3, c8 = idx & 7;
                vg[i] = VT + (size_t)(h * 128 + dv) * TOK + b * SEQ + c8 * 8; vl[i] = OFF_V + dv * VROW + c8 * 16; }
            bf16x8 Qf[2][4];
            f32x16 O[2][4];
            float m_run[2] = {-INFINITY, -INFINITY}, l_run[2] = {0.f, 0.f};
            if (PRODUCER) {
#pragma unroll
                for (int m = 0; m < 2; ++m)
#pragma unroll
                    for (int ks = 0; ks < 4; ++ks) Qf[m][ks] = *(const bf16x8*)(CQ + (size_t)qrow * 512 + h * 128 + m * 64 + 16 * ks + 8 * half);
            } else {
#pragma unroll
                for (int m = 0; m < 2; ++m)
#pragma unroll
                    for (int d = 0; d < 4; ++d) O[m][d] = zero16();
            }
            u32x4 sk[2], sv[2];
            sk[0] = *(const u32x4*)kg[0]; sk[1] = *(const u32x4*)kg[1];
            *(LAS u32x4*)(lds + kl[0]) = sk[0]; *(LAS u32x4*)(lds + kl[1]) = sk[1];
            __syncthreads();
#pragma unroll 1
            for (int i = 0; i <= nt; ++i) {
                const bool ldk = (i + 1 < nt), ldv = (i < nt);
                if (ldk) { const size_t ko = (size_t)(i + 1) * 64 * 512; sk[0] = *(const u32x4*)(kg[0] + ko); sk[1] = *(const u32x4*)(kg[1] + ko); }
                if (ldv) { const size_t vo = (size_t)i * 64; sv[0] = *(const u32x4*)(vg[0] + vo); sv[1] = *(const u32x4*)(vg[1] + vo); }
                if (PRODUCER) {
                    if (i < nt && i <= my_last) {
                        const LAS unsigned char* kb = lds + OFF_K + (i & 1) * KST;
                        LAS unsigned char* pb = lds + OFF_P + (i & 1) * PST + (sub * 2) * 4096 + lane * 16;
                        LAS float* ab = (LAS float*)(lds + OFF_A + (i & 1) * AST) + (sub * 2) * 32 + r;
#pragma unroll
                        for (int m = 0; m < 2; ++m) {
                            f32x16 S[2];
#pragma unroll
                            for (int u = 0; u < 2; ++u) { S[u] = zero16();
#pragma unroll
                                for (int ks = 0; ks < 4; ++ks) { const bf16x8 A = *(const LAS bf16x8*)(kb + m * KB1 + (32 * u + r) * KROW + (16 * ks + 8 * half) * 2); S[u] = mfma32(A, Qf[m][ks], S[u]); } }
                            asm volatile("s_nop 15\n\ts_nop 7" : "+v"(S[0]), "+v"(S[1]));
                            float mx = -INFINITY;
#pragma unroll
                            for (int u = 0; u < 2; ++u)
#pragma unroll
                                for (int k = 0; k < 16; ++k) mx = fmaxf(mx, S[u][k]);
                            mx = fmaxf(mx, __shfl_xor(mx, 32));
                            const float m_new = fmaxf(m_run[m], mx * cs), alpha = __builtin_amdgcn_exp2f(m_run[m] - m_new);
                            float ps = 0.f;
#pragma unroll
                            for (int u = 0; u < 2; ++u)
#pragma unroll
                                for (int k = 0; k < 16; ++k) { const float e = __builtin_amdgcn_exp2f(S[u][k] * cs - m_new); S[u][k] = e; ps += e; }
                            ps += __shfl_xor(ps, 32);
                            l_run[m] = l_run[m] * alpha + ps; m_run[m] = m_new;
                            if (half == 0) ab[m * 32] = alpha;
#pragma unroll
                            for (int u = 0; u < 2; ++u)
#pragma unroll
                                for (int s = 0; s < 2; ++s) { u32x4 w; w.x = mk_pk2(S[u][8 * s + 0], S[u][8 * s + 1]); w.y = mk_pk2(S[u][8 * s + 2], S[u][8 * s + 3]); w.z = mk_pk2(S[u][8 * s + 4], S[u][8 * s + 5]); w.w = mk_pk2(S[u][8 * s + 6], S[u][8 * s + 7]);
                                    *(LAS u32x4*)(pb + m * 4096 + (u * 2 + s) * 1024) = w; }
                        }
                    }
                } else {
                    const int j = i - 1;
                    if (j >= 0 && j <= my_last) {
                        const LAS unsigned char* vb = lds + OFF_V + (j & 1) * VST;
                        const LAS unsigned char* pb = lds + OFF_P + (j & 1) * PST + (sub * 2) * 4096 + lane * 16;
                        const LAS float* ab = (const LAS float*)(lds + OFF_A + (j & 1) * AST) + (sub * 2) * 32 + r;
                        const float a0 = ab[0], a1 = ab[32];
#pragma unroll
                        for (int d = 0; d < 4; ++d)
#pragma unroll
                            for (int k = 0; k < 16; ++k) { O[0][d][k] *= a0; O[1][d][k] *= a1; }
#pragma unroll
                        for (int q = 0; q < 4; ++q) { const bf16x8 P0 = *(const LAS bf16x8*)(pb + q * 1024), P1 = *(const LAS bf16x8*)(pb + 4096 + q * 1024);
#pragma unroll
                            for (int d = 0; d < 4; ++d) { const LAS unsigned char* va = vb + (32 * d + r) * VROW + (16 * q + 4 * half) * 2;
                                const u32x2 lo = *(const LAS u32x2*)va, hi = *(const LAS u32x2*)(va + 16);
                                u32x4 w; w.x = lo.x; w.y = lo.y; w.z = hi.x; w.w = hi.y; const bf16x8 Vf = __builtin_bit_cast(bf16x8, w);
                                O[0][d] = mfma32(Vf, P0, O[0][d]); O[1][d] = mfma32(Vf, P1, O[1][d]); } }
                    }
                }
                if (ldk) { LAS unsigned char* nb = lds + ((i + 1) & 1) * KST; *(LAS u32x4*)(nb + kl[0]) = sk[0]; *(LAS u32x4*)(nb + kl[1]) = sk[1]; }
                if (ldv) { LAS unsigned char* nb = lds + (i & 1) * VST;
                    *(LAS u32x2*)(nb + vl[0]) = (u32x2){sv[0].x, sv[0].y}; *(LAS u32x2*)(nb + vl[0] + 8) = (u32x2){sv[0].z, sv[0].w}; *(LAS u32x2*)(nb + vl[1]) = (u32x2){sv[1].x, sv[1].y}; *(LAS u32x2*)(nb + vl[1] + 8) = (u32x2){sv[1].z, sv[1].w}; }
                __syncthreads();
            }
            LAS float* Lb = (LAS float*)(lds + OFF_L) + (sub * 2) * 32 + r;
            if (PRODUCER && half == 0) { Lb[0] = l_run[0]; Lb[32] = l_run[1]; }
            __syncthreads();
            if (!PRODUCER) {
                asm volatile("s_nop 15\n\ts_nop 7" : "+v"(O[0][0]), "+v"(O[0][1]), "+v"(O[0][2]), "+v"(O[0][3]), "+v"(O[1][0]), "+v"(O[1][1]), "+v"(O[1][2]), "+v"(O[1][3]));
                const float inv0 = 1.0f / Lb[0], inv1 = lam / Lb[32];
                float ss = 0.f;
#pragma unroll
                for (int d = 0; d < 4; ++d)
#pragma unroll
                    for (int k = 0; k < 16; ++k) { const float o = O[0][d][k] * inv0 - O[1][d][k] * inv1; O[0][d][k] = o; ss += o * o; }
                ss += __shfl_xor(ss, 32);
                const float rs = rsqrtf(ss * (1.0f / 128.0f) + 1e-5f) * (1.0f - lam_init);
#pragma unroll
                for (int d = 0; d < 4; ++d)
#pragma unroll
                    for (int ig = 0; ig < 4; ++ig) { const int dv0 = 32 * d + 8 * ig + 4 * half; const f32x4 gn = *(const f32x4*)(sg + dv0);
                        u32x2 w; w.x = mk_pk2(O[0][d][4 * ig + 0] * rs * gn[0], O[0][d][4 * ig + 1] * rs * gn[1]); w.y = mk_pk2(O[0][d][4 * ig + 2] * rs * gn[2], O[0][d][4 * ig + 3] * rs * gn[3]);
                        *(u32x2*)(OUTP + (size_t)qrow * 512 + h * 128 + dv0) = w; }
            }
            __syncthreads();
}
DI void phase_attn2(const Params& p, int l, LAS unsigned char* lds, int tid, int lane, int wave, int G, bf16* OUTP) {
    const bf16* CQ = (const bf16*)(p.ws + WS_P + 5 * PBUF); const bf16* CK = (const bf16*)(p.ws + WS_P + 6 * PBUF); const bf16* VT = (const bf16*)(p.ws + WS_P + 8 * PBUF);
    const float lam_init = 0.8f - 0.6f * expf(-0.3f * (float)l);
    const float* lq = p.in[I_LAMQK] + l * 256;
    const float lam = expf(wave_sum(lq[lane] * lq[64 + lane])) - expf(wave_sum(lq[128 + lane] * lq[192 + lane])) + lam_init;
    const float* sg = p.in[I_SUBLN] + l * 128;
    const bool producer = wave < 4; const int sub = wave & 3;
    for (int pi0 = blockIdx.x; pi0 < 512; pi0 += G) {
        const int pi = (G == 256) ? (((int)blockIdx.x & 7) * 64 + (pi0 >> 8) * 32 + ((int)blockIdx.x >> 3)) : pi0;
#pragma unroll 1
        for (int uu = 0; uu < 2; ++uu) {
            const int bh = pi >> 4, jp = pi & 15, qb = uu ? 31 - jp : jp, b = bh >> 2, h = bh & 3;
            if (producer) attn2_unit<true>(CQ, CK, VT, OUTP, sg, lam, lam_init, lds, tid, lane, sub, b, h, qb);
            else attn2_unit<false>(CQ, CK, VT, OUTP, sg, lam, lam_init, lds, tid, lane, sub, b, h, qb);
        }
    }
}

template <bool P2> DI void phase_ssm(const Params& p, int l, LAS unsigned char* lds, int lane, int wave, int G) {
    const bf16* DU = (const bf16*)(p.ws + WS_P + 7 * PBUF); bf16* YG = (bf16*)(p.ws + WS_YG); float* E = (float*)(p.ws + WS_E);
    const bf16* BB = (const bf16*)(p.ws + WS_BB) + (size_t)l * 32 * 128 * 16; const bf16* CM = (const bf16*)(p.ws + WS_CM) + (size_t)l * 32 * 16 * 128;
    const float* AP = (const float*)(p.ws + WS_AP) + (size_t)l * 32 * 64 * 8; const float* dsk = p.in[I_SSMD] + l * 512;
    const int r = lane & 31, half = lane >> 5, r16 = lane & 15, q4 = lane >> 4;
    constexpr int XRS = 272;
    LAS unsigned char* Xs = lds + wave * (64 * XRS);
    for (int it = blockIdx.x * 8 + wave; it < 16384; it += G * 8) {
        const int g = it & 31, c = (it >> 5) & 63, b = it >> 11, tok0 = b * SEQ + c * 64;
        const int ch = g * 16 + r16; float dk = 0.f; bf16x8 Cf[4]; float uu[4][4];
        if (P2) { dk = dsk[ch];
#pragma unroll
            for (int mt = 0; mt < 4; ++mt)
#pragma unroll
                for (int j = 0; j < 4; ++j) uu[mt][j] = bf2f(DU[(size_t)(tok0 + 16 * mt + 4 * q4 + j) * 512 + ch]); }
        f32x16 X[4][2];
        { bf16x8 Uf[2], Bf[4];
#pragma unroll
            for (int tt = 0; tt < 2; ++tt) { const int tau = 32 * ((r >> 2) & 1) + 16 * tt + (r & 3) + 4 * (r >> 3); Uf[tt] = *(const bf16x8*)(DU + (size_t)(tok0 + tau) * 512 + g * 16 + 8 * half); }
#pragma unroll
            for (int pt = 0; pt < 4; ++pt) Bf[pt] = *(const bf16x8*)(BB + ((size_t)g * 128 + 32 * pt + r) * 16 + 8 * half);
#pragma unroll
            for (int pt = 0; pt < 4; ++pt)
#pragma unroll
                for (int tt = 0; tt < 2; ++tt) X[pt][tt] = mfma32(Uf[tt], Bf[pt], zero16()); }
        asm volatile("s_nop 15\n\ts_nop 15" : "+v"(X[0][0]), "+v"(X[0][1]), "+v"(X[1][0]), "+v"(X[1][1]), "+v"(X[2][0]), "+v"(X[2][1]), "+v"(X[3][0]), "+v"(X[3][1]));
        float ar[2], ai[2], a32r[2], a32i[2], a64r[2], a64i[2];
#pragma unroll
        for (int s = 0; s < 2; ++s) { const float* ap = AP + ((size_t)g * 64 + 32 * s + r) * 8; const f32x4 v = *(const f32x4*)ap; ar[s] = v[0]; ai[s] = v[1]; a32r[s] = v[2]; a32i[s] = v[3]; a64r[s] = ap[4]; a64i[s] = ap[5]; }
        float xr[2] = {0.f, 0.f}, xi[2] = {0.f, 0.f};
        if (P2) {
            const float* e0 = E + (((size_t)(b * 32 + g) * 64) * 64 + r) * 2;
            float sr0 = 0.f, si0 = 0.f, sr1 = 0.f, si1 = 0.f;
#pragma unroll 4
            for (int j = 0; j < c; ++j) { const float2 ea = *(const float2*)(e0 + (size_t)j * 128), eb = *(const float2*)(e0 + (size_t)j * 128 + 64);
                const float t0 = a64r[0] * sr0 - a64i[0] * si0 + ea.x; si0 = a64r[0] * si0 + a64i[0] * sr0 + ea.y; sr0 = t0;
                const float t1 = a64r[1] * sr1 - a64i[1] * si1 + eb.x; si1 = a64r[1] * si1 + a64i[1] * sr1 + eb.y; sr1 = t1; }
            if (half == 0) { xr[0] = sr0; xi[0] = si0; xr[1] = sr1; xi[1] = si1; }
        }
#pragma unroll
        for (int s = 0; s < 2; ++s)
#pragma unroll
            for (int tt = 0; tt < 2; ++tt)
#pragma unroll
                for (int i = 0; i < 16; ++i) { const float nr = ar[s] * xr[s] - ai[s] * xi[s] + X[s][tt][i], ni = ar[s] * xi[s] + ai[s] * xr[s] + X[2 + s][tt][i]; X[s][tt][i] = nr; X[2 + s][tt][i] = ni; xr[s] = nr; xi[s] = ni; }
        float oxr[2], oxi[2];
#pragma unroll
        for (int s = 0; s < 2; ++s) { oxr[s] = __shfl_xor(xr[s], 32); oxi[s] = __shfl_xor(xi[s], 32); }
        if (!P2) {
            if (half == 1) {
#pragma unroll
                for (int s = 0; s < 2; ++s) { float2 e; e.x = xr[s] + a32r[s] * oxr[s] - a32i[s] * oxi[s]; e.y = xi[s] + a32r[s] * oxi[s] + a32i[s] * oxr[s];
                    *(float2*)(E + (((size_t)(b * 32 + g) * 64 + c) * 64 + 32 * s + r) * 2) = e; } }
        } else {
#pragma unroll
            for (int s = 0; s < 2; ++s) { float wr_ = half ? oxr[s] : 0.f, wi_ = half ? oxi[s] : 0.f;
#pragma unroll
                for (int tt = 0; tt < 2; ++tt)
#pragma unroll
                    for (int i = 0; i < 16; ++i) { const float t = ar[s] * wr_ - ai[s] * wi_; wi_ = ar[s] * wi_ + ai[s] * wr_; wr_ = t; X[s][tt][i] += wr_; X[2 + s][tt][i] += wi_; } }
#pragma unroll
            for (int pt = 0; pt < 4; ++pt)
#pragma unroll
                for (int tt = 0; tt < 2; ++tt)
#pragma unroll
                    for (int i = 0; i < 16; ++i) *(LAS unsigned short*)(Xs + (32 * half + 16 * tt + i) * XRS + (32 * pt + r) * 2) = f2bf(X[pt][tt][i]);
#pragma unroll
            for (int ks = 0; ks < 4; ++ks) Cf[ks] = *(const bf16x8*)(CM + ((size_t)g * 16 + r16) * 128 + 32 * ks + 8 * q4);
            LDS_WAIT();
#pragma unroll
            for (int mt = 0; mt < 4; ++mt) { f32x4 acc = {0.f, 0.f, 0.f, 0.f};
#pragma unroll
                for (int ks = 0; ks < 4; ++ks) { const bf16x8 A = *(const LAS bf16x8*)(Xs + (16 * mt + r16) * XRS + (32 * ks + 8 * q4) * 2); acc = mfma16(A, Cf[ks], acc); }
                asm volatile("s_nop 15" : "+v"(acc));
#pragma unroll
                for (int j = 0; j < 4; ++j) { const size_t o = (size_t)(tok0 + 16 * mt + 4 * q4 + j) * 512 + ch; const float y = acc[j] + dk * uu[mt][j]; YG[o] = f2bf(mk_gelu(y)); } }
            LDS_WAIT();
        }
    }
}

DI void phase_ssm1(const Params& p, int l, int lane, int wave, int G) {
    const bf16* DU = (const bf16*)(p.ws + WS_P + 7 * PBUF); float* E = (float*)(p.ws + WS_E);
    const bf16* BB = (const bf16*)(p.ws + WS_BB) + (size_t)l * 32 * 128 * 16;
    const float* AP = (const float*)(p.ws + WS_AP) + (size_t)l * 32 * 64 * 8;
    const int r = lane & 31, half = lane >> 5;
    const int tau0 = 32 * ((r >> 2) & 1) + (r & 3) + 4 * (r >> 3);
    const int step = G * 8; int it = blockIdx.x * 8 + wave;
    bf16x8 Uf[2], Bf[4]; f32x4 apv[2];
#define SSM1_LOAD(IT) do { const int g_ = (IT) & 31, c_ = ((IT) >> 5) & 63, b_ = (IT) >> 11; const size_t t0_ = (size_t)(b_ * SEQ + c_ * 64 + tau0) * 512 + g_ * 16 + 8 * half; \
        Uf[0] = *(const bf16x8*)(DU + t0_); Uf[1] = *(const bf16x8*)(DU + t0_ + (size_t)16 * 512); \
        _Pragma("unroll") for (int pt = 0; pt < 4; ++pt) Bf[pt] = *(const bf16x8*)(BB + ((size_t)g_ * 128 + 32 * pt + r) * 16 + 8 * half); \
        _Pragma("unroll") for (int s = 0; s < 2; ++s) apv[s] = *(const f32x4*)(AP + ((size_t)g_ * 64 + 32 * s + r) * 8); } while (0)
    if (it < 16384) SSM1_LOAD(it);
    for (; it < 16384; it += step) {
        const int g = it & 31, c = (it >> 5) & 63, b = it >> 11;
        f32x16 X[4][2];
#pragma unroll
        for (int pt = 0; pt < 4; ++pt)
#pragma unroll
            for (int tt = 0; tt < 2; ++tt) X[pt][tt] = mfma32(Uf[tt], Bf[pt], zero16());
        float ar[2], ai[2], a32r[2], a32i[2];
#pragma unroll
        for (int s = 0; s < 2; ++s) { ar[s] = apv[s][0]; ai[s] = apv[s][1]; a32r[s] = apv[s][2]; a32i[s] = apv[s][3]; }
        asm volatile("s_nop 15\n\ts_nop 15" : "+v"(X[0][0]), "+v"(X[0][1]), "+v"(X[1][0]), "+v"(X[1][1]), "+v"(X[2][0]), "+v"(X[2][1]), "+v"(X[3][0]), "+v"(X[3][1]));
        if (it + step < 16384) SSM1_LOAD(it + step);
#pragma unroll
        for (int s = 0; s < 2; ++s) { float xr = 0.f, xi = 0.f;
#pragma unroll
            for (int tt = 0; tt < 2; ++tt)
#pragma unroll
                for (int k = 0; k < 16; ++k) { const float nr = ar[s] * xr - ai[s] * xi + X[s][tt][k], ni = ar[s] * xi + ai[s] * xr + X[2 + s][tt][k]; xr = nr; xi = ni; }
            const float oxr = __shfl_xor(xr, 32), oxi = __shfl_xor(xi, 32);
            if (half == 1) { float2 e; e.x = xr + a32r[s] * oxr - a32i[s] * oxi; e.y = xi + a32r[s] * oxi + a32i[s] * oxr;
                *(float2*)(E + (((size_t)(b * 32 + g) * 64 + c) * 64 + 32 * s + r) * 2) = e; } }
    }
#undef SSM1_LOAD
}

DI void phase_final(const Params& p, int tid, int G) {
    const pg8::rowss_t* rowss = (const pg8::rowss_t*)(p.ws + WS_ROWSS) + (size_t)4 * TOK; const float* gf = p.in[I_GFIN]; float* out = p.out; const bf16* xb = (const bf16*)(p.ws + WS_XB);
    for (size_t i = (size_t)blockIdx.x * NTHR + tid; i < (size_t)TOK * 128; i += (size_t)G * NTHR) { const int row = (int)(i >> 7), c8 = (int)(i & 127);
        const float rs = pg8::rstd_row(rowss, row); f32x4 v0, v1; pg8::unpack8(*((const u32x4*)xb + i), v0, v1);
        const f32x4 g0 = *((const f32x4*)gf + 2 * c8), g1 = *((const f32x4*)gf + 2 * c8 + 1);
        *((f32x4*)out + 2 * i) = v0 * rs * g0; *((f32x4*)out + 2 * i + 1) = v1 * rs * g1; }
}

#define XB_TMO      128
#define XB_XCNT(j)  (256  + 64 * (j))
#define XB_XSUB(j)  (1280 + 64 * (j))
#define XB_XGEN(j)  (2304 + 64 * (j))
#define XB_TOP      3328
#define XB_TOPGEN   3392
#define XCD_BAR_WORDS 3456
#define XB_SPIN_CAP (1u << 18)

__device__ __forceinline__ unsigned xb_ld(unsigned* p)              { return __hip_atomic_load(p, __ATOMIC_RELAXED, __HIP_MEMORY_SCOPE_AGENT); }
__device__ __forceinline__ unsigned xb_add(unsigned* p, unsigned v) { return __hip_atomic_fetch_add(p, v, __ATOMIC_RELAXED, __HIP_MEMORY_SCOPE_AGENT); }
__device__ __forceinline__ unsigned xb_xcc_id() { return (unsigned)__builtin_amdgcn_s_getreg((3 << 11) | 20) & 0xFu; }
#define XB_SPIN(cond, bar) do { unsigned _sp = 0; while (cond) { __builtin_amdgcn_s_sleep(1); \
    if ((++_sp & 255u) == 0u) { if (xb_ld(&(bar)[XB_TMO])) break; if (_sp > XB_SPIN_CAP) { atomicAdd(&(bar)[XB_TMO], 1u); break; } } } } while (0)

struct XcdBarrier {
    unsigned* bar; unsigned x;
    volatile LAS unsigned* st;
};

__device__ __forceinline__ XcdBarrier xcd_barrier_post(unsigned* bar, volatile LAS unsigned* st) {
    XcdBarrier b; b.bar = bar; b.x = xb_xcc_id(); b.st = st;
    if (threadIdx.x == 0) (void)xb_add(&bar[XB_XCNT(b.x)], 1u);
    return b;
}
__device__ __forceinline__ void xcd_barrier_complete(unsigned* bar, unsigned x, unsigned& nloc, unsigned& nx) {
    const unsigned G = gridDim.x * gridDim.y * gridDim.z;
    unsigned sum, cnt, mine, sp = 0u;
    for (;;) {
        sum = 0u; cnt = 0u; mine = 0u;
#pragma unroll
        for (unsigned j = 0; j < 16; ++j) { const unsigned c = xb_ld(&bar[XB_XCNT(j)]); sum += c; cnt += (c > 0u) ? 1u : 0u; mine = (j == x) ? c : mine; }
        if (sum == G) break;
        __builtin_amdgcn_s_sleep(1);
        if ((++sp & 255u) == 0u) { if (xb_ld(&bar[XB_TMO])) break; if (sp > XB_SPIN_CAP) { atomicAdd(&bar[XB_TMO], 1u); break; } }
    }
    nloc = mine > 0u ? mine : 1u; nx = cnt > 0u ? cnt : 1u;
}

__device__ __forceinline__ void xcd_barrier(const XcdBarrier& b) {
    asm volatile("s_waitcnt vmcnt(0)" ::: "memory");
    __syncthreads();
    if (threadIdx.x == 0) {
        unsigned* bar = b.bar;
        __builtin_amdgcn_s_waitcnt(0);
        unsigned nloc = b.st[0], nx = b.st[1];
        if (nloc == 0u) { xcd_barrier_complete(bar, b.x, nloc, nx); b.st[0] = nloc; b.st[1] = nx; }
        const unsigned old = xb_add(&bar[XB_XSUB(b.x)], 1u);
        const unsigned gen = old / nloc;
        if (old + 1u == (gen + 1u) * nloc) {
            __builtin_amdgcn_fence(__ATOMIC_RELEASE, "agent");
            asm volatile("s_waitcnt vmcnt(0)" ::: "memory");
            const unsigned og = xb_add(&bar[XB_TOP], 1u);
            const unsigned tg = og / nx;
            if (og + 1u == (tg + 1u) * nx) xb_add(&bar[XB_TOPGEN], 1u);
            else XB_SPIN(xb_ld(&bar[XB_TOPGEN]) == tg, bar);
            __builtin_amdgcn_fence(__ATOMIC_ACQUIRE, "agent");
            xb_add(&bar[XB_XGEN(b.x)], 1u);
            asm volatile("s_waitcnt vmcnt(0)" ::: "memory");
        } else {
            XB_SPIN(xb_ld(&bar[XB_XGEN(b.x)]) == gen, bar);
            __builtin_amdgcn_fence(__ATOMIC_ACQUIRE, "agent");
            asm volatile("s_waitcnt vmcnt(0)" ::: "memory");
        }
    }
    __syncthreads();
}


__global__ void __launch_bounds__(NTHR) mega(Params p) {
    extern __shared__ __attribute__((aligned(16))) unsigned char lds_raw[];
    LAS unsigned char* lds = (LAS unsigned char*)lds_raw;
    const int G = gridDim.x;
#define LAUNDER() int tid = threadIdx.x; asm volatile("" : "+v"(tid)); const int lane = tid & 63, wave = __builtin_amdgcn_readfirstlane(tid >> 6); (void)lane; (void)wave
    const int lo = p.ph_lo, hi = p.ph_hi;
    unsigned char* ws = p.ws;
    int ph = 0;
    volatile LAS unsigned* xb_st = (volatile LAS unsigned*)(lds + 139264);
    XcdBarrier xbar; xbar.bar = (unsigned*)(ws + WS_BAR); xbar.x = 0; xbar.st = xb_st;
    if (ONE_LAUNCH) { if (threadIdx.x < 4) xb_st[threadIdx.x] = 0u; __syncthreads(); xbar = xcd_barrier_post((unsigned*)(ws + WS_BAR), xb_st); }
#ifndef ONLY_KIND
#define ONLY_KIND -1
#endif
#define KEN(k) (ONLY_KIND < 0 || ONLY_KIND == (k))
#ifndef DUP
#define DUP 0
#endif
#define REP(bit) _Pragma("unroll 1") for (int rep_ = 0; rep_ < ((DUP & (bit)) ? 2 : 1); ++rep_)
#define IN_PH() (lo <= ph && ph < hi)
#define END_PH() do { if (ONE_LAUNCH && lo <= ph && ph + 1 < hi) { if (hi < 0) cg::this_grid().sync(); else xcd_barrier(xbar); } ++ph; } while (0)
    if (IN_PH() && KEN(0)) REP(128) { LAUNDER(); phase_prep(p, lds, tid, lane, wave, G); }
    END_PH();
    bf16* XB = (bf16*)(ws + WS_XB); pg8::rowss_t* rowss = (pg8::rowss_t*)(ws + WS_ROWSS);
    for (int l = 0; l < 2; ++l) {
        unsigned char* wl = ws + WS_W + (size_t)l * WL_SIZE;
        const bf16* WinT = (const bf16*)(wl + WL_IN);
        bf16* P0 = (bf16*)(ws + WS_P);
        const pg8::rowss_t* rs_mix = rowss + (size_t)(2 * l) * TOK; pg8::rowss_t* rs_ffn = rowss + (size_t)(2 * l + 1) * TOK; pg8::rowss_t* rs_next = rowss + (size_t)(2 * l + 2) * TOK;
        pg8::StaticOrder S;
        if (IN_PH()) REP(1) {
            if (KEN(1)) { pg8::Gemm g{XB, WinT, TOK, 4096, 1024}; S.init(TOK, 4096, G, (int)blockIdx.x); pg8::EpiProj E{P0, rs_mix}; pg8::gemm_phase<pg8::EpiProj, pg8::StaticOrder>(lds, g, S, E); }
            if (KEN(2)) { pg8::Gemm g{WinT + (size_t)4096 * 1024, XB, 512, TOK, 1024}; S.init(512, TOK, G, (int)blockIdx.x); pg8::EpiVT E{(bf16*)(ws + WS_P + 8 * PBUF), rs_mix}; pg8::gemm_phase<pg8::EpiVT, pg8::StaticOrder>(lds, g, S, E); }
        }
        END_PH();
        if (IN_PH()) { if (KEN(20)) REP(4) { LAUNDER(); phase_attn2(p, l, lds, tid, lane, wave, G, (DUP & 4) && rep_ == 0 ? (bf16*)(ws + WS_YG) : (bf16*)(ws + WS_P + 5 * PBUF)); } if (KEN(21)) { LAUNDER(); phase_branchB(p, l, lds, tid, lane, wave, G); } if (KEN(22)) REP(16) { LAUNDER(); phase_ssm1(p, l, lane, wave, G); } if (KEN(23)) { LAUNDER(); phase_branchA(p, l, tid, G); } }
        END_PH();
        if (IN_PH() && KEN(3)) REP(16) { LAUNDER(); phase_ssm<true>(p, l, lds, lane, wave, G); }
        END_PH();
        if (IN_PH() && KEN(4)) REP(64) { pg8::Gemm g{(const bf16*)(ws + WS_YG), (const bf16*)(wl + WL_GLU), TOK, 512, 512}; S.init(TOK, 512, G, (int)blockIdx.x);
            pg8::EpiGlu E{(const bf16*)(ws + WS_YG), (bf16*)(ws + WS_P + 7 * PBUF), p.in[I_BGLU] + l * 512}; pg8::gemm_phase<pg8::EpiGlu, pg8::StaticOrder>(lds, g, S, E); }
        END_PH();
        unsigned char* GS = (unsigned char*)(ws + WS_P + 1 * PBUF);   bf16* MG = (bf16*)(ws + WS_P + 8 * PBUF);
        if (IN_PH() && KEN(5)) REP(8) {
#pragma unroll 1
            for (int b = 0; b < 4; ++b) {
                { pg8::Gemm g{XB, WinT + (size_t)(4608 + 1024 * b) * 1024, TOK, 1024, 1024}; S.init(TOK, 1024, G, (int)blockIdx.x); pg8::EpiGate E{GS, rs_mix}; pg8::gemm_phase<pg8::EpiGate, pg8::StaticOrder>(lds, g, S, E); }
                const size_t yb = (b == 0) ? 0 : (b == 1) ? 3 : (b == 2) ? 5 : 7;
                pg8::Gemm g{(const bf16*)(ws + WS_P + yb * PBUF), (const bf16*)(wl + WL_BR) + (size_t)b * 1024 * 512, TOK, 1024, 512}; S.init(TOK, 1024, G, (int)blockIdx.x);
                if (b == 0) { pg8::EpiBr<true> E{GS, MG}; pg8::gemm_phase<pg8::EpiBr<true>, pg8::StaticOrder>(lds, g, S, E); }
                else { pg8::EpiBr<false> E{GS, MG}; pg8::gemm_phase<pg8::EpiBr<false>, pg8::StaticOrder>(lds, g, S, E); }
            }
        }
        END_PH();
        if (IN_PH() && KEN(6)) { pg8::Gemm g{MG, (const bf16*)(wl + WL_O), TOK, 1024, 1024}; S.init(TOK, 1024, G, (int)blockIdx.x);
            if (l == 0) { pg8::EpiResidT<true> E{p.in[I_X], XB, rs_ffn}; pg8::gemm_phase<pg8::EpiResidT<true>, pg8::StaticOrder>(lds, g, S, E); }
            else { pg8::EpiResidT<false> E{nullptr, XB, rs_ffn}; pg8::gemm_phase<pg8::EpiResidT<false>, pg8::StaticOrder>(lds, g, S, E); } }
        END_PH();
        bf16* H = (bf16*)(ws + WS_P);
        if (IN_PH() && KEN(7)) REP(2) { pg8::Gemm g{XB, (const bf16*)(wl + WL_FF), TOK, 5632, 1024}; S.init(TOK, 5632, G, (int)blockIdx.x);
            pg8::EpiFfnUp E{H, rs_ffn}; pg8::gemm_phase<pg8::EpiFfnUp, pg8::StaticOrder>(lds, g, S, E); }
        END_PH();
        if (IN_PH() && KEN(8)) { pg8::Gemm g{H, (const bf16*)(wl + WL_D), TOK, 1024, 2816}; S.init(TOK, 1024, G, (int)blockIdx.x);
            pg8::EpiResidT<false> E{nullptr, XB, rs_next}; pg8::gemm_phase<pg8::EpiResidT<false>, pg8::StaticOrder>(lds, g, S, E); }
        END_PH();
    }
    if (IN_PH() && KEN(9)) { LAUNDER(); phase_final(p, tid, G); }
}
constexpr int N_PHASES = 18;
}

extern "C" void kernel_launch(void* const* d_in, const int* in_sizes, int n_in, void* d_out, int out_size, void* d_ws, size_t ws_size, hipStream_t stream) {
    static int grid = 0;
    if (grid == 0) {
        if (n_in != 28 || out_size != mk::TOK * mk::DM || ws_size < mk::WS_END) { fprintf(stderr, "kernel_launch: unexpected shapes (n_in %d out %d ws %zu need %zu)\n", n_in, out_size, ws_size, (size_t)mk::WS_END); grid = -1; return; }
        int dev = 0, cus = 0, per_cu = 0;
        hipGetDevice(&dev); hipDeviceGetAttribute(&cus, hipDeviceAttributeMultiprocessorCount, dev);
        if (hipFuncSetAttribute((const void*)mk::mega, hipFuncAttributeMaxDynamicSharedMemorySize, mk::LDS_BYTES) != hipSuccess) { fprintf(stderr, "kernel_launch: hipFuncSetAttribute failed\n"); grid = -1; return; }
        if (hipOccupancyMaxActiveBlocksPerMultiprocessor(&per_cu, (const void*)mk::mega, mk::NTHR, mk::LDS_BYTES) != hipSuccess || per_cu < 1) { fprintf(stderr, "kernel_launch: occupancy query says %d\n", per_cu); per_cu = 1; }
        (void)hipGetLastError();
        grid = cus * 1;
        if (grid <= 0) grid = 256;
    }
    if (grid < 0) return;
    mk::Params p{};
    for (int i = 0; i < 28; ++i) p.in[i] = (const float*)d_in[i];
    p.out = (float*)d_out; p.ws = (unsigned char*)d_ws;
#if ONE_LAUNCH
    if (hipMemsetAsync((unsigned char*)d_ws + mk::WS_BAR, 0, XCD_BAR_WORDS * sizeof(unsigned), stream) != hipSuccess) { fprintf(stderr, "kernel_launch: memset failed\n"); return; }
    p.ph_lo = 0; p.ph_hi = mk::N_PHASES;
    void* args[] = {&p};
    hipError_t e = hipLaunchCooperativeKernel((const void*)mk::mega, dim3(grid), dim3(mk::NTHR), args, mk::LDS_BYTES, stream);
    if (e != hipSuccess) fprintf(stderr, "cooperative launch failed: %s (grid %d)\n", hipGetErrorString(e), grid);
#else
    for (int ph = 0; ph < mk::N_PHASES; ++ph) { p.ph_lo = ph; p.ph_hi = ph + 1;
        hipLaunchKernelGGL(mk::mega, dim3(grid), dim3(mk::NTHR), mk::LDS_BYTES, stream, p); }
#endif
}
```

```cpp
#include <hip/hip_runtime.h>
#include <hip/hip_cooperative_groups.h>
#include <cstdio>
#include <cstdint>
#ifndef ONE_LAUNCH
#define ONE_LAUNCH 1
#endif
namespace cg = cooperative_groups;
typedef __bf16 mk_bf16x2_t __attribute__((ext_vector_type(2)));
typedef float mk_f32x2_t __attribute__((ext_vector_type(2)));
__device__ __forceinline__ unsigned mk_pk2(float lo, float hi) { mk_f32x2_t v = {lo, hi}; mk_bf16x2_t b = __builtin_convertvector(v, mk_bf16x2_t); return __builtin_bit_cast(unsigned, b); }
__device__ __forceinline__ float mk_lo(unsigned w) { return __uint_as_float(w << 16); }
__device__ __forceinline__ float mk_hi(unsigned w) { return __uint_as_float(w & 0xffff0000u); }
__device__ __forceinline__ float mk_sigm(float x) { return __builtin_amdgcn_rcpf(1.0f + __expf(-x)); }
__device__ __forceinline__ float mk_gelu(float x) { const float u = 1.5957691216f * (x + 0.044715f * x * x * x); return x * __builtin_amdgcn_rcpf(1.0f + __expf(-u)); }
namespace pg8 {
#define PG8_LAS __attribute__((address_space(3)))
typedef unsigned short bf16_t;
typedef short bf16x8 __attribute__((ext_vector_type(8)));
typedef float f32x4 __attribute__((ext_vector_type(4)));
typedef unsigned u32x4 __attribute__((ext_vector_type(4)));
constexpr int BM = 256, BK = 64, HALF = 128, HTB = HALF * BK * 2  , STAGE_BYTES = 8 * HTB, NXCD = 8, WGM = 8;

__host__ __device__ __forceinline__ int lds_byte(int r, int c) { const int st = (r >> 4) * 2 + (c >> 5), rr = r & 15, cc = c & 31, ob = rr * 64 + cc * 2; return st * 1024 + (ob ^ (((ob >> 9) & 1) << 5)); }
__host__ __device__ __forceinline__ void stage_rc(int b, int& R, int& C) { const int st = b / 1024, sb = b % 1024, swz = sb ^ (((sb >> 9) & 1) << 5); R = (st >> 1) * 16 + swz / 64; C = (st & 1) * 32 + (swz % 64) / 2; }
__host__ __device__ __forceinline__ int perm32(int rho) { const int n = rho >> 4, i = rho & 15; return 8 * (i >> 2) + 4 * n + (i & 3); }

struct Unit { int pm, pn; };
struct Gemm { const bf16_t* A; const bf16_t* Bt; int M, N, K; };

struct StaticOrder {
    int nM, nN, nwg, G, c;
    __host__ __device__ void init(int M, int N, int G_, int c_) { nM = M / BM; nN = N / BM; nwg = nM * nN; G = G_; c = c_; }
    __host__ __device__ bool next(int i, Unit& u) const {
        const long L = (long)i * G + c; if (L >= nwg) return false;
        int wgid = (int)L; { const int q = nwg / NXCD, r = nwg % NXCD, xcd = wgid % NXCD, off = wgid / NXCD; wgid = (xcd < r ? xcd * (q + 1) : r * (q + 1) + (xcd - r) * q) + off; }
        const int nig = WGM * nN, gid = wgid / nig, fm = gid * WGM, gsz = (nM - fm) < WGM ? (nM - fm) : WGM;
        u.pm = fm + ((wgid % nig) % gsz); u.pn = (wgid % nig) / gsz; return true;
    }
    __device__ __forceinline__ void a_ready(const Unit&) const {}
    __device__ __forceinline__ void done(const Unit&) const {}
};
typedef unsigned u32x2 __attribute__((ext_vector_type(2)));
constexpr int MK_TOK = 32768;
#define MK_EPI_LOOP_AM _Pragma("unroll") for (int ai = 0; ai < 2; ++ai) _Pragma("unroll") for (int m = 0; m < 4; ++m)
__device__ __forceinline__ u32x4 pack8(const f32x4 a, const f32x4 b) { u32x4 w; w.x = mk_pk2(a[0], a[1]); w.y = mk_pk2(a[2], a[3]); w.z = mk_pk2(b[0], b[1]); w.w = mk_pk2(b[2], b[3]); return w; }
__device__ __forceinline__ void unpack8(const u32x4 w, f32x4& a, f32x4& b) { a = (f32x4){mk_lo(w.x), mk_hi(w.x), mk_lo(w.y), mk_hi(w.y)}; b = (f32x4){mk_lo(w.z), mk_hi(w.z), mk_lo(w.w), mk_hi(w.w)}; }
__device__ __forceinline__ float rstd_of(float ss) { return rsqrtf(ss * (1.0f / 1024.0f) + 1e-6f); }
typedef unsigned long long rowss_t;
__device__ __forceinline__ float rstd_row(const rowss_t* rowss, int row) { return rstd_of((float)rowss[row] * (1.0f / 4294967296.0f)); }

struct EpiProj { static constexpr bool PERM = true, AFTER_DRAIN = false; bf16_t* P; const rowss_t* rowss;
    __device__ __forceinline__ void operator()(const f32x4 (&acc)[2][2][4][2], const Unit& u, int wr, int wc, int fr, int fq) const {
        const int row0 = u.pm * BM + wr * 64 + fr;
        bf16_t* base = P + (size_t)(u.pn >> 1) * ((size_t)MK_TOK * 512) + (u.pn & 1) * 256 + wc * 32 + 8 * fq;
        MK_EPI_LOOP_AM { const int row = row0 + ai * HALF + m * 16; const float rs = rstd_row(rowss, row); bf16_t* rp = base + (size_t)row * 512;
#pragma unroll
            for (int bj = 0; bj < 2; ++bj) *(u32x4*)(rp + bj * HALF) = pack8(acc[ai][bj][m][0] * rs, acc[ai][bj][m][1] * rs); }
    }
};
struct EpiVT { static constexpr bool PERM = true, AFTER_DRAIN = false; bf16_t* VT; const rowss_t* rowss;
    __device__ __forceinline__ void operator()(const f32x4 (&acc)[2][2][4][2], const Unit& u, int wr, int wc, int fr, int fq) const {
        const int row0 = u.pm * BM + wr * 64 + fr, col0 = u.pn * BM + wc * 32 + 8 * fq;
        f32x4 rs[2][2];
#pragma unroll
        for (int bj = 0; bj < 2; ++bj)
#pragma unroll
            for (int n = 0; n < 2; ++n) { const int c_ = col0 + bj * HALF + 4 * n; rs[bj][n] = (f32x4){rstd_row(rowss, c_), rstd_row(rowss, c_ + 1), rstd_row(rowss, c_ + 2), rstd_row(rowss, c_ + 3)}; }
        MK_EPI_LOOP_AM { const int row = row0 + ai * HALF + m * 16; bf16_t* rp = VT + (size_t)row * MK_TOK + col0;
#pragma unroll
            for (int bj = 0; bj < 2; ++bj) *(u32x4*)(rp + bj * HALF) = pack8(acc[ai][bj][m][0] * rs[bj][0], acc[ai][bj][m][1] * rs[bj][1]); }
    }
};
struct EpiGlu { static constexpr bool PERM = true, AFTER_DRAIN = false; const bf16_t* YG; bf16_t* O; const float* bias;
    __device__ __forceinline__ void operator()(const f32x4 (&acc)[2][2][4][2], const Unit& u, int wr, int wc, int fr, int fq) const {
        const int row0 = u.pm * BM + wr * 64 + fr, col0 = u.pn * BM + wc * 32 + 8 * fq;
        f32x4 bv[2][2];
#pragma unroll
        for (int bj = 0; bj < 2; ++bj)
#pragma unroll
            for (int n = 0; n < 2; ++n) bv[bj][n] = *(const f32x4*)(bias + col0 + bj * HALF + 4 * n);
        MK_EPI_LOOP_AM { const int row = row0 + ai * HALF + m * 16; const size_t off = (size_t)row * 512 + col0;
#pragma unroll
            for (int bj = 0; bj < 2; ++bj) { f32x4 y0, y1; unpack8(*(const u32x4*)(YG + off + bj * HALF), y0, y1);
                f32x4 a0 = acc[ai][bj][m][0] + bv[bj][0], a1 = acc[ai][bj][m][1] + bv[bj][1];
#pragma unroll
                for (int j = 0; j < 4; ++j) { y0[j] *= mk_sigm(a0[j]); y1[j] *= mk_sigm(a1[j]); }
                *(u32x4*)(O + off + bj * HALF) = pack8(y0, y1); } }
    }
};
__device__ __forceinline__ unsigned gate_q4(const f32x4 g) { return (unsigned)(g[0] * 255.0f + 0.5f) | ((unsigned)(g[1] * 255.0f + 0.5f) << 8) | ((unsigned)(g[2] * 255.0f + 0.5f) << 16) | ((unsigned)(g[3] * 255.0f + 0.5f) << 24); }
__device__ __forceinline__ f32x4 gate_dq4(unsigned w) { return (f32x4){(float)(w & 255u), (float)((w >> 8) & 255u), (float)((w >> 16) & 255u), (float)(w >> 24)} * (1.0f / 255.0f); }
struct EpiGate { static constexpr bool PERM = true, AFTER_DRAIN = false; unsigned char* GS; const rowss_t* rowss;
    __device__ __forceinline__ void operator()(const f32x4 (&acc)[2][2][4][2], const Unit& u, int wr, int wc, int fr, int fq) const {
        const int row0 = u.pm * BM + wr * 64 + fr, col0 = u.pn * BM + wc * 32 + 8 * fq;
        MK_EPI_LOOP_AM { const int row = row0 + ai * HALF + m * 16; const float rs = rstd_row(rowss, row); const size_t off = (size_t)row * 1024 + col0;
#pragma unroll
            for (int bj = 0; bj < 2; ++bj) { f32x4 a0 = acc[ai][bj][m][0] * rs, a1 = acc[ai][bj][m][1] * rs;
#pragma unroll
                for (int j = 0; j < 4; ++j) { a0[j] = mk_sigm(a0[j]); a1[j] = mk_sigm(a1[j]); }
                u32x2 w; w.x = gate_q4(a0); w.y = gate_q4(a1); *(u32x2*)(GS + off + bj * HALF) = w; } }
    }
};
template <bool FIRST> struct EpiBr { static constexpr bool PERM = true, AFTER_DRAIN = false; const unsigned char* GS; bf16_t* MG;
    __device__ __forceinline__ void operator()(const f32x4 (&acc)[2][2][4][2], const Unit& u, int wr, int wc, int fr, int fq) const {
        const int row0 = u.pm * BM + wr * 64 + fr, col0 = u.pn * BM + wc * 32 + 8 * fq;
        MK_EPI_LOOP_AM { const int row = row0 + ai * HALF + m * 16; const size_t off = (size_t)row * 1024 + col0;
#pragma unroll
            for (int bj = 0; bj < 2; ++bj) { const u32x2 gw = *(const u32x2*)(GS + off + bj * HALF);
                f32x4 v0 = gate_dq4(gw.x) * acc[ai][bj][m][0], v1 = gate_dq4(gw.y) * acc[ai][bj][m][1];
                if (!FIRST) { f32x4 p0, p1; unpack8(*(const u32x4*)(MG + off + bj * HALF), p0, p1); v0 += p0; v1 += p1; }
                *(u32x4*)(MG + off + bj * HALF) = pack8(v0, v1); } }
    }
};
template <bool F32IN> struct EpiResidT { static constexpr bool PERM = false, AFTER_DRAIN = false; const float* xin; bf16_t* xb; rowss_t* rowss_next;
    __device__ __forceinline__ void operator()(const f32x4 (&acc)[2][2][4][2], const Unit& u, int wr, int wc, int fr, int fq) const {
        const int row0 = u.pm * BM + wr * 64 + fr, col0 = u.pn * BM + wc * 32 + 4 * fq;
        MK_EPI_LOOP_AM { const int row = row0 + ai * HALF + m * 16; const size_t off = (size_t)row * 1024 + col0; float ss = 0.f;
#pragma unroll
            for (int bj = 0; bj < 2; ++bj)
#pragma unroll
                for (int n = 0; n < 2; ++n) { const size_t o = off + bj * HALF + n * 16; f32x4 xo;
                    if (F32IN) xo = *(const f32x4*)(xin + o); else { const u32x2 w0 = *(const u32x2*)(xb + o); xo = (f32x4){mk_lo(w0.x), mk_hi(w0.x), mk_lo(w0.y), mk_hi(w0.y)}; }
                    const f32x4 xn = xo + acc[ai][bj][m][n];
                    u32x2 w; w.x = mk_pk2(xn[0], xn[1]); w.y = mk_pk2(xn[2], xn[3]); *(u32x2*)(xb + o) = w;
                    ss += (xn[0] * xn[0] + xn[1] * xn[1]) + (xn[2] * xn[2] + xn[3] * xn[3]); }
            ss += __shfl_xor(ss, 16); ss += __shfl_xor(ss, 32);
            if (fq == 0) __hip_atomic_fetch_add(rowss_next + row, (rowss_t)(ss * 4294967296.0f), __ATOMIC_RELAXED, __HIP_MEMORY_SCOPE_AGENT); }
    }
};
struct EpiFfnUp { static constexpr bool PERM = true, AFTER_DRAIN = false; bf16_t* H; const rowss_t* rowss;
    __device__ __forceinline__ void operator()(const f32x4 (&acc)[2][2][4][2], const Unit& u, int wr, int wc, int fr, int fq) const {
        const int row0 = u.pm * BM + wr * 64 + fr, col0 = u.pn * HALF + wc * 32 + 8 * fq;
        MK_EPI_LOOP_AM { const int row = row0 + ai * HALF + m * 16; const float rs = rstd_row(rowss, row);
            f32x4 g0 = acc[ai][0][m][0] * rs, g1 = acc[ai][0][m][1] * rs, u0 = acc[ai][1][m][0] * rs, u1 = acc[ai][1][m][1] * rs;
#pragma unroll
            for (int j = 0; j < 4; ++j) { g0[j] = g0[j] * mk_sigm(g0[j]) * u0[j]; g1[j] = g1[j] * mk_sigm(g1[j]) * u1[j]; }
            *(u32x4*)(H + (size_t)row * 2816 + col0) = pack8(g0, g1); }
    }
};
template <class Epi, class Sched, bool ALIGN_EPI = true, bool SP2 = true>
__device__ __forceinline__ void gemm_phase(PG8_LAS unsigned char* lds, const Gemm g, const Sched& S, const Epi& E) {
    int tid_l = threadIdx.x; asm volatile("" : "+v"(tid_l)); const int tid = tid_l, wid = __builtin_amdgcn_readfirstlane(tid >> 6), lane = tid & 63, wr = wid >> 2, wc = wid & 3, fr = lane & 15, fq = lane >> 4;
    const int K = g.K, nt = K / BK;
    unsigned voffA[2], voffB[2];
#pragma unroll
    for (int i = 0; i < 2; ++i) { int R, C; stage_rc(tid * 16 + i * 8192, R, C); const int Rb = Epi::PERM ? ((R & ~31) + perm32(R & 31)) : R;
        voffA[i] = (unsigned)(R * K + C) * 2u; voffB[i] = (unsigned)(Rb * K + C) * 2u; }
    const size_t kstep = (size_t)(BK * 2);
    const size_t hstep = (size_t)HALF * K * 2;
    const size_t tstep = 2 * hstep;
    const unsigned ldsw = (unsigned)wid * 1024u;
    const int aoff = lds_byte(wr * 64 + fr, fq * 8), boff = lds_byte(wc * 32 + fr, fq * 8);
#define PG8_SA(b, h) (((b) * 2 + (h)) * HTB)
#define PG8_SB(b, h) ((4 + (b) * 2 + (h)) * HTB)
#define PG8_STAGE(bufoff, gbase, voff) do { _Pragma("unroll") for (int _i = 0; _i < 2; ++_i) \
        __builtin_amdgcn_global_load_lds((const unsigned*)((const char*)(gbase) + (voff)[_i]), (PG8_LAS unsigned*)(lds + (bufoff) + ldsw + _i * 8192), 16, 0, 0); } while (0)
#define PG8_LDA(dst, b, h) do { _Pragma("unroll") for (int m = 0; m < 4; ++m) _Pragma("unroll") for (int k = 0; k < 2; ++k) dst[m][k] = *(const PG8_LAS bf16x8*)(lds + PG8_SA(b, h) + aoff + m * 2048 + k * 1024); } while (0)
#define PG8_LDB(dst, b, h) do { _Pragma("unroll") for (int n = 0; n < 2; ++n) _Pragma("unroll") for (int k = 0; k < 2; ++k) dst[n][k] = *(const PG8_LAS bf16x8*)(lds + PG8_SB(b, h) + boff + n * 2048 + k * 1024); } while (0)
#define PG8_MMA(ai, bj, At, Bt) do { __builtin_amdgcn_s_setprio(1); _Pragma("unroll") for (int m = 0; m < 4; ++m) _Pragma("unroll") for (int n = 0; n < 2; ++n) _Pragma("unroll") for (int k = 0; k < 2; ++k) \
        acc[ai][bj][m][n] = __builtin_amdgcn_mfma_f32_16x16x32_bf16(Bt[n][k], At[m][k], acc[ai][bj][m][n], 0, 0, 0); __builtin_amdgcn_s_setprio(0); } while (0)
#define PG8_WAIT_V(n) asm volatile("s_waitcnt vmcnt(" #n ")" ::: "memory")
#define PG8_WAIT_L(n) asm volatile("s_waitcnt lgkmcnt(" #n ")" ::: "memory")
#define PG8_BAR __builtin_amdgcn_s_barrier()
#define PG8_SCHED __builtin_amdgcn_sched_barrier(0)
    Unit cur, nxt; int ui = 0;
    if (!S.next(0, cur)) return;
    f32x4 acc[2][2][4][2];
#pragma unroll
    for (int a = 0; a < 2; ++a)
#pragma unroll
        for (int b = 0; b < 2; ++b)
#pragma unroll
            for (int m = 0; m < 4; ++m)
#pragma unroll
                for (int n = 0; n < 2; ++n) acc[a][b][m][n] = (f32x4){0.f, 0.f, 0.f, 0.f};
    bf16x8 At[4][2], B0[2][2], B1[2][2];
    const char* cA = (const char*)g.A + (size_t)cur.pm * tstep; const char* cB = (const char*)g.Bt + (size_t)cur.pn * tstep;
    S.a_ready(cur);
    if constexpr (SP2) {
        PG8_STAGE(PG8_SB(0, 0), cB, voffB); PG8_STAGE(PG8_SB(0, 1), cB + hstep, voffB); PG8_STAGE(PG8_SA(0, 0), cA, voffA); PG8_STAGE(PG8_SA(0, 1), cA + hstep, voffA);
        if (wr == 1) PG8_BAR;
        PG8_WAIT_V(2); PG8_BAR;
        PG8_STAGE(PG8_SB(1, 0), cB + kstep, voffB); PG8_STAGE(PG8_SA(1, 0), cA + kstep, voffA); PG8_STAGE(PG8_SB(1, 1), cB + hstep + kstep, voffB);
        PG8_WAIT_V(6); PG8_BAR;
    } else {
        PG8_STAGE(PG8_SB(0, 0), cB, voffB); PG8_STAGE(PG8_SA(0, 0), cA, voffA); PG8_STAGE(PG8_SB(0, 1), cB + hstep, voffB); PG8_STAGE(PG8_SA(0, 1), cA + hstep, voffA);
        if (wr == 1) PG8_BAR;
        PG8_WAIT_V(4); PG8_BAR;
        PG8_STAGE(PG8_SB(1, 0), cB + kstep, voffB); PG8_STAGE(PG8_SA(1, 0), cA + kstep, voffA); PG8_STAGE(PG8_SB(1, 1), cB + hstep + kstep, voffB);
        PG8_WAIT_V(6); PG8_BAR;
    }
    for (;;) {
        const bool has_next = S.next(ui + 1, nxt);
        const char* nA = has_next ? (const char*)g.A + (size_t)nxt.pm * tstep : cA; const char* nB = has_next ? (const char*)g.Bt + (size_t)nxt.pn * tstep : cB;
        for (int t = 0; t < nt; t += 2) {
            const bool last = (t == nt - 2);
            const char* a1 = cA + (size_t)(t + 1) * kstep;
            const char* a2 = last ? nA : cA + (size_t)(t + 2) * kstep; const char* b2 = last ? nB : cB + (size_t)(t + 2) * kstep;
            const char* a3 = a2 + kstep; const char* b3 = b2 + kstep;
            if (last && has_next) S.a_ready(nxt);
            if constexpr (SP2) {
            PG8_LDB(B0, 0, 0); PG8_LDB(B1, 0, 1); PG8_SCHED; PG8_LDA(At, 0, 0); PG8_STAGE(PG8_SA(1, 1), a1 + hstep, voffA);
            PG8_WAIT_V(8); PG8_WAIT_L(0); PG8_BAR; PG8_MMA(0, 0, At, B0); PG8_MMA(0, 1, At, B1); PG8_BAR; PG8_SCHED;
            PG8_LDA(At, 0, 1); PG8_STAGE(PG8_SB(0, 0), b2, voffB); PG8_STAGE(PG8_SB(0, 1), b2 + hstep, voffB); PG8_STAGE(PG8_SA(0, 0), a2, voffA);
            PG8_WAIT_V(8); PG8_WAIT_L(0); PG8_BAR; PG8_MMA(1, 0, At, B0); PG8_MMA(1, 1, At, B1); PG8_BAR; PG8_SCHED;
            PG8_LDB(B0, 1, 0); PG8_LDB(B1, 1, 1); PG8_SCHED; PG8_LDA(At, 1, 0); PG8_STAGE(PG8_SA(0, 1), a2 + hstep, voffA);
            PG8_WAIT_V(8); PG8_WAIT_L(0); PG8_BAR; PG8_MMA(0, 0, At, B0); PG8_MMA(0, 1, At, B1); PG8_BAR; PG8_SCHED;
            PG8_LDA(At, 1, 1); PG8_STAGE(PG8_SB(1, 0), b3, voffB); PG8_STAGE(PG8_SB(1, 1), b3 + hstep, voffB); PG8_STAGE(PG8_SA(1, 0), a3, voffA);
            PG8_WAIT_V(8); PG8_WAIT_L(0); PG8_BAR; PG8_MMA(1, 0, At, B0); PG8_MMA(1, 1, At, B1); PG8_BAR; PG8_SCHED;
            } else {
            PG8_LDB(B0, 0, 0); PG8_SCHED; PG8_LDA(At, 0, 0); PG8_STAGE(PG8_SA(1, 1), a1 + hstep, voffA);
            PG8_WAIT_L(8); PG8_BAR; PG8_WAIT_L(0); PG8_MMA(0, 0, At, B0); PG8_BAR; PG8_SCHED;
            PG8_LDB(B1, 0, 1); PG8_STAGE(PG8_SB(0, 0), b2, voffB);
            PG8_BAR; PG8_WAIT_L(0); PG8_MMA(0, 1, At, B1); PG8_BAR;
            PG8_LDA(At, 0, 1); PG8_STAGE(PG8_SA(0, 0), a2, voffA);
            PG8_BAR; PG8_WAIT_L(0); PG8_MMA(1, 0, At, B0); PG8_BAR; PG8_SCHED;
            PG8_STAGE(PG8_SB(0, 1), b2 + hstep, voffB);
            PG8_WAIT_V(6); PG8_BAR; PG8_MMA(1, 1, At, B1); PG8_BAR;
            PG8_LDB(B0, 1, 0); PG8_SCHED; PG8_LDA(At, 1, 0); PG8_STAGE(PG8_SA(0, 1), a2 + hstep, voffA);
            PG8_WAIT_L(8); PG8_BAR; PG8_WAIT_L(0); PG8_MMA(0, 0, At, B0); PG8_BAR; PG8_SCHED;
            PG8_LDB(B1, 1, 1); PG8_STAGE(PG8_SB(1, 0), b3, voffB);
            PG8_BAR; PG8_WAIT_L(0); PG8_MMA(0, 1, At, B1); PG8_BAR;
            PG8_LDA(At, 1, 1); PG8_STAGE(PG8_SA(1, 0), a3, voffA);
            PG8_BAR; PG8_WAIT_L(0); PG8_MMA(1, 0, At, B0); PG8_BAR; PG8_SCHED;
            PG8_STAGE(PG8_SB(1, 1), b3 + hstep, voffB);
            PG8_WAIT_V(6); PG8_BAR; PG8_MMA(1, 1, At, B1); PG8_BAR;
            }
        }
        if constexpr (ALIGN_EPI) { if (wr == 0) PG8_BAR; }
        if constexpr (!Epi::AFTER_DRAIN) { E(acc, cur, wr, wc, fr, fq); S.done(cur); }
        if (!has_next) break;
#pragma unroll
        for (int a = 0; a < 2; ++a)
#pragma unroll
            for (int b = 0; b < 2; ++b)
#pragma unroll
                for (int m = 0; m < 4; ++m)
#pragma unroll
                    for (int n = 0; n < 2; ++n) acc[a][b][m][n] = (f32x4){0.f, 0.f, 0.f, 0.f};
        cur = nxt; cA = nA; cB = nB; ++ui;
        if constexpr (ALIGN_EPI) { if (wr == 1) PG8_BAR; }
    }
    PG8_WAIT_V(0);
    if constexpr (!ALIGN_EPI) { if (wr == 0) PG8_BAR; }
    PG8_BAR;
    if constexpr (Epi::AFTER_DRAIN) { E.fused(acc, cur, wr, wc, fr, fq, lds, wid, lane); S.done(cur); }
#undef PG8_SA
#undef PG8_SB
#undef PG8_STAGE
#undef PG8_LDA
#undef PG8_LDB
#undef PG8_MMA
#undef PG8_WAIT_V
#undef PG8_WAIT_L
#undef PG8_BAR
#undef PG8_SCHED
}
}

namespace mk {
#define LAS __attribute__((address_space(3)))
#define DI __device__ __forceinline__
typedef unsigned short bf16;
typedef pg8::bf16x8 bf16x8; typedef pg8::f32x4 f32x4; typedef pg8::u32x4 u32x4; typedef pg8::u32x2 u32x2;
typedef float f32x16 __attribute__((ext_vector_type(16)));
constexpr int TOK = 32768, DM = 1024, SEQ = 4096, BW = 512, FFH = 2816, NTHR = 512;
constexpr size_t MiB = 1024 * 1024;
constexpr size_t WS_ROWSS = 474 * MiB;
constexpr size_t WS_BAR = 768 * 1024;
constexpr size_t WS_BB = 1 * MiB;
constexpr size_t WS_CM = WS_BB + 262144;
constexpr size_t WS_AP = WS_CM + 262144;
constexpr size_t WS_SGW = WS_AP + 131072;
constexpr size_t WS_E = 2 * MiB;
constexpr size_t WS_W = 10 * MiB;
constexpr size_t WL_IN = 0, WL_GLU = 17825792, WL_BR = WL_GLU + 524288, WL_O = WL_BR + 4194304, WL_FF = WL_O + 2097152, WL_D = WL_FF + 11534336, WL_SIZE = WL_D + 5767168;
static_assert(WL_SIZE == 40 * MiB, "weights per layer");
constexpr size_t WS_XB = 90 * MiB;
constexpr size_t WS_P = 154 * MiB;
constexpr size_t PBUF = 32 * MiB;
constexpr size_t WS_YG = WS_P + 9 * PBUF;
constexpr size_t WS_END = WS_YG + 32 * MiB + 2 * MiB;
constexpr int LDS_BYTES = 143360;

DI float bf2f(bf16 v) { return __uint_as_float(((unsigned)v) << 16); }
DI bf16 f2bf(float f) { return (bf16)(mk_pk2(f, 0.f) & 0xffffu); }
DI float wave_sum(float v) {
#pragma unroll
    for (int o = 1; o < 64; o <<= 1) v += __shfl_xor(v, o);
    return v; }
DI f32x16 mfma32(bf16x8 a, bf16x8 b, f32x16 c) { return __builtin_amdgcn_mfma_f32_32x32x16_bf16(a, b, c, 0, 0, 0); }
DI f32x4 mfma16(bf16x8 a, bf16x8 b, f32x4 c) { return __builtin_amdgcn_mfma_f32_16x16x32_bf16(a, b, c, 0, 0, 0); }
DI int crow(int i, int h) { return (i & 3) + 8 * (i >> 2) + 4 * h; }
DI f32x16 zero16() { f32x16 z;
#pragma unroll
    for (int i = 0; i < 16; ++i) z[i] = 0.f;
    return z; }
#define LDS_WAIT() asm volatile("s_waitcnt lgkmcnt(0)" ::: "memory")

struct Params { const float* in[28]; float* out; unsigned char* ws; int ph_lo, ph_hi; };
enum { I_X = 0, I_GMIX, I_WIN, I_CONVW, I_CONVB, I_SGW, I_SGB, I_LNG, I_LNB, I_LAMQK, I_SUBLN, I_ARE, I_AIM, I_LOGDT, I_BRE, I_BIM, I_CRE, I_CIM, I_SSMD, I_WGLU, I_BGLU, I_WBR, I_WO, I_GFFN, I_WFG, I_WFU, I_WFD, I_GFIN };

DI void tr_item(const float* W, int ldn, int k0, int n0, const float* gs, bf16* WT, int ldk, int drow0, LAS float* scr, int lane) {
    float tv[32];
#pragma unroll
    for (int i = 0; i < 32; ++i) { const int kk = 2 * i + (lane >> 5); tv[i] = W[(size_t)(k0 + kk) * ldn + n0 + (lane & 31)]; }
    if (gs) {
#pragma unroll
        for (int i = 0; i < 32; ++i) tv[i] *= gs[k0 + 2 * i + (lane >> 5)]; }
#pragma unroll
    for (int i = 0; i < 32; ++i) scr[(2 * i + (lane >> 5)) * 33 + (lane & 31)] = tv[i];
    LDS_WAIT();
    const int c = lane & 7;
#pragma unroll
    for (int j = 0; j < 4; ++j) { const int n = (lane >> 3) + 8 * j; const LAS float* s = scr + (8 * c) * 33 + n;
        u32x4 o; o.x = mk_pk2(s[0 * 33], s[1 * 33]); o.y = mk_pk2(s[2 * 33], s[3 * 33]); o.z = mk_pk2(s[4 * 33], s[5 * 33]); o.w = mk_pk2(s[6 * 33], s[7 * 33]);
        *(u32x4*)(WT + (size_t)(drow0 + n) * ldk + k0 + 8 * c) = o; }
    LDS_WAIT();
}
DI void dsincos(double x, double& s, double& c) {
    const double twopi = 6.283185307179586476925; const double k = rint(x / twopi); const double r = x - k * twopi, r2 = r * r;
    double ss = 1.0, cc = 1.0;
#pragma unroll
    for (int n = 13; n >= 1; --n) { ss = 1.0 - r2 * (1.0 / ((2.0 * n) * (2.0 * n + 1.0))) * ss; cc = 1.0 - r2 * (1.0 / ((2.0 * n - 1.0) * (2.0 * n))) * cc; }
    s = ss * r; c = cc;
}
DI void phase_prep(const Params& p, LAS unsigned char* lds, int tid, int lane, int wave, int G) {
    unsigned char* ws = p.ws;
    const int gw = blockIdx.x * 8 + wave, NGW = G * 8, gt = blockIdx.x * NTHR + tid, NGT = G * NTHR;
    LAS float* scr = (LAS float*)(lds + wave * 8704);
    for (int l = 0; l < 2; ++l) {
        unsigned char* wl = ws + WS_W + (size_t)l * WL_SIZE;
        for (int mi = 0; mi < 10; ++mi) {
            const float* src; int K, N; const float* gs = nullptr; bf16* dst; int map = 0;
            if (mi == 0) { src = p.in[I_WIN] + (size_t)l * 1024 * 8704; K = 1024; N = 8704; gs = p.in[I_GMIX] + l * 1024; dst = (bf16*)(wl + WL_IN); map = 1; }
            else if (mi == 1) { src = p.in[I_WGLU] + (size_t)l * 512 * 512; K = 512; N = 512; dst = (bf16*)(wl + WL_GLU); }
            else if (mi < 6) { const int b = mi - 2; src = p.in[I_WBR] + ((size_t)l * 4 + b) * 512 * 1024; K = 512; N = 1024; dst = (bf16*)(wl + WL_BR) + (size_t)b * 1024 * 512; }
            else if (mi == 6) { src = p.in[I_WO] + (size_t)l * 1024 * 1024; K = 1024; N = 1024; dst = (bf16*)(wl + WL_O); }
            else if (mi == 7) { src = p.in[I_WFG] + (size_t)l * 1024 * 2816; K = 1024; N = 2816; gs = p.in[I_GFFN] + l * 1024; dst = (bf16*)(wl + WL_FF); map = 2; }
            else if (mi == 8) { src = p.in[I_WFU] + (size_t)l * 1024 * 2816; K = 1024; N = 2816; gs = p.in[I_GFFN] + l * 1024; dst = (bf16*)(wl + WL_FF); map = 3; }
            else { src = p.in[I_WFD] + (size_t)l * 2816 * 1024; K = 2816; N = 1024; dst = (bf16*)(wl + WL_D); }
            const int nblk = N / 32, nit = (K / 64) * nblk;
            for (int it = gw; it < nit; it += NGW) {
                const int kb = it / nblk, nb = it % nblk, n0 = nb * 32; int dr = n0;
                if (map == 1) { if (n0 >= 3584 && n0 < 4096) dr = n0 + 512; else if (n0 >= 4096 && n0 < 4608) dr = n0 - 512; }
                else if (map == 2) dr = (n0 >> 7) * 256 + (n0 & 127);
                else if (map == 3) dr = (n0 >> 7) * 256 + 128 + (n0 & 127);
                tr_item(src, N, kb * 64, n0, gs, dst, K, dr, scr, lane);
            }
        }
    }
    { const float* x = p.in[I_X]; bf16* xb = (bf16*)(ws + WS_XB); pg8::rowss_t* rowss = (pg8::rowss_t*)(ws + WS_ROWSS);
        for (int row0 = gw * 4; row0 < TOK; row0 += NGW * 4) { f32x4 v[4][4];
#pragma unroll
            for (int q = 0; q < 4; ++q)
#pragma unroll
                for (int j = 0; j < 4; ++j) v[q][j] = *((const f32x4*)(x + (size_t)(row0 + q) * DM) + lane + 64 * j);
#pragma unroll
            for (int q = 0; q < 4; ++q) { float ss = 0.f;
#pragma unroll
                for (int j = 0; j < 4; ++j) { const f32x4 t = v[q][j]; ss += (t[0] * t[0] + t[1] * t[1]) + (t[2] * t[2] + t[3] * t[3]);
                    u32x2 w; w.x = mk_pk2(t[0], t[1]); w.y = mk_pk2(t[2], t[3]); *((u32x2*)(xb + (size_t)(row0 + q) * DM) + lane + 64 * j) = w; }
                ss = wave_sum(ss); if (lane == 0) rowss[row0 + q] = (pg8::rowss_t)(ss * 4294967296.0f); } }
        for (int i = gt; i < 4 * TOK; i += NGT) rowss[TOK + i] = 0ull; }
    { const float* sgw = p.in[I_SGW]; bf16* o = (bf16*)(ws + WS_SGW);
        for (int i = gt; i < 2 * 4 * 128 * 128; i += NGT) { const int s = i & 127, t = (i >> 7) & 127; o[i] = f2bf(s <= t ? sgw[i] : 0.f); } }
    for (int i = gt; i < 2 * 32 * 64; i += NGT) {
        const int pp = i & 63, lg = i >> 6;
        const double dt = exp((double)p.in[I_LOGDT][lg]); const double are = p.in[I_ARE][i], aim = p.in[I_AIM][i];
        const double mag = exp(dt * are); double sn, cs; dsincos(dt * aim, sn, cs);
        const double abr = mag * cs, abi = mag * sn, den = are * are + aim * aim, nr = abr - 1.0, ni = abi;
        const double cr = (nr * are + ni * aim) / den, ci = (ni * are - nr * aim) / den;
        bf16* bb = (bf16*)(ws + WS_BB) + (size_t)lg * 128 * 16; const float* bre = p.in[I_BRE] + (size_t)i * 16; const float* bim = p.in[I_BIM] + (size_t)i * 16;
        for (int h = 0; h < 16; ++h) { const double br = bre[h], bi = bim[h]; bb[pp * 16 + h] = f2bf((float)(cr * br - ci * bi)); bb[(64 + pp) * 16 + h] = f2bf((float)(cr * bi + ci * br)); }
        bf16* cm = (bf16*)(ws + WS_CM) + (size_t)lg * 16 * 128; const float* cre = p.in[I_CRE] + (size_t)lg * 16 * 64; const float* cim = p.in[I_CIM] + (size_t)lg * 16 * 64;
        for (int h = 0; h < 16; ++h) { cm[h * 128 + pp] = f2bf(cre[h * 64 + pp]); cm[h * 128 + 64 + pp] = f2bf(-cim[h * 64 + pp]); }
        double pr = abr, pi = abi; float* ap = (float*)(ws + WS_AP) + (size_t)i * 8; ap[0] = (float)pr; ap[1] = (float)pi;
        for (int q = 0; q < 5; ++q) { const double t = pr * pr - pi * pi; pi = 2.0 * pr * pi; pr = t; }
        ap[2] = (float)pr; ap[3] = (float)pi;
        { const double t = pr * pr - pi * pi; pi = 2.0 * pr * pi; pr = t; }
        ap[4] = (float)pr; ap[5] = (float)pi; ap[6] = 0.f; ap[7] = 0.f;
    }
}

DI void phase_branchA(const Params& p, int l, int tid, int G) {
    bf16* AB = (bf16*)(p.ws + WS_P); const bf16* AC = (const bf16*)(p.ws + WS_P + PBUF); const bf16* AX = (const bf16*)(p.ws + WS_P + 2 * PBUF);
    const float* cw = p.in[I_CONVW] + l * 3 * 512; const float* cb = p.in[I_CONVB] + l * 512;
    for (int idx = blockIdx.x * NTHR + tid; idx < (TOK / 16) * 64; idx += G * NTHR) {
        const int cgp = idx & 63, run = idx >> 6, c0 = cgp * 8, t0 = run * 16;
        f32x4 w0[2], w1[2], w2[2], bb[2];
#pragma unroll
        for (int e = 0; e < 2; ++e) { w0[e] = *(const f32x4*)(cw + c0 + 4 * e); w1[e] = *(const f32x4*)(cw + 512 + c0 + 4 * e); w2[e] = *(const f32x4*)(cw + 1024 + c0 + 4 * e); bb[e] = *(const f32x4*)(cb + c0 + 4 * e); }
        f32x4 zm2[2] = {{0.f, 0.f, 0.f, 0.f}, {0.f, 0.f, 0.f, 0.f}}, zm1[2] = {{0.f, 0.f, 0.f, 0.f}, {0.f, 0.f, 0.f, 0.f}};
        if ((t0 & (SEQ - 1)) != 0) {
            f32x4 a0, a1, x0, x1;
            pg8::unpack8(*(const u32x4*)(AC + (size_t)(t0 - 2) * 512 + c0), a0, a1); pg8::unpack8(*(const u32x4*)(AX + (size_t)(t0 - 2) * 512 + c0), x0, x1); zm2[0] = a0 * x0; zm2[1] = a1 * x1;
            pg8::unpack8(*(const u32x4*)(AC + (size_t)(t0 - 1) * 512 + c0), a0, a1); pg8::unpack8(*(const u32x4*)(AX + (size_t)(t0 - 1) * 512 + c0), x0, x1); zm1[0] = a0 * x0; zm1[1] = a1 * x1;
        }
#pragma unroll 4
        for (int i = 0; i < 16; ++i) { const size_t off = (size_t)(t0 + i) * 512 + c0;
            f32x4 a0, a1, x0, x1, b0, b1; pg8::unpack8(*(const u32x4*)(AC + off), a0, a1); pg8::unpack8(*(const u32x4*)(AX + off), x0, x1); pg8::unpack8(*(const u32x4*)(AB + off), b0, b1);
            const f32x4 z0 = a0 * x0, z1 = a1 * x1;
            const f32x4 y0 = b0 * (w0[0] * zm2[0] + w1[0] * zm1[0] + w2[0] * z0 + bb[0]), y1 = b1 * (w0[1] * zm2[1] + w1[1] * zm1[1] + w2[1] * z1 + bb[1]);
            *(u32x4*)(AB + off) = pg8::pack8(y0, y1);
            zm2[0] = zm1[0]; zm2[1] = zm1[1]; zm1[0] = z0; zm1[1] = z1; }
    }
}

DI void phase_branchB(const Params& p, int l, LAS unsigned char* lds, int tid, int lane, int wave, int G) {
    bf16* BU = (bf16*)(p.ws + WS_P + 3 * PBUF); const bf16* BV = (const bf16*)(p.ws + WS_P + 4 * PBUF);
    const bf16* SGW = (const bf16*)(p.ws + WS_SGW) + (size_t)l * 4 * 128 * 128; const float* sgb = p.in[I_SGB] + l * 4 * 128;
    const float* lng = p.in[I_LNG] + l * 512 + lane * 8; const float* lnb = p.in[I_LNB] + l * 512 + lane * 8;
    constexpr int RS = 1040;
    const int r = lane & 31, half = lane >> 5;
    for (int item = blockIdx.x; item < TOK / 128; item += G) {
        const int tok0 = item * 128;
        { const f32x4 g0 = *(const f32x4*)lng, g1 = *(const f32x4*)(lng + 4), b0 = *(const f32x4*)lnb, b1 = *(const f32x4*)(lnb + 4);
            for (int tt = 0; tt < 16; ++tt) { const int s = wave * 16 + tt;
                f32x4 v0, v1; pg8::unpack8(*(const u32x4*)(BV + (size_t)(tok0 + s) * 512 + lane * 8), v0, v1);
#pragma unroll
                for (int j = 0; j < 4; ++j) { v0[j] = mk_gelu(v0[j]); v1[j] = mk_gelu(v1[j]); }
                const float mean = wave_sum((v0[0] + v0[1]) + (v0[2] + v0[3]) + (v1[0] + v1[1]) + (v1[2] + v1[3])) * (1.0f / 512.0f);
                v0 = v0 - mean; v1 = v1 - mean;
                const float var = wave_sum((v0[0] * v0[0] + v0[1] * v0[1]) + (v0[2] * v0[2] + v0[3] * v0[3]) + (v1[0] * v1[0] + v1[1] * v1[1]) + (v1[2] * v1[2] + v1[3] * v1[3])) * (1.0f / 512.0f);
                const float rstd = rsqrtf(var + 1e-5f);
                v0 = v0 * rstd * g0 + b0; v1 = v1 * rstd * g1 + b1;
                *(LAS u32x4*)(lds + s * RS + lane * 16) = pg8::pack8(v0, v1); } }
        __syncthreads();
        const int g = wave >> 1, dh = wave & 1;
        f32x16 acc[4][2];
#pragma unroll
        for (int a = 0; a < 4; ++a) { acc[a][0] = zero16(); acc[a][1] = zero16(); }
#pragma unroll
        for (int ks = 0; ks < 8; ++ks) {
            bf16x8 Vf[2];
#pragma unroll
            for (int dt = 0; dt < 2; ++dt) { const LAS unsigned short* vp = (const LAS unsigned short*)(lds + (16 * ks + 8 * half) * RS + (g * 128 + dh * 64 + dt * 32 + r) * 2);
#pragma unroll
                for (int j = 0; j < 8; ++j) Vf[dt][j] = (short)vp[j * (RS / 2)]; }
#pragma unroll
            for (int tt = ks >> 1; tt < 4; ++tt) { const bf16x8 Wf = *(const bf16x8*)(SGW + ((size_t)g * 128 + 32 * tt + r) * 128 + 16 * ks + 8 * half);
                acc[tt][0] = mfma32(Vf[0], Wf, acc[tt][0]); acc[tt][1] = mfma32(Vf[1], Wf, acc[tt][1]); }
        }
        asm volatile("s_nop 15\n\ts_nop 7" : "+v"(acc[0][0]), "+v"(acc[0][1]), "+v"(acc[1][0]), "+v"(acc[1][1]), "+v"(acc[2][0]), "+v"(acc[2][1]), "+v"(acc[3][0]), "+v"(acc[3][1]));
#pragma unroll
        for (int tt = 0; tt < 4; ++tt) { const int t = 32 * tt + r; const float bias = sgb[g * 128 + t];
#pragma unroll
            for (int dt = 0; dt < 2; ++dt)
#pragma unroll
                for (int ig = 0; ig < 4; ++ig) { bf16* up = BU + (size_t)(tok0 + t) * 512 + g * 128 + dh * 64 + dt * 32 + 8 * ig + 4 * half;
                    const u32x2 uw = *(const u32x2*)up;
                    const float y0 = mk_gelu(mk_lo(uw.x)) * (acc[tt][dt][4 * ig + 0] + bias), y1 = mk_gelu(mk_hi(uw.x)) * (acc[tt][dt][4 * ig + 1] + bias);
                    const float y2 = mk_gelu(mk_lo(uw.y)) * (acc[tt][dt][4 * ig + 2] + bias), y3 = mk_gelu(mk_hi(uw.y)) * (acc[tt][dt][4 * ig + 3] + bias);
                    u32x2 o; o.x = mk_pk2(y0, y1); o.y = mk_pk2(y2, y3); *(u32x2*)up = o; } }
        __syncthreads();
    }
}

DI void phase_attn(const Params& p, int l, LAS unsigned char* lds, int tid, int lane, int wave, int G, bf16* OUTP) {
    const bf16* CQ = (const bf16*)(p.ws + WS_P + 5 * PBUF); const bf16* CK = (const bf16*)(p.ws + WS_P + 6 * PBUF); const bf16* VT = (const bf16*)(p.ws + WS_P + 8 * PBUF);
    const float lam_init = 0.8f - 0.6f * expf(-0.3f * (float)l);
    const float* lq = p.in[I_LAMQK] + l * 256;
    const float lam = expf(wave_sum(lq[lane] * lq[64 + lane])) - expf(wave_sum(lq[128 + lane] * lq[192 + lane])) + lam_init;
    const float* sg = p.in[I_SUBLN] + l * 128;
    const int m = wave & 1, sub = wave >> 1, r = lane & 31, half = lane >> 5;
    constexpr int KROW = 144, VROW = 136, KBYTES = 64 * KROW  , VOFF = 2 * KBYTES  , STAGE = VOFF + 128 * KROW  ;
    const float cs = 0.125f * 1.44269504089f;
    for (int pi = blockIdx.x; pi < 512; pi += G) {
#pragma unroll 1
        for (int uu = 0; uu < 2; ++uu) {
            const int bh = pi >> 4, jp = pi & 15, qb = uu ? 31 - jp : jp, b = bh >> 2, h = bh & 3;
            const int tokq0 = b * SEQ + qb * 128, qrow = tokq0 + 32 * sub + r;
            bf16x8 Qf[4];
#pragma unroll
            for (int ks = 0; ks < 4; ++ks) Qf[ks] = *(const bf16x8*)(CQ + (size_t)qrow * 512 + h * 128 + m * 64 + 16 * ks + 8 * half);
            const int nt = 2 * qb + 2, my_last = 2 * qb + (sub >> 1);
            const bf16* kg[2]; const bf16* vg[2]; int kl[2], vl[2];
#pragma unroll
            for (int i = 0; i < 2; ++i) { const int idx = tid + 512 * i; const int key = idx >> 4, c16 = idx & 15;
                kg[i] = CK + (size_t)(b * SEQ + key) * 512 + h * 128 + c16 * 8; kl[i] = (c16 >> 3) * KBYTES + key * KROW + (c16 & 7) * 16;
                const int dv = idx >> 3, c8 = idx & 7;
                vg[i] = VT + (size_t)(h * 128 + dv) * TOK + b * SEQ + c8 * 8; vl[i] = VOFF + dv * VROW + c8 * 16; }
            u32x4 st[4];
            st[0] = *(const u32x4*)kg[0]; st[1] = *(const u32x4*)kg[1]; st[2] = *(const u32x4*)vg[0]; st[3] = *(const u32x4*)vg[1];
            *(LAS u32x4*)(lds + kl[0]) = st[0]; *(LAS u32x4*)(lds + kl[1]) = st[1]; *(LAS u32x2*)(lds + vl[0]) = (u32x2){st[2].x, st[2].y}; *(LAS u32x2*)(lds + vl[0] + 8) = (u32x2){st[2].z, st[2].w}; *(LAS u32x2*)(lds + vl[1]) = (u32x2){st[3].x, st[3].y}; *(LAS u32x2*)(lds + vl[1] + 8) = (u32x2){st[3].z, st[3].w};
            __syncthreads();
            f32x16 O[4];
#pragma unroll
            for (int i = 0; i < 4; ++i) O[i] = zero16();
            float m_run = -INFINITY, l_run = 0.f;
#pragma unroll 1
            for (int kt = 0; kt < nt; ++kt) {
                const bool more = (kt + 1 < nt);
                if (more) { const size_t ko = (size_t)(kt + 1) * 64 * 512, vo = (size_t)(kt + 1) * 64;
                    st[0] = *(const u32x4*)(kg[0] + ko); st[1] = *(const u32x4*)(kg[1] + ko); st[2] = *(const u32x4*)(vg[0] + vo); st[3] = *(const u32x4*)(vg[1] + vo); }
                const LAS unsigned char* buf = lds + (kt & 1) * STAGE;
                if (kt <= my_last) {
                    f32x16 S[2];
#pragma unroll
                    for (int u = 0; u < 2; ++u) { S[u] = zero16();
#pragma unroll
                        for (int ks = 0; ks < 4; ++ks) { const bf16x8 A = *(const LAS bf16x8*)(buf + m * KBYTES + (32 * u + r) * KROW + (16 * ks + 8 * half) * 2); S[u] = mfma32(A, Qf[ks], S[u]); } }
                    asm volatile("s_nop 15\n\ts_nop 7" : "+v"(S[0]), "+v"(S[1]));
                    float mx = -INFINITY;
#pragma unroll
                    for (int u = 0; u < 2; ++u)
#pragma unroll
                        for (int i = 0; i < 16; ++i) mx = fmaxf(mx, S[u][i]);
                    mx = fmaxf(mx, __shfl_xor(mx, 32));
                    const float m_new = fmaxf(m_run, mx * cs), alpha = __builtin_amdgcn_exp2f(m_run - m_new);
                    float ps = 0.f;
#pragma unroll
                    for (int u = 0; u < 2; ++u)
#pragma unroll
                        for (int i = 0; i < 16; ++i) { const float e = __builtin_amdgcn_exp2f(S[u][i] * cs - m_new); S[u][i] = e; ps += e; }
                    ps += __shfl_xor(ps, 32);
                    l_run = l_run * alpha + ps; m_run = m_new;
#pragma unroll
                    for (int d = 0; d < 4; ++d)
#pragma unroll
                        for (int i = 0; i < 16; ++i) O[d][i] *= alpha;
                    bf16x8 Pf[2][2];
#pragma unroll
                    for (int u = 0; u < 2; ++u)
#pragma unroll
                        for (int s = 0; s < 2; ++s) { u32x4 w; w.x = mk_pk2(S[u][8 * s + 0], S[u][8 * s + 1]); w.y = mk_pk2(S[u][8 * s + 2], S[u][8 * s + 3]); w.z = mk_pk2(S[u][8 * s + 4], S[u][8 * s + 5]); w.w = mk_pk2(S[u][8 * s + 6], S[u][8 * s + 7]);
                            Pf[u][s] = __builtin_bit_cast(bf16x8, w); }
#pragma unroll
                    for (int d = 0; d < 4; ++d)
#pragma unroll
                        for (int u = 0; u < 2; ++u)
#pragma unroll
                            for (int s = 0; s < 2; ++s) { const LAS unsigned char* va = buf + VOFF + (32 * d + r) * VROW + (32 * u + 16 * s + 4 * half) * 2;
                                const u32x2 lo = *(const LAS u32x2*)va, hi = *(const LAS u32x2*)(va + 16);
                                u32x4 w; w.x = lo.x; w.y = lo.y; w.z = hi.x; w.w = hi.y;
                                O[d] = mfma32(__builtin_bit_cast(bf16x8, w), Pf[u][s], O[d]); }
                }
                if (more) { LAS unsigned char* nb = lds + ((kt + 1) & 1) * STAGE;
                    *(LAS u32x4*)(nb + kl[0]) = st[0]; *(LAS u32x4*)(nb + kl[1]) = st[1]; *(LAS u32x2*)(nb + vl[0]) = (u32x2){st[2].x, st[2].y}; *(LAS u32x2*)(nb + vl[0] + 8) = (u32x2){st[2].z, st[2].w}; *(LAS u32x2*)(nb + vl[1]) = (u32x2){st[3].x, st[3].y}; *(LAS u32x2*)(nb + vl[1] + 8) = (u32x2){st[3].z, st[3].w}; }
                __syncthreads();
            }
            asm volatile("s_nop 15\n\ts_nop 7" : "+v"(O[0]), "+v"(O[1]), "+v"(O[2]), "+v"(O[3]));
            const float inv = 1.0f / l_run;
            LAS float* Cb = (LAS float*)lds;
            if (m == 1) { const float f = inv * lam;
#pragma unroll
                for (int d = 0; d < 4; ++d)
#pragma unroll
                    for (int i = 0; i < 16; ++i) Cb[(sub * 128 + 32 * d + crow(i, half)) * 33 + r] = O[d][i] * f; }
            __syncthreads();
            if (m == 0) { float ss = 0.f;
#pragma unroll
                for (int d = 0; d < 4; ++d)
#pragma unroll
                    for (int i = 0; i < 16; ++i) { const float o = O[d][i] * inv - Cb[(sub * 128 + 32 * d + crow(i, half)) * 33 + r]; O[d][i] = o; ss += o * o; }
                ss += __shfl_xor(ss, 32);
                const float rs = rsqrtf(ss * (1.0f / 128.0f) + 1e-5f) * (1.0f - lam_init);
#pragma unroll
                for (int d = 0; d < 4; ++d)
#pragma unroll
                    for (int ig = 0; ig < 4; ++ig) { const int dv0 = 32 * d + 8 * ig + 4 * half; const f32x4 gn = *(const f32x4*)(sg + dv0);
                        u32x2 w; w.x = mk_pk2(O[d][4 * ig + 0] * rs * gn[0], O[d][4 * ig + 1] * rs * gn[1]); w.y = mk_pk2(O[d][4 * ig + 2] * rs * gn[2], O[d][4 * ig + 3] * rs * gn[3]);
                        *(u32x2*)(OUTP + (size_t)qrow * 512 + h * 128 + dv0) = w; } }
            __syncthreads();
        }
    }
}

template <bool PRODUCER> DI void attn2_unit(const bf16* CQ, const bf16* CK, const bf16* VT, bf16* OUTP, const float* sg, float lam, float lam_init, LAS unsigned char* lds, int tid, int lane, int sub, int b, int h, int qb) {
    const int r = lane & 31, half = lane >> 5;
    constexpr int KROW = 144, VROW = 136, KB1 = 64 * KROW, KST = 2 * KB1  , VST = 128 * VROW  ;
    constexpr int OFF_K = 0, OFF_V = 2 * KST  , OFF_P = OFF_V + 2 * VST  , PST = 32768, OFF_A = OFF_P + 2 * PST  , AST = 1024, OFF_L = 139392;
    const float cs = 0.125f * 1.44269504089f;
            const int tokq0 = b * SEQ + qb * 128, qrow = tokq0 + 32 * sub + r;
            const int nt = 2 * qb + 2, my_last = 2 * qb + (sub >> 1);
            const bf16* kg[2]; const bf16* vg[2]; int kl[2], vl[2];
#pragma unroll
            for (int i = 0; i < 2; ++i) { const int idx = tid + 512 * i; const int key = idx >> 4, c16 = idx & 15;
                kg[i] = CK + (size_t)(b * SEQ + key) * 512 + h * 128 + c16 * 8; kl[i] = OFF_K + (c16 >> 3) * KB1 + key * KROW + (c16 & 7) * 16;
                const int dv = idx >> 3, c8 = idx & 7;
                vg[i] = VT + (size_t)(h * 128 + dv) * TOK + b * SEQ + c8 * 8; vl[i] = OFF_V + dv * VROW + c8 * 16; }
            bf16x8 Qf[2][4];
            f32x16 O[2][4];
            float m_run[2] = {-INFINITY, -INFINITY}, l_run[2] = {0.f, 0.f};
            if (PRODUCER) {
#pragma unroll
                for (int m = 0; m < 2; ++m)
#pragma unroll
                    for (int ks = 0; ks < 4; ++ks) Qf[m][ks] = *(const bf16x8*)(CQ + (size_t)qrow * 512 + h * 128 + m * 64 + 16 * ks + 8 * half);
            } else {
#pragma unroll
                for (int m = 0; m < 2; ++m)
#pragma unroll
                    for (int d = 0; d < 4; ++d) O[m][d] = zero16();
            }
            u32x4 sk[2], sv[2];
            sk[0] = *(const u32x4*)kg[0]; sk[1] = *(const u32x4*)kg[1];
            *(LAS u32x4*)(lds + kl[0]) = sk[0]; *(LAS u32x4*)(lds + kl[1]) = sk[1];
            __syncthreads();
#pragma unroll 1
            for (int i = 0; i <= nt; ++i) {
                const bool ldk = (i + 1 < nt), ldv = (i < nt);
                if (ldk) { const size_t ko = (size_t)(i + 1) * 64 * 512; sk[0] = *(const u32x4*)(kg[0] + ko); sk[1] = *(const u32x4*)(kg[1] + ko); }
                if (ldv) { const size_t vo = (size_t)i * 64; sv[0] = *(const u32x4*)(vg[0] + vo); sv[1] = *(const u32x4*)(vg[1] + vo); }
                if (PRODUCER) {
                    if (i < nt && i <= my_last) {
                        const LAS unsigned char* kb = lds + OFF_K + (i & 1) * KST;
                        LAS unsigned char* pb = lds + OFF_P + (i & 1) * PST + (sub * 2) * 4096 + lane * 16;
                        LAS float* ab = (LAS float*)(lds + OFF_A + (i & 1) * AST) + (sub * 2) * 32 + r;
#pragma unroll
                        for (int m = 0; m < 2; ++m) {
                            f32x16 S[2];
#pragma unroll
                            for (int u = 0; u < 2; ++u) { S[u] = zero16();
#pragma unroll
                                for (int ks = 0; ks < 4; ++ks) { const bf16x8 A = *(const LAS bf16x8*)(kb + m * KB1 + (32 * u + r) * KROW + (16 * ks + 8 * half) * 2); S[u] = mfma32(A, Qf[m][ks], S[u]); } }
                            asm volatile("s_nop 15\n\ts_nop 7" : "+v"(S[0]), "+v"(S[1]));
                            float mx = -INFINITY;
#pragma unroll
                            for (int u = 0; u < 2; ++u)
#pragma unroll
                                for (int k = 0; k < 16; ++k) mx = fmaxf(mx, S[u][k]);
                            mx = fmaxf(mx, __shfl_xor(mx, 32));
                            const float m_new = fmaxf(m_run[m], mx * cs), alpha = __builtin_amdgcn_exp2f(m_run[m] - m_new);
                            float ps = 0.f;
#pragma unroll
                            for (int u = 0; u < 2; ++u)
#pragma unroll
                                for (int k = 0; k < 16; ++k) { const float e = __builtin_amdgcn_exp2f(S[u][k] * cs - m_new); S[u][k] = e; ps += e; }
                            ps += __shfl_xor(ps, 32);
                            l_run[m] = l_run[m] * alpha + ps; m_run[m] = m_new;
                            if (half == 0) ab[m * 32] = alpha;
#pragma unroll
                            for (int u = 0; u < 2; ++u)
#pragma unroll
                                for (int s = 0; s < 2; ++s) { u32x4 w; w.x = mk_pk2(S[u][8 * s + 0], S[u][8 * s + 1]); w.y = mk_pk2(S[u][8 * s + 2], S[u][8 * s + 3]); w.z = mk_pk2(S[u][8 * s + 4], S[u][8 * s + 5]); w.w = mk_pk2(S[u][8 * s + 6], S[u][8 * s + 7]);
                                    *(LAS u32x4*)(pb + m * 4096 + (u * 2 + s) * 1024) = w; }
                        }
                    }
                } else {
                    const int j = i - 1;
                    if (j >= 0 && j <= my_last) {
                        const LAS unsigned char* vb = lds + OFF_V + (j & 1) * VST;
                        const LAS unsigned char* pb = lds + OFF_P + (j & 1) * PST + (sub * 2) * 4096 + lane * 16;
                        const LAS float* ab = (const LAS float*)(lds + OFF_A + (j & 1) * AST) + (sub * 2) * 32 + r;
                        const float a0 = ab[0], a1 = ab[32];
#pragma unroll
                        for (int d = 0; d < 4; ++d)
#pragma unroll
                            for (int k = 0; k < 16; ++k) { O[0][d][k] *= a0; O[1][d][k] *= a1; }
#pragma unroll
                        for (int q = 0; q < 4; ++q) { const bf16x8 P0 = *(const LAS bf16x8*)(pb + q * 1024), P1 = *(const LAS bf16x8*)(pb + 4096 + q * 1024);
#pragma unroll
                            for (int d = 0; d < 4; ++d) { const LAS unsigned char* va = vb + (32 * d + r) * VROW + (16 * q + 4 * half) * 2;
                                const u32x2 lo = *(const LAS u32x2*)va, hi = *(const LAS u32x2*)(va + 16);
                                u32x4 w; w.x = lo.x; w.y = lo.y; w.z = hi.x; w.w = hi.y; const bf16x8 Vf = __builtin_bit_cast(bf16x8, w);
                                O[0][d] = mfma32(Vf, P0, O[0][d]); O[1][d] = mfma32(Vf, P1, O[1][d]); } }
                    }
                }
                if (ldk) { LAS unsigned char* nb = lds + ((i + 1) & 1) * KST; *(LAS u32x4*)(nb + kl[0]) = sk[0]; *(LAS u32x4*)(nb + kl[1]) = sk[1]; }
                if (ldv) { LAS unsigned char* nb = lds + (i & 1) * VST;
                    *(LAS u32x2*)(nb + vl[0]) = (u32x2){sv[0].x, sv[0].y}; *(LAS u32x2*)(nb + vl[0] + 8) = (u32x2){sv[0].z, sv[0].w}; *(LAS u32x2*)(nb + vl[1]) = (u32x2){sv[1].x, sv[1].y}; *(LAS u32x2*)(nb + vl[1] + 8) = (u32x2){sv[1].z, sv[1].w}; }
                __syncthreads();
            }
            LAS float* Lb = (LAS float*)(lds + OFF_L) + (sub * 2) * 32 + r;
            if (PRODUCER && half == 0) { Lb[0] = l_run[0]; Lb[32] = l_run[1]; }
            __syncthreads();
            if (!PRODUCER) {
                asm volatile("s_nop 15\n\ts_nop 7" : "+v"(O[0][0]), "+v"(O[0][1]), "+v"(O[0][2]), "+v"(O[0][3]), "+v"(O[1][0]), "+v"(O[1][1]), "+v"(O[1][2]), "+v"(O[1][3]));
                const float inv0 = 1.0f / Lb[0], inv1 = lam / Lb[32];
                float ss = 0.f;
#pragma unroll
                for (int d = 0; d < 4; ++d)
#pragma unroll
                    for (int k = 0; k < 16; ++k) { const float o = O[0][d][k] * inv0 - O[1][d][k] * inv1; O[0][d][k] = o; ss += o * o; }
                ss += __shfl_xor(ss, 32);
                const float rs = rsqrtf(ss * (1.0f / 128.0f) + 1e-5f) * (1.0f - lam_init);
#pragma unroll
                for (int d = 0; d < 4; ++d)
#pragma unroll
                    for (int ig = 0; ig < 4; ++ig) { const int dv0 = 32 * d + 8 * ig + 4 * half; const f32x4 gn = *(const f32x4*)(sg + dv0);
                        u32x2 w; w.x = mk_pk2(O[0][d][4 * ig + 0] * rs * gn[0], O[0][d][4 * ig + 1] * rs * gn[1]); w.y = mk_pk2(O[0][d][4 * ig + 2] * rs * gn[2], O[0][d][4 * ig + 3] * rs * gn[3]);
                        *(u32x2*)(OUTP + (size_t)qrow * 512 + h * 128 + dv0) = w; }
            }
            __syncthreads();
}
DI void phase_attn2(const Params& p, int l, LAS unsigned char* lds, int tid, int lane, int wave, int G, bf16* OUTP) {
    const bf16* CQ = (const bf16*)(p.ws + WS_P + 5 * PBUF); const bf16* CK = (const bf16*)(p.ws + WS_P + 6 * PBUF); const bf16* VT = (const bf16*)(p.ws + WS_P + 8 * PBUF);
    const float lam_init = 0.8f - 0.6f * expf(-0.3f * (float)l);
    const float* lq = p.in[I_LAMQK] + l * 256;
    const float lam = expf(wave_sum(lq[lane] * lq[64 + lane])) - expf(wave_sum(lq[128 + lane] * lq[192 + lane])) + lam_init;
    const float* sg = p.in[I_SUBLN] + l * 128;
    const bool producer = wave < 4; const int sub = wave & 3;
    for (int pi0 = blockIdx.x; pi0 < 512; pi0 += G) {
        const int pi = (G == 256) ? (((int)blockIdx.x & 7) * 64 + (pi0 >> 8) * 32 + ((int)blockIdx.x >> 3)) : pi0;
#pragma unroll 1
        for (int uu = 0; uu < 2; ++uu) {
            const int bh = pi >> 4, jp = pi & 15, qb = uu ? 31 - jp : jp, b = bh >> 2, h = bh & 3;
            if (producer) attn2_unit<true>(CQ, CK, VT, OUTP, sg, lam, lam_init, lds, tid, lane, sub, b, h, qb);
            else attn2_unit<false>(CQ, CK, VT, OUTP, sg, lam, lam_init, lds, tid, lane, sub, b, h, qb);
        }
    }
}

template <bool P2> DI void phase_ssm(const Params& p, int l, LAS unsigned char* lds, int lane, int wave, int G) {
    const bf16* DU = (const bf16*)(p.ws + WS_P + 7 * PBUF); bf16* YG = (bf16*)(p.ws + WS_YG); float* E = (float*)(p.ws + WS_E);
    const bf16* BB = (const bf16*)(p.ws + WS_BB) + (size_t)l * 32 * 128 * 16; const bf16* CM = (const bf16*)(p.ws + WS_CM) + (size_t)l * 32 * 16 * 128;
    const float* AP = (const float*)(p.ws + WS_AP) + (size_t)l * 32 * 64 * 8; const float* dsk = p.in[I_SSMD] + l * 512;
    const int r = lane & 31, half = lane >> 5, r16 = lane & 15, q4 = lane >> 4;
    constexpr int XRS = 272;
    LAS unsigned char* Xs = lds + wave * (64 * XRS);
    for (int sw = blockIdx.x * 8 + wave; sw < 2048; sw += G * 8) {
      const int g = (sw & 7) + 8 * ((sw >> 3) & 3), cb = (sw >> 5) & 7, b = sw >> 8;
      float sr0 = 0.f, si0 = 0.f, sr1 = 0.f, si1 = 0.f;
#pragma unroll 1
      for (int ci = 0; ci < 8; ++ci) {
        const int c = cb * 8 + ci, tok0 = b * SEQ + c * 64;
        const int ch = g * 16 + r16; float dk = 0.f; bf16x8 Cf[4]; float uu[4][4];
        if (P2) { dk = dsk[ch];
#pragma unroll
            for (int mt = 0; mt < 4; ++mt)
#pragma unroll
                for (int j = 0; j < 4; ++j) uu[mt][j] = bf2f(DU[(size_t)(tok0 + 16 * mt + 4 * q4 + j) * 512 + ch]); }
        f32x16 X[4][2];
        { bf16x8 Uf[2], Bf[4];
#pragma unroll
            for (int tt = 0; tt < 2; ++tt) { const int tau = 32 * ((r >> 2) & 1) + 16 * tt + (r & 3) + 4 * (r >> 3); Uf[tt] = *(const bf16x8*)(DU + (size_t)(tok0 + tau) * 512 + g * 16 + 8 * half); }
#pragma unroll
            for (int pt = 0; pt < 4; ++pt) Bf[pt] = *(const bf16x8*)(BB + ((size_t)g * 128 + 32 * pt + r) * 16 + 8 * half);
#pragma unroll
            for (int pt = 0; pt < 4; ++pt)
#pragma unroll
                for (int tt = 0; tt < 2; ++tt) X[pt][tt] = mfma32(Uf[tt], Bf[pt], zero16()); }
        asm volatile("s_nop 15\n\ts_nop 15" : "+v"(X[0][0]), "+v"(X[0][1]), "+v"(X[1][0]), "+v"(X[1][1]), "+v"(X[2][0]), "+v"(X[2][1]), "+v"(X[3][0]), "+v"(X[3][1]));
        float ar[2], ai[2], a32r[2], a32i[2], a64r[2], a64i[2];
#pragma unroll
        for (int s = 0; s < 2; ++s) { const float* ap = AP + ((size_t)g * 64 + 32 * s + r) * 8; const f32x4 v = *(const f32x4*)ap; ar[s] = v[0]; ai[s] = v[1]; a32r[s] = v[2]; a32i[s] = v[3]; a64r[s] = ap[4]; a64i[s] = ap[5]; }
        float xr[2] = {0.f, 0.f}, xi[2] = {0.f, 0.f};
        if (P2) {
            const float* e0 = E + (((size_t)(b * 32 + g) * 64) * 64 + r) * 2;
#pragma unroll 4
            for (int j = (ci == 0 ? 0 : c - 1); j < c; ++j) { const float2 ea = *(const float2*)(e0 + (size_t)j * 128), eb = *(const float2*)(e0 + (size_t)j * 128 + 64);
                const float t0 = a64r[0] * sr0 - a64i[0] * si0 + ea.x; si0 = a64r[0] * si0 + a64i[0] * sr0 + ea.y; sr0 = t0;
                const float t1 = a64r[1] * sr1 - a64i[1] * si1 + eb.x; si1 = a64r[1] * si1 + a64i[1] * sr1 + eb.y; sr1 = t1; }
            if (half == 0) { xr[0] = sr0; xi[0] = si0; xr[1] = sr1; xi[1] = si1; }
        }
#pragma unroll
        for (int s = 0; s < 2; ++s)
#pragma unroll
            for (int tt = 0; tt < 2; ++tt)
#pragma unroll
                for (int i = 0; i < 16; ++i) { const float nr = ar[s] * xr[s] - ai[s] * xi[s] + X[s][tt][i], ni = ar[s] * xi[s] + ai[s] * xr[s] + X[2 + s][tt][i]; X[s][tt][i] = nr; X[2 + s][tt][i] = ni; xr[s] = nr; xi[s] = ni; }
        float oxr[2], oxi[2];
#pragma unroll
        for (int s = 0; s < 2; ++s) { oxr[s] = __shfl_xor(xr[s], 32); oxi[s] = __shfl_xor(xi[s], 32); }
        if (!P2) {
            if (half == 1) {
#pragma unroll
                for (int s = 0; s < 2; ++s) { float2 e; e.x = xr[s] + a32r[s] * oxr[s] - a32i[s] * oxi[s]; e.y = xi[s] + a32r[s] * oxi[s] + a32i[s] * oxr[s];
                    *(float2*)(E + (((size_t)(b * 32 + g) * 64 + c) * 64 + 32 * s + r) * 2) = e; } }
        } else {
#pragma unroll
            for (int s = 0; s < 2; ++s) { float wr_ = half ? oxr[s] : 0.f, wi_ = half ? oxi[s] : 0.f;
#pragma unroll
                for (int tt = 0; tt < 2; ++tt)
#pragma unroll
                    for (int i = 0; i < 16; ++i) { const float t = ar[s] * wr_ - ai[s] * wi_; wi_ = ar[s] * wi_ + ai[s] * wr_; wr_ = t; X[s][tt][i] += wr_; X[2 + s][tt][i] += wi_; } }
#pragma unroll
            for (int pt = 0; pt < 4; ++pt)
#pragma unroll
                for (int tt = 0; tt < 2; ++tt)
#pragma unroll
                    for (int i = 0; i < 16; ++i) *(LAS unsigned short*)(Xs + (32 * half + 16 * tt + i) * XRS + (32 * pt + r) * 2) = f2bf(X[pt][tt][i]);
#pragma unroll
            for (int ks = 0; ks < 4; ++ks) Cf[ks] = *(const bf16x8*)(CM + ((size_t)g * 16 + r16) * 128 + 32 * ks + 8 * q4);
            LDS_WAIT();
#pragma unroll
            for (int mt = 0; mt < 4; ++mt) { f32x4 acc = {0.f, 0.f, 0.f, 0.f};
#pragma unroll
                for (int ks = 0; ks < 4; ++ks) { const bf16x8 A = *(const LAS bf16x8*)(Xs + (16 * mt + r16) * XRS + (32 * ks + 8 * q4) * 2); acc = mfma16(A, Cf[ks], acc); }
                asm volatile("s_nop 15" : "+v"(acc));
#pragma unroll
                for (int j = 0; j < 4; ++j) { const size_t o = (size_t)(tok0 + 16 * mt + 4 * q4 + j) * 512 + ch; const float y = acc[j] + dk * uu[mt][j]; YG[o] = f2bf(mk_gelu(y)); } }
            LDS_WAIT();
        }
      }
    }
}

DI void phase_ssm1(const Params& p, int l, int lane, int wave, int G) {
    const bf16* DU = (const bf16*)(p.ws + WS_P + 7 * PBUF); float* E = (float*)(p.ws + WS_E);
    const bf16* BB = (const bf16*)(p.ws + WS_BB) + (size_t)l * 32 * 128 * 16;
    const float* AP = (const float*)(p.ws + WS_AP) + (size_t)l * 32 * 64 * 8;
    const int r = lane & 31, half = lane >> 5;
    const int tau0 = 32 * ((r >> 2) & 1) + (r & 3) + 4 * (r >> 3);
    const int step = G * 8; int it = blockIdx.x * 8 + wave;
    bf16x8 Uf[2], Bf[4]; f32x4 apv[2];
#define SSM1_LOAD(IT) do { const int g_ = (IT) & 31, c_ = ((IT) >> 5) & 63, b_ = (IT) >> 11; const size_t t0_ = (size_t)(b_ * SEQ + c_ * 64 + tau0) * 512 + g_ * 16 + 8 * half; \
        Uf[0] = *(const bf16x8*)(DU + t0_); Uf[1] = *(const bf16x8*)(DU + t0_ + (size_t)16 * 512); \
        _Pragma("unroll") for (int pt = 0; pt < 4; ++pt) Bf[pt] = *(const bf16x8*)(BB + ((size_t)g_ * 128 + 32 * pt + r) * 16 + 8 * half); \
        _Pragma("unroll") for (int s = 0; s < 2; ++s) apv[s] = *(const f32x4*)(AP + ((size_t)g_ * 64 + 32 * s + r) * 8); } while (0)
    if (it < 16384) SSM1_LOAD(it);
    for (; it < 16384; it += step) {
        const int g = it & 31, c = (it >> 5) & 63, b = it >> 11;
        f32x16 X[4][2];
#pragma unroll
        for (int pt = 0; pt < 4; ++pt)
#pragma unroll
            for (int tt = 0; tt < 2; ++tt) X[pt][tt] = mfma32(Uf[tt], Bf[pt], zero16());
        float ar[2], ai[2], a32r[2], a32i[2];
#pragma unroll
        for (int s = 0; s < 2; ++s) { ar[s] = apv[s][0]; ai[s] = apv[s][1]; a32r[s] = apv[s][2]; a32i[s] = apv[s][3]; }
        asm volatile("s_nop 15\n\ts_nop 15" : "+v"(X[0][0]), "+v"(X[0][1]), "+v"(X[1][0]), "+v"(X[1][1]), "+v"(X[2][0]), "+v"(X[2][1]), "+v"(X[3][0]), "+v"(X[3][1]));
        if (it + step < 16384) SSM1_LOAD(it + step);
#pragma unroll
        for (int s = 0; s < 2; ++s) { float xr = 0.f, xi = 0.f;
#pragma unroll
            for (int tt = 0; tt < 2; ++tt)
#pragma unroll
                for (int k = 0; k < 16; ++k) { const float nr = ar[s] * xr - ai[s] * xi + X[s][tt][k], ni = ar[s] * xi + ai[s] * xr + X[2 + s][tt][k]; xr = nr; xi = ni; }
            const float oxr = __shfl_xor(xr, 32), oxi = __shfl_xor(xi, 32);
            if (half == 1) { float2 e; e.x = xr + a32r[s] * oxr - a32i[s] * oxi; e.y = xi + a32r[s] * oxi + a32i[s] * oxr;
                *(float2*)(E + (((size_t)(b * 32 + g) * 64 + c) * 64 + 32 * s + r) * 2) = e; } }
    }
#undef SSM1_LOAD
}

DI void phase_final(const Params& p, int tid, int G) {
    const pg8::rowss_t* rowss = (const pg8::rowss_t*)(p.ws + WS_ROWSS) + (size_t)4 * TOK; const float* gf = p.in[I_GFIN]; float* out = p.out; const bf16* xb = (const bf16*)(p.ws + WS_XB);
    for (size_t i = (size_t)blockIdx.x * NTHR + tid; i < (size_t)TOK * 128; i += (size_t)G * NTHR) { const int row = (int)(i >> 7), c8 = (int)(i & 127);
        const float rs = pg8::rstd_row(rowss, row); f32x4 v0, v1; pg8::unpack8(*((const u32x4*)xb + i), v0, v1);
        const f32x4 g0 = *((const f32x4*)gf + 2 * c8), g1 = *((const f32x4*)gf + 2 * c8 + 1);
        *((f32x4*)out + 2 * i) = v0 * rs * g0; *((f32x4*)out + 2 * i + 1) = v1 * rs * g1; }
}

#define XB_TMO      128
#define XB_XCNT(j)  (256  + 64 * (j))
#define XB_XSUB(j)  (1280 + 64 * (j))
#define XB_XGEN(j)  (2304 + 64 * (j))
#define XB_TOP      3328
#define XB_TOPGEN   3392
#define XCD_BAR_WORDS 3456
#define XB_SPIN_CAP (1u << 18)

__device__ __forceinline__ unsigned xb_ld(unsigned* p)              { return __hip_atomic_load(p, __ATOMIC_RELAXED, __HIP_MEMORY_SCOPE_AGENT); }
__device__ __forceinline__ unsigned xb_add(unsigned* p, unsigned v) { return __hip_atomic_fetch_add(p, v, __ATOMIC_RELAXED, __HIP_MEMORY_SCOPE_AGENT); }
__device__ __forceinline__ unsigned xb_xcc_id() { return (unsigned)__builtin_amdgcn_s_getreg((3 << 11) | 20) & 0xFu; }
#define XB_SPIN(cond, bar) do { unsigned _sp = 0; while (cond) { __builtin_amdgcn_s_sleep(1); \
    if ((++_sp & 255u) == 0u) { if (xb_ld(&(bar)[XB_TMO])) break; if (_sp > XB_SPIN_CAP) { atomicAdd(&(bar)[XB_TMO], 1u); break; } } } } while (0)

struct XcdBarrier {
    unsigned* bar; unsigned x;
    volatile LAS unsigned* st;
};

__device__ __forceinline__ XcdBarrier xcd_barrier_post(unsigned* bar, volatile LAS unsigned* st) {
    XcdBarrier b; b.bar = bar; b.x = xb_xcc_id(); b.st = st;
    if (threadIdx.x == 0) (void)xb_add(&bar[XB_XCNT(b.x)], 1u);
    return b;
}
__device__ __forceinline__ void xcd_barrier_complete(unsigned* bar, unsigned x, unsigned& nloc, unsigned& nx) {
    const unsigned G = gridDim.x * gridDim.y * gridDim.z;
    unsigned sum, cnt, mine, sp = 0u;
    for (;;) {
        sum = 0u; cnt = 0u; mine = 0u;
#pragma unroll
        for (unsigned j = 0; j < 16; ++j) { const unsigned c = xb_ld(&bar[XB_XCNT(j)]); sum += c; cnt += (c > 0u) ? 1u : 0u; mine = (j == x) ? c : mine; }
        if (sum == G) break;
        __builtin_amdgcn_s_sleep(1);
        if ((++sp & 255u) == 0u) { if (xb_ld(&bar[XB_TMO])) break; if (sp > XB_SPIN_CAP) { atomicAdd(&bar[XB_TMO], 1u); break; } }
    }
    nloc = mine > 0u ? mine : 1u; nx = cnt > 0u ? cnt : 1u;
}

__device__ __forceinline__ void xcd_barrier(const XcdBarrier& b) {
    asm volatile("s_waitcnt vmcnt(0)" ::: "memory");
    __syncthreads();
    if (threadIdx.x == 0) {
        unsigned* bar = b.bar;
        __builtin_amdgcn_s_waitcnt(0);
        unsigned nloc = b.st[0], nx = b.st[1];
        if (nloc == 0u) { xcd_barrier_complete(bar, b.x, nloc, nx); b.st[0] = nloc; b.st[1] = nx; }
        const unsigned old = xb_add(&bar[XB_XSUB(b.x)], 1u);
        const unsigned gen = old / nloc;
        if (old + 1u == (gen + 1u) * nloc) {
            __builtin_amdgcn_fence(__ATOMIC_RELEASE, "agent");
            asm volatile("s_waitcnt vmcnt(0)" ::: "memory");
            const unsigned og = xb_add(&bar[XB_TOP], 1u);
            const unsigned tg = og / nx;
            if (og + 1u == (tg + 1u) * nx) xb_add(&bar[XB_TOPGEN], 1u);
            else XB_SPIN(xb_ld(&bar[XB_TOPGEN]) == tg, bar);
            __builtin_amdgcn_fence(__ATOMIC_ACQUIRE, "agent");
            xb_add(&bar[XB_XGEN(b.x)], 1u);
            asm volatile("s_waitcnt vmcnt(0)" ::: "memory");
        } else {
            XB_SPIN(xb_ld(&bar[XB_XGEN(b.x)]) == gen, bar);
            __builtin_amdgcn_fence(__ATOMIC_ACQUIRE, "agent");
            asm volatile("s_waitcnt vmcnt(0)" ::: "memory");
        }
    }
    __syncthreads();
}


__global__ void __launch_bounds__(NTHR) mega(Params p) {
    extern __shared__ __attribute__((aligned(16))) unsigned char lds_raw[];
    LAS unsigned char* lds = (LAS unsigned char*)lds_raw;
    const int G = gridDim.x;
#define LAUNDER() int tid = threadIdx.x; asm volatile("" : "+v"(tid)); const int lane = tid & 63, wave = __builtin_amdgcn_readfirstlane(tid >> 6); (void)lane; (void)wave
    const int lo = p.ph_lo, hi = p.ph_hi;
    unsigned char* ws = p.ws;
    int ph = 0;
    volatile LAS unsigned* xb_st = (volatile LAS unsigned*)(lds + 139264);
    XcdBarrier xbar; xbar.bar = (unsigned*)(ws + WS_BAR); xbar.x = 0; xbar.st = xb_st;
    if (ONE_LAUNCH) { if (threadIdx.x < 4) xb_st[threadIdx.x] = 0u; __syncthreads(); xbar = xcd_barrier_post((unsigned*)(ws + WS_BAR), xb_st); }
#ifndef ONLY_KIND
#define ONLY_KIND -1
#endif
#define KEN(k) (ONLY_KIND < 0 || ONLY_KIND == (k))
#ifndef DUP
#define DUP 0
#endif
#define REP(bit) _Pragma("unroll 1") for (int rep_ = 0; rep_ < ((DUP & (bit)) ? 2 : 1); ++rep_)
#define IN_PH() (lo <= ph && ph < hi)
#define END_PH() do { if (ONE_LAUNCH && lo <= ph && ph + 1 < hi) { if (hi < 0) cg::this_grid().sync(); else xcd_barrier(xbar); } ++ph; } while (0)
    if (IN_PH() && KEN(0)) REP(128) { LAUNDER(); phase_prep(p, lds, tid, lane, wave, G); }
    END_PH();
    bf16* XB = (bf16*)(ws + WS_XB); pg8::rowss_t* rowss = (pg8::rowss_t*)(ws + WS_ROWSS);
    for (int l = 0; l < 2; ++l) {
        unsigned char* wl = ws + WS_W + (size_t)l * WL_SIZE;
        const bf16* WinT = (const bf16*)(wl + WL_IN);
        bf16* P0 = (bf16*)(ws + WS_P);
        const pg8::rowss_t* rs_mix = rowss + (size_t)(2 * l) * TOK; pg8::rowss_t* rs_ffn = rowss + (size_t)(2 * l + 1) * TOK; pg8::rowss_t* rs_next = rowss + (size_t)(2 * l + 2) * TOK;
        pg8::StaticOrder S;
        if (IN_PH()) REP(1) {
            if (KEN(1)) { pg8::Gemm g{XB, WinT, TOK, 4096, 1024}; S.init(TOK, 4096, G, (int)blockIdx.x); pg8::EpiProj E{P0, rs_mix}; pg8::gemm_phase<pg8::EpiProj, pg8::StaticOrder>(lds, g, S, E); }
            if (KEN(2)) { pg8::Gemm g{WinT + (size_t)4096 * 1024, XB, 512, TOK, 1024}; S.init(512, TOK, G, (int)blockIdx.x); pg8::EpiVT E{(bf16*)(ws + WS_P + 8 * PBUF), rs_mix}; pg8::gemm_phase<pg8::EpiVT, pg8::StaticOrder>(lds, g, S, E); }
        }
        END_PH();
        if (IN_PH()) { if (KEN(20)) REP(4) { LAUNDER(); phase_attn2(p, l, lds, tid, lane, wave, G, (DUP & 4) && rep_ == 0 ? (bf16*)(ws + WS_YG) : (bf16*)(ws + WS_P + 5 * PBUF)); } if (KEN(21)) { LAUNDER(); phase_branchB(p, l, lds, tid, lane, wave, G); } if (KEN(22)) REP(16) { LAUNDER(); phase_ssm1(p, l, lane, wave, G); } if (KEN(23)) { LAUNDER(); phase_branchA(p, l, tid, G); } }
        END_PH();
        if (IN_PH() && KEN(3)) REP(16) { LAUNDER(); phase_ssm<true>(p, l, lds, lane, wave, G); }
        END_PH();
        if (IN_PH() && KEN(4)) REP(64) { pg8::Gemm g{(const bf16*)(ws + WS_YG), (const bf16*)(wl + WL_GLU), TOK, 512, 512}; S.init(TOK, 512, G, (int)blockIdx.x);
            pg8::EpiGlu E{(const bf16*)(ws + WS_YG), (bf16*)(ws + WS_P + 7 * PBUF), p.in[I_BGLU] + l * 512}; pg8::gemm_phase<pg8::EpiGlu, pg8::StaticOrder>(lds, g, S, E); }
        END_PH();
        unsigned char* GS = (unsigned char*)(ws + WS_P + 1 * PBUF);   bf16* MG = (bf16*)(ws + WS_P + 8 * PBUF);
        if (IN_PH() && KEN(5)) REP(8) {
#pragma unroll 1
            for (int b = 0; b < 4; ++b) {
                { pg8::Gemm g{XB, WinT + (size_t)(4608 + 1024 * b) * 1024, TOK, 1024, 1024}; S.init(TOK, 1024, G, (int)blockIdx.x); pg8::EpiGate E{GS, rs_mix}; pg8::gemm_phase<pg8::EpiGate, pg8::StaticOrder>(lds, g, S, E); }
                const size_t yb = (b == 0) ? 0 : (b == 1) ? 3 : (b == 2) ? 5 : 7;
                pg8::Gemm g{(const bf16*)(ws + WS_P + yb * PBUF), (const bf16*)(wl + WL_BR) + (size_t)b * 1024 * 512, TOK, 1024, 512}; S.init(TOK, 1024, G, (int)blockIdx.x);
                if (b == 0) { pg8::EpiBr<true> E{GS, MG}; pg8::gemm_phase<pg8::EpiBr<true>, pg8::StaticOrder>(lds, g, S, E); }
                else { pg8::EpiBr<false> E{GS, MG}; pg8::gemm_phase<pg8::EpiBr<false>, pg8::StaticOrder>(lds, g, S, E); }
            }
        }
        END_PH();
        if (IN_PH() && KEN(6)) { pg8::Gemm g{MG, (const bf16*)(wl + WL_O), TOK, 1024, 1024}; S.init(TOK, 1024, G, (int)blockIdx.x);
            if (l == 0) { pg8::EpiResidT<true> E{p.in[I_X], XB, rs_ffn}; pg8::gemm_phase<pg8::EpiResidT<true>, pg8::StaticOrder>(lds, g, S, E); }
            else { pg8::EpiResidT<false> E{nullptr, XB, rs_ffn}; pg8::gemm_phase<pg8::EpiResidT<false>, pg8::StaticOrder>(lds, g, S, E); } }
        END_PH();
        bf16* H = (bf16*)(ws + WS_P);
        if (IN_PH() && KEN(7)) REP(2) { pg8::Gemm g{XB, (const bf16*)(wl + WL_FF), TOK, 5632, 1024}; S.init(TOK, 5632, G, (int)blockIdx.x);
            pg8::EpiFfnUp E{H, rs_ffn}; pg8::gemm_phase<pg8::EpiFfnUp, pg8::StaticOrder>(lds, g, S, E); }
        END_PH();
        if (IN_PH() && KEN(8)) { pg8::Gemm g{H, (const bf16*)(wl + WL_D), TOK, 1024, 2816}; S.init(TOK, 1024, G, (int)blockIdx.x);
            pg8::EpiResidT<false> E{nullptr, XB, rs_next}; pg8::gemm_phase<pg8::EpiResidT<false>, pg8::StaticOrder>(lds, g, S, E); }
        END_PH();
    }
    if (IN_PH() && KEN(9)) { LAUNDER(); phase_final(p, tid, G); }
}
constexpr int N_PHASES = 18;
}

extern "C" void kernel_launch(void* const* d_in, const int* in_sizes, int n_in, void* d_out, int out_size, void* d_ws, size_t ws_size, hipStream_t stream) {
    static int grid = 0;
    if (grid == 0) {
        if (n_in != 28 || out_size != mk::TOK * mk::DM || ws_size < mk::WS_END) { fprintf(stderr, "kernel_launch: unexpected shapes (n_in %d out %d ws %zu need %zu)\n", n_in, out_size, ws_size, (size_t)mk::WS_END); grid = -1; return; }
        int dev = 0, cus = 0, per_cu = 0;
        hipGetDevice(&dev); hipDeviceGetAttribute(&cus, hipDeviceAttributeMultiprocessorCount, dev);
        if (hipFuncSetAttribute((const void*)mk::mega, hipFuncAttributeMaxDynamicSharedMemorySize, mk::LDS_BYTES) != hipSuccess) { fprintf(stderr, "kernel_launch: hipFuncSetAttribute failed\n"); grid = -1; return; }
        if (hipOccupancyMaxActiveBlocksPerMultiprocessor(&per_cu, (const void*)mk::mega, mk::NTHR, mk::LDS_BYTES) != hipSuccess || per_cu < 1) { fprintf(stderr, "kernel_launch: occupancy query says %d\n", per_cu); per_cu = 1; }
        (void)hipGetLastError();
        grid = cus * 1;
        if (grid <= 0) grid = 256;
    }
    if (grid < 0) return;
    mk::Params p{};
    for (int i = 0; i < 28; ++i) p.in[i] = (const float*)d_in[i];
    p.out = (float*)d_out; p.ws = (unsigned char*)d_ws;
#if ONE_LAUNCH
    if (hipMemsetAsync((unsigned char*)d_ws + mk::WS_BAR, 0, XCD_BAR_WORDS * sizeof(unsigned), stream) != hipSuccess) { fprintf(stderr, "kernel_launch: memset failed\n"); return; }
    p.ph_lo = 0; p.ph_hi = mk::N_PHASES;
    void* args[] = {&p};
    hipError_t e = hipLaunchCooperativeKernel((const void*)mk::mega, dim3(grid), dim3(mk::NTHR), args, mk::LDS_BYTES, stream);
    if (e != hipSuccess) fprintf(stderr, "cooperative launch failed: %s (grid %d)\n", hipGetErrorString(e), grid);
#else
    for (int ph = 0; ph < mk::N_PHASES; ++ph) { p.ph_lo = ph; p.ph_hi = ph + 1;
        hipLaunchKernelGGL(mk::mega, dim3(grid), dim3(mk::NTHR), mk::LDS_BYTES, stream, p); }
#endif
}
```

```cpp
#include <hip/hip_runtime.h>
#include <hip/hip_cooperative_groups.h>
#include <cstdio>
#include <cstdint>
#ifndef ONE_LAUNCH
#define ONE_LAUNCH 1
#endif
namespace cg = cooperative_groups;
typedef __bf16 mk_bf16x2_t __attribute__((ext_vector_type(2)));
typedef float mk_f32x2_t __attribute__((ext_vector_type(2)));
__device__ __forceinline__ unsigned mk_pk2(float lo, float hi) { mk_f32x2_t v = {lo, hi}; mk_bf16x2_t b = __builtin_convertvector(v, mk_bf16x2_t); return __builtin_bit_cast(unsigned, b); }
__device__ __forceinline__ float mk_lo(unsigned w) { return __uint_as_float(w << 16); }
__device__ __forceinline__ float mk_hi(unsigned w) { return __uint_as_float(w & 0xffff0000u); }
__device__ __forceinline__ float mk_sigm(float x) { return __builtin_amdgcn_rcpf(1.0f + __expf(-x)); }
__device__ __forceinline__ float mk_gelu(float x) { const float u = 1.5957691216f * (x + 0.044715f * x * x * x); return x * __builtin_amdgcn_rcpf(1.0f + __expf(-u)); }
namespace pg8 {
#define PG8_LAS __attribute__((address_space(3)))
typedef unsigned short bf16_t;
typedef short bf16x8 __attribute__((ext_vector_type(8)));
typedef float f32x4 __attribute__((ext_vector_type(4)));
typedef unsigned u32x4 __attribute__((ext_vector_type(4)));
constexpr int BM = 256, BK = 64, HALF = 128, HTB = HALF * BK * 2  , STAGE_BYTES = 8 * HTB, NXCD = 8, WGM = 8;

__host__ __device__ __forceinline__ int lds_byte(int r, int c) { const int st = (r >> 4) * 2 + (c >> 5), rr = r & 15, cc = c & 31, ob = rr * 64 + cc * 2; return st * 1024 + (ob ^ (((ob >> 9) & 1) << 5)); }
__host__ __device__ __forceinline__ void stage_rc(int b, int& R, int& C) { const int st = b / 1024, sb = b % 1024, swz = sb ^ (((sb >> 9) & 1) << 5); R = (st >> 1) * 16 + swz / 64; C = (st & 1) * 32 + (swz % 64) / 2; }
__host__ __device__ __forceinline__ int perm32(int rho) { const int n = rho >> 4, i = rho & 15; return 8 * (i >> 2) + 4 * n + (i & 3); }

struct Unit { int pm, pn; };
struct Gemm { const bf16_t* A; const bf16_t* Bt; int M, N, K; };

struct StaticOrder {
    int nM, nN, nwg, G, c;
    __host__ __device__ void init(int M, int N, int G_, int c_) { nM = M / BM; nN = N / BM; nwg = nM * nN; G = G_; c = c_; }
    __host__ __device__ bool next(int i, Unit& u) const {
        const long L = (long)i * G + c; if (L >= nwg) return false;
        int wgid = (int)L; { const int q = nwg / NXCD, r = nwg % NXCD, xcd = wgid % NXCD, off = wgid / NXCD; wgid = (xcd < r ? xcd * (q + 1) : r * (q + 1) + (xcd - r) * q) + off; }
        const int nig = WGM * nN, gid = wgid / nig, fm = gid * WGM, gsz = (nM - fm) < WGM ? (nM - fm) : WGM;
        u.pm = fm + ((wgid % nig) % gsz); u.pn = (wgid % nig) / gsz; return true;
    }
    __device__ __forceinline__ void a_ready(const Unit&) const {}
    __device__ __forceinline__ void done(const Unit&) const {}
};
typedef unsigned u32x2 __attribute__((ext_vector_type(2)));
constexpr int MK_TOK = 32768;
#define MK_EPI_LOOP_AM _Pragma("unroll") for (int ai = 0; ai < 2; ++ai) _Pragma("unroll") for (int m = 0; m < 4; ++m)
__device__ __forceinline__ u32x4 pack8(const f32x4 a, const f32x4 b) { u32x4 w; w.x = mk_pk2(a[0], a[1]); w.y = mk_pk2(a[2], a[3]); w.z = mk_pk2(b[0], b[1]); w.w = mk_pk2(b[2], b[3]); return w; }
__device__ __forceinline__ void unpack8(const u32x4 w, f32x4& a, f32x4& b) { a = (f32x4){mk_lo(w.x), mk_hi(w.x), mk_lo(w.y), mk_hi(w.y)}; b = (f32x4){mk_lo(w.z), mk_hi(w.z), mk_lo(w.w), mk_hi(w.w)}; }
__device__ __forceinline__ float rstd_of(float ss) { return rsqrtf(ss * (1.0f / 1024.0f) + 1e-6f); }
typedef unsigned long long rowss_t;
__device__ __forceinline__ float rstd_row(const rowss_t* rowss, int row) { return rstd_of((float)rowss[row] * (1.0f / 4294967296.0f)); }

struct EpiProj { static constexpr bool PERM = true, AFTER_DRAIN = false; bf16_t* P; const rowss_t* rowss;
    __device__ __forceinline__ void operator()(const f32x4 (&acc)[2][2][4][2], const Unit& u, int wr, int wc, int fr, int fq) const {
        const int row0 = u.pm * BM + wr * 64 + fr;
        bf16_t* base = P + (size_t)(u.pn >> 1) * ((size_t)MK_TOK * 512) + (u.pn & 1) * 256 + wc * 32 + 8 * fq;
        MK_EPI_LOOP_AM { const int row = row0 + ai * HALF + m * 16; const float rs = rstd_row(rowss, row); bf16_t* rp = base + (size_t)row * 512;
#pragma unroll
            for (int bj = 0; bj < 2; ++bj) *(u32x4*)(rp + bj * HALF) = pack8(acc[ai][bj][m][0] * rs, acc[ai][bj][m][1] * rs); }
    }
};
struct EpiVT { static constexpr bool PERM = true, AFTER_DRAIN = false; bf16_t* VT; const rowss_t* rowss;
    __device__ __forceinline__ void operator()(const f32x4 (&acc)[2][2][4][2], const Unit& u, int wr, int wc, int fr, int fq) const {
        const int row0 = u.pm * BM + wr * 64 + fr, col0 = u.pn * BM + wc * 32 + 8 * fq;
        f32x4 rs[2][2];
#pragma unroll
        for (int bj = 0; bj < 2; ++bj)
#pragma unroll
            for (int n = 0; n < 2; ++n) { const int c_ = col0 + bj * HALF + 4 * n; rs[bj][n] = (f32x4){rstd_row(rowss, c_), rstd_row(rowss, c_ + 1), rstd_row(rowss, c_ + 2), rstd_row(rowss, c_ + 3)}; }
        MK_EPI_LOOP_AM { const int row = row0 + ai * HALF + m * 16; bf16_t* rp = VT + (size_t)row * MK_TOK + col0;
#pragma unroll
            for (int bj = 0; bj < 2; ++bj) *(u32x4*)(rp + bj * HALF) = pack8(acc[ai][bj][m][0] * rs[bj][0], acc[ai][bj][m][1] * rs[bj][1]); }
    }
};
struct EpiGlu { static constexpr bool PERM = true, AFTER_DRAIN = false; const bf16_t* YG; bf16_t* O; const float* bias;
    __device__ __forceinline__ void operator()(const f32x4 (&acc)[2][2][4][2], const Unit& u, int wr, int wc, int fr, int fq) const {
        const int row0 = u.pm * BM + wr * 64 + fr, col0 = u.pn * BM + wc * 32 + 8 * fq;
        f32x4 bv[2][2];
#pragma unroll
        for (int bj = 0; bj < 2; ++bj)
#pragma unroll
            for (int n = 0; n < 2; ++n) bv[bj][n] = *(const f32x4*)(bias + col0 + bj * HALF + 4 * n);
        MK_EPI_LOOP_AM { const int row = row0 + ai * HALF + m * 16; const size_t off = (size_t)row * 512 + col0;
#pragma unroll
            for (int bj = 0; bj < 2; ++bj) { f32x4 y0, y1; unpack8(*(const u32x4*)(YG + off + bj * HALF), y0, y1);
                f32x4 a0 = acc[ai][bj][m][0] + bv[bj][0], a1 = acc[ai][bj][m][1] + bv[bj][1];
#pragma unroll
                for (int j = 0; j < 4; ++j) { y0[j] *= mk_sigm(a0[j]); y1[j] *= mk_sigm(a1[j]); }
                *(u32x4*)(O + off + bj * HALF) = pack8(y0, y1); } }
    }
};
__device__ __forceinline__ unsigned gate_q4(const f32x4 g) { return (unsigned)(g[0] * 255.0f + 0.5f) | ((unsigned)(g[1] * 255.0f + 0.5f) << 8) | ((unsigned)(g[2] * 255.0f + 0.5f) << 16) | ((unsigned)(g[3] * 255.0f + 0.5f) << 24); }
__device__ __forceinline__ f32x4 gate_dq4(unsigned w) { return (f32x4){(float)(w & 255u), (float)((w >> 8) & 255u), (float)((w >> 16) & 255u), (float)(w >> 24)} * (1.0f / 255.0f); }
struct EpiGate { static constexpr bool PERM = true, AFTER_DRAIN = false; unsigned char* GS; const rowss_t* rowss;
    __device__ __forceinline__ void operator()(const f32x4 (&acc)[2][2][4][2], const Unit& u, int wr, int wc, int fr, int fq) const {
        const int row0 = u.pm * BM + wr * 64 + fr, col0 = u.pn * BM + wc * 32 + 8 * fq;
        MK_EPI_LOOP_AM { const int row = row0 + ai * HALF + m * 16; const float rs = rstd_row(rowss, row); const size_t off = (size_t)row * 1024 + col0;
#pragma unroll
            for (int bj = 0; bj < 2; ++bj) { f32x4 a0 = acc[ai][bj][m][0] * rs, a1 = acc[ai][bj][m][1] * rs;
#pragma unroll
                for (int j = 0; j < 4; ++j) { a0[j] = mk_sigm(a0[j]); a1[j] = mk_sigm(a1[j]); }
                u32x2 w; w.x = gate_q4(a0); w.y = gate_q4(a1); *(u32x2*)(GS + off + bj * HALF) = w; } }
    }
};
template <bool FIRST> struct EpiBr { static constexpr bool PERM = true, AFTER_DRAIN = false; const unsigned char* GS; bf16_t* MG;
    __device__ __forceinline__ void operator()(const f32x4 (&acc)[2][2][4][2], const Unit& u, int wr, int wc, int fr, int fq) const {
        const int row0 = u.pm * BM + wr * 64 + fr, col0 = u.pn * BM + wc * 32 + 8 * fq;
        MK_EPI_LOOP_AM { const int row = row0 + ai * HALF + m * 16; const size_t off = (size_t)row * 1024 + col0;
#pragma unroll
            for (int bj = 0; bj < 2; ++bj) { const u32x2 gw = *(const u32x2*)(GS + off + bj * HALF);
                f32x4 v0 = gate_dq4(gw.x) * acc[ai][bj][m][0], v1 = gate_dq4(gw.y) * acc[ai][bj][m][1];
                if (!FIRST) { f32x4 p0, p1; unpack8(*(const u32x4*)(MG + off + bj * HALF), p0, p1); v0 += p0; v1 += p1; }
                *(u32x4*)(MG + off + bj * HALF) = pack8(v0, v1); } }
    }
};
template <bool F32IN> struct EpiResidT { static constexpr bool PERM = false, AFTER_DRAIN = false; const float* xin; bf16_t* xb; rowss_t* rowss_next;
    __device__ __forceinline__ void operator()(const f32x4 (&acc)[2][2][4][2], const Unit& u, int wr, int wc, int fr, int fq) const {
        const int row0 = u.pm * BM + wr * 64 + fr, col0 = u.pn * BM + wc * 32 + 4 * fq;
        MK_EPI_LOOP_AM { const int row = row0 + ai * HALF + m * 16; const size_t off = (size_t)row * 1024 + col0; float ss = 0.f;
#pragma unroll
            for (int bj = 0; bj < 2; ++bj)
#pragma unroll
                for (int n = 0; n < 2; ++n) { const size_t o = off + bj * HALF + n * 16; f32x4 xo;
                    if (F32IN) xo = *(const f32x4*)(xin + o); else { const u32x2 w0 = *(const u32x2*)(xb + o); xo = (f32x4){mk_lo(w0.x), mk_hi(w0.x), mk_lo(w0.y), mk_hi(w0.y)}; }
                    const f32x4 xn = xo + acc[ai][bj][m][n];
                    u32x2 w; w.x = mk_pk2(xn[0], xn[1]); w.y = mk_pk2(xn[2], xn[3]); *(u32x2*)(xb + o) = w;
                    ss += (xn[0] * xn[0] + xn[1] * xn[1]) + (xn[2] * xn[2] + xn[3] * xn[3]); }
            ss += __shfl_xor(ss, 16); ss += __shfl_xor(ss, 32);
            if (fq == 0) __hip_atomic_fetch_add(rowss_next + row, (rowss_t)(ss * 4294967296.0f), __ATOMIC_RELAXED, __HIP_MEMORY_SCOPE_AGENT); }
    }
};
struct EpiFfnUp { static constexpr bool PERM = true, AFTER_DRAIN = false; bf16_t* H; const rowss_t* rowss;
    __device__ __forceinline__ void operator()(const f32x4 (&acc)[2][2][4][2], const Unit& u, int wr, int wc, int fr, int fq) const {
        const int row0 = u.pm * BM + wr * 64 + fr, col0 = u.pn * HALF + wc * 32 + 8 * fq;
        MK_EPI_LOOP_AM { const int row = row0 + ai * HALF + m * 16; const float rs = rstd_row(rowss, row);
            f32x4 g0 = acc[ai][0][m][0] * rs, g1 = acc[ai][0][m][1] * rs, u0 = acc[ai][1][m][0] * rs, u1 = acc[ai][1][m][1] * rs;
#pragma unroll
            for (int j = 0; j < 4; ++j) { g0[j] = g0[j] * mk_sigm(g0[j]) * u0[j]; g1[j] = g1[j] * mk_sigm(g1[j]) * u1[j]; }
            *(u32x4*)(H + (size_t)row * 2816 + col0) = pack8(g0, g1); }
    }
};
template <class Epi, class Sched, bool ALIGN_EPI = true, bool SP2 = true>
__device__ __forceinline__ void gemm_phase(PG8_LAS unsigned char* lds, const Gemm g, const Sched& S, const Epi& E) {
    int tid_l = threadIdx.x; asm volatile("" : "+v"(tid_l)); const int tid = tid_l, wid = __builtin_amdgcn_readfirstlane(tid >> 6), lane = tid & 63, wr = wid >> 2, wc = wid & 3, fr = lane & 15, fq = lane >> 4;
    const int K = g.K, nt = K / BK;
    unsigned voffA[2], voffB[2];
#pragma unroll
    for (int i = 0; i < 2; ++i) { int R, C; stage_rc(tid * 16 + i * 8192, R, C); const int Rb = Epi::PERM ? ((R & ~31) + perm32(R & 31)) : R;
        voffA[i] = (unsigned)(R * K + C) * 2u; voffB[i] = (unsigned)(Rb * K + C) * 2u; }
    const size_t kstep = (size_t)(BK * 2);
    const size_t hstep = (size_t)HALF * K * 2;
    const size_t tstep = 2 * hstep;
    const unsigned ldsw = (unsigned)wid * 1024u;
    const int aoff = lds_byte(wr * 64 + fr, fq * 8), boff = lds_byte(wc * 32 + fr, fq * 8);
#define PG8_SA(b, h) (((b) * 2 + (h)) * HTB)
#define PG8_SB(b, h) ((4 + (b) * 2 + (h)) * HTB)
#define PG8_STAGE(bufoff, gbase, voff) do { _Pragma("unroll") for (int _i = 0; _i < 2; ++_i) \
        __builtin_amdgcn_global_load_lds((const unsigned*)((const char*)(gbase) + (voff)[_i]), (PG8_LAS unsigned*)(lds + (bufoff) + ldsw + _i * 8192), 16, 0, 0); } while (0)
#define PG8_LDA(dst, b, h) do { _Pragma("unroll") for (int m = 0; m < 4; ++m) _Pragma("unroll") for (int k = 0; k < 2; ++k) dst[m][k] = *(const PG8_LAS bf16x8*)(lds + PG8_SA(b, h) + aoff + m * 2048 + k * 1024); } while (0)
#define PG8_LDB(dst, b, h) do { _Pragma("unroll") for (int n = 0; n < 2; ++n) _Pragma("unroll") for (int k = 0; k < 2; ++k) dst[n][k] = *(const PG8_LAS bf16x8*)(lds + PG8_SB(b, h) + boff + n * 2048 + k * 1024); } while (0)
#define PG8_MMA(ai, bj, At, Bt) do { __builtin_amdgcn_s_setprio(1); _Pragma("unroll") for (int m = 0; m < 4; ++m) _Pragma("unroll") for (int n = 0; n < 2; ++n) _Pragma("unroll") for (int k = 0; k < 2; ++k) \
        acc[ai][bj][m][n] = __builtin_amdgcn_mfma_f32_16x16x32_bf16(Bt[n][k], At[m][k], acc[ai][bj][m][n], 0, 0, 0); __builtin_amdgcn_s_setprio(0); } while (0)
#define PG8_WAIT_V(n) asm volatile("s_waitcnt vmcnt(" #n ")" ::: "memory")
#define PG8_WAIT_L(n) asm volatile("s_waitcnt lgkmcnt(" #n ")" ::: "memory")
#define PG8_BAR __builtin_amdgcn_s_barrier()
#define PG8_SCHED __builtin_amdgcn_sched_barrier(0)
    Unit cur, nxt; int ui = 0;
    if (!S.next(0, cur)) return;
    f32x4 acc[2][2][4][2];
#pragma unroll
    for (int a = 0; a < 2; ++a)
#pragma unroll
        for (int b = 0; b < 2; ++b)
#pragma unroll
            for (int m = 0; m < 4; ++m)
#pragma unroll
                for (int n = 0; n < 2; ++n) acc[a][b][m][n] = (f32x4){0.f, 0.f, 0.f, 0.f};
    bf16x8 At[4][2], B0[2][2], B1[2][2];
    const char* cA = (const char*)g.A + (size_t)cur.pm * tstep; const char* cB = (const char*)g.Bt + (size_t)cur.pn * tstep;
    S.a_ready(cur);
    if constexpr (SP2) {
        PG8_STAGE(PG8_SB(0, 0), cB, voffB); PG8_STAGE(PG8_SB(0, 1), cB + hstep, voffB); PG8_STAGE(PG8_SA(0, 0), cA, voffA); PG8_STAGE(PG8_SA(0, 1), cA + hstep, voffA);
        if (wr == 1) PG8_BAR;
        PG8_WAIT_V(2); PG8_BAR;
        PG8_STAGE(PG8_SB(1, 0), cB + kstep, voffB); PG8_STAGE(PG8_SA(1, 0), cA + kstep, voffA); PG8_STAGE(PG8_SB(1, 1), cB + hstep + kstep, voffB);
        PG8_WAIT_V(6); PG8_BAR;
    } else {
        PG8_STAGE(PG8_SB(0, 0), cB, voffB); PG8_STAGE(PG8_SA(0, 0), cA, voffA); PG8_STAGE(PG8_SB(0, 1), cB + hstep, voffB); PG8_STAGE(PG8_SA(0, 1), cA + hstep, voffA);
        if (wr == 1) PG8_BAR;
        PG8_WAIT_V(4); PG8_BAR;
        PG8_STAGE(PG8_SB(1, 0), cB + kstep, voffB); PG8_STAGE(PG8_SA(1, 0), cA + kstep, voffA); PG8_STAGE(PG8_SB(1, 1), cB + hstep + kstep, voffB);
        PG8_WAIT_V(6); PG8_BAR;
    }
    for (;;) {
        const bool has_next = S.next(ui + 1, nxt);
        const char* nA = has_next ? (const char*)g.A + (size_t)nxt.pm * tstep : cA; const char* nB = has_next ? (const char*)g.Bt + (size_t)nxt.pn * tstep : cB;
        for (int t = 0; t < nt; t += 2) {
            const bool last = (t == nt - 2);
            const char* a1 = cA + (size_t)(t + 1) * kstep;
            const char* a2 = last ? nA : cA + (size_t)(t + 2) * kstep; const char* b2 = last ? nB : cB + (size_t)(t + 2) * kstep;
            const char* a3 = a2 + kstep; const char* b3 = b2 + kstep;
            if (last && has_next) S.a_ready(nxt);
            if constexpr (SP2) {
            PG8_LDB(B0, 0, 0); PG8_LDB(B1, 0, 1); PG8_SCHED; PG8_LDA(At, 0, 0); PG8_STAGE(PG8_SA(1, 1), a1 + hstep, voffA);
            PG8_WAIT_V(8); PG8_WAIT_L(0); PG8_BAR; PG8_MMA(0, 0, At, B0); PG8_MMA(0, 1, At, B1); PG8_BAR; PG8_SCHED;
            PG8_LDA(At, 0, 1); PG8_STAGE(PG8_SB(0, 0), b2, voffB); PG8_STAGE(PG8_SB(0, 1), b2 + hstep, voffB); PG8_STAGE(PG8_SA(0, 0), a2, voffA);
            PG8_WAIT_V(8); PG8_WAIT_L(0); PG8_BAR; PG8_MMA(1, 0, At, B0); PG8_MMA(1, 1, At, B1); PG8_BAR; PG8_SCHED;
            PG8_LDB(B0, 1, 0); PG8_LDB(B1, 1, 1); PG8_SCHED; PG8_LDA(At, 1, 0); PG8_STAGE(PG8_SA(0, 1), a2 + hstep, voffA);
            PG8_WAIT_V(8); PG8_WAIT_L(0); PG8_BAR; PG8_MMA(0, 0, At, B0); PG8_MMA(0, 1, At, B1); PG8_BAR; PG8_SCHED;
            PG8_LDA(At, 1, 1); PG8_STAGE(PG8_SB(1, 0), b3, voffB); PG8_STAGE(PG8_SB(1, 1), b3 + hstep, voffB); PG8_STAGE(PG8_SA(1, 0), a3, voffA);
            PG8_WAIT_V(8); PG8_WAIT_L(0); PG8_BAR; PG8_MMA(1, 0, At, B0); PG8_MMA(1, 1, At, B1); PG8_BAR; PG8_SCHED;
            } else {
            PG8_LDB(B0, 0, 0); PG8_SCHED; PG8_LDA(At, 0, 0); PG8_STAGE(PG8_SA(1, 1), a1 + hstep, voffA);
            PG8_WAIT_L(8); PG8_BAR; PG8_WAIT_L(0); PG8_MMA(0, 0, At, B0); PG8_BAR; PG8_SCHED;
            PG8_LDB(B1, 0, 1); PG8_STAGE(PG8_SB(0, 0), b2, voffB);
            PG8_BAR; PG8_WAIT_L(0); PG8_MMA(0, 1, At, B1); PG8_BAR;
            PG8_LDA(At, 0, 1); PG8_STAGE(PG8_SA(0, 0), a2, voffA);
            PG8_BAR; PG8_WAIT_L(0); PG8_MMA(1, 0, At, B0); PG8_BAR; PG8_SCHED;
            PG8_STAGE(PG8_SB(0, 1), b2 + hstep, voffB);
            PG8_WAIT_V(6); PG8_BAR; PG8_MMA(1, 1, At, B1); PG8_BAR;
            PG8_LDB(B0, 1, 0); PG8_SCHED; PG8_LDA(At, 1, 0); PG8_STAGE(PG8_SA(0, 1), a2 + hstep, voffA);
            PG8_WAIT_L(8); PG8_BAR; PG8_WAIT_L(0); PG8_MMA(0, 0, At, B0); PG8_BAR; PG8_SCHED;
            PG8_LDB(B1, 1, 1); PG8_STAGE(PG8_SB(1, 0), b3, voffB);
            PG8_BAR; PG8_WAIT_L(0); PG8_MMA(0, 1, At, B1); PG8_BAR;
            PG8_LDA(At, 1, 1); PG8_STAGE(PG8_SA(1, 0), a3, voffA);
            PG8_BAR; PG8_WAIT_L(0); PG8_MMA(1, 0, At, B0); PG8_BAR; PG8_SCHED;
            PG8_STAGE(PG8_SB(1, 1), b3 + hstep, voffB);
            PG8_WAIT_V(6); PG8_BAR; PG8_MMA(1, 1, At, B1); PG8_BAR;
            }
        }
        if constexpr (ALIGN_EPI) { if (wr == 0) PG8_BAR; }
        if constexpr (!Epi::AFTER_DRAIN) { E(acc, cur, wr, wc, fr, fq); S.done(cur); }
        if (!has_next) break;
#pragma unroll
        for (int a = 0; a < 2; ++a)
#pragma unroll
            for (int b = 0; b < 2; ++b)
#pragma unroll
                for (int m = 0; m < 4; ++m)
#pragma unroll
                    for (int n = 0; n < 2; ++n) acc[a][b][m][n] = (f32x4){0.f, 0.f, 0.f, 0.f};
        cur = nxt; cA = nA; cB = nB; ++ui;
        if constexpr (ALIGN_EPI) { if (wr == 1) PG8_BAR; }
    }
    PG8_WAIT_V(0);
    if constexpr (!ALIGN_EPI) { if (wr == 0) PG8_BAR; }
    PG8_BAR;
    if constexpr (Epi::AFTER_DRAIN) { E.fused(acc, cur, wr, wc, fr, fq, lds, wid, lane); S.done(cur); }
#undef PG8_SA
#undef PG8_SB
#undef PG8_STAGE
#undef PG8_LDA
#undef PG8_LDB
#undef PG8_MMA
#undef PG8_WAIT_V
#undef PG8_WAIT_L
#undef PG8_BAR
#undef PG8_SCHED
}
}

namespace mk {
#define LAS __attribute__((address_space(3)))
#define DI __device__ __forceinline__
typedef unsigned short bf16;
typedef pg8::bf16x8 bf16x8; typedef pg8::f32x4 f32x4; typedef pg8::u32x4 u32x4; typedef pg8::u32x2 u32x2;
typedef float f32x16 __attribute__((ext_vector_type(16)));
constexpr int TOK = 32768, DM = 1024, SEQ = 4096, BW = 512, FFH = 2816, NTHR = 512;
constexpr size_t MiB = 1024 * 1024;
constexpr size_t WS_ROWSS = 474 * MiB;
constexpr size_t WS_BAR = 768 * 1024;
constexpr size_t WS_BB = 1 * MiB;
constexpr size_t WS_CM = WS_BB + 262144;
constexpr size_t WS_AP = WS_CM + 262144;
constexpr size_t WS_SGW = WS_AP + 131072;
constexpr size_t WS_E = 2 * MiB;
constexpr size_t WS_W = 10 * MiB;
constexpr size_t WL_IN = 0, WL_GLU = 17825792, WL_BR = WL_GLU + 524288, WL_O = WL_BR + 4194304, WL_FF = WL_O + 2097152, WL_D = WL_FF + 11534336, WL_SIZE = WL_D + 5767168;
static_assert(WL_SIZE == 40 * MiB, "weights per layer");
constexpr size_t WS_XB = 90 * MiB;
constexpr size_t WS_P = 154 * MiB;
constexpr size_t PBUF = 32 * MiB;
constexpr size_t WS_YG = WS_P + 9 * PBUF;
constexpr size_t WS_END = WS_YG + 32 * MiB + 2 * MiB;
constexpr int LDS_BYTES = 143360;

DI float bf2f(bf16 v) { return __uint_as_float(((unsigned)v) << 16); }
DI bf16 f2bf(float f) { return (bf16)(mk_pk2(f, 0.f) & 0xffffu); }
DI float wave_sum(float v) {
#pragma unroll
    for (int o = 1; o < 64; o <<= 1) v += __shfl_xor(v, o);
    return v; }
DI f32x16 mfma32(bf16x8 a, bf16x8 b, f32x16 c) { return __builtin_amdgcn_mfma_f32_32x32x16_bf16(a, b, c, 0, 0, 0); }
DI f32x4 mfma16(bf16x8 a, bf16x8 b, f32x4 c) { return __builtin_amdgcn_mfma_f32_16x16x32_bf16(a, b, c, 0, 0, 0); }
DI int crow(int i, int h) { return (i & 3) + 8 * (i >> 2) + 4 * h; }
DI f32x16 zero16() { f32x16 z;
#pragma unroll
    for (int i = 0; i < 16; ++i) z[i] = 0.f;
    return z; }
#define LDS_WAIT() asm volatile("s_waitcnt lgkmcnt(0)" ::: "memory")

struct Params { const float* in[28]; float* out; unsigned char* ws; int ph_lo, ph_hi; };
enum { I_X = 0, I_GMIX, I_WIN, I_CONVW, I_CONVB, I_SGW, I_SGB, I_LNG, I_LNB, I_LAMQK, I_SUBLN, I_ARE, I_AIM, I_LOGDT, I_BRE, I_BIM, I_CRE, I_CIM, I_SSMD, I_WGLU, I_BGLU, I_WBR, I_WO, I_GFFN, I_WFG, I_WFU, I_WFD, I_GFIN };

DI void tr_item(const float* W, int ldn, int k0, int n0, const float* gs, bf16* WT, int ldk, int drow0, LAS float* scr, int lane) {
    float tv[32];
#pragma unroll
    for (int i = 0; i < 32; ++i) { const int kk = 2 * i + (lane >> 5); tv[i] = W[(size_t)(k0 + kk) * ldn + n0 + (lane & 31)]; }
    if (gs) {
#pragma unroll
        for (int i = 0; i < 32; ++i) tv[i] *= gs[k0 + 2 * i + (lane >> 5)]; }
#pragma unroll
    for (int i = 0; i < 32; ++i) scr[(2 * i + (lane >> 5)) * 33 + (lane & 31)] = tv[i];
    LDS_WAIT();
    const int c = lane & 7;
#pragma unroll
    for (int j = 0; j < 4; ++j) { const int n = (lane >> 3) + 8 * j; const LAS float* s = scr + (8 * c) * 33 + n;
        u32x4 o; o.x = mk_pk2(s[0 * 33], s[1 * 33]); o.y = mk_pk2(s[2 * 33], s[3 * 33]); o.z = mk_pk2(s[4 * 33], s[5 * 33]); o.w = mk_pk2(s[6 * 33], s[7 * 33]);
        *(u32x4*)(WT + (size_t)(drow0 + n) * ldk + k0 + 8 * c) = o; }
    LDS_WAIT();
}
DI void dsincos(double x, double& s, double& c) {
    const double twopi = 6.283185307179586476925; const double k = rint(x / twopi); const double r = x - k * twopi, r2 = r * r;
    double ss = 1.0, cc = 1.0;
#pragma unroll
    for (int n = 13; n >= 1; --n) { ss = 1.0 - r2 * (1.0 / ((2.0 * n) * (2.0 * n + 1.0))) * ss; cc = 1.0 - r2 * (1.0 / ((2.0 * n - 1.0) * (2.0 * n))) * cc; }
    s = ss * r; c = cc;
}
DI void phase_prep(const Params& p, LAS unsigned char* lds, int tid, int lane, int wave, int G) {
    unsigned char* ws = p.ws;
    const int gw = blockIdx.x * 8 + wave, NGW = G * 8, gt = blockIdx.x * NTHR + tid, NGT = G * NTHR;
    LAS float* scr = (LAS float*)(lds + wave * 8704);
    for (int l = 0; l < 2; ++l) {
        unsigned char* wl = ws + WS_W + (size_t)l * WL_SIZE;
        for (int mi = 0; mi < 10; ++mi) {
            const float* src; int K, N; const float* gs = nullptr; bf16* dst; int map = 0;
            if (mi == 0) { src = p.in[I_WIN] + (size_t)l * 1024 * 8704; K = 1024; N = 8704; gs = p.in[I_GMIX] + l * 1024; dst = (bf16*)(wl + WL_IN); map = 1; }
            else if (mi == 1) { src = p.in[I_WGLU] + (size_t)l * 512 * 512; K = 512; N = 512; dst = (bf16*)(wl + WL_GLU); }
            else if (mi < 6) { const int b = mi - 2; src = p.in[I_WBR] + ((size_t)l * 4 + b) * 512 * 1024; K = 512; N = 1024; dst = (bf16*)(wl + WL_BR) + (size_t)b * 1024 * 512; }
            else if (mi == 6) { src = p.in[I_WO] + (size_t)l * 1024 * 1024; K = 1024; N = 1024; dst = (bf16*)(wl + WL_O); }
            else if (mi == 7) { src = p.in[I_WFG] + (size_t)l * 1024 * 2816; K = 1024; N = 2816; gs = p.in[I_GFFN] + l * 1024; dst = (bf16*)(wl + WL_FF); map = 2; }
            else if (mi == 8) { src = p.in[I_WFU] + (size_t)l * 1024 * 2816; K = 1024; N = 2816; gs = p.in[I_GFFN] + l * 1024; dst = (bf16*)(wl + WL_FF); map = 3; }
            else { src = p.in[I_WFD] + (size_t)l * 2816 * 1024; K = 2816; N = 1024; dst = (bf16*)(wl + WL_D); }
            const int nblk = N / 32, nit = (K / 64) * nblk;
            for (int it = gw; it < nit; it += NGW) {
                const int kb = it / nblk, nb = it % nblk, n0 = nb * 32; int dr = n0;
                if (map == 1) { if (n0 >= 3584 && n0 < 4096) dr = n0 + 512; else if (n0 >= 4096 && n0 < 4608) dr = n0 - 512; }
                else if (map == 2) dr = (n0 >> 7) * 256 + (n0 & 127);
                else if (map == 3) dr = (n0 >> 7) * 256 + 128 + (n0 & 127);
                tr_item(src, N, kb * 64, n0, gs, dst, K, dr, scr, lane);
            }
        }
    }
    { const float* x = p.in[I_X]; bf16* xb = (bf16*)(ws + WS_XB); pg8::rowss_t* rowss = (pg8::rowss_t*)(ws + WS_ROWSS);
        for (int row0 = gw * 4; row0 < TOK; row0 += NGW * 4) { f32x4 v[4][4];
#pragma unroll
            for (int q = 0; q < 4; ++q)
#pragma unroll
                for (int j = 0; j < 4; ++j) v[q][j] = *((const f32x4*)(x + (size_t)(row0 + q) * DM) + lane + 64 * j);
#pragma unroll
            for (int q = 0; q < 4; ++q) { float ss = 0.f;
#pragma unroll
                for (int j = 0; j < 4; ++j) { const f32x4 t = v[q][j]; ss += (t[0] * t[0] + t[1] * t[1]) + (t[2] * t[2] + t[3] * t[3]);
                    u32x2 w; w.x = mk_pk2(t[0], t[1]); w.y = mk_pk2(t[2], t[3]); *((u32x2*)(xb + (size_t)(row0 + q) * DM) + lane + 64 * j) = w; }
                ss = wave_sum(ss); if (lane == 0) rowss[row0 + q] = (pg8::rowss_t)(ss * 4294967296.0f); } }
        for (int i = gt; i < 4 * TOK; i += NGT) rowss[TOK + i] = 0ull; }
    { const float* sgw = p.in[I_SGW]; bf16* o = (bf16*)(ws + WS_SGW);
        for (int i = gt; i < 2 * 4 * 128 * 128; i += NGT) { const int s = i & 127, t = (i >> 7) & 127; o[i] = f2bf(s <= t ? sgw[i] : 0.f); } }
    for (int i = gt; i < 2 * 32 * 64; i += NGT) {
        const int pp = i & 63, lg = i >> 6;
        const double dt = exp((double)p.in[I_LOGDT][lg]); const double are = p.in[I_ARE][i], aim = p.in[I_AIM][i];
        const double mag = exp(dt * are); double sn, cs; dsincos(dt * aim, sn, cs);
        const double abr = mag * cs, abi = mag * sn, den = are * are + aim * aim, nr = abr - 1.0, ni = abi;
        const double cr = (nr * are + ni * aim) / den, ci = (ni * are - nr * aim) / den;
        bf16* bb = (bf16*)(ws + WS_BB) + (size_t)lg * 128 * 16; const float* bre = p.in[I_BRE] + (size_t)i * 16; const float* bim = p.in[I_BIM] + (size_t)i * 16;
        for (int h = 0; h < 16; ++h) { const double br = bre[h], bi = bim[h]; bb[pp * 16 + h] = f2bf((float)(cr * br - ci * bi)); bb[(64 + pp) * 16 + h] = f2bf((float)(cr * bi + ci * br)); }
        bf16* cm = (bf16*)(ws + WS_CM) + (size_t)lg * 16 * 128; const float* cre = p.in[I_CRE] + (size_t)lg * 16 * 64; const float* cim = p.in[I_CIM] + (size_t)lg * 16 * 64;
        for (int h = 0; h < 16; ++h) { cm[h * 128 + pp] = f2bf(cre[h * 64 + pp]); cm[h * 128 + 64 + pp] = f2bf(-cim[h * 64 + pp]); }
        double pr = abr, pi = abi; float* ap = (float*)(ws + WS_AP) + (size_t)i * 8; ap[0] = (float)pr; ap[1] = (float)pi;
        for (int q = 0; q < 5; ++q) { const double t = pr * pr - pi * pi; pi = 2.0 * pr * pi; pr = t; }
        ap[2] = (float)pr; ap[3] = (float)pi;
        { const double t = pr * pr - pi * pi; pi = 2.0 * pr * pi; pr = t; }
        ap[4] = (float)pr; ap[5] = (float)pi; ap[6] = 0.f; ap[7] = 0.f;
    }
}

DI void phase_branchA(const Params& p, int l, int tid, int G) {
    bf16* AB = (bf16*)(p.ws + WS_P); const bf16* AC = (const bf16*)(p.ws + WS_P + PBUF); const bf16* AX = (const bf16*)(p.ws + WS_P + 2 * PBUF);
    const float* cw = p.in[I_CONVW] + l * 3 * 512; const float* cb = p.in[I_CONVB] + l * 512;
    for (int idx = blockIdx.x * NTHR + tid; idx < (TOK / 16) * 64; idx += G * NTHR) {
        const int cgp = idx & 63, run = idx >> 6, c0 = cgp * 8, t0 = run * 16;
        f32x4 w0[2], w1[2], w2[2], bb[2];
#pragma unroll
        for (int e = 0; e < 2; ++e) { w0[e] = *(const f32x4*)(cw + c0 + 4 * e); w1[e] = *(const f32x4*)(cw + 512 + c0 + 4 * e); w2[e] = *(const f32x4*)(cw + 1024 + c0 + 4 * e); bb[e] = *(const f32x4*)(cb + c0 + 4 * e); }
        f32x4 zm2[2] = {{0.f, 0.f, 0.f, 0.f}, {0.f, 0.f, 0.f, 0.f}}, zm1[2] = {{0.f, 0.f, 0.f, 0.f}, {0.f, 0.f, 0.f, 0.f}};
        if ((t0 & (SEQ - 1)) != 0) {
            f32x4 a0, a1, x0, x1;
            pg8::unpack8(*(const u32x4*)(AC + (size_t)(t0 - 2) * 512 + c0), a0, a1); pg8::unpack8(*(const u32x4*)(AX + (size_t)(t0 - 2) * 512 + c0), x0, x1); zm2[0] = a0 * x0; zm2[1] = a1 * x1;
            pg8::unpack8(*(const u32x4*)(AC + (size_t)(t0 - 1) * 512 + c0), a0, a1); pg8::unpack8(*(const u32x4*)(AX + (size_t)(t0 - 1) * 512 + c0), x0, x1); zm1[0] = a0 * x0; zm1[1] = a1 * x1;
        }
#pragma unroll 4
        for (int i = 0; i < 16; ++i) { const size_t off = (size_t)(t0 + i) * 512 + c0;
            f32x4 a0, a1, x0, x1, b0, b1; pg8::unpack8(*(const u32x4*)(AC + off), a0, a1); pg8::unpack8(*(const u32x4*)(AX + off), x0, x1); pg8::unpack8(*(const u32x4*)(AB + off), b0, b1);
            const f32x4 z0 = a0 * x0, z1 = a1 * x1;
            const f32x4 y0 = b0 * (w0[0] * zm2[0] + w1[0] * zm1[0] + w2[0] * z0 + bb[0]), y1 = b1 * (w0[1] * zm2[1] + w1[1] * zm1[1] + w2[1] * z1 + bb[1]);
            *(u32x4*)(AB + off) = pg8::pack8(y0, y1);
            zm2[0] = zm1[0]; zm2[1] = zm1[1]; zm1[0] = z0; zm1[1] = z1; }
    }
}

DI void phase_branchB(const Params& p, int l, LAS unsigned char* lds, int tid, int lane, int wave, int G) {
    bf16* BU = (bf16*)(p.ws + WS_P + 3 * PBUF); const bf16* BV = (const bf16*)(p.ws + WS_P + 4 * PBUF);
    const bf16* SGW = (const bf16*)(p.ws + WS_SGW) + (size_t)l * 4 * 128 * 128; const float* sgb = p.in[I_SGB] + l * 4 * 128;
    const float* lng = p.in[I_LNG] + l * 512 + lane * 8; const float* lnb = p.in[I_LNB] + l * 512 + lane * 8;
    constexpr int RS = 1040;
    const int r = lane & 31, half = lane >> 5;
    for (int item = blockIdx.x; item < TOK / 128; item += G) {
        const int tok0 = item * 128;
        { const f32x4 g0 = *(const f32x4*)lng, g1 = *(const f32x4*)(lng + 4), b0 = *(const f32x4*)lnb, b1 = *(const f32x4*)(lnb + 4);
            for (int tt = 0; tt < 16; ++tt) { const int s = wave * 16 + tt;
                f32x4 v0, v1; pg8::unpack8(*(const u32x4*)(BV + (size_t)(tok0 + s) * 512 + lane * 8), v0, v1);
#pragma unroll
                for (int j = 0; j < 4; ++j) { v0[j] = mk_gelu(v0[j]); v1[j] = mk_gelu(v1[j]); }
                const float mean = wave_sum((v0[0] + v0[1]) + (v0[2] + v0[3]) + (v1[0] + v1[1]) + (v1[2] + v1[3])) * (1.0f / 512.0f);
                v0 = v0 - mean; v1 = v1 - mean;
                const float var = wave_sum((v0[0] * v0[0] + v0[1] * v0[1]) + (v0[2] * v0[2] + v0[3] * v0[3]) + (v1[0] * v1[0] + v1[1] * v1[1]) + (v1[2] * v1[2] + v1[3] * v1[3])) * (1.0f / 512.0f);
                const float rstd = rsqrtf(var + 1e-5f);
                v0 = v0 * rstd * g0 + b0; v1 = v1 * rstd * g1 + b1;
                *(LAS u32x4*)(lds + s * RS + lane * 16) = pg8::pack8(v0, v1); } }
        __syncthreads();
        const int g = wave >> 1, dh = wave & 1;
        f32x16 acc[4][2];
#pragma unroll
        for (int a = 0; a < 4; ++a) { acc[a][0] = zero16(); acc[a][1] = zero16(); }
#pragma unroll
        for (int ks = 0; ks < 8; ++ks) {
            bf16x8 Vf[2];
#pragma unroll
            for (int dt = 0; dt < 2; ++dt) { const LAS unsigned short* vp = (const LAS unsigned short*)(lds + (16 * ks + 8 * half) * RS + (g * 128 + dh * 64 + dt * 32 + r) * 2);
#pragma unroll
                for (int j = 0; j < 8; ++j) Vf[dt][j] = (short)vp[j * (RS / 2)]; }
#pragma unroll
            for (int tt = ks >> 1; tt < 4; ++tt) { const bf16x8 Wf = *(const bf16x8*)(SGW + ((size_t)g * 128 + 32 * tt + r) * 128 + 16 * ks + 8 * half);
                acc[tt][0] = mfma32(Vf[0], Wf, acc[tt][0]); acc[tt][1] = mfma32(Vf[1], Wf, acc[tt][1]); }
        }
        asm volatile("s_nop 15\n\ts_nop 7" : "+v"(acc[0][0]), "+v"(acc[0][1]), "+v"(acc[1][0]), "+v"(acc[1][1]), "+v"(acc[2][0]), "+v"(acc[2][1]), "+v"(acc[3][0]), "+v"(acc[3][1]));
#pragma unroll
        for (int tt = 0; tt < 4; ++tt) { const int t = 32 * tt + r; const float bias = sgb[g * 128 + t];
#pragma unroll
            for (int dt = 0; dt < 2; ++dt)
#pragma unroll
                for (int ig = 0; ig < 4; ++ig) { bf16* up = BU + (size_t)(tok0 + t) * 512 + g * 128 + dh * 64 + dt * 32 + 8 * ig + 4 * half;
                    const u32x2 uw = *(const u32x2*)up;
                    const float y0 = mk_gelu(mk_lo(uw.x)) * (acc[tt][dt][4 * ig + 0] + bias), y1 = mk_gelu(mk_hi(uw.x)) * (acc[tt][dt][4 * ig + 1] + bias);
                    const float y2 = mk_gelu(mk_lo(uw.y)) * (acc[tt][dt][4 * ig + 2] + bias), y3 = mk_gelu(mk_hi(uw.y)) * (acc[tt][dt][4 * ig + 3] + bias);
                    u32x2 o; o.x = mk_pk2(y0, y1); o.y = mk_pk2(y2, y3); *(u32x2*)up = o; } }
        __syncthreads();
    }
}

DI void phase_attn(const Params& p, int l, LAS unsigned char* lds, int tid, int lane, int wave, int G, bf16* OUTP) {
    const bf16* CQ = (const bf16*)(p.ws + WS_P + 5 * PBUF); const bf16* CK = (const bf16*)(p.ws + WS_P + 6 * PBUF); const bf16* VT = (const bf16*)(p.ws + WS_P + 8 * PBUF);
    const float lam_init = 0.8f - 0.6f * expf(-0.3f * (float)l);
    const float* lq = p.in[I_LAMQK] + l * 256;
    const float lam = expf(wave_sum(lq[lane] * lq[64 + lane])) - expf(wave_sum(lq[128 + lane] * lq[192 + lane])) + lam_init;
    const float* sg = p.in[I_SUBLN] + l * 128;
    const int m = wave & 1, sub = wave >> 1, r = lane & 31, half = lane >> 5;
    constexpr int KROW = 144, VROW = 136, KBYTES = 64 * KROW  , VOFF = 2 * KBYTES  , STAGE = VOFF + 128 * KROW  ;
    const float cs = 0.125f * 1.44269504089f;
    for (int pi = blockIdx.x; pi < 512; pi += G) {
#pragma unroll 1
        for (int uu = 0; uu < 2; ++uu) {
            const int bh = pi >> 4, jp = pi & 15, qb = uu ? 31 - jp : jp, b = bh >> 2, h = bh & 3;
            const int tokq0 = b * SEQ + qb * 128, qrow = tokq0 + 32 * sub + r;
            bf16x8 Qf[4];
#pragma unroll
            for (int ks = 0; ks < 4; ++ks) Qf[ks] = *(const bf16x8*)(CQ + (size_t)qrow * 512 + h * 128 + m * 64 + 16 * ks + 8 * half);
            const int nt = 2 * qb + 2, my_last = 2 * qb + (sub >> 1);
            const bf16* kg[2]; const bf16* vg[2]; int kl[2], vl[2];
#pragma unroll
            for (int i = 0; i < 2; ++i) { const int idx = tid + 512 * i; const int key = idx >> 4, c16 = idx & 15;
                kg[i] = CK + (size_t)(b * SEQ + key) * 512 + h * 128 + c16 * 8; kl[i] = (c16 >> 3) * KBYTES + key * KROW + (c16 & 7) * 16;
                const int dv = idx >> 3, c8 = idx & 7;
                vg[i] = VT + (size_t)(h * 128 + dv) * TOK + b * SEQ + c8 * 8; vl[i] = VOFF + dv * VROW + c8 * 16; }
            u32x4 st[4];
            st[0] = *(const u32x4*)kg[0]; st[1] = *(const u32x4*)kg[1]; st[2] = *(const u32x4*)vg[0]; st[3] = *(const u32x4*)vg[1];
            *(LAS u32x4*)(lds + kl[0]) = st[0]; *(LAS u32x4*)(lds + kl[1]) = st[1]; *(LAS u32x2*)(lds + vl[0]) = (u32x2){st[2].x, st[2].y}; *(LAS u32x2*)(lds + vl[0] + 8) = (u32x2){st[2].z, st[2].w}; *(LAS u32x2*)(lds + vl[1]) = (u32x2){st[3].x, st[3].y}; *(LAS u32x2*)(lds + vl[1] + 8) = (u32x2){st[3].z, st[3].w};
            __syncthreads();
            f32x16 O[4];
#pragma unroll
            for (int i = 0; i < 4; ++i) O[i] = zero16();
            float m_run = -INFINITY, l_run = 0.f;
#pragma unroll 1
            for (int kt = 0; kt < nt; ++kt) {
                const bool more = (kt + 1 < nt);
                if (more) { const size_t ko = (size_t)(kt + 1) * 64 * 512, vo = (size_t)(kt + 1) * 64;
                    st[0] = *(const u32x4*)(kg[0] + ko); st[1] = *(const u32x4*)(kg[1] + ko); st[2] = *(const u32x4*)(vg[0] + vo); st[3] = *(const u32x4*)(vg[1] + vo); }
                const LAS unsigned char* buf = lds + (kt & 1) * STAGE;
                if (kt <= my_last) {
                    f32x16 S[2];
#pragma unroll
                    for (int u = 0; u < 2; ++u) { S[u] = zero16();
#pragma unroll
                        for (int ks = 0; ks < 4; ++ks) { const bf16x8 A = *(const LAS bf16x8*)(buf + m * KBYTES + (32 * u + r) * KROW + (16 * ks + 8 * half) * 2); S[u] = mfma32(A, Qf[ks], S[u]); } }
                    asm volatile("s_nop 15\n\ts_nop 7" : "+v"(S[0]), "+v"(S[1]));
                    float mx = -INFINITY;
#pragma unroll
                    for (int u = 0; u < 2; ++u)
#pragma unroll
                        for (int i = 0; i < 16; ++i) mx = fmaxf(mx, S[u][i]);
                    mx = fmaxf(mx, __shfl_xor(mx, 32));
                    const float m_new = fmaxf(m_run, mx * cs), alpha = __builtin_amdgcn_exp2f(m_run - m_new);
                    float ps = 0.f;
#pragma unroll
                    for (int u = 0; u < 2; ++u)
#pragma unroll
                        for (int i = 0; i < 16; ++i) { const float e = __builtin_amdgcn_exp2f(S[u][i] * cs - m_new); S[u][i] = e; ps += e; }
                    ps += __shfl_xor(ps, 32);
                    l_run = l_run * alpha + ps; m_run = m_new;
#pragma unroll
                    for (int d = 0; d < 4; ++d)
#pragma unroll
                        for (int i = 0; i < 16; ++i) O[d][i] *= alpha;
                    bf16x8 Pf[2][2];
#pragma unroll
                    for (int u = 0; u < 2; ++u)
#pragma unroll
                        for (int s = 0; s < 2; ++s) { u32x4 w; w.x = mk_pk2(S[u][8 * s + 0], S[u][8 * s + 1]); w.y = mk_pk2(S[u][8 * s + 2], S[u][8 * s + 3]); w.z = mk_pk2(S[u][8 * s + 4], S[u][8 * s + 5]); w.w = mk_pk2(S[u][8 * s + 6], S[u][8 * s + 7]);
                            Pf[u][s] = __builtin_bit_cast(bf16x8, w); }
#pragma unroll
                    for (int d = 0; d < 4; ++d)
#pragma unroll
                        for (int u = 0; u < 2; ++u)
#pragma unroll
                            for (int s = 0; s < 2; ++s) { const LAS unsigned char* va = buf + VOFF + (32 * d + r) * VROW + (32 * u + 16 * s + 4 * half) * 2;
                                const u32x2 lo = *(const LAS u32x2*)va, hi = *(const LAS u32x2*)(va + 16);
                                u32x4 w; w.x = lo.x; w.y = lo.y; w.z = hi.x; w.w = hi.y;
                                O[d] = mfma32(__builtin_bit_cast(bf16x8, w), Pf[u][s], O[d]); }
                }
                if (more) { LAS unsigned char* nb = lds + ((kt + 1) & 1) * STAGE;
                    *(LAS u32x4*)(nb + kl[0]) = st[0]; *(LAS u32x4*)(nb + kl[1]) = st[1]; *(LAS u32x2*)(nb + vl[0]) = (u32x2){st[2].x, st[2].y}; *(LAS u32x2*)(nb + vl[0] + 8) = (u32x2){st[2].z, st[2].w}; *(LAS u32x2*)(nb + vl[1]) = (u32x2){st[3].x, st[3].y}; *(LAS u32x2*)(nb + vl[1] + 8) = (u32x2){st[3].z, st[3].w}; }
                __syncthreads();
            }
            asm volatile("s_nop 15\n\ts_nop 7" : "+v"(O[0]), "+v"(O[1]), "+v"(O[2]), "+v"(O[3]));
            const float inv = 1.0f / l_run;
            LAS float* Cb = (LAS float*)lds;
            if (m == 1) { const float f = inv * lam;
#pragma unroll
                for (int d = 0; d < 4; ++d)
#pragma unroll
                    for (int i = 0; i < 16; ++i) Cb[(sub * 128 + 32 * d + crow(i, half)) * 33 + r] = O[d][i] * f; }
            __syncthreads();
            if (m == 0) { float ss = 0.f;
#pragma unroll
                for (int d = 0; d < 4; ++d)
#pragma unroll
                    for (int i = 0; i < 16; ++i) { const float o = O[d][i] * inv - Cb[(sub * 128 + 32 * d + crow(i, half)) * 33 + r]; O[d][i] = o; ss += o * o; }
                ss += __shfl_xor(ss, 32);
                const float rs = rsqrtf(ss * (1.0f / 128.0f) + 1e-5f) * (1.0f - lam_init);
#pragma unroll
                for (int d = 0; d < 4; ++d)
#pragma unroll
                    for (int ig = 0; ig < 4; ++ig) { const int dv0 = 32 * d + 8 * ig + 4 * half; const f32x4 gn = *(const f32x4*)(sg + dv0);
                        u32x2 w; w.x = mk_pk2(O[d][4 * ig + 0] * rs * gn[0], O[d][4 * ig + 1] * rs * gn[1]); w.y = mk_pk2(O[d][4 * ig + 2] * rs * gn[2], O[d][4 * ig + 3] * rs * gn[3]);
                        *(u32x2*)(OUTP + (size_t)qrow * 512 + h * 128 + dv0) = w; } }
            __syncthreads();
        }
    }
}

template <bool PRODUCER> DI void attn2_unit(const bf16* CQ, const bf16* CK, const bf16* VT, bf16* OUTP, const float* sg, float lam, float lam_init, LAS unsigned char* lds, int tid, int lane, int sub, int b, int h, int qb) {
    const int r = lane & 31, half = lane >> 5;
    constexpr int KROW = 144, VROW = 136, KB1 = 64 * KROW, KST = 2 * KB1  , VST = 128 * VROW  ;
    constexpr int OFF_K = 0, OFF_V = 2 * KST  , OFF_P = OFF_V + 2 * VST  , PST = 32768, OFF_A = OFF_P + 2 * PST  , AST = 1024, OFF_L = 139392;
    const float cs = 0.125f * 1.44269504089f;
            const int tokq0 = b * SEQ + qb * 128, qrow = tokq0 + 32 * sub + r;
            const int nt = 2 * qb + 2, my_last = 2 * qb + (sub >> 1);
            const bf16* kg[2]; const bf16* vg[2]; int kl[2], vl[2];
#pragma unroll
            for (int i = 0; i < 2; ++i) { const int idx = tid + 512 * i; const int key = idx >> 4, c16 = idx & 15;
                kg[i] = CK + (size_t)(b * SEQ + key) * 512 + h * 128 + c16 * 8; kl[i] = OFF_K + (c16 >> 3) * KB1 + key * KROW + (c16 & 7) * 16;
                const int dv = idx >> 3, c8 = idx & 7;
                vg[i] = VT + (size_t)(h * 128 + dv) * TOK + b * SEQ + c8 * 8; vl[i] = OFF_V + dv * VROW + c8 * 16; }
            bf16x8 Qf[2][4];
            f32x16 O[2][4];
            float m_run[2] = {-INFINITY, -INFINITY}, l_run[2] = {0.f, 0.f};
            if (PRODUCER) {
#pragma unroll
                for (int m = 0; m < 2; ++m)
#pragma unroll
                    for (int ks = 0; ks < 4; ++ks) Qf[m][ks] = *(const bf16x8*)(CQ + (size_t)qrow * 512 + h * 128 + m * 64 + 16 * ks + 8 * half);
            } else {
#pragma unroll
                for (int m = 0; m < 2; ++m)
#pragma unroll
                    for (int d = 0; d < 4; ++d) O[m][d] = zero16();
            }
            u32x4 sk[2], sv[2];
            sk[0] = *(const u32x4*)kg[0]; sk[1] = *(const u32x4*)kg[1];
            *(LAS u32x4*)(lds + kl[0]) = sk[0]; *(LAS u32x4*)(lds + kl[1]) = sk[1];
            __syncthreads();
#pragma unroll 1
            for (int i = 0; i <= nt; ++i) {
                const bool ldk = (i + 1 < nt), ldv = (i < nt);
                if (ldk) { const size_t ko = (size_t)(i + 1) * 64 * 512; sk[0] = *(const u32x4*)(kg[0] + ko); sk[1] = *(const u32x4*)(kg[1] + ko); }
                if (ldv) { const size_t vo = (size_t)i * 64; sv[0] = *(const u32x4*)(vg[0] + vo); sv[1] = *(const u32x4*)(vg[1] + vo); }
                if (PRODUCER) {
                    if (i < nt && i <= my_last) {
                        const LAS unsigned char* kb = lds + OFF_K + (i & 1) * KST;
                        LAS unsigned char* pb = lds + OFF_P + (i & 1) * PST + (sub * 2) * 4096 + lane * 16;
                        LAS float* ab = (LAS float*)(lds + OFF_A + (i & 1) * AST) + (sub * 2) * 32 + r;
#pragma unroll
                        for (int m = 0; m < 2; ++m) {
                            f32x16 S[2];
#pragma unroll
                            for (int u = 0; u < 2; ++u) { S[u] = zero16();
#pragma unroll
                                for (int ks = 0; ks < 4; ++ks) { const bf16x8 A = *(const LAS bf16x8*)(kb + m * KB1 + (32 * u + r) * KROW + (16 * ks + 8 * half) * 2); S[u] = mfma32(A, Qf[m][ks], S[u]); } }
                            asm volatile("s_nop 15\n\ts_nop 7" : "+v"(S[0]), "+v"(S[1]));
                            float mx = -INFINITY;
#pragma unroll
                            for (int u = 0; u < 2; ++u)
#pragma unroll
                                for (int k = 0; k < 16; ++k) mx = fmaxf(mx, S[u][k]);
                            mx = fmaxf(mx, __shfl_xor(mx, 32));
                            const float m_new = fmaxf(m_run[m], mx * cs), alpha = __builtin_amdgcn_exp2f(m_run[m] - m_new);
                            float ps = 0.f;
#pragma unroll
                            for (int u = 0; u < 2; ++u)
#pragma unroll
                                for (int k = 0; k < 16; ++k) { const float e = __builtin_amdgcn_exp2f(S[u][k] * cs - m_new); S[u][k] = e; ps += e; }
                            ps += __shfl_xor(ps, 32);
                            l_run[m] = l_run[m] * alpha + ps; m_run[m] = m_new;
                            if (half == 0) ab[m * 32] = alpha;
#pragma unroll
                            for (int u = 0; u < 2; ++u)
#pragma unroll
                                for (int s = 0; s < 2; ++s) { u32x4 w; w.x = mk_pk2(S[u][8 * s + 0], S[u][8 * s + 1]); w.y = mk_pk2(S[u][8 * s + 2], S[u][8 * s + 3]); w.z = mk_pk2(S[u][8 * s + 4], S[u][8 * s + 5]); w.w = mk_pk2(S[u][8 * s + 6], S[u][8 * s + 7]);
                                    *(LAS u32x4*)(pb + m * 4096 + (u * 2 + s) * 1024) = w; }
                        }
                    }
                } else {
                    const int j = i - 1;
                    if (j >= 0 && j <= my_last) {
                        const LAS unsigned char* vb = lds + OFF_V + (j & 1) * VST;
                        const LAS unsigned char* pb = lds + OFF_P + (j & 1) * PST + (sub * 2) * 4096 + lane * 16;
                        const LAS float* ab = (const LAS float*)(lds + OFF_A + (j & 1) * AST) + (sub * 2) * 32 + r;
                        const float a0 = ab[0], a1 = ab[32];
#pragma unroll
                        for (int d = 0; d < 4; ++d)
#pragma unroll
                            for (int k = 0; k < 16; ++k) { O[0][d][k] *= a0; O[1][d][k] *= a1; }
#pragma unroll
                        for (int q = 0; q < 4; ++q) { const bf16x8 P0 = *(const LAS bf16x8*)(pb + q * 1024), P1 = *(const LAS bf16x8*)(pb + 4096 + q * 1024);
#pragma unroll
                            for (int d = 0; d < 4; ++d) { const LAS unsigned char* va = vb + (32 * d + r) * VROW + (16 * q + 4 * half) * 2;
                                const u32x2 lo = *(const LAS u32x2*)va, hi = *(const LAS u32x2*)(va + 16);
                                u32x4 w; w.x = lo.x; w.y = lo.y; w.z = hi.x; w.w = hi.y; const bf16x8 Vf = __builtin_bit_cast(bf16x8, w);
                                O[0][d] = mfma32(Vf, P0, O[0][d]); O[1][d] = mfma32(Vf, P1, O[1][d]); } }
                    }
                }
                if (ldk) { LAS unsigned char* nb = lds + ((i + 1) & 1) * KST; *(LAS u32x4*)(nb + kl[0]) = sk[0]; *(LAS u32x4*)(nb + kl[1]) = sk[1]; }
                if (ldv) { LAS unsigned char* nb = lds + (i & 1) * VST;
                    *(LAS u32x2*)(nb + vl[0]) = (u32x2){sv[0].x, sv[0].y}; *(LAS u32x2*)(nb + vl[0] + 8) = (u32x2){sv[0].z, sv[0].w}; *(LAS u32x2*)(nb + vl[1]) = (u32x2){sv[1].x, sv[1].y}; *(LAS u32x2*)(nb + vl[1] + 8) = (u32x2){sv[1].z, sv[1].w}; }
                __syncthreads();
            }
            LAS float* Lb = (LAS float*)(lds + OFF_L) + (sub * 2) * 32 + r;
            if (PRODUCER && half == 0) { Lb[0] = l_run[0]; Lb[32] = l_run[1]; }
            __syncthreads();
            if (!PRODUCER) {
                asm volatile("s_nop 15\n\ts_nop 7" : "+v"(O[0][0]), "+v"(O[0][1]), "+v"(O[0][2]), "+v"(O[0][3]), "+v"(O[1][0]), "+v"(O[1][1]), "+v"(O[1][2]), "+v"(O[1][3]));
                const float inv0 = 1.0f / Lb[0], inv1 = lam / Lb[32];
                float ss = 0.f;
#pragma unroll
                for (int d = 0; d < 4; ++d)
#pragma unroll
                    for (int k = 0; k < 16; ++k) { const float o = O[0][d][k] * inv0 - O[1][d][k] * inv1; O[0][d][k] = o; ss += o * o; }
                ss += __shfl_xor(ss, 32);
                const float rs = rsqrtf(ss * (1.0f / 128.0f) + 1e-5f) * (1.0f - lam_init);
#pragma unroll
                for (int d = 0; d < 4; ++d)
#pragma unroll
                    for (int ig = 0; ig < 4; ++ig) { const int dv0 = 32 * d + 8 * ig + 4 * half; const f32x4 gn = *(const f32x4*)(sg + dv0);
                        u32x2 w; w.x = mk_pk2(O[0][d][4 * ig + 0] * rs * gn[0], O[0][d][4 * ig + 1] * rs * gn[1]); w.y = mk_pk2(O[0][d][4 * ig + 2] * rs * gn[2], O[0][d][4 * ig + 3] * rs * gn[3]);
                        *(u32x2*)(OUTP + (size_t)qrow * 512 + h * 128 + dv0) = w; }
            }
            __syncthreads();
}
DI void phase_attn2(const Params& p, int l, LAS unsigned char* lds, int tid, int lane, int wave, int G, bf16* OUTP) {
    const bf16* CQ = (const bf16*)(p.ws + WS_P + 5 * PBUF); const bf16* CK = (const bf16*)(p.ws + WS_P + 6 * PBUF); const bf16* VT = (const bf16*)(p.ws + WS_P + 8 * PBUF);
    const float lam_init = 0.8f - 0.6f * expf(-0.3f * (float)l);
    const float* lq = p.in[I_LAMQK] + l * 256;
    const float lam = expf(wave_sum(lq[lane] * lq[64 + lane])) - expf(wave_sum(lq[128 + lane] * lq[192 + lane])) + lam_init;
    const float* sg = p.in[I_SUBLN] + l * 128;
    const bool producer = wave < 4; const int sub = wave & 3;
    if (producer) __builtin_amdgcn_s_setprio(2);
    for (int pi0 = blockIdx.x; pi0 < 512; pi0 += G) {
        const int pi = (G == 256) ? (((int)blockIdx.x & 7) * 64 + (pi0 >> 8) * 32 + ((int)blockIdx.x >> 3)) : pi0;
#pragma unroll 1
        for (int uu = 0; uu < 2; ++uu) {
            const int bh = pi >> 4, jp = pi & 15, qb = uu ? 31 - jp : jp, b = bh >> 2, h = bh & 3;
            if (producer) attn2_unit<true>(CQ, CK, VT, OUTP, sg, lam, lam_init, lds, tid, lane, sub, b, h, qb);
            else attn2_unit<false>(CQ, CK, VT, OUTP, sg, lam, lam_init, lds, tid, lane, sub, b, h, qb);
        }
    }
    __builtin_amdgcn_s_setprio(0);
}

template <bool P2> DI void phase_ssm(const Params& p, int l, LAS unsigned char* lds, int lane, int wave, int G) {
    const bf16* DU = (const bf16*)(p.ws + WS_P + 7 * PBUF); bf16* YG = (bf16*)(p.ws + WS_YG); float* E = (float*)(p.ws + WS_E);
    const bf16* BB = (const bf16*)(p.ws + WS_BB) + (size_t)l * 32 * 128 * 16; const bf16* CM = (const bf16*)(p.ws + WS_CM) + (size_t)l * 32 * 16 * 128;
    const float* AP = (const float*)(p.ws + WS_AP) + (size_t)l * 32 * 64 * 8; const float* dsk = p.in[I_SSMD] + l * 512;
    const int r = lane & 31, half = lane >> 5, r16 = lane & 15, q4 = lane >> 4;
    constexpr int XRS = 272;
    LAS unsigned char* Xs = lds + wave * (64 * XRS);
    for (int sw = blockIdx.x * 8 + wave; sw < 2048; sw += G * 8) {
      const int g = (sw & 7) + 8 * ((sw >> 3) & 3), cb = (sw >> 5) & 7, b = sw >> 8;
      float sr0 = 0.f, si0 = 0.f, sr1 = 0.f, si1 = 0.f;
#pragma unroll 1
      for (int ci = 0; ci < 8; ++ci) {
        const int c = cb * 8 + ci, tok0 = b * SEQ + c * 64;
        const int ch = g * 16 + r16; float dk = 0.f; bf16x8 Cf[4]; float uu[4][4];
        if (P2) { dk = dsk[ch];
#pragma unroll
            for (int mt = 0; mt < 4; ++mt)
#pragma unroll
                for (int j = 0; j < 4; ++j) uu[mt][j] = bf2f(DU[(size_t)(tok0 + 16 * mt + 4 * q4 + j) * 512 + ch]); }
        f32x16 X[4][2];
        { bf16x8 Uf[2], Bf[4];
#pragma unroll
            for (int tt = 0; tt < 2; ++tt) { const int tau = 32 * ((r >> 2) & 1) + 16 * tt + (r & 3) + 4 * (r >> 3); Uf[tt] = *(const bf16x8*)(DU + (size_t)(tok0 + tau) * 512 + g * 16 + 8 * half); }
#pragma unroll
            for (int pt = 0; pt < 4; ++pt) Bf[pt] = *(const bf16x8*)(BB + ((size_t)g * 128 + 32 * pt + r) * 16 + 8 * half);
#pragma unroll
            for (int pt = 0; pt < 4; ++pt)
#pragma unroll
                for (int tt = 0; tt < 2; ++tt) X[pt][tt] = mfma32(Uf[tt], Bf[pt], zero16()); }
        asm volatile("s_nop 15\n\ts_nop 15" : "+v"(X[0][0]), "+v"(X[0][1]), "+v"(X[1][0]), "+v"(X[1][1]), "+v"(X[2][0]), "+v"(X[2][1]), "+v"(X[3][0]), "+v"(X[3][1]));
        float ar[2], ai[2], a32r[2], a32i[2], a64r[2], a64i[2];
#pragma unroll
        for (int s = 0; s < 2; ++s) { const float* ap = AP + ((size_t)g * 64 + 32 * s + r) * 8; const f32x4 v = *(const f32x4*)ap; ar[s] = v[0]; ai[s] = v[1]; a32r[s] = v[2]; a32i[s] = v[3]; a64r[s] = ap[4]; a64i[s] = ap[5]; }
        float xr[2] = {0.f, 0.f}, xi[2] = {0.f, 0.f};
        if (P2) {
            const float* e0 = E + (((size_t)(b * 32 + g) * 64) * 64 + r) * 2;
#pragma unroll 4
            for (int j = (ci == 0 ? 0 : c - 1); j < c; ++j) { const float2 ea = *(const float2*)(e0 + (size_t)j * 128), eb = *(const float2*)(e0 + (size_t)j * 128 + 64);
                const float t0 = a64r[0] * sr0 - a64i[0] * si0 + ea.x; si0 = a64r[0] * si0 + a64i[0] * sr0 + ea.y; sr0 = t0;
                const float t1 = a64r[1] * sr1 - a64i[1] * si1 + eb.x; si1 = a64r[1] * si1 + a64i[1] * sr1 + eb.y; sr1 = t1; }
            if (half == 0) { xr[0] = sr0; xi[0] = si0; xr[1] = sr1; xi[1] = si1; }
        }
#pragma unroll
        for (int s = 0; s < 2; ++s)
#pragma unroll
            for (int tt = 0; tt < 2; ++tt)
#pragma unroll
                for (int i = 0; i < 16; ++i) { const float nr = ar[s] * xr[s] - ai[s] * xi[s] + X[s][tt][i], ni = ar[s] * xi[s] + ai[s] * xr[s] + X[2 + s][tt][i]; X[s][tt][i] = nr; X[2 + s][tt][i] = ni; xr[s] = nr; xi[s] = ni; }
        float oxr[2], oxi[2];
#pragma unroll
        for (int s = 0; s < 2; ++s) { oxr[s] = __shfl_xor(xr[s], 32); oxi[s] = __shfl_xor(xi[s], 32); }
        if (!P2) {
            if (half == 1) {
#pragma unroll
                for (int s = 0; s < 2; ++s) { float2 e; e.x = xr[s] + a32r[s] * oxr[s] - a32i[s] * oxi[s]; e.y = xi[s] + a32r[s] * oxi[s] + a32i[s] * oxr[s];
                    *(float2*)(E + (((size_t)(b * 32 + g) * 64 + c) * 64 + 32 * s + r) * 2) = e; } }
        } else {
#pragma unroll
            for (int s = 0; s < 2; ++s) { float wr_ = half ? oxr[s] : 0.f, wi_ = half ? oxi[s] : 0.f;
#pragma unroll
                for (int tt = 0; tt < 2; ++tt)
#pragma unroll
                    for (int i = 0; i < 16; ++i) { const float t = ar[s] * wr_ - ai[s] * wi_; wi_ = ar[s] * wi_ + ai[s] * wr_; wr_ = t; X[s][tt][i] += wr_; X[2 + s][tt][i] += wi_; } }
#pragma unroll
            for (int pt = 0; pt < 4; ++pt)
#pragma unroll
                for (int tt = 0; tt < 2; ++tt)
#pragma unroll
                    for (int i = 0; i < 16; ++i) *(LAS unsigned short*)(Xs + (32 * half + 16 * tt + i) * XRS + (32 * pt + r) * 2) = f2bf(X[pt][tt][i]);
#pragma unroll
            for (int ks = 0; ks < 4; ++ks) Cf[ks] = *(const bf16x8*)(CM + ((size_t)g * 16 + r16) * 128 + 32 * ks + 8 * q4);
            LDS_WAIT();
#pragma unroll
            for (int mt = 0; mt < 4; ++mt) { f32x4 acc = {0.f, 0.f, 0.f, 0.f};
#pragma unroll
                for (int ks = 0; ks < 4; ++ks) { const bf16x8 A = *(const LAS bf16x8*)(Xs + (16 * mt + r16) * XRS + (32 * ks + 8 * q4) * 2); acc = mfma16(A, Cf[ks], acc); }
                asm volatile("s_nop 15" : "+v"(acc));
#pragma unroll
                for (int j = 0; j < 4; ++j) { const size_t o = (size_t)(tok0 + 16 * mt + 4 * q4 + j) * 512 + ch; const float y = acc[j] + dk * uu[mt][j]; YG[o] = f2bf(mk_gelu(y)); } }
            LDS_WAIT();
        }
      }
    }
}

DI void phase_ssm1(const Params& p, int l, int lane, int wave, int G) {
    const bf16* DU = (const bf16*)(p.ws + WS_P + 7 * PBUF); float* E = (float*)(p.ws + WS_E);
    const bf16* BB = (const bf16*)(p.ws + WS_BB) + (size_t)l * 32 * 128 * 16;
    const float* AP = (const float*)(p.ws + WS_AP) + (size_t)l * 32 * 64 * 8;
    const int r = lane & 31, half = lane >> 5;
    const int tau0 = 32 * ((r >> 2) & 1) + (r & 3) + 4 * (r >> 3);
    const int step = G * 8; int it = blockIdx.x * 8 + wave;
    bf16x8 Uf[2], Bf[4]; f32x4 apv[2];
#define SSM1_LOAD(IT) do { const int g_ = (IT) & 31, c_ = ((IT) >> 5) & 63, b_ = (IT) >> 11; const size_t t0_ = (size_t)(b_ * SEQ + c_ * 64 + tau0) * 512 + g_ * 16 + 8 * half; \
        Uf[0] = *(const bf16x8*)(DU + t0_); Uf[1] = *(const bf16x8*)(DU + t0_ + (size_t)16 * 512); \
        _Pragma("unroll") for (int pt = 0; pt < 4; ++pt) Bf[pt] = *(const bf16x8*)(BB + ((size_t)g_ * 128 + 32 * pt + r) * 16 + 8 * half); \
        _Pragma("unroll") for (int s = 0; s < 2; ++s) apv[s] = *(const f32x4*)(AP + ((size_t)g_ * 64 + 32 * s + r) * 8); } while (0)
    if (it < 16384) SSM1_LOAD(it);
    for (; it < 16384; it += step) {
        const int g = it & 31, c = (it >> 5) & 63, b = it >> 11;
        f32x16 X[4][2];
#pragma unroll
        for (int pt = 0; pt < 4; ++pt)
#pragma unroll
            for (int tt = 0; tt < 2; ++tt) X[pt][tt] = mfma32(Uf[tt], Bf[pt], zero16());
        float ar[2], ai[2], a32r[2], a32i[2];
#pragma unroll
        for (int s = 0; s < 2; ++s) { ar[s] = apv[s][0]; ai[s] = apv[s][1]; a32r[s] = apv[s][2]; a32i[s] = apv[s][3]; }
        asm volatile("s_nop 15\n\ts_nop 15" : "+v"(X[0][0]), "+v"(X[0][1]), "+v"(X[1][0]), "+v"(X[1][1]), "+v"(X[2][0]), "+v"(X[2][1]), "+v"(X[3][0]), "+v"(X[3][1]));
        if (it + step < 16384) SSM1_LOAD(it + step);
#pragma unroll
        for (int s = 0; s < 2; ++s) { float xr = 0.f, xi = 0.f;
#pragma unroll
            for (int tt = 0; tt < 2; ++tt)
#pragma unroll
                for (int k = 0; k < 16; ++k) { const float nr = ar[s] * xr - ai[s] * xi + X[s][tt][k], ni = ar[s] * xi + ai[s] * xr + X[2 + s][tt][k]; xr = nr; xi = ni; }
            const float oxr = __shfl_xor(xr, 32), oxi = __shfl_xor(xi, 32);
            if (half == 1) { float2 e; e.x = xr + a32r[s] * oxr - a32i[s] * oxi; e.y = xi + a32r[s] * oxi + a32i[s] * oxr;
                *(float2*)(E + (((size_t)(b * 32 + g) * 64 + c) * 64 + 32 * s + r) * 2) = e; } }
    }
#undef SSM1_LOAD
}

DI void phase_final(const Params& p, int tid, int G) {
    const pg8::rowss_t* rowss = (const pg8::rowss_t*)(p.ws + WS_ROWSS) + (size_t)4 * TOK; const float* gf = p.in[I_GFIN]; float* out = p.out; const bf16* xb = (const bf16*)(p.ws + WS_XB);
    for (size_t i = (size_t)blockIdx.x * NTHR + tid; i < (size_t)TOK * 128; i += (size_t)G * NTHR) { const int row = (int)(i >> 7), c8 = (int)(i & 127);
        const float rs = pg8::rstd_row(rowss, row); f32x4 v0, v1; pg8::unpack8(*((const u32x4*)xb + i), v0, v1);
        const f32x4 g0 = *((const f32x4*)gf + 2 * c8), g1 = *((const f32x4*)gf + 2 * c8 + 1);
        *((f32x4*)out + 2 * i) = v0 * rs * g0; *((f32x4*)out + 2 * i + 1) = v1 * rs * g1; }
}

#define XB_TMO      128
#define XB_XCNT(j)  (256  + 64 * (j))
#define XB_XSUB(j)  (1280 + 64 * (j))
#define XB_XGEN(j)  (2304 + 64 * (j))
#define XB_TOP      3328
#define XB_TOPGEN   3392
#define XCD_BAR_WORDS 3456
#define XB_SPIN_CAP (1u << 18)

__device__ __forceinline__ unsigned xb_ld(unsigned* p)              { return __hip_atomic_load(p, __ATOMIC_RELAXED, __HIP_MEMORY_SCOPE_AGENT); }
__device__ __forceinline__ unsigned xb_add(unsigned* p, unsigned v) { return __hip_atomic_fetch_add(p, v, __ATOMIC_RELAXED, __HIP_MEMORY_SCOPE_AGENT); }
__device__ __forceinline__ unsigned xb_xcc_id() { return (unsigned)__builtin_amdgcn_s_getreg((3 << 11) | 20) & 0xFu; }
#define XB_SPIN(cond, bar) do { unsigned _sp = 0; while (cond) { __builtin_amdgcn_s_sleep(1); \
    if ((++_sp & 255u) == 0u) { if (xb_ld(&(bar)[XB_TMO])) break; if (_sp > XB_SPIN_CAP) { atomicAdd(&(bar)[XB_TMO], 1u); break; } } } } while (0)

struct XcdBarrier {
    unsigned* bar; unsigned x;
    volatile LAS unsigned* st;
};

__device__ __forceinline__ XcdBarrier xcd_barrier_post(unsigned* bar, volatile LAS unsigned* st) {
    XcdBarrier b; b.bar = bar; b.x = xb_xcc_id(); b.st = st;
    if (threadIdx.x == 0) (void)xb_add(&bar[XB_XCNT(b.x)], 1u);
    return b;
}
__device__ __forceinline__ void xcd_barrier_complete(unsigned* bar, unsigned x, unsigned& nloc, unsigned& nx) {
    const unsigned G = gridDim.x * gridDim.y * gridDim.z;
    unsigned sum, cnt, mine, sp = 0u;
    for (;;) {
        sum = 0u; cnt = 0u; mine = 0u;
#pragma unroll
        for (unsigned j = 0; j < 16; ++j) { const unsigned c = xb_ld(&bar[XB_XCNT(j)]); sum += c; cnt += (c > 0u) ? 1u : 0u; mine = (j == x) ? c : mine; }
        if (sum == G) break;
        __builtin_amdgcn_s_sleep(1);
        if ((++sp & 255u) == 0u) { if (xb_ld(&bar[XB_TMO])) break; if (sp > XB_SPIN_CAP) { atomicAdd(&bar[XB_TMO], 1u); break; } }
    }
    nloc = mine > 0u ? mine : 1u; nx = cnt > 0u ? cnt : 1u;
}

__device__ __forceinline__ void xcd_barrier(const XcdBarrier& b) {
    asm volatile("s_waitcnt vmcnt(0)" ::: "memory");
    __syncthreads();
    if (threadIdx.x == 0) {
        unsigned* bar = b.bar;
        __builtin_amdgcn_s_waitcnt(0);
        unsigned nloc = b.st[0], nx = b.st[1];
        if (nloc == 0u) { xcd_barrier_complete(bar, b.x, nloc, nx); b.st[0] = nloc; b.st[1] = nx; }
        const unsigned old = xb_add(&bar[XB_XSUB(b.x)], 1u);
        const unsigned gen = old / nloc;
        if (old + 1u == (gen + 1u) * nloc) {
            __builtin_amdgcn_fence(__ATOMIC_RELEASE, "agent");
            asm volatile("s_waitcnt vmcnt(0)" ::: "memory");
            const unsigned og = xb_add(&bar[XB_TOP], 1u);
            const unsigned tg = og / nx;
            if (og + 1u == (tg + 1u) * nx) xb_add(&bar[XB_TOPGEN], 1u);
            else XB_SPIN(xb_ld(&bar[XB_TOPGEN]) == tg, bar);
            __builtin_amdgcn_fence(__ATOMIC_ACQUIRE, "agent");
            xb_add(&bar[XB_XGEN(b.x)], 1u);
            asm volatile("s_waitcnt vmcnt(0)" ::: "memory");
        } else {
            XB_SPIN(xb_ld(&bar[XB_XGEN(b.x)]) == gen, bar);
            __builtin_amdgcn_fence(__ATOMIC_ACQUIRE, "agent");
            asm volatile("s_waitcnt vmcnt(0)" ::: "memory");
        }
    }
    __syncthreads();
}


__global__ void __launch_bounds__(NTHR) mega(Params p) {
    extern __shared__ __attribute__((aligned(16))) unsigned char lds_raw[];
    LAS unsigned char* lds = (LAS unsigned char*)lds_raw;
    const int G = gridDim.x;
#define LAUNDER() int tid = threadIdx.x; asm volatile("" : "+v"(tid)); const int lane = tid & 63, wave = __builtin_amdgcn_readfirstlane(tid >> 6); (void)lane; (void)wave
    const int lo = p.ph_lo, hi = p.ph_hi;
    unsigned char* ws = p.ws;
    int ph = 0;
    volatile LAS unsigned* xb_st = (volatile LAS unsigned*)(lds + 139264);
    XcdBarrier xbar; xbar.bar = (unsigned*)(ws + WS_BAR); xbar.x = 0; xbar.st = xb_st;
    if (ONE_LAUNCH) { if (threadIdx.x < 4) xb_st[threadIdx.x] = 0u; __syncthreads(); xbar = xcd_barrier_post((unsigned*)(ws + WS_BAR), xb_st); }
#ifndef ONLY_KIND
#define ONLY_KIND -1
#endif
#define KEN(k) (ONLY_KIND < 0 || ONLY_KIND == (k))
#ifndef DUP
#define DUP 0
#endif
#define REP(bit) _Pragma("unroll 1") for (int rep_ = 0; rep_ < ((DUP & (bit)) ? 2 : 1); ++rep_)
#define IN_PH() (lo <= ph && ph < hi)
#define END_PH() do { if (ONE_LAUNCH && lo <= ph && ph + 1 < hi) { if (hi < 0) cg::this_grid().sync(); else xcd_barrier(xbar); } ++ph; } while (0)
    if (IN_PH() && KEN(0)) REP(128) { LAUNDER(); phase_prep(p, lds, tid, lane, wave, G); }
    END_PH();
    bf16* XB = (bf16*)(ws + WS_XB); pg8::rowss_t* rowss = (pg8::rowss_t*)(ws + WS_ROWSS);
    for (int l = 0; l < 2; ++l) {
        unsigned char* wl = ws + WS_W + (size_t)l * WL_SIZE;
        const bf16* WinT = (const bf16*)(wl + WL_IN);
        bf16* P0 = (bf16*)(ws + WS_P);
        const pg8::rowss_t* rs_mix = rowss + (size_t)(2 * l) * TOK; pg8::rowss_t* rs_ffn = rowss + (size_t)(2 * l + 1) * TOK; pg8::rowss_t* rs_next = rowss + (size_t)(2 * l + 2) * TOK;
        pg8::StaticOrder S;
        if (IN_PH()) REP(1) {
            if (KEN(1)) { pg8::Gemm g{XB, WinT, TOK, 4096, 1024}; S.init(TOK, 4096, G, (int)blockIdx.x); pg8::EpiProj E{P0, rs_mix}; pg8::gemm_phase<pg8::EpiProj, pg8::StaticOrder>(lds, g, S, E); }
            if (KEN(2)) { pg8::Gemm g{WinT + (size_t)4096 * 1024, XB, 512, TOK, 1024}; S.init(512, TOK, G, (int)blockIdx.x); pg8::EpiVT E{(bf16*)(ws + WS_P + 8 * PBUF), rs_mix}; pg8::gemm_phase<pg8::EpiVT, pg8::StaticOrder>(lds, g, S, E); }
        }
        END_PH();
        if (IN_PH()) { if (KEN(20)) REP(4) { LAUNDER(); phase_attn2(p, l, lds, tid, lane, wave, G, (DUP & 4) && rep_ == 0 ? (bf16*)(ws + WS_YG) : (bf16*)(ws + WS_P + 5 * PBUF)); } if (KEN(21)) { LAUNDER(); phase_branchB(p, l, lds, tid, lane, wave, G); } if (KEN(22)) REP(16) { LAUNDER(); phase_ssm1(p, l, lane, wave, G); } if (KEN(23)) { LAUNDER(); phase_branchA(p, l, tid, G); } }
        END_PH();
        if (IN_PH() && KEN(3)) REP(16) { LAUNDER(); phase_ssm<true>(p, l, lds, lane, wave, G); }
        END_PH();
        if (IN_PH() && KEN(4)) REP(64) { pg8::Gemm g{(const bf16*)(ws + WS_YG), (const bf16*)(wl + WL_GLU), TOK, 512, 512}; S.init(TOK, 512, G, (int)blockIdx.x);
            pg8::EpiGlu E{(const bf16*)(ws + WS_YG), (bf16*)(ws + WS_P + 7 * PBUF), p.in[I_BGLU] + l * 512}; pg8::gemm_phase<pg8::EpiGlu, pg8::StaticOrder>(lds, g, S, E); }
        END_PH();
        unsigned char* GS = (unsigned char*)(ws + WS_P + 1 * PBUF);   bf16* MG = (bf16*)(ws + WS_P + 8 * PBUF);
        if (IN_PH() && KEN(5)) REP(8) {
#pragma unroll 1
            for (int b = 0; b < 4; ++b) {
                { pg8::Gemm g{XB, WinT + (size_t)(4608 + 1024 * b) * 1024, TOK, 1024, 1024}; S.init(TOK, 1024, G, (int)blockIdx.x); pg8::EpiGate E{GS, rs_mix}; pg8::gemm_phase<pg8::EpiGate, pg8::StaticOrder>(lds, g, S, E); }
                const size_t yb = (b == 0) ? 0 : (b == 1) ? 3 : (b == 2) ? 5 : 7;
                pg8::Gemm g{(const bf16*)(ws + WS_P + yb * PBUF), (const bf16*)(wl + WL_BR) + (size_t)b * 1024 * 512, TOK, 1024, 512}; S.init(TOK, 1024, G, (int)blockIdx.x);
                if (b == 0) { pg8::EpiBr<true> E{GS, MG}; pg8::gemm_phase<pg8::EpiBr<true>, pg8::StaticOrder>(lds, g, S, E); }
                else { pg8::EpiBr<false> E{GS, MG}; pg8::gemm_phase<pg8::EpiBr<false>, pg8::StaticOrder>(lds, g, S, E); }
            }
        }
        END_PH();
        if (IN_PH() && KEN(6)) { pg8::Gemm g{MG, (const bf16*)(wl + WL_O), TOK, 1024, 1024}; S.init(TOK, 1024, G, (int)blockIdx.x);
            if (l == 0) { pg8::EpiResidT<true> E{p.in[I_X], XB, rs_ffn}; pg8::gemm_phase<pg8::EpiResidT<true>, pg8::StaticOrder>(lds, g, S, E); }
            else { pg8::EpiResidT<false> E{nullptr, XB, rs_ffn}; pg8::gemm_phase<pg8::EpiResidT<false>, pg8::StaticOrder>(lds, g, S, E); } }
        END_PH();
        bf16* H = (bf16*)(ws + WS_P);
        if (IN_PH() && KEN(7)) REP(2) { pg8::Gemm g{XB, (const bf16*)(wl + WL_FF), TOK, 5632, 1024}; S.init(TOK, 5632, G, (int)blockIdx.x);
            pg8::EpiFfnUp E{H, rs_ffn}; pg8::gemm_phase<pg8::EpiFfnUp, pg8::StaticOrder>(lds, g, S, E); }
        END_PH();
        if (IN_PH() && KEN(8)) { pg8::Gemm g{H, (const bf16*)(wl + WL_D), TOK, 1024, 2816}; S.init(TOK, 1024, G, (int)blockIdx.x);
            pg8::EpiResidT<false> E{nullptr, XB, rs_next}; pg8::gemm_phase<pg8::EpiResidT<false>, pg8::StaticOrder>(lds, g, S, E); }
        END_PH();
    }
    if (IN_PH() && KEN(9)) { LAUNDER(); phase_final(p, tid, G); }
}
constexpr int N_PHASES = 18;
}

extern "C" void kernel_launch(void* const* d_in, const int* in_sizes, int n_in, void* d_out, int out_size, void* d_ws, size_t ws_size, hipStream_t stream) {
    static int grid = 0;
    if (grid == 0) {
        if (n_in != 28 || out_size != mk::TOK * mk::DM || ws_size < mk::WS_END) { fprintf(stderr, "kernel_launch: unexpected shapes (n_in %d out %d ws %zu need %zu)\n", n_in, out_size, ws_size, (size_t)mk::WS_END); grid = -1; return; }
        int dev = 0, cus = 0, per_cu = 0;
        hipGetDevice(&dev); hipDeviceGetAttribute(&cus, hipDeviceAttributeMultiprocessorCount, dev);
        if (hipFuncSetAttribute((const void*)mk::mega, hipFuncAttributeMaxDynamicSharedMemorySize, mk::LDS_BYTES) != hipSuccess) { fprintf(stderr, "kernel_launch: hipFuncSetAttribute failed\n"); grid = -1; return; }
        if (hipOccupancyMaxActiveBlocksPerMultiprocessor(&per_cu, (const void*)mk::mega, mk::NTHR, mk::LDS_BYTES) != hipSuccess || per_cu < 1) { fprintf(stderr, "kernel_launch: occupancy query says %d\n", per_cu); per_cu = 1; }
        (void)hipGetLastError();
        grid = cus * 1;
        if (grid <= 0) grid = 256;
    }
    if (grid < 0) return;
    mk::Params p{};
    for (int i = 0; i < 28; ++i) p.in[i] = (const float*)d_in[i];
    p.out = (float*)d_out; p.ws = (unsigned char*)d_ws;
#if ONE_LAUNCH
    if (hipMemsetAsync((unsigned char*)d_ws + mk::WS_BAR, 0, XCD_BAR_WORDS * sizeof(unsigned), stream) != hipSuccess) { fprintf(stderr, "kernel_launch: memset failed\n"); return; }
    p.ph_lo = 0; p.ph_hi = mk::N_PHASES;
    void* args[] = {&p};
    hipError_t e = hipLaunchCooperativeKernel((const void*)mk::mega, dim3(grid), dim3(mk::NTHR), args, mk::LDS_BYTES, stream);
    if (e != hipSuccess) fprintf(stderr, "cooperative launch failed: %s (grid %d)\n", hipGetErrorString(e), grid);
#else
    for (int ph = 0; ph < mk::N_PHASES; ++ph) { p.ph_lo = ph; p.ph_hi = ph + 1;
        hipLaunchKernelGGL(mk::mega, dim3(grid), dim3(mk::NTHR), mk::LDS_BYTES, stream, p); }
#endif
}
```

```cpp
#include <hip/hip_runtime.h>
#include <hip/hip_cooperative_groups.h>
#include <cstdio>
#include <cstdint>
#ifndef ONE_LAUNCH
#define ONE_LAUNCH 1
#endif
namespace cg = cooperative_groups;
typedef __bf16 mk_bf16x2_t __attribute__((ext_vector_type(2)));
typedef float mk_f32x2_t __attribute__((ext_vector_type(2)));
__device__ __forceinline__ unsigned mk_pk2(float lo, float hi) { mk_f32x2_t v = {lo, hi}; mk_bf16x2_t b = __builtin_convertvector(v, mk_bf16x2_t); return __builtin_bit_cast(unsigned, b); }
__device__ __forceinline__ float mk_lo(unsigned w) { return __uint_as_float(w << 16); }
__device__ __forceinline__ float mk_hi(unsigned w) { return __uint_as_float(w & 0xffff0000u); }
__device__ __forceinline__ float mk_sigm(float x) { return __builtin_amdgcn_rcpf(1.0f + __expf(-x)); }
__device__ __forceinline__ float mk_gelu(float x) { const float u = 1.5957691216f * (x + 0.044715f * x * x * x); return x * __builtin_amdgcn_rcpf(1.0f + __expf(-u)); }
namespace pg8 {
#define PG8_LAS __attribute__((address_space(3)))
typedef unsigned short bf16_t;
typedef short bf16x8 __attribute__((ext_vector_type(8)));
typedef float f32x4 __attribute__((ext_vector_type(4)));
typedef unsigned u32x4 __attribute__((ext_vector_type(4)));
constexpr int BM = 256, BK = 64, HALF = 128, HTB = HALF * BK * 2  , STAGE_BYTES = 8 * HTB, NXCD = 8, WGM = 8;

__host__ __device__ __forceinline__ int lds_byte(int r, int c) { const int st = (r >> 4) * 2 + (c >> 5), rr = r & 15, cc = c & 31, ob = rr * 64 + cc * 2; return st * 1024 + (ob ^ (((ob >> 9) & 1) << 5)); }
__host__ __device__ __forceinline__ void stage_rc(int b, int& R, int& C) { const int st = b / 1024, sb = b % 1024, swz = sb ^ (((sb >> 9) & 1) << 5); R = (st >> 1) * 16 + swz / 64; C = (st & 1) * 32 + (swz % 64) / 2; }
__host__ __device__ __forceinline__ int perm32(int rho) { const int n = rho >> 4, i = rho & 15; return 8 * (i >> 2) + 4 * n + (i & 3); }

struct Unit { int pm, pn; };
struct Gemm { const bf16_t* A; const bf16_t* Bt; int M, N, K; };

struct StaticOrder {
    int nM, nN, nwg, G, c;
    __host__ __device__ void init(int M, int N, int G_, int c_) { nM = M / BM; nN = N / BM; nwg = nM * nN; G = G_; c = c_; }
    __host__ __device__ bool next(int i, Unit& u) const {
        const long L = (long)i * G + c; if (L >= nwg) return false;
        int wgid = (int)L; { const int q = nwg / NXCD, r = nwg % NXCD, xcd = wgid % NXCD, off = wgid / NXCD; wgid = (xcd < r ? xcd * (q + 1) : r * (q + 1) + (xcd - r) * q) + off; }
        const int nig = WGM * nN, gid = wgid / nig, fm = gid * WGM, gsz = (nM - fm) < WGM ? (nM - fm) : WGM;
        u.pm = fm + ((wgid % nig) % gsz); u.pn = (wgid % nig) / gsz; return true;
    }
    __device__ __forceinline__ void a_ready(const Unit&) const {}
    __device__ __forceinline__ void done(const Unit&) const {}
};
typedef unsigned u32x2 __attribute__((ext_vector_type(2)));
constexpr int MK_TOK = 32768;
#define MK_EPI_LOOP_AM _Pragma("unroll") for (int ai = 0; ai < 2; ++ai) _Pragma("unroll") for (int m = 0; m < 4; ++m)
__device__ __forceinline__ u32x4 pack8(const f32x4 a, const f32x4 b) { u32x4 w; w.x = mk_pk2(a[0], a[1]); w.y = mk_pk2(a[2], a[3]); w.z = mk_pk2(b[0], b[1]); w.w = mk_pk2(b[2], b[3]); return w; }
__device__ __forceinline__ void unpack8(const u32x4 w, f32x4& a, f32x4& b) { a = (f32x4){mk_lo(w.x), mk_hi(w.x), mk_lo(w.y), mk_hi(w.y)}; b = (f32x4){mk_lo(w.z), mk_hi(w.z), mk_lo(w.w), mk_hi(w.w)}; }
__device__ __forceinline__ float rstd_of(float ss) { return rsqrtf(ss * (1.0f / 1024.0f) + 1e-6f); }
typedef unsigned long long rowss_t;
__device__ __forceinline__ float rstd_row(const rowss_t* rowss, int row) { return rstd_of((float)rowss[row] * (1.0f / 4294967296.0f)); }

struct EpiProj { static constexpr bool PERM = true, AFTER_DRAIN = false; bf16_t* P; const rowss_t* rowss;
    __device__ __forceinline__ void operator()(const f32x4 (&acc)[2][2][4][2], const Unit& u, int wr, int wc, int fr, int fq) const {
        const int row0 = u.pm * BM + wr * 64 + fr;
        bf16_t* base = P + (size_t)(u.pn >> 1) * ((size_t)MK_TOK * 512) + (u.pn & 1) * 256 + wc * 32 + 8 * fq;
        MK_EPI_LOOP_AM { const int row = row0 + ai * HALF + m * 16; const float rs = rstd_row(rowss, row); bf16_t* rp = base + (size_t)row * 512;
#pragma unroll
            for (int bj = 0; bj < 2; ++bj) *(u32x4*)(rp + bj * HALF) = pack8(acc[ai][bj][m][0] * rs, acc[ai][bj][m][1] * rs); }
    }
};
struct EpiVT { static constexpr bool PERM = true, AFTER_DRAIN = false; bf16_t* VT; const rowss_t* rowss;
    __device__ __forceinline__ void operator()(const f32x4 (&acc)[2][2][4][2], const Unit& u, int wr, int wc, int fr, int fq) const {
        const int row0 = u.pm * BM + wr * 64 + fr, col0 = u.pn * BM + wc * 32 + 8 * fq;
        f32x4 rs[2][2];
#pragma unroll
        for (int bj = 0; bj < 2; ++bj)
#pragma unroll
            for (int n = 0; n < 2; ++n) { const int c_ = col0 + bj * HALF + 4 * n; rs[bj][n] = (f32x4){rstd_row(rowss, c_), rstd_row(rowss, c_ + 1), rstd_row(rowss, c_ + 2), rstd_row(rowss, c_ + 3)}; }
        MK_EPI_LOOP_AM { const int row = row0 + ai * HALF + m * 16; bf16_t* rp = VT + (size_t)row * MK_TOK + col0;
#pragma unroll
            for (int bj = 0; bj < 2; ++bj) *(u32x4*)(rp + bj * HALF) = pack8(acc[ai][bj][m][0] * rs[bj][0], acc[ai][bj][m][1] * rs[bj][1]); }
    }
};
struct EpiGlu { static constexpr bool PERM = true, AFTER_DRAIN = false; const bf16_t* YG; bf16_t* O; const float* bias;
    __device__ __forceinline__ void operator()(const f32x4 (&acc)[2][2][4][2], const Unit& u, int wr, int wc, int fr, int fq) const {
        const int row0 = u.pm * BM + wr * 64 + fr, col0 = u.pn * BM + wc * 32 + 8 * fq;
        f32x4 bv[2][2];
#pragma unroll
        for (int bj = 0; bj < 2; ++bj)
#pragma unroll
            for (int n = 0; n < 2; ++n) bv[bj][n] = *(const f32x4*)(bias + col0 + bj * HALF + 4 * n);
        MK_EPI_LOOP_AM { const int row = row0 + ai * HALF + m * 16; const size_t off = (size_t)row * 512 + col0;
#pragma unroll
            for (int bj = 0; bj < 2; ++bj) { f32x4 y0, y1; unpack8(*(const u32x4*)(YG + off + bj * HALF), y0, y1);
                f32x4 a0 = acc[ai][bj][m][0] + bv[bj][0], a1 = acc[ai][bj][m][1] + bv[bj][1];
#pragma unroll
                for (int j = 0; j < 4; ++j) { y0[j] *= mk_sigm(a0[j]); y1[j] *= mk_sigm(a1[j]); }
                *(u32x4*)(O + off + bj * HALF) = pack8(y0, y1); } }
    }
};
__device__ __forceinline__ unsigned gate_q4(const f32x4 g) { return (unsigned)(g[0] * 255.0f + 0.5f) | ((unsigned)(g[1] * 255.0f + 0.5f) << 8) | ((unsigned)(g[2] * 255.0f + 0.5f) << 16) | ((unsigned)(g[3] * 255.0f + 0.5f) << 24); }
__device__ __forceinline__ f32x4 gate_dq4(unsigned w) { return (f32x4){(float)(w & 255u), (float)((w >> 8) & 255u), (float)((w >> 16) & 255u), (float)(w >> 24)} * (1.0f / 255.0f); }
struct EpiGate { static constexpr bool PERM = true, AFTER_DRAIN = false; unsigned char* GS; const rowss_t* rowss;
    __device__ __forceinline__ void operator()(const f32x4 (&acc)[2][2][4][2], const Unit& u, int wr, int wc, int fr, int fq) const {
        const int row0 = u.pm * BM + wr * 64 + fr, col0 = u.pn * BM + wc * 32 + 8 * fq;
        MK_EPI_LOOP_AM { const int row = row0 + ai * HALF + m * 16; const float rs = rstd_row(rowss, row); const size_t off = (size_t)row * 1024 + col0;
#pragma unroll
            for (int bj = 0; bj < 2; ++bj) { f32x4 a0 = acc[ai][bj][m][0] * rs, a1 = acc[ai][bj][m][1] * rs;
#pragma unroll
                for (int j = 0; j < 4; ++j) { a0[j] = mk_sigm(a0[j]); a1[j] = mk_sigm(a1[j]); }
                u32x2 w; w.x = gate_q4(a0); w.y = gate_q4(a1); *(u32x2*)(GS + off + bj * HALF) = w; } }
    }
};
template <bool FIRST> struct EpiBr { static constexpr bool PERM = true, AFTER_DRAIN = false; const unsigned char* GS; bf16_t* MG;
    __device__ __forceinline__ void operator()(const f32x4 (&acc)[2][2][4][2], const Unit& u, int wr, int wc, int fr, int fq) const {
        const int row0 = u.pm * BM + wr * 64 + fr, col0 = u.pn * BM + wc * 32 + 8 * fq;
        MK_EPI_LOOP_AM { const int row = row0 + ai * HALF + m * 16; const size_t off = (size_t)row * 1024 + col0;
#pragma unroll
            for (int bj = 0; bj < 2; ++bj) { const u32x2 gw = *(const u32x2*)(GS + off + bj * HALF);
                f32x4 v0 = gate_dq4(gw.x) * acc[ai][bj][m][0], v1 = gate_dq4(gw.y) * acc[ai][bj][m][1];
                if (!FIRST) { f32x4 p0, p1; unpack8(*(const u32x4*)(MG + off + bj * HALF), p0, p1); v0 += p0; v1 += p1; }
                *(u32x4*)(MG + off + bj * HALF) = pack8(v0, v1); } }
    }
};
template <bool F32IN> struct EpiResidT { static constexpr bool PERM = false, AFTER_DRAIN = false; const float* xin; bf16_t* xb; rowss_t* rowss_next;
    __device__ __forceinline__ void operator()(const f32x4 (&acc)[2][2][4][2], const Unit& u, int wr, int wc, int fr, int fq) const {
        const int row0 = u.pm * BM + wr * 64 + fr, col0 = u.pn * BM + wc * 32 + 4 * fq;
        MK_EPI_LOOP_AM { const int row = row0 + ai * HALF + m * 16; const size_t off = (size_t)row * 1024 + col0; float ss = 0.f;
#pragma unroll
            for (int bj = 0; bj < 2; ++bj)
#pragma unroll
                for (int n = 0; n < 2; ++n) { const size_t o = off + bj * HALF + n * 16; f32x4 xo;
                    if (F32IN) xo = *(const f32x4*)(xin + o); else { const u32x2 w0 = *(const u32x2*)(xb + o); xo = (f32x4){mk_lo(w0.x), mk_hi(w0.x), mk_lo(w0.y), mk_hi(w0.y)}; }
                    const f32x4 xn = xo + acc[ai][bj][m][n];
                    u32x2 w; w.x = mk_pk2(xn[0], xn[1]); w.y = mk_pk2(xn[2], xn[3]); *(u32x2*)(xb + o) = w;
                    ss += (xn[0] * xn[0] + xn[1] * xn[1]) + (xn[2] * xn[2] + xn[3] * xn[3]); }
            ss += __shfl_xor(ss, 16); ss += __shfl_xor(ss, 32);
            if (fq == 0) __hip_atomic_fetch_add(rowss_next + row, (rowss_t)(ss * 4294967296.0f), __ATOMIC_RELAXED, __HIP_MEMORY_SCOPE_AGENT); }
    }
};
struct EpiFfnUp { static constexpr bool PERM = true, AFTER_DRAIN = false; bf16_t* H; const rowss_t* rowss;
    __device__ __forceinline__ void operator()(const f32x4 (&acc)[2][2][4][2], const Unit& u, int wr, int wc, int fr, int fq) const {
        const int row0 = u.pm * BM + wr * 64 + fr, col0 = u.pn * HALF + wc * 32 + 8 * fq;
        MK_EPI_LOOP_AM { const int row = row0 + ai * HALF + m * 16; const float rs = rstd_row(rowss, row);
            f32x4 g0 = acc[ai][0][m][0] * rs, g1 = acc[ai][0][m][1] * rs, u0 = acc[ai][1][m][0] * rs, u1 = acc[ai][1][m][1] * rs;
#pragma unroll
            for (int j = 0; j < 4; ++j) { g0[j] = g0[j] * mk_sigm(g0[j]) * u0[j]; g1[j] = g1[j] * mk_sigm(g1[j]) * u1[j]; }
            *(u32x4*)(H + (size_t)row * 2816 + col0) = pack8(g0, g1); }
    }
};
template <class Epi, class Sched, bool ALIGN_EPI = true, bool SP2 = true>
__device__ __forceinline__ void gemm_phase(PG8_LAS unsigned char* lds, const Gemm g, const Sched& S, const Epi& E) {
    int tid_l = threadIdx.x; asm volatile("" : "+v"(tid_l)); const int tid = tid_l, wid = __builtin_amdgcn_readfirstlane(tid >> 6), lane = tid & 63, wr = wid >> 2, wc = wid & 3, fr = lane & 15, fq = lane >> 4;
    const int K = g.K, nt = K / BK;
    unsigned voffA[2], voffB[2];
#pragma unroll
    for (int i = 0; i < 2; ++i) { int R, C; stage_rc(tid * 16 + i * 8192, R, C); const int Rb = Epi::PERM ? ((R & ~31) + perm32(R & 31)) : R;
        voffA[i] = (unsigned)(R * K + C) * 2u; voffB[i] = (unsigned)(Rb * K + C) * 2u; }
    const size_t kstep = (size_t)(BK * 2);
    const size_t hstep = (size_t)HALF * K * 2;
    const size_t tstep = 2 * hstep;
    const unsigned ldsw = (unsigned)wid * 1024u;
    const int aoff = lds_byte(wr * 64 + fr, fq * 8), boff = lds_byte(wc * 32 + fr, fq * 8);
#define PG8_SA(b, h) (((b) * 2 + (h)) * HTB)
#define PG8_SB(b, h) ((4 + (b) * 2 + (h)) * HTB)
#define PG8_STAGE(bufoff, gbase, voff) do { _Pragma("unroll") for (int _i = 0; _i < 2; ++_i) \
        __builtin_amdgcn_global_load_lds((const unsigned*)((const char*)(gbase) + (voff)[_i]), (PG8_LAS unsigned*)(lds + (bufoff) + ldsw + _i * 8192), 16, 0, 0); } while (0)
#define PG8_LDA(dst, b, h) do { _Pragma("unroll") for (int m = 0; m < 4; ++m) _Pragma("unroll") for (int k = 0; k < 2; ++k) dst[m][k] = *(const PG8_LAS bf16x8*)(lds + PG8_SA(b, h) + aoff + m * 2048 + k * 1024); } while (0)
#define PG8_LDB(dst, b, h) do { _Pragma("unroll") for (int n = 0; n < 2; ++n) _Pragma("unroll") for (int k = 0; k < 2; ++k) dst[n][k] = *(const PG8_LAS bf16x8*)(lds + PG8_SB(b, h) + boff + n * 2048 + k * 1024); } while (0)
#define PG8_MMA(ai, bj, At, Bt) do { __builtin_amdgcn_s_setprio(1); _Pragma("unroll") for (int m = 0; m < 4; ++m) _Pragma("unroll") for (int n = 0; n < 2; ++n) _Pragma("unroll") for (int k = 0; k < 2; ++k) \
        acc[ai][bj][m][n] = __builtin_amdgcn_mfma_f32_16x16x32_bf16(Bt[n][k], At[m][k], acc[ai][bj][m][n], 0, 0, 0); __builtin_amdgcn_s_setprio(0); } while (0)
#define PG8_WAIT_V(n) asm volatile("s_waitcnt vmcnt(" #n ")" ::: "memory")
#define PG8_WAIT_L(n) asm volatile("s_waitcnt lgkmcnt(" #n ")" ::: "memory")
#define PG8_BAR __builtin_amdgcn_s_barrier()
#define PG8_SCHED __builtin_amdgcn_sched_barrier(0)
    Unit cur, nxt; int ui = 0;
    if (!S.next(0, cur)) return;
    f32x4 acc[2][2][4][2];
#pragma unroll
    for (int a = 0; a < 2; ++a)
#pragma unroll
        for (int b = 0; b < 2; ++b)
#pragma unroll
            for (int m = 0; m < 4; ++m)
#pragma unroll
                for (int n = 0; n < 2; ++n) acc[a][b][m][n] = (f32x4){0.f, 0.f, 0.f, 0.f};
    bf16x8 At[4][2], B0[2][2], B1[2][2];
    const char* cA = (const char*)g.A + (size_t)cur.pm * tstep; const char* cB = (const char*)g.Bt + (size_t)cur.pn * tstep;
    S.a_ready(cur);
    if constexpr (SP2) {
        PG8_STAGE(PG8_SB(0, 0), cB, voffB); PG8_STAGE(PG8_SB(0, 1), cB + hstep, voffB); PG8_STAGE(PG8_SA(0, 0), cA, voffA); PG8_STAGE(PG8_SA(0, 1), cA + hstep, voffA);
        if (wr == 1) PG8_BAR;
        PG8_WAIT_V(2); PG8_BAR;
        PG8_STAGE(PG8_SB(1, 0), cB + kstep, voffB); PG8_STAGE(PG8_SA(1, 0), cA + kstep, voffA); PG8_STAGE(PG8_SB(1, 1), cB + hstep + kstep, voffB);
        PG8_WAIT_V(6); PG8_BAR;
    } else {
        PG8_STAGE(PG8_SB(0, 0), cB, voffB); PG8_STAGE(PG8_SA(0, 0), cA, voffA); PG8_STAGE(PG8_SB(0, 1), cB + hstep, voffB); PG8_STAGE(PG8_SA(0, 1), cA + hstep, voffA);
        if (wr == 1) PG8_BAR;
        PG8_WAIT_V(4); PG8_BAR;
        PG8_STAGE(PG8_SB(1, 0), cB + kstep, voffB); PG8_STAGE(PG8_SA(1, 0), cA + kstep, voffA); PG8_STAGE(PG8_SB(1, 1), cB + hstep + kstep, voffB);
        PG8_WAIT_V(6); PG8_BAR;
    }
    for (;;) {
        const bool has_next = S.next(ui + 1, nxt);
        const char* nA = has_next ? (const char*)g.A + (size_t)nxt.pm * tstep : cA; const char* nB = has_next ? (const char*)g.Bt + (size_t)nxt.pn * tstep : cB;
        for (int t = 0; t < nt; t += 2) {
            const bool last = (t == nt - 2);
            const char* a1 = cA + (size_t)(t + 1) * kstep;
            const char* a2 = last ? nA : cA + (size_t)(t + 2) * kstep; const char* b2 = last ? nB : cB + (size_t)(t + 2) * kstep;
            const char* a3 = a2 + kstep; const char* b3 = b2 + kstep;
            if (last && has_next) S.a_ready(nxt);
            if constexpr (SP2) {
            PG8_LDB(B0, 0, 0); PG8_LDB(B1, 0, 1); PG8_SCHED; PG8_LDA(At, 0, 0); PG8_STAGE(PG8_SA(1, 1), a1 + hstep, voffA);
            PG8_WAIT_V(8); PG8_WAIT_L(0); PG8_BAR; PG8_MMA(0, 0, At, B0); PG8_MMA(0, 1, At, B1); PG8_BAR; PG8_SCHED;
            PG8_LDA(At, 0, 1); PG8_STAGE(PG8_SB(0, 0), b2, voffB); PG8_STAGE(PG8_SB(0, 1), b2 + hstep, voffB); PG8_STAGE(PG8_SA(0, 0), a2, voffA);
            PG8_WAIT_V(8); PG8_WAIT_L(0); PG8_BAR; PG8_MMA(1, 0, At, B0); PG8_MMA(1, 1, At, B1); PG8_BAR; PG8_SCHED;
            PG8_LDB(B0, 1, 0); PG8_LDB(B1, 1, 1); PG8_SCHED; PG8_LDA(At, 1, 0); PG8_STAGE(PG8_SA(0, 1), a2 + hstep, voffA);
            PG8_WAIT_V(8); PG8_WAIT_L(0); PG8_BAR; PG8_MMA(0, 0, At, B0); PG8_MMA(0, 1, At, B1); PG8_BAR; PG8_SCHED;
            PG8_LDA(At, 1, 1); PG8_STAGE(PG8_SB(1, 0), b3, voffB); PG8_STAGE(PG8_SB(1, 1), b3 + hstep, voffB); PG8_STAGE(PG8_SA(1, 0), a3, voffA);
            PG8_WAIT_V(8); PG8_WAIT_L(0); PG8_BAR; PG8_MMA(1, 0, At, B0); PG8_MMA(1, 1, At, B1); PG8_BAR; PG8_SCHED;
            } else {
            PG8_LDB(B0, 0, 0); PG8_SCHED; PG8_LDA(At, 0, 0); PG8_STAGE(PG8_SA(1, 1), a1 + hstep, voffA);
            PG8_WAIT_L(8); PG8_BAR; PG8_WAIT_L(0); PG8_MMA(0, 0, At, B0); PG8_BAR; PG8_SCHED;
            PG8_LDB(B1, 0, 1); PG8_STAGE(PG8_SB(0, 0), b2, voffB);
            PG8_BAR; PG8_WAIT_L(0); PG8_MMA(0, 1, At, B1); PG8_BAR;
            PG8_LDA(At, 0, 1); PG8_STAGE(PG8_SA(0, 0), a2, voffA);
            PG8_BAR; PG8_WAIT_L(0); PG8_MMA(1, 0, At, B0); PG8_BAR; PG8_SCHED;
            PG8_STAGE(PG8_SB(0, 1), b2 + hstep, voffB);
            PG8_WAIT_V(6); PG8_BAR; PG8_MMA(1, 1, At, B1); PG8_BAR;
            PG8_LDB(B0, 1, 0); PG8_SCHED; PG8_LDA(At, 1, 0); PG8_STAGE(PG8_SA(0, 1), a2 + hstep, voffA);
            PG8_WAIT_L(8); PG8_BAR; PG8_WAIT_L(0); PG8_MMA(0, 0, At, B0); PG8_BAR; PG8_SCHED;
            PG8_LDB(B1, 1, 1); PG8_STAGE(PG8_SB(1, 0), b3, voffB);
            PG8_BAR; PG8_WAIT_L(0); PG8_MMA(0, 1, At, B1); PG8_BAR;
            PG8_LDA(At, 1, 1); PG8_STAGE(PG8_SA(1, 0), a3, voffA);
            PG8_BAR; PG8_WAIT_L(0); PG8_MMA(1, 0, At, B0); PG8_BAR; PG8_SCHED;
            PG8_STAGE(PG8_SB(1, 1), b3 + hstep, voffB);
            PG8_WAIT_V(6); PG8_BAR; PG8_MMA(1, 1, At, B1); PG8_BAR;
            }
        }
        if constexpr (ALIGN_EPI) { if (wr == 0) PG8_BAR; }
        if constexpr (!Epi::AFTER_DRAIN) { E(acc, cur, wr, wc, fr, fq); S.done(cur); }
        if (!has_next) break;
#pragma unroll
        for (int a = 0; a < 2; ++a)
#pragma unroll
            for (int b = 0; b < 2; ++b)
#pragma unroll
                for (int m = 0; m < 4; ++m)
#pragma unroll
                    for (int n = 0; n < 2; ++n) acc[a][b][m][n] = (f32x4){0.f, 0.f, 0.f, 0.f};
        cur = nxt; cA = nA; cB = nB; ++ui;
        if constexpr (ALIGN_EPI) { if (wr == 1) PG8_BAR; }
    }
    PG8_WAIT_V(0);
    if constexpr (!ALIGN_EPI) { if (wr == 0) PG8_BAR; }
    PG8_BAR;
    if constexpr (Epi::AFTER_DRAIN) { E.fused(acc, cur, wr, wc, fr, fq, lds, wid, lane); S.done(cur); }
#undef PG8_SA
#undef PG8_SB
#undef PG8_STAGE
#undef PG8_LDA
#undef PG8_LDB
#undef PG8_MMA
#undef PG8_WAIT_V
#undef PG8_WAIT_L
#undef PG8_BAR
#undef PG8_SCHED
}
}

namespace mk {
#define LAS __attribute__((address_space(3)))
#define DI __device__ __forceinline__
typedef unsigned short bf16;
typedef pg8::bf16x8 bf16x8; typedef pg8::f32x4 f32x4; typedef pg8::u32x4 u32x4; typedef pg8::u32x2 u32x2;
typedef float f32x16 __attribute__((ext_vector_type(16)));
constexpr int TOK = 32768, DM = 1024, SEQ = 4096, BW = 512, FFH = 2816, NTHR = 512;
constexpr size_t MiB = 1024 * 1024;
constexpr size_t WS_ROWSS = 474 * MiB;
constexpr size_t WS_BAR = 768 * 1024;
constexpr size_t WS_BB = 1 * MiB;
constexpr size_t WS_CM = WS_BB + 262144;
constexpr size_t WS_AP = WS_CM + 262144;
constexpr size_t WS_SGW = WS_AP + 131072;
constexpr size_t WS_E = 2 * MiB;
constexpr size_t WS_W = 10 * MiB;
constexpr size_t WL_IN = 0, WL_GLU = 17825792, WL_BR = WL_GLU + 524288, WL_O = WL_BR + 4194304, WL_FF = WL_O + 2097152, WL_D = WL_FF + 11534336, WL_SIZE = WL_D + 5767168;
static_assert(WL_SIZE == 40 * MiB, "weights per layer");
constexpr size_t WS_XB = 90 * MiB;
constexpr size_t WS_P = 154 * MiB;
constexpr size_t PBUF = 32 * MiB;
constexpr size_t WS_YG = WS_P + 9 * PBUF;
constexpr size_t WS_END = WS_YG + 32 * MiB + 2 * MiB;
constexpr int LDS_BYTES = 143360;

DI float bf2f(bf16 v) { return __uint_as_float(((unsigned)v) << 16); }
DI bf16 f2bf(float f) { return (bf16)(mk_pk2(f, 0.f) & 0xffffu); }
DI float wave_sum(float v) {
#pragma unroll
    for (int o = 1; o < 64; o <<= 1) v += __shfl_xor(v, o);
    return v; }
DI f32x16 mfma32(bf16x8 a, bf16x8 b, f32x16 c) { return __builtin_amdgcn_mfma_f32_32x32x16_bf16(a, b, c, 0, 0, 0); }
DI f32x4 mfma16(bf16x8 a, bf16x8 b, f32x4 c) { return __builtin_amdgcn_mfma_f32_16x16x32_bf16(a, b, c, 0, 0, 0); }
DI int crow(int i, int h) { return (i & 3) + 8 * (i >> 2) + 4 * h; }
DI f32x16 zero16() { f32x16 z;
#pragma unroll
    for (int i = 0; i < 16; ++i) z[i] = 0.f;
    return z; }
#define LDS_WAIT() asm volatile("s_waitcnt lgkmcnt(0)" ::: "memory")

struct Params { const float* in[28]; float* out; unsigned char* ws; int ph_lo, ph_hi; };
enum { I_X = 0, I_GMIX, I_WIN, I_CONVW, I_CONVB, I_SGW, I_SGB, I_LNG, I_LNB, I_LAMQK, I_SUBLN, I_ARE, I_AIM, I_LOGDT, I_BRE, I_BIM, I_CRE, I_CIM, I_SSMD, I_WGLU, I_BGLU, I_WBR, I_WO, I_GFFN, I_WFG, I_WFU, I_WFD, I_GFIN };

DI void tr_item(const float* W, int ldn, int k0, int n0, const float* gs, bf16* WT, int ldk, int drow0, LAS float* scr, int lane) {
    float tv[32];
#pragma unroll
    for (int i = 0; i < 32; ++i) { const int kk = 2 * i + (lane >> 5); tv[i] = W[(size_t)(k0 + kk) * ldn + n0 + (lane & 31)]; }
    if (gs) {
#pragma unroll
        for (int i = 0; i < 32; ++i) tv[i] *= gs[k0 + 2 * i + (lane >> 5)]; }
#pragma unroll
    for (int i = 0; i < 32; ++i) scr[(2 * i + (lane >> 5)) * 33 + (lane & 31)] = tv[i];
    LDS_WAIT();
    const int c = lane & 7;
#pragma unroll
    for (int j = 0; j < 4; ++j) { const int n = (lane >> 3) + 8 * j; const LAS float* s = scr + (8 * c) * 33 + n;
        u32x4 o; o.x = mk_pk2(s[0 * 33], s[1 * 33]); o.y = mk_pk2(s[2 * 33], s[3 * 33]); o.z = mk_pk2(s[4 * 33], s[5 * 33]); o.w = mk_pk2(s[6 * 33], s[7 * 33]);
        *(u32x4*)(WT + (size_t)(drow0 + n) * ldk + k0 + 8 * c) = o; }
    LDS_WAIT();
}
DI void dsincos(double x, double& s, double& c) {
    const double twopi = 6.283185307179586476925; const double k = rint(x / twopi); const double r = x - k * twopi, r2 = r * r;
    double ss = 1.0, cc = 1.0;
#pragma unroll
    for (int n = 13; n >= 1; --n) { ss = 1.0 - r2 * (1.0 / ((2.0 * n) * (2.0 * n + 1.0))) * ss; cc = 1.0 - r2 * (1.0 / ((2.0 * n - 1.0) * (2.0 * n))) * cc; }
    s = ss * r; c = cc;
}
DI void phase_prep(const Params& p, LAS unsigned char* lds, int tid, int lane, int wave, int G) {
    unsigned char* ws = p.ws;
    const int gw = blockIdx.x * 8 + wave, NGW = G * 8, gt = blockIdx.x * NTHR + tid, NGT = G * NTHR;
    LAS float* scr = (LAS float*)(lds + wave * 8704);
    for (int l = 0; l < 2; ++l) {
        unsigned char* wl = ws + WS_W + (size_t)l * WL_SIZE;
        for (int mi = 0; mi < 10; ++mi) {
            const float* src; int K, N; const float* gs = nullptr; bf16* dst; int map = 0;
            if (mi == 0) { src = p.in[I_WIN] + (size_t)l * 1024 * 8704; K = 1024; N = 8704; gs = p.in[I_GMIX] + l * 1024; dst = (bf16*)(wl + WL_IN); map = 1; }
            else if (mi == 1) { src = p.in[I_WGLU] + (size_t)l * 512 * 512; K = 512; N = 512; dst = (bf16*)(wl + WL_GLU); }
            else if (mi < 6) { const int b = mi - 2; src = p.in[I_WBR] + ((size_t)l * 4 + b) * 512 * 1024; K = 512; N = 1024; dst = (bf16*)(wl + WL_BR) + (size_t)b * 1024 * 512; }
            else if (mi == 6) { src = p.in[I_WO] + (size_t)l * 1024 * 1024; K = 1024; N = 1024; dst = (bf16*)(wl + WL_O); }
            else if (mi == 7) { src = p.in[I_WFG] + (size_t)l * 1024 * 2816; K = 1024; N = 2816; gs = p.in[I_GFFN] + l * 1024; dst = (bf16*)(wl + WL_FF); map = 2; }
            else if (mi == 8) { src = p.in[I_WFU] + (size_t)l * 1024 * 2816; K = 1024; N = 2816; gs = p.in[I_GFFN] + l * 1024; dst = (bf16*)(wl + WL_FF); map = 3; }
            else { src = p.in[I_WFD] + (size_t)l * 2816 * 1024; K = 2816; N = 1024; dst = (bf16*)(wl + WL_D); }
            const int nblk = N / 32, nit = (K / 64) * nblk;
            for (int it = gw; it < nit; it += NGW) {
                const int kb = it / nblk, nb = it % nblk, n0 = nb * 32; int dr = n0;
                if (map == 1) { if (n0 >= 3584 && n0 < 4096) dr = n0 + 512; else if (n0 >= 4096 && n0 < 4608) dr = n0 - 512; }
                else if (map == 2) dr = (n0 >> 7) * 256 + (n0 & 127);
                else if (map == 3) dr = (n0 >> 7) * 256 + 128 + (n0 & 127);
                tr_item(src, N, kb * 64, n0, gs, dst, K, dr, scr, lane);
            }
        }
    }
    { const float* x = p.in[I_X]; bf16* xb = (bf16*)(ws + WS_XB); pg8::rowss_t* rowss = (pg8::rowss_t*)(ws + WS_ROWSS);
        for (int row0 = gw * 4; row0 < TOK; row0 += NGW * 4) { f32x4 v[4][4];
#pragma unroll
            for (int q = 0; q < 4; ++q)
#pragma unroll
                for (int j = 0; j < 4; ++j) v[q][j] = *((const f32x4*)(x + (size_t)(row0 + q) * DM) + lane + 64 * j);
#pragma unroll
            for (int q = 0; q < 4; ++q) { float ss = 0.f;
#pragma unroll
                for (int j = 0; j < 4; ++j) { const f32x4 t = v[q][j]; ss += (t[0] * t[0] + t[1] * t[1]) + (t[2] * t[2] + t[3] * t[3]);
                    u32x2 w; w.x = mk_pk2(t[0], t[1]); w.y = mk_pk2(t[2], t[3]); *((u32x2*)(xb + (size_t)(row0 + q) * DM) + lane + 64 * j) = w; }
                ss = wave_sum(ss); if (lane == 0) rowss[row0 + q] = (pg8::rowss_t)(ss * 4294967296.0f); } }
        for (int i = gt; i < 4 * TOK; i += NGT) rowss[TOK + i] = 0ull; }
    { const float* sgw = p.in[I_SGW]; bf16* o = (bf16*)(ws + WS_SGW);
        for (int i = gt; i < 2 * 4 * 128 * 128; i += NGT) { const int s = i & 127, t = (i >> 7) & 127; o[i] = f2bf(s <= t ? sgw[i] : 0.f); } }
    for (int i = gt; i < 2 * 32 * 64; i += NGT) {
        const int pp = i & 63, lg = i >> 6;
        const double dt = exp((double)p.in[I_LOGDT][lg]); const double are = p.in[I_ARE][i], aim = p.in[I_AIM][i];
        const double mag = exp(dt * are); double sn, cs; dsincos(dt * aim, sn, cs);
        const double abr = mag * cs, abi = mag * sn, den = are * are + aim * aim, nr = abr - 1.0, ni = abi;
        const double cr = (nr * are + ni * aim) / den, ci = (ni * are - nr * aim) / den;
        bf16* bb = (bf16*)(ws + WS_BB) + (size_t)lg * 128 * 16; const float* bre = p.in[I_BRE] + (size_t)i * 16; const float* bim = p.in[I_BIM] + (size_t)i * 16;
        for (int h = 0; h < 16; ++h) { const double br = bre[h], bi = bim[h]; bb[pp * 16 + h] = f2bf((float)(cr * br - ci * bi)); bb[(64 + pp) * 16 + h] = f2bf((float)(cr * bi + ci * br)); }
        bf16* cm = (bf16*)(ws + WS_CM) + (size_t)lg * 16 * 128; const float* cre = p.in[I_CRE] + (size_t)lg * 16 * 64; const float* cim = p.in[I_CIM] + (size_t)lg * 16 * 64;
        for (int h = 0; h < 16; ++h) { cm[h * 128 + pp] = f2bf(cre[h * 64 + pp]); cm[h * 128 + 64 + pp] = f2bf(-cim[h * 64 + pp]); }
        double pr = abr, pi = abi; float* ap = (float*)(ws + WS_AP) + (size_t)i * 8; ap[0] = (float)pr; ap[1] = (float)pi;
        for (int q = 0; q < 5; ++q) { const double t = pr * pr - pi * pi; pi = 2.0 * pr * pi; pr = t; }
        ap[2] = (float)pr; ap[3] = (float)pi;
        { const double t = pr * pr - pi * pi; pi = 2.0 * pr * pi; pr = t; }
        ap[4] = (float)pr; ap[5] = (float)pi; ap[6] = 0.f; ap[7] = 0.f;
    }
}

DI void phase_branchA(const Params& p, int l, int tid, int G) {
    bf16* AB = (bf16*)(p.ws + WS_P); const bf16* AC = (const bf16*)(p.ws + WS_P + PBUF); const bf16* AX = (const bf16*)(p.ws + WS_P + 2 * PBUF);
    const float* cw = p.in[I_CONVW] + l * 3 * 512; const float* cb = p.in[I_CONVB] + l * 512;
    for (int idx = blockIdx.x * NTHR + tid; idx < (TOK / 16) * 64; idx += G * NTHR) {
        const int cgp = idx & 63, run = idx >> 6, c0 = cgp * 8, t0 = run * 16;
        f32x4 w0[2], w1[2], w2[2], bb[2];
#pragma unroll
        for (int e = 0; e < 2; ++e) { w0[e] = *(const f32x4*)(cw + c0 + 4 * e); w1[e] = *(const f32x4*)(cw + 512 + c0 + 4 * e); w2[e] = *(const f32x4*)(cw + 1024 + c0 + 4 * e); bb[e] = *(const f32x4*)(cb + c0 + 4 * e); }
        f32x4 zm2[2] = {{0.f, 0.f, 0.f, 0.f}, {0.f, 0.f, 0.f, 0.f}}, zm1[2] = {{0.f, 0.f, 0.f, 0.f}, {0.f, 0.f, 0.f, 0.f}};
        if ((t0 & (SEQ - 1)) != 0) {
            f32x4 a0, a1, x0, x1;
            pg8::unpack8(*(const u32x4*)(AC + (size_t)(t0 - 2) * 512 + c0), a0, a1); pg8::unpack8(*(const u32x4*)(AX + (size_t)(t0 - 2) * 512 + c0), x0, x1); zm2[0] = a0 * x0; zm2[1] = a1 * x1;
            pg8::unpack8(*(const u32x4*)(AC + (size_t)(t0 - 1) * 512 + c0), a0, a1); pg8::unpack8(*(const u32x4*)(AX + (size_t)(t0 - 1) * 512 + c0), x0, x1); zm1[0] = a0 * x0; zm1[1] = a1 * x1;
        }
#pragma unroll 4
        for (int i = 0; i < 16; ++i) { const size_t off = (size_t)(t0 + i) * 512 + c0;
            f32x4 a0, a1, x0, x1, b0, b1; pg8::unpack8(*(const u32x4*)(AC + off), a0, a1); pg8::unpack8(*(const u32x4*)(AX + off), x0, x1); pg8::unpack8(*(const u32x4*)(AB + off), b0, b1);
            const f32x4 z0 = a0 * x0, z1 = a1 * x1;
            const f32x4 y0 = b0 * (w0[0] * zm2[0] + w1[0] * zm1[0] + w2[0] * z0 + bb[0]), y1 = b1 * (w0[1] * zm2[1] + w1[1] * zm1[1] + w2[1] * z1 + bb[1]);
            *(u32x4*)(AB + off) = pg8::pack8(y0, y1);
            zm2[0] = zm1[0]; zm2[1] = zm1[1]; zm1[0] = z0; zm1[1] = z1; }
    }
}

DI void phase_branchB(const Params& p, int l, LAS unsigned char* lds, int tid, int lane, int wave, int G) {
    bf16* BU = (bf16*)(p.ws + WS_P + 3 * PBUF); const bf16* BV = (const bf16*)(p.ws + WS_P + 4 * PBUF);
    const bf16* SGW = (const bf16*)(p.ws + WS_SGW) + (size_t)l * 4 * 128 * 128; const float* sgb = p.in[I_SGB] + l * 4 * 128;
    const float* lng = p.in[I_LNG] + l * 512 + lane * 8; const float* lnb = p.in[I_LNB] + l * 512 + lane * 8;
    constexpr int RS = 1040;
    const int r = lane & 31, half = lane >> 5;
    for (int item = blockIdx.x; item < TOK / 128; item += G) {
        const int tok0 = item * 128;
        { const f32x4 g0 = *(const f32x4*)lng, g1 = *(const f32x4*)(lng + 4), b0 = *(const f32x4*)lnb, b1 = *(const f32x4*)(lnb + 4);
            for (int tt = 0; tt < 16; ++tt) { const int s = wave * 16 + tt;
                f32x4 v0, v1; pg8::unpack8(*(const u32x4*)(BV + (size_t)(tok0 + s) * 512 + lane * 8), v0, v1);
#pragma unroll
                for (int j = 0; j < 4; ++j) { v0[j] = mk_gelu(v0[j]); v1[j] = mk_gelu(v1[j]); }
                const float mean = wave_sum((v0[0] + v0[1]) + (v0[2] + v0[3]) + (v1[0] + v1[1]) + (v1[2] + v1[3])) * (1.0f / 512.0f);
                v0 = v0 - mean; v1 = v1 - mean;
                const float var = wave_sum((v0[0] * v0[0] + v0[1] * v0[1]) + (v0[2] * v0[2] + v0[3] * v0[3]) + (v1[0] * v1[0] + v1[1] * v1[1]) + (v1[2] * v1[2] + v1[3] * v1[3])) * (1.0f / 512.0f);
                const float rstd = rsqrtf(var + 1e-5f);
                v0 = v0 * rstd * g0 + b0; v1 = v1 * rstd * g1 + b1;
                *(LAS u32x4*)(lds + s * RS + lane * 16) = pg8::pack8(v0, v1); } }
        __syncthreads();
        const int g = wave >> 1, dh = wave & 1;
        f32x16 acc[4][2];
#pragma unroll
        for (int a = 0; a < 4; ++a) { acc[a][0] = zero16(); acc[a][1] = zero16(); }
#pragma unroll
        for (int ks = 0; ks < 8; ++ks) {
            bf16x8 Vf[2];
#pragma unroll
            for (int dt = 0; dt < 2; ++dt) { const LAS unsigned short* vp = (const LAS unsigned short*)(lds + (16 * ks + 8 * half) * RS + (g * 128 + dh * 64 + dt * 32 + r) * 2);
#pragma unroll
                for (int j = 0; j < 8; ++j) Vf[dt][j] = (short)vp[j * (RS / 2)]; }
#pragma unroll
            for (int tt = ks >> 1; tt < 4; ++tt) { const bf16x8 Wf = *(const bf16x8*)(SGW + ((size_t)g * 128 + 32 * tt + r) * 128 + 16 * ks + 8 * half);
                acc[tt][0] = mfma32(Vf[0], Wf, acc[tt][0]); acc[tt][1] = mfma32(Vf[1], Wf, acc[tt][1]); }
        }
        asm volatile("s_nop 15\n\ts_nop 7" : "+v"(acc[0][0]), "+v"(acc[0][1]), "+v"(acc[1][0]), "+v"(acc[1][1]), "+v"(acc[2][0]), "+v"(acc[2][1]), "+v"(acc[3][0]), "+v"(acc[3][1]));
#pragma unroll
        for (int tt = 0; tt < 4; ++tt) { const int t = 32 * tt + r; const float bias = sgb[g * 128 + t];
#pragma unroll
            for (int dt = 0; dt < 2; ++dt)
#pragma unroll
                for (int ig = 0; ig < 4; ++ig) { bf16* up = BU + (size_t)(tok0 + t) * 512 + g * 128 + dh * 64 + dt * 32 + 8 * ig + 4 * half;
                    const u32x2 uw = *(const u32x2*)up;
                    const float y0 = mk_gelu(mk_lo(uw.x)) * (acc[tt][dt][4 * ig + 0] + bias), y1 = mk_gelu(mk_hi(uw.x)) * (acc[tt][dt][4 * ig + 1] + bias);
                    const float y2 = mk_gelu(mk_lo(uw.y)) * (acc[tt][dt][4 * ig + 2] + bias), y3 = mk_gelu(mk_hi(uw.y)) * (acc[tt][dt][4 * ig + 3] + bias);
                    u32x2 o; o.x = mk_pk2(y0, y1); o.y = mk_pk2(y2, y3); *(u32x2*)up = o; } }
        __syncthreads();
    }
}

DI void phase_attn(const Params& p, int l, LAS unsigned char* lds, int tid, int lane, int wave, int G, bf16* OUTP) {
    const bf16* CQ = (const bf16*)(p.ws + WS_P + 5 * PBUF); const bf16* CK = (const bf16*)(p.ws + WS_P + 6 * PBUF); const bf16* VT = (const bf16*)(p.ws + WS_P + 8 * PBUF);
    const float lam_init = 0.8f - 0.6f * expf(-0.3f * (float)l);
    const float* lq = p.in[I_LAMQK] + l * 256;
    const float lam = expf(wave_sum(lq[lane] * lq[64 + lane])) - expf(wave_sum(lq[128 + lane] * lq[192 + lane])) + lam_init;
    const float* sg = p.in[I_SUBLN] + l * 128;
    const int m = wave & 1, sub = wave >> 1, r = lane & 31, half = lane >> 5;
    constexpr int KROW = 144, VROW = 136, KBYTES = 64 * KROW  , VOFF = 2 * KBYTES  , STAGE = VOFF + 128 * KROW  ;
    const float cs = 0.125f * 1.44269504089f;
    for (int pi = blockIdx.x; pi < 512; pi += G) {
#pragma unroll 1
        for (int uu = 0; uu < 2; ++uu) {
            const int bh = pi >> 4, jp = pi & 15, qb = uu ? 31 - jp : jp, b = bh >> 2, h = bh & 3;
            const int tokq0 = b * SEQ + qb * 128, qrow = tokq0 + 32 * sub + r;
            bf16x8 Qf[4];
#pragma unroll
            for (int ks = 0; ks < 4; ++ks) Qf[ks] = *(const bf16x8*)(CQ + (size_t)qrow * 512 + h * 128 + m * 64 + 16 * ks + 8 * half);
            const int nt = 2 * qb + 2, my_last = 2 * qb + (sub >> 1);
            const bf16* kg[2]; const bf16* vg[2]; int kl[2], vl[2];
#pragma unroll
            for (int i = 0; i < 2; ++i) { const int idx = tid + 512 * i; const int key = idx >> 4, c16 = idx & 15;
                kg[i] = CK + (size_t)(b * SEQ + key) * 512 + h * 128 + c16 * 8; kl[i] = (c16 >> 3) * KBYTES + key * KROW + (c16 & 7) * 16;
                const int dv = idx >> 3, c8 = idx & 7;
                vg[i] = VT + (size_t)(h * 128 + dv) * TOK + b * SEQ + c8 * 8; vl[i] = VOFF + dv * VROW + c8 * 16; }
            u32x4 st[4];
            st[0] = *(const u32x4*)kg[0]; st[1] = *(const u32x4*)kg[1]; st[2] = *(const u32x4*)vg[0]; st[3] = *(const u32x4*)vg[1];
            *(LAS u32x4*)(lds + kl[0]) = st[0]; *(LAS u32x4*)(lds + kl[1]) = st[1]; *(LAS u32x2*)(lds + vl[0]) = (u32x2){st[2].x, st[2].y}; *(LAS u32x2*)(lds + vl[0] + 8) = (u32x2){st[2].z, st[2].w}; *(LAS u32x2*)(lds + vl[1]) = (u32x2){st[3].x, st[3].y}; *(LAS u32x2*)(lds + vl[1] + 8) = (u32x2){st[3].z, st[3].w};
            __syncthreads();
            f32x16 O[4];
#pragma unroll
            for (int i = 0; i < 4; ++i) O[i] = zero16();
            float m_run = -INFINITY, l_run = 0.f;
#pragma unroll 1
            for (int kt = 0; kt < nt; ++kt) {
                const bool more = (kt + 1 < nt);
                if (more) { const size_t ko = (size_t)(kt + 1) * 64 * 512, vo = (size_t)(kt + 1) * 64;
                    st[0] = *(const u32x4*)(kg[0] + ko); st[1] = *(const u32x4*)(kg[1] + ko); st[2] = *(const u32x4*)(vg[0] + vo); st[3] = *(const u32x4*)(vg[1] + vo); }
                const LAS unsigned char* buf = lds + (kt & 1) * STAGE;
                if (kt <= my_last) {
                    f32x16 S[2];
#pragma unroll
                    for (int u = 0; u < 2; ++u) { S[u] = zero16();
#pragma unroll
                        for (int ks = 0; ks < 4; ++ks) { const bf16x8 A = *(const LAS bf16x8*)(buf + m * KBYTES + (32 * u + r) * KROW + (16 * ks + 8 * half) * 2); S[u] = mfma32(A, Qf[ks], S[u]); } }
                    asm volatile("s_nop 15\n\ts_nop 7" : "+v"(S[0]), "+v"(S[1]));
                    float mx = -INFINITY;
#pragma unroll
                    for (int u = 0; u < 2; ++u)
#pragma unroll
                        for (int i = 0; i < 16; ++i) mx = fmaxf(mx, S[u][i]);
                    mx = fmaxf(mx, __shfl_xor(mx, 32));
                    const float m_new = fmaxf(m_run, mx * cs), alpha = __builtin_amdgcn_exp2f(m_run - m_new);
                    float ps = 0.f;
#pragma unroll
                    for (int u = 0; u < 2; ++u)
#pragma unroll
                        for (int i = 0; i < 16; ++i) { const float e = __builtin_amdgcn_exp2f(S[u][i] * cs - m_new); S[u][i] = e; ps += e; }
                    ps += __shfl_xor(ps, 32);
                    l_run = l_run * alpha + ps; m_run = m_new;
#pragma unroll
                    for (int d = 0; d < 4; ++d)
#pragma unroll
                        for (int i = 0; i < 16; ++i) O[d][i] *= alpha;
                    bf16x8 Pf[2][2];
#pragma unroll
                    for (int u = 0; u < 2; ++u)
#pragma unroll
                        for (int s = 0; s < 2; ++s) { u32x4 w; w.x = mk_pk2(S[u][8 * s + 0], S[u][8 * s + 1]); w.y = mk_pk2(S[u][8 * s + 2], S[u][8 * s + 3]); w.z = mk_pk2(S[u][8 * s + 4], S[u][8 * s + 5]); w.w = mk_pk2(S[u][8 * s + 6], S[u][8 * s + 7]);
                            Pf[u][s] = __builtin_bit_cast(bf16x8, w); }
#pragma unroll
                    for (int d = 0; d < 4; ++d)
#pragma unroll
                        for (int u = 0; u < 2; ++u)
#pragma unroll
                            for (int s = 0; s < 2; ++s) { const LAS unsigned char* va = buf + VOFF + (32 * d + r) * VROW + (32 * u + 16 * s + 4 * half) * 2;
                                const u32x2 lo = *(const LAS u32x2*)va, hi = *(const LAS u32x2*)(va + 16);
                                u32x4 w; w.x = lo.x; w.y = lo.y; w.z = hi.x; w.w = hi.y;
                                O[d] = mfma32(__builtin_bit_cast(bf16x8, w), Pf[u][s], O[d]); }
                }
                if (more) { LAS unsigned char* nb = lds + ((kt + 1) & 1) * STAGE;
                    *(LAS u32x4*)(nb + kl[0]) = st[0]; *(LAS u32x4*)(nb + kl[1]) = st[1]; *(LAS u32x2*)(nb + vl[0]) = (u32x2){st[2].x, st[2].y}; *(LAS u32x2*)(nb + vl[0] + 8) = (u32x2){st[2].z, st[2].w}; *(LAS u32x2*)(nb + vl[1]) = (u32x2){st[3].x, st[3].y}; *(LAS u32x2*)(nb + vl[1] + 8) = (u32x2){st[3].z, st[3].w}; }
                __syncthreads();
            }
            asm volatile("s_nop 15\n\ts_nop 7" : "+v"(O[0]), "+v"(O[1]), "+v"(O[2]), "+v"(O[3]));
            const float inv = 1.0f / l_run;
            LAS float* Cb = (LAS float*)lds;
            if (m == 1) { const float f = inv * lam;
#pragma unroll
                for (int d = 0; d < 4; ++d)
#pragma unroll
                    for (int i = 0; i < 16; ++i) Cb[(sub * 128 + 32 * d + crow(i, half)) * 33 + r] = O[d][i] * f; }
            __syncthreads();
            if (m == 0) { float ss = 0.f;
#pragma unroll
                for (int d = 0; d < 4; ++d)
#pragma unroll
                    for (int i = 0; i < 16; ++i) { const float o = O[d][i] * inv - Cb[(sub * 128 + 32 * d + crow(i, half)) * 33 + r]; O[d][i] = o; ss += o * o; }
                ss += __shfl_xor(ss, 32);
                const float rs = rsqrtf(ss * (1.0f / 128.0f) + 1e-5f) * (1.0f - lam_init);
#pragma unroll
                for (int d = 0; d < 4; ++d)
#pragma unroll
                    for (int ig = 0; ig < 4; ++ig) { const int dv0 = 32 * d + 8 * ig + 4 * half; const f32x4 gn = *(const f32x4*)(sg + dv0);
                        u32x2 w; w.x = mk_pk2(O[d][4 * ig + 0] * rs * gn[0], O[d][4 * ig + 1] * rs * gn[1]); w.y = mk_pk2(O[d][4 * ig + 2] * rs * gn[2], O[d][4 * ig + 3] * rs * gn[3]);
                        *(u32x2*)(OUTP + (size_t)qrow * 512 + h * 128 + dv0) = w; } }
            __syncthreads();
        }
    }
}

template <bool PRODUCER> DI void attn2_unit(const bf16* CQ, const bf16* CK, const bf16* VT, bf16* OUTP, const float* sg, float lam, float lam_init, LAS unsigned char* lds, int tid, int lane, int sub, int b, int h, int qb) {
    const int r = lane & 31, half = lane >> 5;
    constexpr int KROW = 144, VROW = 136, KB1 = 64 * KROW, KST = 2 * KB1  , VST = 128 * VROW  ;
    constexpr int OFF_K = 0, OFF_V = 2 * KST  , OFF_P = OFF_V + 2 * VST  , PST = 32768, OFF_A = OFF_P + 2 * PST  , AST = 1024, OFF_L = 139392;
    const float cs = 0.125f * 1.44269504089f;
            const int tokq0 = b * SEQ + qb * 128, qrow = tokq0 + 32 * sub + r;
            const int nt = 2 * qb + 2, my_last = 2 * qb + (sub >> 1);
            const bf16* kg[2]; const bf16* vg[2]; int kl[2], vl[2];
#pragma unroll
            for (int i = 0; i < 2; ++i) { const int idx = tid + 512 * i; const int key = idx >> 4, c16 = idx & 15;
                kg[i] = CK + (size_t)(b * SEQ + key) * 512 + h * 128 + c16 * 8; kl[i] = OFF_K + (c16 >> 3) * KB1 + key * KROW + (c16 & 7) * 16;
                const int dv = idx >> 3, c8 = idx & 7;
                vg[i] = VT + (size_t)(h * 128 + dv) * TOK + b * SEQ + c8 * 8; vl[i] = OFF_V + dv * VROW + c8 * 16; }
            bf16x8 Qf[2][4];
            f32x16 O[2][4];
            float m_run[2] = {-INFINITY, -INFINITY}, l_run[2] = {0.f, 0.f};
            if (PRODUCER) {
#pragma unroll
                for (int m = 0; m < 2; ++m)
#pragma unroll
                    for (int ks = 0; ks < 4; ++ks) Qf[m][ks] = *(const bf16x8*)(CQ + (size_t)qrow * 512 + h * 128 + m * 64 + 16 * ks + 8 * half);
            } else {
#pragma unroll
                for (int m = 0; m < 2; ++m)
#pragma unroll
                    for (int d = 0; d < 4; ++d) O[m][d] = zero16();
            }
            u32x4 sk[2], sv[2];
            sk[0] = *(const u32x4*)kg[0]; sk[1] = *(const u32x4*)kg[1];
            *(LAS u32x4*)(lds + kl[0]) = sk[0]; *(LAS u32x4*)(lds + kl[1]) = sk[1];
            __syncthreads();
#pragma unroll 1
            for (int i = 0; i <= nt; ++i) {
                const bool ldk = (i + 1 < nt), ldv = (i < nt);
                if (ldk) { const size_t ko = (size_t)(i + 1) * 64 * 512; sk[0] = *(const u32x4*)(kg[0] + ko); sk[1] = *(const u32x4*)(kg[1] + ko); }
                if (ldv) { const size_t vo = (size_t)i * 64; sv[0] = *(const u32x4*)(vg[0] + vo); sv[1] = *(const u32x4*)(vg[1] + vo); }
                if (PRODUCER) {
                    if (i < nt && i <= my_last) {
                        const LAS unsigned char* kb = lds + OFF_K + (i & 1) * KST;
                        LAS unsigned char* pb = lds + OFF_P + (i & 1) * PST + (sub * 2) * 4096 + lane * 16;
                        LAS float* ab = (LAS float*)(lds + OFF_A + (i & 1) * AST) + (sub * 2) * 32 + r;
#pragma unroll
                        for (int m = 0; m < 2; ++m) {
                            f32x16 S[2];
#pragma unroll
                            for (int u = 0; u < 2; ++u) { S[u] = zero16();
#pragma unroll
                                for (int ks = 0; ks < 4; ++ks) { const bf16x8 A = *(const LAS bf16x8*)(kb + m * KB1 + (32 * u + r) * KROW + (16 * ks + 8 * half) * 2); S[u] = mfma32(A, Qf[m][ks], S[u]); } }
                            asm volatile("s_nop 15\n\ts_nop 7" : "+v"(S[0]), "+v"(S[1]));
                            float mx = -INFINITY;
#pragma unroll
                            for (int u = 0; u < 2; ++u)
#pragma unroll
                                for (int k = 0; k < 16; ++k) mx = fmaxf(mx, S[u][k]);
                            mx = fmaxf(mx, __shfl_xor(mx, 32));
                            const float cand = mx * cs; const float m_new = (cand - m_run[m] > 8.0f) ? cand : m_run[m]; const float alpha = __builtin_amdgcn_exp2f(m_run[m] - m_new);
                            float ps = 0.f;
#pragma unroll
                            for (int u = 0; u < 2; ++u)
#pragma unroll
                                for (int k = 0; k < 16; ++k) { const float e = __builtin_amdgcn_exp2f(S[u][k] * cs - m_new); S[u][k] = e; ps += e; }
                            ps += __shfl_xor(ps, 32);
                            l_run[m] = l_run[m] * alpha + ps; m_run[m] = m_new;
                            if (half == 0) ab[m * 32] = alpha;
#pragma unroll
                            for (int u = 0; u < 2; ++u)
#pragma unroll
                                for (int s = 0; s < 2; ++s) { u32x4 w; w.x = mk_pk2(S[u][8 * s + 0], S[u][8 * s + 1]); w.y = mk_pk2(S[u][8 * s + 2], S[u][8 * s + 3]); w.z = mk_pk2(S[u][8 * s + 4], S[u][8 * s + 5]); w.w = mk_pk2(S[u][8 * s + 6], S[u][8 * s + 7]);
                                    *(LAS u32x4*)(pb + m * 4096 + (u * 2 + s) * 1024) = w; }
                        }
                    }
                } else {
                    const int j = i - 1;
                    if (j >= 0 && j <= my_last) {
                        const LAS unsigned char* vb = lds + OFF_V + (j & 1) * VST;
                        const LAS unsigned char* pb = lds + OFF_P + (j & 1) * PST + (sub * 2) * 4096 + lane * 16;
                        const LAS float* ab = (const LAS float*)(lds + OFF_A + (j & 1) * AST) + (sub * 2) * 32 + r;
                        const float a0 = ab[0], a1 = ab[32];
                        if (__builtin_amdgcn_ballot_w64(a0 != 1.0f || a1 != 1.0f) != 0ull) {
#pragma unroll
                        for (int d = 0; d < 4; ++d)
#pragma unroll
                            for (int k = 0; k < 16; ++k) { O[0][d][k] *= a0; O[1][d][k] *= a1; }
                        }
#pragma unroll
                        for (int q = 0; q < 4; ++q) { const bf16x8 P0 = *(const LAS bf16x8*)(pb + q * 1024), P1 = *(const LAS bf16x8*)(pb + 4096 + q * 1024);
#pragma unroll
                            for (int d = 0; d < 4; ++d) { const LAS unsigned char* va = vb + (32 * d + r) * VROW + (16 * q + 4 * half) * 2;
                                const u32x2 lo = *(const LAS u32x2*)va, hi = *(const LAS u32x2*)(va + 16);
                                u32x4 w; w.x = lo.x; w.y = lo.y; w.z = hi.x; w.w = hi.y; const bf16x8 Vf = __builtin_bit_cast(bf16x8, w);
                                O[0][d] = mfma32(Vf, P0, O[0][d]); O[1][d] = mfma32(Vf, P1, O[1][d]); } }
                    }
                }
                if (ldk) { LAS unsigned char* nb = lds + ((i + 1) & 1) * KST; *(LAS u32x4*)(nb + kl[0]) = sk[0]; *(LAS u32x4*)(nb + kl[1]) = sk[1]; }
                if (ldv) { LAS unsigned char* nb = lds + (i & 1) * VST;
                    *(LAS u32x2*)(nb + vl[0]) = (u32x2){sv[0].x, sv[0].y}; *(LAS u32x2*)(nb + vl[0] + 8) = (u32x2){sv[0].z, sv[0].w}; *(LAS u32x2*)(nb + vl[1]) = (u32x2){sv[1].x, sv[1].y}; *(LAS u32x2*)(nb + vl[1] + 8) = (u32x2){sv[1].z, sv[1].w}; }
                __syncthreads();
            }
            LAS float* Lb = (LAS float*)(lds + OFF_L) + (sub * 2) * 32 + r;
            if (PRODUCER && half == 0) { Lb[0] = l_run[0]; Lb[32] = l_run[1]; }
            __syncthreads();
            if (!PRODUCER) {
                asm volatile("s_nop 15\n\ts_nop 7" : "+v"(O[0][0]), "+v"(O[0][1]), "+v"(O[0][2]), "+v"(O[0][3]), "+v"(O[1][0]), "+v"(O[1][1]), "+v"(O[1][2]), "+v"(O[1][3]));
                const float inv0 = 1.0f / Lb[0], inv1 = lam / Lb[32];
                float ss = 0.f;
#pragma unroll
                for (int d = 0; d < 4; ++d)
#pragma unroll
                    for (int k = 0; k < 16; ++k) { const float o = O[0][d][k] * inv0 - O[1][d][k] * inv1; O[0][d][k] = o; ss += o * o; }
                ss += __shfl_xor(ss, 32);
                const float rs = rsqrtf(ss * (1.0f / 128.0f) + 1e-5f) * (1.0f - lam_init);
#pragma unroll
                for (int d = 0; d < 4; ++d)
#pragma unroll
                    for (int ig = 0; ig < 4; ++ig) { const int dv0 = 32 * d + 8 * ig + 4 * half; const f32x4 gn = *(const f32x4*)(sg + dv0);
                        u32x2 w; w.x = mk_pk2(O[0][d][4 * ig + 0] * rs * gn[0], O[0][d][4 * ig + 1] * rs * gn[1]); w.y = mk_pk2(O[0][d][4 * ig + 2] * rs * gn[2], O[0][d][4 * ig + 3] * rs * gn[3]);
                        *(u32x2*)(OUTP + (size_t)qrow * 512 + h * 128 + dv0) = w; }
            }
            __syncthreads();
}
DI void phase_attn2(const Params& p, int l, LAS unsigned char* lds, int tid, int lane, int wave, int G, bf16* OUTP) {
    const bf16* CQ = (const bf16*)(p.ws + WS_P + 5 * PBUF); const bf16* CK = (const bf16*)(p.ws + WS_P + 6 * PBUF); const bf16* VT = (const bf16*)(p.ws + WS_P + 8 * PBUF);
    const float lam_init = 0.8f - 0.6f * expf(-0.3f * (float)l);
    const float* lq = p.in[I_LAMQK] + l * 256;
    const float lam = expf(wave_sum(lq[lane] * lq[64 + lane])) - expf(wave_sum(lq[128 + lane] * lq[192 + lane])) + lam_init;
    const float* sg = p.in[I_SUBLN] + l * 128;
    const bool producer = wave < 4; const int sub = wave & 3;
    if (producer) __builtin_amdgcn_s_setprio(2);
    for (int pi0 = blockIdx.x; pi0 < 512; pi0 += G) {
        const int pi = (G == 256) ? (((int)blockIdx.x & 7) * 64 + (pi0 >> 8) * 32 + ((int)blockIdx.x >> 3)) : pi0;
#pragma unroll 1
        for (int uu = 0; uu < 2; ++uu) {
            const int bh = pi >> 4, jp = pi & 15, qb = uu ? 31 - jp : jp, b = bh >> 2, h = bh & 3;
            if (producer) attn2_unit<true>(CQ, CK, VT, OUTP, sg, lam, lam_init, lds, tid, lane, sub, b, h, qb);
            else attn2_unit<false>(CQ, CK, VT, OUTP, sg, lam, lam_init, lds, tid, lane, sub, b, h, qb);
        }
    }
    __builtin_amdgcn_s_setprio(0);
}

template <bool P2> DI void phase_ssm(const Params& p, int l, LAS unsigned char* lds, int lane, int wave, int G) {
    const bf16* DU = (const bf16*)(p.ws + WS_P + 7 * PBUF); bf16* YG = (bf16*)(p.ws + WS_YG); float* E = (float*)(p.ws + WS_E);
    const bf16* BB = (const bf16*)(p.ws + WS_BB) + (size_t)l * 32 * 128 * 16; const bf16* CM = (const bf16*)(p.ws + WS_CM) + (size_t)l * 32 * 16 * 128;
    const float* AP = (const float*)(p.ws + WS_AP) + (size_t)l * 32 * 64 * 8; const float* dsk = p.in[I_SSMD] + l * 512;
    const int r = lane & 31, half = lane >> 5, r16 = lane & 15, q4 = lane >> 4;
    constexpr int XRS = 272;
    LAS unsigned char* Xs = lds + wave * (64 * XRS);
    for (int sw = blockIdx.x * 8 + wave; sw < 2048; sw += G * 8) {
      const int g = (sw & 7) + 8 * ((sw >> 3) & 3), cb = (sw >> 5) & 7, b = sw >> 8;
      float sr0 = 0.f, si0 = 0.f, sr1 = 0.f, si1 = 0.f;
#pragma unroll 1
      for (int ci = 0; ci < 8; ++ci) {
        const int c = cb * 8 + ci, tok0 = b * SEQ + c * 64;
        const int ch = g * 16 + r16; float dk = 0.f; bf16x8 Cf[4]; float uu[4][4];
        if (P2) { dk = dsk[ch];
#pragma unroll
            for (int mt = 0; mt < 4; ++mt)
#pragma unroll
                for (int j = 0; j < 4; ++j) uu[mt][j] = bf2f(DU[(size_t)(tok0 + 16 * mt + 4 * q4 + j) * 512 + ch]); }
        f32x16 X[4][2];
        { bf16x8 Uf[2], Bf[4];
#pragma unroll
            for (int tt = 0; tt < 2; ++tt) { const int tau = 32 * ((r >> 2) & 1) + 16 * tt + (r & 3) + 4 * (r >> 3); Uf[tt] = *(const bf16x8*)(DU + (size_t)(tok0 + tau) * 512 + g * 16 + 8 * half); }
#pragma unroll
            for (int pt = 0; pt < 4; ++pt) Bf[pt] = *(const bf16x8*)(BB + ((size_t)g * 128 + 32 * pt + r) * 16 + 8 * half);
#pragma unroll
            for (int pt = 0; pt < 4; ++pt)
#pragma unroll
                for (int tt = 0; tt < 2; ++tt) X[pt][tt] = mfma32(Uf[tt], Bf[pt], zero16()); }
        asm volatile("s_nop 15\n\ts_nop 15" : "+v"(X[0][0]), "+v"(X[0][1]), "+v"(X[1][0]), "+v"(X[1][1]), "+v"(X[2][0]), "+v"(X[2][1]), "+v"(X[3][0]), "+v"(X[3][1]));
        float ar[2], ai[2], a32r[2], a32i[2], a64r[2], a64i[2];
#pragma unroll
        for (int s = 0; s < 2; ++s) { const float* ap = AP + ((size_t)g * 64 + 32 * s + r) * 8; const f32x4 v = *(const f32x4*)ap; ar[s] = v[0]; ai[s] = v[1]; a32r[s] = v[2]; a32i[s] = v[3]; a64r[s] = ap[4]; a64i[s] = ap[5]; }
        float xr[2] = {0.f, 0.f}, xi[2] = {0.f, 0.f};
        if (P2) {
            const float* e0 = E + (((size_t)(b * 32 + g) * 64) * 64 + r) * 2;
#pragma unroll 4
            for (int j = (ci == 0 ? 0 : c - 1); j < c; ++j) { const float2 ea = *(const float2*)(e0 + (size_t)j * 128), eb = *(const float2*)(e0 + (size_t)j * 128 + 64);
                const float t0 = a64r[0] * sr0 - a64i[0] * si0 + ea.x; si0 = a64r[0] * si0 + a64i[0] * sr0 + ea.y; sr0 = t0;
                const float t1 = a64r[1] * sr1 - a64i[1] * si1 + eb.x; si1 = a64r[1] * si1 + a64i[1] * sr1 + eb.y; sr1 = t1; }
            if (half == 0) { xr[0] = sr0; xi[0] = si0; xr[1] = sr1; xi[1] = si1; }
        }
#pragma unroll
        for (int s = 0; s < 2; ++s)
#pragma unroll
            for (int tt = 0; tt < 2; ++tt)
#pragma unroll
                for (int i = 0; i < 16; ++i) { const float nr = ar[s] * xr[s] - ai[s] * xi[s] + X[s][tt][i], ni = ar[s] * xi[s] + ai[s] * xr[s] + X[2 + s][tt][i]; X[s][tt][i] = nr; X[2 + s][tt][i] = ni; xr[s] = nr; xi[s] = ni; }
        float oxr[2], oxi[2];
#pragma unroll
        for (int s = 0; s < 2; ++s) { oxr[s] = __shfl_xor(xr[s], 32); oxi[s] = __shfl_xor(xi[s], 32); }
        if (!P2) {
            if (half == 1) {
#pragma unroll
                for (int s = 0; s < 2; ++s) { float2 e; e.x = xr[s] + a32r[s] * oxr[s] - a32i[s] * oxi[s]; e.y = xi[s] + a32r[s] * oxi[s] + a32i[s] * oxr[s];
                    *(float2*)(E + (((size_t)(b * 32 + g) * 64 + c) * 64 + 32 * s + r) * 2) = e; } }
        } else {
#pragma unroll
            for (int s = 0; s < 2; ++s) { float wr_ = half ? oxr[s] : 0.f, wi_ = half ? oxi[s] : 0.f;
#pragma unroll
                for (int tt = 0; tt < 2; ++tt)
#pragma unroll
                    for (int i = 0; i < 16; ++i) { const float t = ar[s] * wr_ - ai[s] * wi_; wi_ = ar[s] * wi_ + ai[s] * wr_; wr_ = t; X[s][tt][i] += wr_; X[2 + s][tt][i] += wi_; } }
#pragma unroll
            for (int pt = 0; pt < 4; ++pt)
#pragma unroll
                for (int tt = 0; tt < 2; ++tt)
#pragma unroll
                    for (int i = 0; i < 16; ++i) *(LAS unsigned short*)(Xs + (32 * half + 16 * tt + i) * XRS + (32 * pt + r) * 2) = f2bf(X[pt][tt][i]);
#pragma unroll
            for (int ks = 0; ks < 4; ++ks) Cf[ks] = *(const bf16x8*)(CM + ((size_t)g * 16 + r16) * 128 + 32 * ks + 8 * q4);
            LDS_WAIT();
#pragma unroll
            for (int mt = 0; mt < 4; ++mt) { f32x4 acc = {0.f, 0.f, 0.f, 0.f};
#pragma unroll
                for (int ks = 0; ks < 4; ++ks) { const bf16x8 A = *(const LAS bf16x8*)(Xs + (16 * mt + r16) * XRS + (32 * ks + 8 * q4) * 2); acc = mfma16(A, Cf[ks], acc); }
                asm volatile("s_nop 15" : "+v"(acc));
#pragma unroll
                for (int j = 0; j < 4; ++j) { const size_t o = (size_t)(tok0 + 16 * mt + 4 * q4 + j) * 512 + ch; const float y = acc[j] + dk * uu[mt][j]; YG[o] = f2bf(mk_gelu(y)); } }
            LDS_WAIT();
        }
      }
    }
}

DI void phase_ssm1(const Params& p, int l, int lane, int wave, int G) {
    const bf16* DU = (const bf16*)(p.ws + WS_P + 7 * PBUF); float* E = (float*)(p.ws + WS_E);
    const bf16* BB = (const bf16*)(p.ws + WS_BB) + (size_t)l * 32 * 128 * 16;
    const float* AP = (const float*)(p.ws + WS_AP) + (size_t)l * 32 * 64 * 8;
    const int r = lane & 31, half = lane >> 5;
    const int tau0 = 32 * ((r >> 2) & 1) + (r & 3) + 4 * (r >> 3);
    const int step = G * 8; int it = blockIdx.x * 8 + wave;
    bf16x8 Uf[2], Bf[4]; f32x4 apv[2];
#define SSM1_LOAD(IT) do { const int g_ = (IT) & 31, c_ = ((IT) >> 5) & 63, b_ = (IT) >> 11; const size_t t0_ = (size_t)(b_ * SEQ + c_ * 64 + tau0) * 512 + g_ * 16 + 8 * half; \
        Uf[0] = *(const bf16x8*)(DU + t0_); Uf[1] = *(const bf16x8*)(DU + t0_ + (size_t)16 * 512); \
        _Pragma("unroll") for (int pt = 0; pt < 4; ++pt) Bf[pt] = *(const bf16x8*)(BB + ((size_t)g_ * 128 + 32 * pt + r) * 16 + 8 * half); \
        _Pragma("unroll") for (int s = 0; s < 2; ++s) apv[s] = *(const f32x4*)(AP + ((size_t)g_ * 64 + 32 * s + r) * 8); } while (0)
    if (it < 16384) SSM1_LOAD(it);
    for (; it < 16384; it += step) {
        const int g = it & 31, c = (it >> 5) & 63, b = it >> 11;
        f32x16 X[4][2];
#pragma unroll
        for (int pt = 0; pt < 4; ++pt)
#pragma unroll
            for (int tt = 0; tt < 2; ++tt) X[pt][tt] = mfma32(Uf[tt], Bf[pt], zero16());
        float ar[2], ai[2], a32r[2], a32i[2];
#pragma unroll
        for (int s = 0; s < 2; ++s) { ar[s] = apv[s][0]; ai[s] = apv[s][1]; a32r[s] = apv[s][2]; a32i[s] = apv[s][3]; }
        asm volatile("s_nop 15\n\ts_nop 15" : "+v"(X[0][0]), "+v"(X[0][1]), "+v"(X[1][0]), "+v"(X[1][1]), "+v"(X[2][0]), "+v"(X[2][1]), "+v"(X[3][0]), "+v"(X[3][1]));
        if (it + step < 16384) SSM1_LOAD(it + step);
#pragma unroll
        for (int s = 0; s < 2; ++s) { float xr = 0.f, xi = 0.f;
#pragma unroll
            for (int tt = 0; tt < 2; ++tt)
#pragma unroll
                for (int k = 0; k < 16; ++k) { const float nr = ar[s] * xr - ai[s] * xi + X[s][tt][k], ni = ar[s] * xi + ai[s] * xr + X[2 + s][tt][k]; xr = nr; xi = ni; }
            const float oxr = __shfl_xor(xr, 32), oxi = __shfl_xor(xi, 32);
            if (half == 1) { float2 e; e.x = xr + a32r[s] * oxr - a32i[s] * oxi; e.y = xi + a32r[s] * oxi + a32i[s] * oxr;
                *(float2*)(E + (((size_t)(b * 32 + g) * 64 + c) * 64 + 32 * s + r) * 2) = e; } }
    }
#undef SSM1_LOAD
}

DI void phase_final(const Params& p, int tid, int G) {
    const pg8::rowss_t* rowss = (const pg8::rowss_t*)(p.ws + WS_ROWSS) + (size_t)4 * TOK; const float* gf = p.in[I_GFIN]; float* out = p.out; const bf16* xb = (const bf16*)(p.ws + WS_XB);
    for (size_t i = (size_t)blockIdx.x * NTHR + tid; i < (size_t)TOK * 128; i += (size_t)G * NTHR) { const int row = (int)(i >> 7), c8 = (int)(i & 127);
        const float rs = pg8::rstd_row(rowss, row); f32x4 v0, v1; pg8::unpack8(*((const u32x4*)xb + i), v0, v1);
        const f32x4 g0 = *((const f32x4*)gf + 2 * c8), g1 = *((const f32x4*)gf + 2 * c8 + 1);
        *((f32x4*)out + 2 * i) = v0 * rs * g0; *((f32x4*)out + 2 * i + 1) = v1 * rs * g1; }
}

#define XB_TMO      128
#define XB_XCNT(j)  (256  + 64 * (j))
#define XB_XSUB(j)  (1280 + 64 * (j))
#define XB_XGEN(j)  (2304 + 64 * (j))
#define XB_TOP      3328
#define XB_TOPGEN   3392
#define XCD_BAR_WORDS 3456
#define XB_SPIN_CAP (1u << 18)

__device__ __forceinline__ unsigned xb_ld(unsigned* p)              { return __hip_atomic_load(p, __ATOMIC_RELAXED, __HIP_MEMORY_SCOPE_AGENT); }
__device__ __forceinline__ unsigned xb_add(unsigned* p, unsigned v) { return __hip_atomic_fetch_add(p, v, __ATOMIC_RELAXED, __HIP_MEMORY_SCOPE_AGENT); }
__device__ __forceinline__ unsigned xb_xcc_id() { return (unsigned)__builtin_amdgcn_s_getreg((3 << 11) | 20) & 0xFu; }
#define XB_SPIN(cond, bar) do { unsigned _sp = 0; while (cond) { __builtin_amdgcn_s_sleep(1); \
    if ((++_sp & 255u) == 0u) { if (xb_ld(&(bar)[XB_TMO])) break; if (_sp > XB_SPIN_CAP) { atomicAdd(&(bar)[XB_TMO], 1u); break; } } } } while (0)

struct XcdBarrier {
    unsigned* bar; unsigned x;
    volatile LAS unsigned* st;
};

__device__ __forceinline__ XcdBarrier xcd_barrier_post(unsigned* bar, volatile LAS unsigned* st) {
    XcdBarrier b; b.bar = bar; b.x = xb_xcc_id(); b.st = st;
    if (threadIdx.x == 0) (void)xb_add(&bar[XB_XCNT(b.x)], 1u);
    return b;
}
__device__ __forceinline__ void xcd_barrier_complete(unsigned* bar, unsigned x, unsigned& nloc, unsigned& nx) {
    const unsigned G = gridDim.x * gridDim.y * gridDim.z;
    unsigned sum, cnt, mine, sp = 0u;
    for (;;) {
        sum = 0u; cnt = 0u; mine = 0u;
#pragma unroll
        for (unsigned j = 0; j < 16; ++j) { const unsigned c = xb_ld(&bar[XB_XCNT(j)]); sum += c; cnt += (c > 0u) ? 1u : 0u; mine = (j == x) ? c : mine; }
        if (sum == G) break;
        __builtin_amdgcn_s_sleep(1);
        if ((++sp & 255u) == 0u) { if (xb_ld(&bar[XB_TMO])) break; if (sp > XB_SPIN_CAP) { atomicAdd(&bar[XB_TMO], 1u); break; } }
    }
    nloc = mine > 0u ? mine : 1u; nx = cnt > 0u ? cnt : 1u;
}

__device__ __forceinline__ void xcd_barrier(const XcdBarrier& b) {
    asm volatile("s_waitcnt vmcnt(0)" ::: "memory");
    __syncthreads();
    if (threadIdx.x == 0) {
        unsigned* bar = b.bar;
        __builtin_amdgcn_s_waitcnt(0);
        unsigned nloc = b.st[0], nx = b.st[1];
        if (nloc == 0u) { xcd_barrier_complete(bar, b.x, nloc, nx); b.st[0] = nloc; b.st[1] = nx; }
        const unsigned old = xb_add(&bar[XB_XSUB(b.x)], 1u);
        const unsigned gen = old / nloc;
        if (old + 1u == (gen + 1u) * nloc) {
            __builtin_amdgcn_fence(__ATOMIC_RELEASE, "agent");
            asm volatile("s_waitcnt vmcnt(0)" ::: "memory");
            const unsigned og = xb_add(&bar[XB_TOP], 1u);
            const unsigned tg = og / nx;
            if (og + 1u == (tg + 1u) * nx) xb_add(&bar[XB_TOPGEN], 1u);
            else XB_SPIN(xb_ld(&bar[XB_TOPGEN]) == tg, bar);
            __builtin_amdgcn_fence(__ATOMIC_ACQUIRE, "agent");
            xb_add(&bar[XB_XGEN(b.x)], 1u);
            asm volatile("s_waitcnt vmcnt(0)" ::: "memory");
        } else {
            XB_SPIN(xb_ld(&bar[XB_XGEN(b.x)]) == gen, bar);
            __builtin_amdgcn_fence(__ATOMIC_ACQUIRE, "agent");
            asm volatile("s_waitcnt vmcnt(0)" ::: "memory");
        }
    }
    __syncthreads();
}


__global__ void __launch_bounds__(NTHR) mega(Params p) {
    extern __shared__ __attribute__((aligned(16))) unsigned char lds_raw[];
    LAS unsigned char* lds = (LAS unsigned char*)lds_raw;
    const int G = gridDim.x;
#define LAUNDER() int tid = threadIdx.x; asm volatile("" : "+v"(tid)); const int lane = tid & 63, wave = __builtin_amdgcn_readfirstlane(tid >> 6); (void)lane; (void)wave
    const int lo = p.ph_lo, hi = p.ph_hi;
    unsigned char* ws = p.ws;
    int ph = 0;
    volatile LAS unsigned* xb_st = (volatile LAS unsigned*)(lds + 139264);
    XcdBarrier xbar; xbar.bar = (unsigned*)(ws + WS_BAR); xbar.x = 0; xbar.st = xb_st;
    if (ONE_LAUNCH) { if (threadIdx.x < 4) xb_st[threadIdx.x] = 0u; __syncthreads(); xbar = xcd_barrier_post((unsigned*)(ws + WS_BAR), xb_st); }
#ifndef ONLY_KIND
#define ONLY_KIND -1
#endif
#define KEN(k) (ONLY_KIND < 0 || ONLY_KIND == (k))
#ifndef DUP
#define DUP 0
#endif
#define REP(bit) _Pragma("unroll 1") for (int rep_ = 0; rep_ < ((DUP & (bit)) ? 2 : 1); ++rep_)
#define IN_PH() (lo <= ph && ph < hi)
#define END_PH() do { if (ONE_LAUNCH && lo <= ph && ph + 1 < hi) { if (hi < 0) cg::this_grid().sync(); else xcd_barrier(xbar); } ++ph; } while (0)
    if (IN_PH() && KEN(0)) REP(128) { LAUNDER(); phase_prep(p, lds, tid, lane, wave, G); }
    END_PH();
    bf16* XB = (bf16*)(ws + WS_XB); pg8::rowss_t* rowss = (pg8::rowss_t*)(ws + WS_ROWSS);
    for (int l = 0; l < 2; ++l) {
        unsigned char* wl = ws + WS_W + (size_t)l * WL_SIZE;
        const bf16* WinT = (const bf16*)(wl + WL_IN);
        bf16* P0 = (bf16*)(ws + WS_P);
        const pg8::rowss_t* rs_mix = rowss + (size_t)(2 * l) * TOK; pg8::rowss_t* rs_ffn = rowss + (size_t)(2 * l + 1) * TOK; pg8::rowss_t* rs_next = rowss + (size_t)(2 * l + 2) * TOK;
        pg8::StaticOrder S;
        if (IN_PH()) REP(1) {
            if (KEN(1)) { pg8::Gemm g{XB, WinT, TOK, 4096, 1024}; S.init(TOK, 4096, G, (int)blockIdx.x); pg8::EpiProj E{P0, rs_mix}; pg8::gemm_phase<pg8::EpiProj, pg8::StaticOrder>(lds, g, S, E); }
            if (KEN(2)) { pg8::Gemm g{WinT + (size_t)4096 * 1024, XB, 512, TOK, 1024}; S.init(512, TOK, G, (int)blockIdx.x); pg8::EpiVT E{(bf16*)(ws + WS_P + 8 * PBUF), rs_mix}; pg8::gemm_phase<pg8::EpiVT, pg8::StaticOrder>(lds, g, S, E); }
        }
        END_PH();
        if (IN_PH()) { if (KEN(20)) REP(4) { LAUNDER(); phase_attn2(p, l, lds, tid, lane, wave, G, (DUP & 4) && rep_ == 0 ? (bf16*)(ws + WS_YG) : (bf16*)(ws + WS_P + 5 * PBUF)); } if (KEN(21)) { LAUNDER(); phase_branchB(p, l, lds, tid, lane, wave, G); } if (KEN(22)) REP(16) { LAUNDER(); phase_ssm1(p, l, lane, wave, G); } if (KEN(23)) { LAUNDER(); phase_branchA(p, l, tid, G); } }
        END_PH();
        if (IN_PH() && KEN(3)) REP(16) { LAUNDER(); phase_ssm<true>(p, l, lds, lane, wave, G); }
        END_PH();
        if (IN_PH() && KEN(4)) REP(64) { pg8::Gemm g{(const bf16*)(ws + WS_YG), (const bf16*)(wl + WL_GLU), TOK, 512, 512}; S.init(TOK, 512, G, (int)blockIdx.x);
            pg8::EpiGlu E{(const bf16*)(ws + WS_YG), (bf16*)(ws + WS_P + 7 * PBUF), p.in[I_BGLU] + l * 512}; pg8::gemm_phase<pg8::EpiGlu, pg8::StaticOrder>(lds, g, S, E); }
        END_PH();
        unsigned char* GS = (unsigned char*)(ws + WS_P + 1 * PBUF);   bf16* MG = (bf16*)(ws + WS_P + 8 * PBUF);
        if (IN_PH() && KEN(5)) REP(8) {
#pragma unroll 1
            for (int b = 0; b < 4; ++b) {
                { pg8::Gemm g{XB, WinT + (size_t)(4608 + 1024 * b) * 1024, TOK, 1024, 1024}; S.init(TOK, 1024, G, (int)blockIdx.x); pg8::EpiGate E{GS, rs_mix}; pg8::gemm_phase<pg8::EpiGate, pg8::StaticOrder>(lds, g, S, E); }
                const size_t yb = (b == 0) ? 0 : (b == 1) ? 3 : (b == 2) ? 5 : 7;
                pg8::Gemm g{(const bf16*)(ws + WS_P + yb * PBUF), (const bf16*)(wl + WL_BR) + (size_t)b * 1024 * 512, TOK, 1024, 512}; S.init(TOK, 1024, G, (int)blockIdx.x);
                if (b == 0) { pg8::EpiBr<true> E{GS, MG}; pg8::gemm_phase<pg8::EpiBr<true>, pg8::StaticOrder>(lds, g, S, E); }
                else { pg8::EpiBr<false> E{GS, MG}; pg8::gemm_phase<pg8::EpiBr<false>, pg8::StaticOrder>(lds, g, S, E); }
            }
        }
        END_PH();
        if (IN_PH() && KEN(6)) { pg8::Gemm g{MG, (const bf16*)(wl + WL_O), TOK, 1024, 1024}; S.init(TOK, 1024, G, (int)blockIdx.x);
            if (l == 0) { pg8::EpiResidT<true> E{p.in[I_X], XB, rs_ffn}; pg8::gemm_phase<pg8::EpiResidT<true>, pg8::StaticOrder>(lds, g, S, E); }
            else { pg8::EpiResidT<false> E{nullptr, XB, rs_ffn}; pg8::gemm_phase<pg8::EpiResidT<false>, pg8::StaticOrder>(lds, g, S, E); } }
        END_PH();
        bf16* H = (bf16*)(ws + WS_P);
        if (IN_PH() && KEN(7)) REP(2) { pg8::Gemm g{XB, (const bf16*)(wl + WL_FF), TOK, 5632, 1024}; S.init(TOK, 5632, G, (int)blockIdx.x);
            pg8::EpiFfnUp E{H, rs_ffn}; pg8::gemm_phase<pg8::EpiFfnUp, pg8::StaticOrder>(lds, g, S, E); }
        END_PH();
        if (IN_PH() && KEN(8)) { pg8::Gemm g{H, (const bf16*)(wl + WL_D), TOK, 1024, 2816}; S.init(TOK, 1024, G, (int)blockIdx.x);
            pg8::EpiResidT<false> E{nullptr, XB, rs_next}; pg8::gemm_phase<pg8::EpiResidT<false>, pg8::StaticOrder>(lds, g, S, E); }
        END_PH();
    }
    if (IN_PH() && KEN(9)) { LAUNDER(); phase_final(p, tid, G); }
}
constexpr int N_PHASES = 18;
}

extern "C" void kernel_launch(void* const* d_in, const int* in_sizes, int n_in, void* d_out, int out_size, void* d_ws, size_t ws_size, hipStream_t stream) {
    static int grid = 0;
    if (grid == 0) {
        if (n_in != 28 || out_size != mk::TOK * mk::DM || ws_size < mk::WS_END) { fprintf(stderr, "kernel_launch: unexpected shapes (n_in %d out %d ws %zu need %zu)\n", n_in, out_size, ws_size, (size_t)mk::WS_END); grid = -1; return; }
        int dev = 0, cus = 0, per_cu = 0;
        hipGetDevice(&dev); hipDeviceGetAttribute(&cus, hipDeviceAttributeMultiprocessorCount, dev);
        if (hipFuncSetAttribute((const void*)mk::mega, hipFuncAttributeMaxDynamicSharedMemorySize, mk::LDS_BYTES) != hipSuccess) { fprintf(stderr, "kernel_launch: hipFuncSetAttribute failed\n"); grid = -1; return; }
        if (hipOccupancyMaxActiveBlocksPerMultiprocessor(&per_cu, (const void*)mk::mega, mk::NTHR, mk::LDS_BYTES) != hipSuccess || per_cu < 1) { fprintf(stderr, "kernel_launch: occupancy query says %d\n", per_cu); per_cu = 1; }
        (void)hipGetLastError();
        grid = cus * 1;
        if (grid <= 0) grid = 256;
    }
    if (grid < 0) return;
    mk::Params p{};
    for (int i = 0; i < 28; ++i) p.in[i] = (const float*)d_in[i];
    p.out = (float*)d_out; p.ws = (unsigned char*)d_ws;
#if ONE_LAUNCH
    if (hipMemsetAsync((unsigned char*)d_ws + mk::WS_BAR, 0, XCD_BAR_WORDS * sizeof(unsigned), stream) != hipSuccess) { fprintf(stderr, "kernel_launch: memset failed\n"); return; }
    p.ph_lo = 0; p.ph_hi = mk::N_PHASES;
    void* args[] = {&p};
    hipError_t e = hipLaunchCooperativeKernel((const void*)mk::mega, dim3(grid), dim3(mk::NTHR), args, mk::LDS_BYTES, stream);
    if (e != hipSuccess) fprintf(stderr, "cooperative launch failed: %s (grid %d)\n", hipGetErrorString(e), grid);
#else
    for (int ph = 0; ph < mk::N_PHASES; ++ph) { p.ph_lo = ph; p.ph_hi = ph + 1;
        hipLaunchKernelGGL(mk::mega, dim3(grid), dim3(mk::NTHR), mk::LDS_BYTES, stream, p); }
#endif
}
```
